# Optimizing an MI355X kernel written in HIP

```python
import math
import jax, jax.numpy as jnp
from jax import lax
import numpy as np

D_MODEL = 2048
BATCH = 2
SEQ = 16384
DEPTH = 2

CTX_LEN = 256
GRID_W = 64
N_MIXERS = 4
GROUP_WIDTH = D_MODEL // N_MIXERS
HEAD_DIM = 128
NA_HEADS = GROUP_WIDTH // HEAD_DIM
NA_WIN_R = 8
NA_WIN_C = 16
DIFF_HEADS = GROUP_WIDTH // HEAD_DIM
DIFF_DIM = HEAD_DIM // 2
DIFF_Q_BLOCK = 128
RET_HEADS = GROUP_WIDTH // HEAD_DIM
RET_CHUNK = 128
SWA_Q_HEADS = GROUP_WIDTH // HEAD_DIM
SWA_KV_HEADS = SWA_Q_HEADS // 2
SWA_KV_WIDTH = SWA_KV_HEADS * HEAD_DIM
SWA_WINDOW = 128
SWA_BLOCK = 128
N_EXPERTS = 16
EXPERT_FF = D_MODEL // 2
EC_CAPACITY = 2
ROPE_BASE = 10000.0
NORM_EPS = 1e-6
GN_EPS = 1e-5
NEG_INF = -1e30
IN_SPLITS = (GROUP_WIDTH,) * 3 + (GROUP_WIDTH,) * 3 + (GROUP_WIDTH,) * 4 + (GROUP_WIDTH, SWA_KV_WIDTH, SWA_KV_WIDTH)
IN_WIDTH = sum(IN_SPLITS)
SPLIT_POINTS = tuple(int(v) for v in np.cumsum(IN_SPLITS)[:-1])

kernel_name = 'hybrid_diffusion_parallel_heads_ec_moe'


def rmsnorm(x, g):
    xf = x.astype(jnp.float32)
    y = xf * lax.rsqrt(jnp.mean(xf * xf, axis=-1, keepdims=True) + NORM_EPS)
    return (y * g.astype(jnp.float32)).astype(x.dtype)


def axial_rope_tables(n_tok, dim, dtype):
    t = jnp.arange(n_tok)
    row = (t // GRID_W).astype(jnp.float32)
    col = (t % GRID_W).astype(jnp.float32)
    nf = dim // 4
    inv = ROPE_BASE ** (-jnp.arange(nf, dtype=jnp.float32) / nf)
    ar = row[:, None, None] * inv
    ac = col[:, None, None] * inv
    return tuple(a.astype(dtype) for a in (jnp.cos(ar), jnp.sin(ar), jnp.cos(ac), jnp.sin(ac)))


def _rot_half(u, cos, sin):
    u1, u2 = jnp.split(u, 2, axis=-1)
    return jnp.concatenate([u1 * cos - u2 * sin, u2 * cos + u1 * sin], axis=-1)


def apply_axial_rope(x, tables):
    cos_r, sin_r, cos_c, sin_c = tables
    x_row, x_col = jnp.split(x, 2, axis=-1)
    return jnp.concatenate([_rot_half(x_row, cos_r, sin_r), _rot_half(x_col, cos_c, sin_c)], axis=-1)


def split_heads(t, n_heads):
    return t.reshape(t.shape[0], t.shape[1], n_heads, t.shape[-1] // n_heads)


def context_attention(q, k, v, sink=None):
    b, l, hq, d = q.shape
    hkv = k.shape[2]
    grp = hq // hkv
    qg = q.reshape(b, l, hkv, grp, d)
    s = jnp.einsum('bqkgd,bskd->bkgqs', qg, k).astype(jnp.float32) * (d ** -0.5)
    if sink is not None:
        s_sink = jnp.broadcast_to(sink.astype(jnp.float32).reshape(1, hkv, grp, 1, 1), s.shape[:-1] + (1,))
        p = jax.nn.softmax(jnp.concatenate([s, s_sink], axis=-1), axis=-1)[..., :-1]
    else:
        p = jax.nn.softmax(s, axis=-1)
    o = jnp.einsum('bkgqs,bskd->bqkgd', p.astype(v.dtype), v)
    return o.reshape(b, l, hq * d)


def neighbourhood_attention(q, k, v, kc, vc, rpb):
    b, n, h, d = q.shape
    rows = n // GRID_W
    kr = min(NA_WIN_R, rows)
    r = jnp.arange(rows)
    row_idx = jnp.clip(r - kr // 2, 0, rows - kr)[:, None] + jnp.arange(kr)[None, :]
    cols = jnp.arange(GRID_W)
    col_start = jnp.clip(cols - NA_WIN_C // 2, 0, GRID_W - NA_WIN_C)
    col_ok = (cols[None, :] >= col_start[:, None]) & (cols[None, :] < col_start[:, None] + NA_WIN_C)
    row_off = row_idx - r[:, None] + NA_WIN_R - 1
    col_off = jnp.clip(cols[None, :] - cols[:, None] + NA_WIN_C - 1, 0, 2 * NA_WIN_C - 2)
    bias = rpb.astype(jnp.float32)[:, row_off][:, :, :, col_off]
    bias = jnp.where(col_ok[None, None, None], bias, NEG_INF).transpose(0, 1, 3, 2, 4)
    qg = q.reshape(b, rows, GRID_W, h, d)
    kg = k.reshape(b, rows, GRID_W, h, d)[:, row_idx]
    vg = v.reshape(b, rows, GRID_W, h, d)[:, row_idx]
    scale = d ** -0.5
    s_loc = jnp.einsum('brqhd,brkchd->bhrqkc', qg, kg).astype(jnp.float32) * scale + bias[None]
    s_ctx = jnp.einsum('brqhd,blhd->bhrql', qg, kc).astype(jnp.float32) * scale
    nloc = kr * GRID_W
    logits = jnp.concatenate([s_loc.reshape(b, h, rows, GRID_W, nloc), s_ctx], axis=-1)
    p = jax.nn.softmax(logits, axis=-1).astype(v.dtype)
    p_loc = p[..., :nloc].reshape(b, h, rows, GRID_W, kr, GRID_W)
    o = jnp.einsum('bhrqkc,brkchd->brqhd', p_loc, vg) + jnp.einsum('bhrql,blhd->brqhd', p[..., nloc:], vc)
    return o.reshape(b, n, h * d)


def _diff_apply(q, k, v, lam):
    d = q.shape[-1]
    s = jnp.einsum('bqhmd,bshmd->bhmqs', q, k).astype(jnp.float32) * (d ** -0.5)
    p = jax.nn.softmax(s, axis=-1)
    w = p[:, :, 0] - lam * p[:, :, 1]
    return jnp.einsum('bhqs,bshe->bqhe', w.astype(v.dtype), v)


def _diff_post(o, g, lam_init):
    b, t, h, e = o.shape
    return (rmsnorm(o, g) * (1.0 - lam_init)).reshape(b, t, h * e)


def differential_attention(q, k, v, kc, vc, lam, lam_init, norm_g):
    b, n, h, _, d = q.shape
    k_all = jnp.concatenate([k, kc], axis=1)
    v_all = jnp.concatenate([v, vc], axis=1)
    nb = n // DIFF_Q_BLOCK
    q_blocks = jnp.swapaxes(q.reshape(b, nb, DIFF_Q_BLOCK, h, 2, d), 0, 1)
    o = lax.map(lambda qb: _diff_apply(qb, k_all, v_all, lam), q_blocks)
    o = jnp.swapaxes(o, 0, 1).reshape(b, n, h, 2 * d)
    return _diff_post(o, norm_g, lam_init)


def _retention_chunks(q, k, v, log_gamma, s0):
    b, t, h, d = q.shape
    nc = t // RET_CHUNK
    pos = jnp.arange(RET_CHUNK, dtype=jnp.float32)
    rel = pos[:, None] - pos[None, :]
    intra = jnp.where(rel >= 0, jnp.exp(jnp.maximum(rel, 0.0) * log_gamma[:, None, None]), 0.0)
    q_dec = jnp.exp((pos + 1.0) * log_gamma[:, None])[..., None]
    k_dec = jnp.exp((RET_CHUNK - 1.0 - pos) * log_gamma[:, None])[..., None]
    c_dec = jnp.exp(RET_CHUNK * log_gamma)[:, None, None]

    def to_chunks(a):
        return a.astype(jnp.float32).reshape(b, nc, RET_CHUNK, h, d).transpose(1, 0, 3, 2, 4)

    def step(s, qkv):
        qi, ki, vi = qkv
        a = jnp.einsum('bhnd,bhmd->bhnm', qi, ki) * intra
        o = jnp.einsum('bhnm,bhme->bhne', a, vi) + jnp.einsum('bhnd,bhde->bhne', qi * q_dec, s)
        s = c_dec * s + jnp.einsum('bhmd,bhme->bhde', ki * k_dec, vi)
        return s, o

    s_fin, o = lax.scan(step, s0, (to_chunks(q), to_chunks(k), to_chunks(v)))
    return o.transpose(1, 0, 3, 2, 4).reshape(b, t, h, d), s_fin


def _retention_post(o, gate, gn_g, gn_b):
    b, t, h, d = o.shape
    mu = jnp.mean(o, axis=-1, keepdims=True)
    var = jnp.mean(jnp.square(o - mu), axis=-1, keepdims=True)
    y = ((o - mu) * lax.rsqrt(var + GN_EPS)).reshape(b, t, h * d)
    y = y * gn_g.astype(jnp.float32) + gn_b.astype(jnp.float32)
    return (jax.nn.silu(gate.astype(jnp.float32)) * y).astype(gate.dtype)


def bidirectional_retention(q, k, v, gate, qc, kc, vc, decay_f, decay_b, gn_g, gn_b):
    b, _, h, d = q.shape
    lg_f = jax.nn.log_sigmoid(decay_f.astype(jnp.float32))
    lg_b = jax.nn.log_sigmoid(decay_b.astype(jnp.float32))
    s0 = jnp.zeros((b, h, d, d), jnp.float32)
    rev = lambda a: jnp.flip(a, axis=1)
    oc_f, s_f = _retention_chunks(qc, kc, vc, lg_f, s0)
    oc_b, s_b = _retention_chunks(rev(qc), rev(kc), rev(vc), lg_b, s0)
    o_f, _ = _retention_chunks(q, k, v, lg_f, s_f)
    o_b, _ = _retention_chunks(rev(q), rev(k), rev(v), lg_b, s_b)
    return (_retention_post(o_f + rev(o_b), gate, gn_g, gn_b), oc_f + rev(oc_b))


def window_gqa_sink(q, k, v, kc, vc, sink):
    b, n, hq, d = q.shape
    hkv = k.shape[2]
    grp = hq // hkv
    nb = n // SWA_BLOCK

    def band(a):
        ab = jnp.pad(a.reshape(b, nb, SWA_BLOCK, hkv, d), ((0, 0), (1, 1), (0, 0), (0, 0), (0, 0)))
        return jnp.concatenate([ab[:, :-2], ab[:, 1:-1], ab[:, 2:]], axis=2)

    kw, vw = band(k), band(v)
    qb = q.reshape(b, nb, SWA_BLOCK, hkv, grp, d)
    i = jnp.arange(SWA_BLOCK)[:, None]
    j = jnp.arange(3 * SWA_BLOCK)[None, :]
    kpos = (jnp.arange(nb)[:, None, None] - 1) * SWA_BLOCK + j[None]
    ok = (jnp.abs((j - SWA_BLOCK) - i)[None] <= SWA_WINDOW) & (kpos >= 0) & (kpos < n)
    scale = d ** -0.5
    s_loc = jnp.einsum('bnqkgd,bnskd->bnkgqs', qb, kw).astype(jnp.float32) * scale
    s_loc = jnp.where(ok[None, :, None, None], s_loc, NEG_INF)
    s_ctx = jnp.einsum('bnqkgd,blkd->bnkgql', qb, kc).astype(jnp.float32) * scale
    s_sink = jnp.broadcast_to(sink.astype(jnp.float32).reshape(1, 1, hkv, grp, 1, 1), s_ctx.shape[:-1] + (1,))
    nloc = 3 * SWA_BLOCK
    p = jax.nn.softmax(jnp.concatenate([s_loc, s_ctx, s_sink], axis=-1), axis=-1).astype(v.dtype)
    o = jnp.einsum('bnkgqs,bnskd->bnqkgd', p[..., :nloc], vw) + jnp.einsum('bnkgql,blkd->bnqkgd', p[..., nloc:-1], vc)
    return o.reshape(b, n, hq * d)


def expert_choice_ffn(h, w_router, w_gate, w_up, w_down):
    b, t, dm = h.shape
    cap = EC_CAPACITY * t // N_EXPERTS
    aff = jax.nn.softmax((h @ w_router).astype(jnp.float32), axis=-1)
    gate, idx = lax.top_k(jnp.swapaxes(aff, 1, 2), cap)
    xin = jax.vmap(lambda hb, ib: hb[ib])(h, idx)
    a = jnp.einsum('becd,edf->becf', xin, w_gate)
    u = jnp.einsum('becd,edf->becf', xin, w_up)
    y = jnp.einsum('becf,efd->becd', jax.nn.silu(a) * u, w_down) * gate[..., None].astype(h.dtype)
    return jax.vmap(lambda yb, ib: jnp.zeros((t, dm), yb.dtype).at[ib.reshape(-1)].add(yb.reshape(-1, dm)))(y, idx)


def hybrid_layer(x, xc, c, c_ctx, rope_d, rope_h, layer_idx, with_ctx,
                 w_mod, b_mod, norm1_g, w_in, na_rpb, diff_lambda, diff_norm_g,
                 ret_decay_fwd, ret_decay_bwd, ret_gn_g, ret_gn_b, swa_sink, w_out,
                 norm2_g, w_router, w_gate, w_up, w_down):
    b, n, _ = x.shape
    lc = xc.shape[1]
    mod = jax.nn.silu(c) @ w_mod + b_mod
    mod_c = jax.nn.silu(c_ctx) @ w_mod + b_mod
    sh1, sc1, g1, sh2, sc2, g2 = jnp.split(mod[:, None, :], 6, axis=-1)
    sh1c, sc1c, g1c, sh2c, sc2c, g2c = jnp.split(mod_c, 6, axis=-1)
    h = rmsnorm(x, norm1_g) * (1.0 + sc1) + sh1
    hc = rmsnorm(xc, norm1_g) * (1.0 + sc1c) + sh1c
    pl = jnp.split(h @ w_in, SPLIT_POINTS, axis=-1)
    pc = jnp.split(hc @ w_in, SPLIT_POINTS, axis=-1)

    qa, ka, va = [split_heads(t, NA_HEADS) for t in pl[0:3]]
    qac, kac, vac = [split_heads(t, NA_HEADS) for t in pc[0:3]]
    o_a = neighbourhood_attention(qa, ka, va, kac, vac, na_rpb)

    qb = apply_axial_rope(split_heads(pl[3], 2 * DIFF_HEADS), rope_d).reshape(b, n, DIFF_HEADS, 2, DIFF_DIM)
    kb = apply_axial_rope(split_heads(pl[4], 2 * DIFF_HEADS), rope_d).reshape(b, n, DIFF_HEADS, 2, DIFF_DIM)
    vb = split_heads(pl[5], DIFF_HEADS)
    qbc = pc[3].reshape(b, lc, DIFF_HEADS, 2, DIFF_DIM)
    kbc = pc[4].reshape(b, lc, DIFF_HEADS, 2, DIFF_DIM)
    vbc = split_heads(pc[5], DIFF_HEADS)
    lam_init = 0.8 - 0.6 * math.exp(-0.3 * layer_idx)
    lq1, lk1, lq2, lk2 = diff_lambda.astype(jnp.float32)
    lam = jnp.exp(jnp.sum(lq1 * lk1)) - jnp.exp(jnp.sum(lq2 * lk2)) + lam_init
    o_b = differential_attention(qb, kb, vb, kbc, vbc, lam, lam_init, diff_norm_g)

    ret_scale = HEAD_DIM ** -0.5
    q_ret = apply_axial_rope(split_heads(pl[6], RET_HEADS), rope_h)
    k_ret = apply_axial_rope(split_heads(pl[7], RET_HEADS), rope_h) * ret_scale
    v_ret = split_heads(pl[8], RET_HEADS)
    q_retc = split_heads(pc[6], RET_HEADS)
    k_retc = split_heads(pc[7], RET_HEADS) * ret_scale
    v_retc = split_heads(pc[8], RET_HEADS)
    o_c, ret_ctx = bidirectional_retention(q_ret, k_ret, v_ret, pl[9], q_retc, k_retc, v_retc,
                                           ret_decay_fwd, ret_decay_bwd, ret_gn_g, ret_gn_b)

    qd = apply_axial_rope(split_heads(pl[10], SWA_Q_HEADS), rope_h)
    kd = apply_axial_rope(split_heads(pl[11], SWA_KV_HEADS), rope_h)
    vd = split_heads(pl[12], SWA_KV_HEADS)
    qdc = split_heads(pc[10], SWA_Q_HEADS)
    kdc = split_heads(pc[11], SWA_KV_HEADS)
    vdc = split_heads(pc[12], SWA_KV_HEADS)
    o_d = window_gqa_sink(qd, kd, vd, kdc, vdc, swa_sink)

    x = x + g1 * (jnp.concatenate([o_a, o_b, o_c, o_d], axis=-1) @ w_out)
    h2 = rmsnorm(x, norm2_g) * (1.0 + sc2) + sh2
    x = x + g2 * expert_choice_ffn(h2, w_router, w_gate, w_up, w_down)

    if with_ctx:
        oc = jnp.concatenate([
            context_attention(qac, kac, vac),
            _diff_post(_diff_apply(qbc, kbc, vbc, lam), diff_norm_g, lam_init),
            _retention_post(ret_ctx, pc[9], ret_gn_g, ret_gn_b),
            context_attention(qdc, kdc, vdc, swa_sink)], axis=-1)
        xc = xc + g1c * (oc @ w_out)
        h2c = rmsnorm(xc, norm2_g) * (1.0 + sc2c) + sh2c
        xc = xc + g2c * expert_choice_ffn(h2c, w_router, w_gate, w_up, w_down)
    return x, xc


def setup_inputs(seed: int = 0) -> dict:
    key = jax.random.key(seed)
    ks = jax.random.split(key, 23)
    D = D_MODEL

    def nrm(k, shape, scale):
        return jax.random.normal(k, shape, jnp.float32) * scale

    ret_base = jnp.log(2.0 ** (5.0 + jnp.arange(RET_HEADS, dtype=jnp.float32)) - 1.0)
    return {
        'x': nrm(ks[0], (BATCH, SEQ, D), 1.0),
        'c': nrm(ks[1], (BATCH, D), 1.0),
        'ctx': nrm(ks[2], (BATCH, CTX_LEN, D), 1.0),
        'c_ctx': nrm(ks[3], (D,), 1.0),
        'w_mod': nrm(ks[4], (DEPTH, D, 6 * D), 0.5 * D ** -0.5),
        'b_mod': nrm(ks[5], (DEPTH, 6 * D), 0.02),
        'norm1_g': 1.0 + nrm(ks[6], (DEPTH, D), 0.05),
        'w_in': nrm(ks[7], (DEPTH, D, IN_WIDTH), D ** -0.5),
        'na_rpb': nrm(ks[8], (DEPTH, NA_HEADS, 2 * NA_WIN_R - 1, 2 * NA_WIN_C - 1), 0.1),
        'diff_lambda': nrm(ks[9], (DEPTH, 4, DIFF_DIM), 0.1),
        'diff_norm_g': 1.0 + nrm(ks[10], (DEPTH, 2 * DIFF_DIM), 0.05),
        'ret_decay_fwd': ret_base + nrm(ks[11], (DEPTH, RET_HEADS), 0.1),
        'ret_decay_bwd': ret_base + nrm(ks[12], (DEPTH, RET_HEADS), 0.1),
        'ret_gn_g': 1.0 + nrm(ks[13], (DEPTH, GROUP_WIDTH), 0.05),
        'ret_gn_b': nrm(ks[14], (DEPTH, GROUP_WIDTH), 0.02),
        'swa_sink': nrm(ks[15], (DEPTH, SWA_Q_HEADS), 0.5),
        'w_out': nrm(ks[16], (DEPTH, D, D), D ** -0.5),
        'norm2_g': 1.0 + nrm(ks[17], (DEPTH, D), 0.05),
        'w_router': nrm(ks[18], (DEPTH, D, N_EXPERTS), D ** -0.5),
        'w_gate': nrm(ks[19], (DEPTH, N_EXPERTS, D, EXPERT_FF), D ** -0.5),
        'w_up': nrm(ks[20], (DEPTH, N_EXPERTS, D, EXPERT_FF), D ** -0.5),
        'w_down': nrm(ks[21], (DEPTH, N_EXPERTS, EXPERT_FF, D), EXPERT_FF ** -0.5),
        'final_norm_g': 1.0 + nrm(ks[22], (D,), 0.05),
    }


def reference(x, c, ctx, c_ctx, w_mod, b_mod, norm1_g, w_in, na_rpb, diff_lambda, diff_norm_g,
              ret_decay_fwd, ret_decay_bwd, ret_gn_g, ret_gn_b, swa_sink, w_out, norm2_g,
              w_router, w_gate, w_up, w_down, final_norm_g):
    n = x.shape[1]
    rope_d = axial_rope_tables(n, DIFF_DIM, x.dtype)
    rope_h = axial_rope_tables(n, HEAD_DIM, x.dtype)
    xc = ctx
    for li in range(DEPTH):
        x, xc = hybrid_layer(x, xc, c, c_ctx, rope_d, rope_h, li, li < DEPTH - 1,
                             w_mod[li], b_mod[li], norm1_g[li], w_in[li], na_rpb[li], diff_lambda[li],
                             diff_norm_g[li], ret_decay_fwd[li], ret_decay_bwd[li], ret_gn_g[li], ret_gn_b[li],
                             swa_sink[li], w_out[li], norm2_g[li], w_router[li], w_gate[li], w_up[li], w_down[li])
    return rmsnorm(x, final_norm_g)
```

```cpp
#include <hip/hip_runtime.h>
#include <cstdio>
#include <cstdint>

#define LAS __attribute__((address_space(3)))
typedef unsigned short bf16_t;
typedef short bf16x8 __attribute__((ext_vector_type(8)));
typedef short s16x4 __attribute__((ext_vector_type(4)));
typedef float f32x4 __attribute__((ext_vector_type(4)));
typedef float f32x2 __attribute__((ext_vector_type(2)));
typedef float f32x16 __attribute__((ext_vector_type(16)));
typedef unsigned u32x4 __attribute__((ext_vector_type(4)));
typedef unsigned u32x2 __attribute__((ext_vector_type(2)));

constexpr int DM = 2048, NBATCH = 2, SEQ = 16384, LCTX = 256, DEPTH = 2;
constexpr int NLAT = NBATCH * SEQ;
constexpr int NCTX = NBATCH * LCTX;
constexpr int MTOT = NLAT + NCTX;
constexpr int INW = 6144;
constexpr int HD = 128;
constexpr int NE = 16, FF = 1024, CAP = 2048, CAPC = 32;
constexpr int MOE_ROWS = NBATCH * NE * CAP + NE * 256;
constexpr int NCH = 130;
constexpr int C_AQ = 0, C_AK = 512, C_AV = 1024, C_BQ = 1536, C_BK = 2048, C_BV = 2560, C_CQ = 3072, C_CK = 3584, C_CV = 4096, C_CG = 4608, C_DQ = 5120, C_DK = 5632, C_DV = 5888;
constexpr float LOG2E = 1.4426950408889634f;
constexpr float NEGBIG = -1e30f;

constexpr size_t al256(size_t x) { return (x + 255) / 256 * 256; }
constexpr size_t WS_CTL = 0;
constexpr size_t CTL_BYTES = 65536;
constexpr size_t WS_MODP = WS_CTL + CTL_BYTES;
constexpr size_t WS_MOD = WS_MODP + al256((size_t)16 * 2 * 3 * 12288 * 4);
constexpr size_t WS_MISC = WS_MOD + al256((size_t)2 * 3 * 12288 * 4);
constexpr size_t WS_ROPE = WS_MISC + 256;
constexpr size_t WS_XC = WS_ROPE + al256((size_t)(256 * 32 * 2 + 256 * 16 * 2) * 4);
constexpr size_t WS_AFF = WS_XC + al256((size_t)NCTX * DM * 4);
constexpr size_t WS_ROWIDX = WS_AFF + al256((size_t)MTOT * NE * 4);
constexpr size_t WS_GATEV = WS_ROWIDX + al256((size_t)MOE_ROWS * 4);
constexpr size_t WS_SLOT = WS_GATEV + al256((size_t)MOE_ROWS * 4);
constexpr size_t WS_H = WS_SLOT + al256((size_t)MTOT * NE * 4);
constexpr size_t H_BYTES = (size_t)MTOT * DM * 2;
constexpr size_t WS_P = WS_H + al256(H_BYTES);
constexpr size_t P_BYTES = (size_t)MTOT * INW * 2;
constexpr size_t WS_O = WS_P + al256(P_BYTES);
constexpr size_t WS_S = WS_O + al256(H_BYTES);
constexpr size_t S_BYTES = (size_t)2 * 8 * NCH * 16384 * 2;
constexpr size_t WS_W = WS_S + al256(S_BYTES);
constexpr size_t W_IN_B = (size_t)INW * DM * 2, W_OUT_B = (size_t)DM * DM * 2, W_GU_B = (size_t)NE * 2048 * DM * 2, W_DN_B = (size_t)NE * DM * FF * 2;
constexpr size_t WL_IN = 0, WL_OUT = WL_IN + W_IN_B, WL_GU = WL_OUT + W_OUT_B, WL_DN = WL_GU + W_GU_B, WL_BYTES = WL_DN + W_DN_B;
constexpr size_t WS_XB = WS_W + 2 * WL_BYTES;
constexpr size_t WS_END = WS_XB + al256((size_t)NLAT * DM * 2);
constexpr size_t ACT_OFF = 0;
constexpr size_t Y_OFF = al256((size_t)MOE_ROWS * FF * 2);
static_assert(Y_OFF + (size_t)MOE_ROWS * DM * 2 <= al256(P_BYTES) + H_BYTES, "Y must fit in P + O");
static_assert((size_t)2 * 8 * NCH * 16384 * 2 <= (size_t)NLAT * DM * 2, "retention U (bf16) must fit in the latent part of H");

__device__ __forceinline__ unsigned cvt_pk_bf16(float lo, float hi) { unsigned r; asm volatile("v_cvt_pk_bf16_f32 %0, %1, %2" : "=v"(r) : "v"(lo), "v"(hi)); return r; }
__device__ __forceinline__ bf16_t f2bf(float f) { return (bf16_t)(cvt_pk_bf16(f, 0.f) & 0xffffu); }
__device__ __forceinline__ float bf2f(bf16_t b) { return __uint_as_float(((unsigned)b) << 16); }
__device__ __forceinline__ float bflo(unsigned w) { return __uint_as_float(w << 16); }
__device__ __forceinline__ float bfhi(unsigned w) { return __uint_as_float(w & 0xffff0000u); }
__device__ __forceinline__ float siluf(float x) { return x / (1.0f + __expf(-x)); }
template <int M> __device__ __forceinline__ float xshf(float v) { return __int_as_float(__builtin_amdgcn_ds_swizzle(__float_as_int(v), (M << 10) | 0x1f)); }
__device__ __forceinline__ float sum32(float s) { s += xshf<1>(s); s += xshf<2>(s); s += xshf<4>(s); s += xshf<8>(s); s += xshf<16>(s); return s; }
__device__ __forceinline__ float sum64(float s) { s = sum32(s); auto rr = __builtin_amdgcn_permlane32_swap(__float_as_uint(s), __float_as_uint(s), false, false); return __uint_as_float(rr[0]) + __uint_as_float(rr[1]); }
__device__ __forceinline__ unsigned lane_up(unsigned v, int lane, int o) { return (unsigned)__builtin_amdgcn_ds_bpermute((lane - o) << 2, (int)v); }
__device__ __forceinline__ int crow(int r, int hi) { return (r & 3) + 8 * (r >> 2) + 4 * hi; }

#define XB_TMO      128
#define XB_XCNT(j)  (256  + 64 * (j))
#define XB_XSUB(j)  (1280 + 64 * (j))
#define XB_XGEN(j)  (2304 + 64 * (j))
#define XB_TOP      3328
#define XB_TOPGEN   3392
#define XCD_BAR_WORDS 3456
#define XB_SPIN_CAP (1u << 24)
__device__ __forceinline__ unsigned xb_ld(unsigned* p)              { return __hip_atomic_load(p, __ATOMIC_RELAXED, __HIP_MEMORY_SCOPE_AGENT); }
__device__ __forceinline__ unsigned xb_add(unsigned* p, unsigned v) { return __hip_atomic_fetch_add(p, v, __ATOMIC_RELAXED, __HIP_MEMORY_SCOPE_AGENT); }
__device__ __forceinline__ unsigned xb_xcc_id() { return (unsigned)__builtin_amdgcn_s_getreg((3 << 11) | 20) & 0xFu; }
#define XB_SPIN(cond, bar) do { unsigned _sp = 0; while (cond) { __builtin_amdgcn_s_sleep(1); \
    if ((++_sp & 255u) == 0u) { if (xb_ld(&(bar)[XB_TMO])) break; if (_sp > XB_SPIN_CAP) { atomicAdd(&(bar)[XB_TMO], 1u); break; } } } } while (0)
struct XcdBarrier { unsigned* bar; unsigned x; volatile LAS unsigned* st; };
__device__ __forceinline__ XcdBarrier xcd_barrier_post(unsigned* bar, volatile LAS unsigned* st, bool leader) {
    XcdBarrier b; b.bar = bar; b.x = xb_xcc_id(); b.st = st;
    if (leader) (void)xb_add(&bar[XB_XCNT(b.x)], 1u);
    return b;
}
__device__ __forceinline__ void xcd_barrier_complete(unsigned* bar, unsigned x, unsigned& nloc, unsigned& nx) {
    const unsigned G = gridDim.x * gridDim.y * gridDim.z;
    unsigned sum, cnt, mine, sp = 0u;
    for (;;) {
        sum = 0u; cnt = 0u; mine = 0u;
#pragma unroll
        for (unsigned j = 0; j < 16; ++j) { const unsigned c = xb_ld(&bar[XB_XCNT(j)]); sum += c; cnt += (c > 0u) ? 1u : 0u; mine = (j == x) ? c : mine; }
        if (sum == G) break;
        __builtin_amdgcn_s_sleep(1);
        if ((++sp & 255u) == 0u) { if (xb_ld(&bar[XB_TMO])) break; if (sp > XB_SPIN_CAP) { atomicAdd(&bar[XB_TMO], 1u); break; } }
    }
    nloc = mine > 0u ? mine : 1u; nx = cnt > 0u ? cnt : 1u;
}
__device__ __forceinline__ void xcd_barrier(const XcdBarrier& b, bool leader) {
    asm volatile("s_waitcnt vmcnt(0)" ::: "memory");
    __syncthreads();
    if (leader) {
        unsigned* bar = b.bar;
        __builtin_amdgcn_s_waitcnt(0);
        unsigned nloc = b.st[0], nx = b.st[1];
        if (nloc == 0u) { xcd_barrier_complete(bar, b.x, nloc, nx); b.st[0] = nloc; b.st[1] = nx; }
        const unsigned old = xb_add(&bar[XB_XSUB(b.x)], 1u);
        const unsigned gen = old / nloc;
        if (old + 1u == (gen + 1u) * nloc) {
            __builtin_amdgcn_fence(__ATOMIC_RELEASE, "agent");
            asm volatile("s_waitcnt vmcnt(0)" ::: "memory");
            const unsigned og = xb_add(&bar[XB_TOP], 1u);
            const unsigned tg = og / nx;
            if (og + 1u == (tg + 1u) * nx) xb_add(&bar[XB_TOPGEN], 1u);
            else XB_SPIN(xb_ld(&bar[XB_TOPGEN]) == tg, bar);
            __builtin_amdgcn_fence(__ATOMIC_ACQUIRE, "agent");
            xb_add(&bar[XB_XGEN(b.x)], 1u);
            asm volatile("s_waitcnt vmcnt(0)" ::: "memory");
        } else {
            XB_SPIN(xb_ld(&bar[XB_XGEN(b.x)]) == gen, bar);
            __builtin_amdgcn_fence(__ATOMIC_ACQUIRE, "agent");
            asm volatile("s_waitcnt vmcnt(0)" ::: "memory");
        }
    }
    __syncthreads();
}
namespace pg8 {
constexpr int BM = 256, BK = 64, HALF = 128, HTB = HALF * BK * 2, STAGE_BYTES = 8 * HTB, NXCD = 8, WGM = 8;
__host__ __device__ __forceinline__ int lds_byte(int r, int c) { const int st = (r >> 4) * 2 + (c >> 5), rr = r & 15, cc = c & 31, ob = rr * 64 + cc * 2; return st * 1024 + (ob ^ (((ob >> 9) & 1) << 5)); }
__host__ __device__ __forceinline__ void stage_rc(int b, int& R, int& C) { const int st = b / 1024, sb = b % 1024, swz = sb ^ (((sb >> 9) & 1) << 5); R = (st >> 1) * 16 + swz / 64; C = (st & 1) * 32 + (swz % 64) / 2; }
__host__ __device__ __forceinline__ int perm32(int rho) { const int n = rho >> 4, i = rho & 15; return 8 * (i >> 2) + 4 * n + (i & 3); }

struct Unit { int pm, pn; };
struct Gemm { const bf16_t* A; const bf16_t* Bt; int K; const int* rowidx; };

struct StaticOrder {
    int nM, nN, nwg, G, c;
    __device__ void init(int nM_, int nN_, int G_, int c_) { nM = nM_; nN = nN_; nwg = nM * nN; G = G_; c = c_; }
    __device__ bool next(int i, Unit& u) const {
        const long L = (long)i * G + c; if (L >= nwg) return false;
        int wgid = (int)L; { const int q = nwg / NXCD, r = nwg % NXCD, xcd = wgid % NXCD, off = wgid / NXCD; wgid = (xcd < r ? xcd * (q + 1) : r * (q + 1) + (xcd - r) * q) + off; }
        const int nig = WGM * nN, gid = wgid / nig, fm = gid * WGM, gsz = (nM - fm) < WGM ? (nM - fm) : WGM;
        u.pm = fm + ((wgid % nig) % gsz); u.pn = (wgid % nig) / gsz; return true;
    }
};
struct OffsetOrder : StaticOrder {
    int pm0;
    __device__ bool next(int i, Unit& u) const { if (!StaticOrder::next(i, u)) return false; u.pm += pm0; return true; }
};
__device__ __forceinline__ int moe_expert_of_tile(int pm) { return pm < 256 ? ((pm >> 3) & 15) : (pm - 256); }
struct MoeOrder : StaticOrder {
    __device__ bool next(int i, Unit& u) const { if (!StaticOrder::next(i, u)) return false; u.pn += moe_expert_of_tile(u.pm) * 8; return true; }
};

template <class Epi, class Sched, bool GATHER, bool NOEPI = false>
__device__ __forceinline__ void gemm_phase(LAS unsigned char* lds, const Gemm g, const Sched& S, const Epi& E, LAS int* idxl, const int tid) {
    const int wid = __builtin_amdgcn_readfirstlane(tid >> 6), lane = tid & 63, wr = wid >> 2, wc = wid & 3, fr = lane & 15, fq = lane >> 4;
    const int K = g.K, nt = K / BK;
    unsigned voffA[2], voffB[2]; int RA[2];
#pragma unroll
    for (int i = 0; i < 2; ++i) { int R, C; stage_rc(tid * 16 + i * 8192, R, C); const int Rb = Epi::PERM ? ((R & ~31) + perm32(R & 31)) : R;
        voffA[i] = (unsigned)(R * K + C) * 2u; voffB[i] = (unsigned)(Rb * K + C) * 2u; RA[i] = R; if (GATHER) voffA[i] = (unsigned)C * 2u; }
    const size_t kstep = (size_t)(BK * 2);
    const size_t hstep = (size_t)HALF * K * 2;
    const size_t tstep = 2 * hstep;
    const unsigned ldsw = (unsigned)wid * 1024u;
    const int aoff = lds_byte(wr * 64 + fr, fq * 8), boff = lds_byte(wc * 32 + fr, fq * 8);
#define PG8_SA(b, h) (((b) * 2 + (h)) * HTB)
#define PG8_SB(b, h) ((4 + (b) * 2 + (h)) * HTB)
#define PG8_STAGE(bufoff, gbase, voff) do { _Pragma("unroll") for (int _i = 0; _i < 2; ++_i) \
        __builtin_amdgcn_global_load_lds((const unsigned*)((const char*)(gbase) + (voff)[_i]), (LAS unsigned*)(lds + (bufoff) + ldsw + _i * 8192), 16, 0, 0); } while (0)
#define PG8_STAGE_A(bufoff, h, pA, offs) do { _Pragma("unroll") for (int _i = 0; _i < 2; ++_i) { const char* _p; \
        if constexpr (GATHER) _p = (const char*)(pA) + (offs)[h][_i]; else _p = (const char*)(pA) + (size_t)(h) * hstep + voffA[_i]; \
        __builtin_amdgcn_global_load_lds((const unsigned*)_p, (LAS unsigned*)(lds + (bufoff) + ldsw + _i * 8192), 16, 0, 0); } } while (0)
#define PG8_LDA(dst, b, h) do { _Pragma("unroll") for (int m = 0; m < 4; ++m) _Pragma("unroll") for (int k = 0; k < 2; ++k) dst[m][k] = *(const LAS bf16x8*)(lds + PG8_SA(b, h) + aoff + m * 2048 + k * 1024); } while (0)
#define PG8_LDB(dst, b, h) do { _Pragma("unroll") for (int n = 0; n < 2; ++n) _Pragma("unroll") for (int k = 0; k < 2; ++k) dst[n][k] = *(const LAS bf16x8*)(lds + PG8_SB(b, h) + boff + n * 2048 + k * 1024); } while (0)
#define PG8_MMA(ai, bj, At, Bt) do { __builtin_amdgcn_s_setprio(1); _Pragma("unroll") for (int m = 0; m < 4; ++m) _Pragma("unroll") for (int n = 0; n < 2; ++n) _Pragma("unroll") for (int k = 0; k < 2; ++k) \
        acc[ai][bj][m][n] = __builtin_amdgcn_mfma_f32_16x16x32_bf16(Bt[n][k], At[m][k], acc[ai][bj][m][n], 0, 0, 0); __builtin_amdgcn_s_setprio(0); } while (0)
#define PG8_WAIT_V(n) asm volatile("s_waitcnt vmcnt(" #n ")" ::: "memory")
#define PG8_WAIT_L(n) asm volatile("s_waitcnt lgkmcnt(" #n ")" ::: "memory")
#define PG8_BAR __builtin_amdgcn_s_barrier()
#define PG8_SCHED __builtin_amdgcn_sched_barrier(0)
    Unit cur, nxt; int ui = 0;
    if (!S.next(0, cur)) return;
    f32x4 acc[2][2][4][2];
#pragma unroll
    for (int a = 0; a < 2; ++a)
#pragma unroll
        for (int b = 0; b < 2; ++b)
#pragma unroll
            for (int m = 0; m < 4; ++m)
#pragma unroll
                for (int n = 0; n < 2; ++n) acc[a][b][m][n] = (f32x4){0.f, 0.f, 0.f, 0.f};
    bf16x8 At[4][2], B0[2][2], B1[2][2];
    unsigned oc[2][2] = {{0u, 0u}, {0u, 0u}}, on[2][2] = {{0u, 0u}, {0u, 0u}};
#define PG8_GOFF(dst, ui_) do { if constexpr (GATHER) { _Pragma("unroll") for (int _h = 0; _h < 2; ++_h) _Pragma("unroll") for (int _i = 0; _i < 2; ++_i) \
        dst[_h][_i] = (unsigned)idxl[(ui_) * BM + _h * HALF + RA[_i]] * (unsigned)(K * 2) + voffA[_i]; } } while (0)
    if constexpr (GATHER) {
        for (int i = 0; i < 16; ++i) { Unit uu; if (!S.next(i, uu)) break; if (tid < BM) idxl[i * BM + tid] = g.rowidx[uu.pm * BM + tid]; }
        __syncthreads();
    }
    PG8_GOFF(oc, 0);
    const char* cA = GATHER ? (const char*)g.A : (const char*)g.A + (size_t)cur.pm * tstep; const char* cB = (const char*)g.Bt + (size_t)cur.pn * tstep;
    PG8_STAGE(PG8_SB(0, 0), cB, voffB); PG8_STAGE(PG8_SB(0, 1), cB + hstep, voffB); PG8_STAGE_A(PG8_SA(0, 0), 0, cA, oc); PG8_STAGE_A(PG8_SA(0, 1), 1, cA, oc);
    if (wr == 1) PG8_BAR;
    PG8_WAIT_V(2); PG8_BAR;
    PG8_STAGE(PG8_SB(1, 0), cB + kstep, voffB); PG8_STAGE_A(PG8_SA(1, 0), 0, cA + kstep, oc); PG8_STAGE(PG8_SB(1, 1), cB + hstep + kstep, voffB);
    PG8_WAIT_V(6); PG8_BAR;
    for (;;) {
        const bool has_next = S.next(ui + 1, nxt);
        if (has_next) PG8_GOFF(on, ui + 1); else { if constexpr (GATHER) { on[0][0] = oc[0][0]; on[0][1] = oc[0][1]; on[1][0] = oc[1][0]; on[1][1] = oc[1][1]; } }
        const char* nA = GATHER ? (const char*)g.A : (has_next ? (const char*)g.A + (size_t)nxt.pm * tstep : cA);
        const char* nB = has_next ? (const char*)g.Bt + (size_t)nxt.pn * tstep : cB;
        for (int t = 0; t < nt; t += 2) {
            const bool last = (t == nt - 2);
            const char* a1 = cA + (size_t)(t + 1) * kstep;
            const char* a2 = last ? nA : cA + (size_t)(t + 2) * kstep; const char* b2 = last ? nB : cB + (size_t)(t + 2) * kstep;
            const char* a3 = a2 + kstep; const char* b3 = b2 + kstep;
            unsigned o2[2][2];
#pragma unroll
            for (int _h = 0; _h < 2; ++_h)
#pragma unroll
                for (int _i = 0; _i < 2; ++_i) o2[_h][_i] = last ? on[_h][_i] : oc[_h][_i];
            PG8_LDB(B0, 0, 0); PG8_LDB(B1, 0, 1); PG8_SCHED; PG8_LDA(At, 0, 0); PG8_STAGE_A(PG8_SA(1, 1), 1, a1, oc);
            PG8_WAIT_V(8); PG8_WAIT_L(0); PG8_BAR; PG8_MMA(0, 0, At, B0); PG8_MMA(0, 1, At, B1); PG8_BAR; PG8_SCHED;
            PG8_LDA(At, 0, 1); PG8_STAGE(PG8_SB(0, 0), b2, voffB); PG8_STAGE(PG8_SB(0, 1), b2 + hstep, voffB); PG8_STAGE_A(PG8_SA(0, 0), 0, a2, o2);
            PG8_WAIT_V(8); PG8_WAIT_L(0); PG8_BAR; PG8_MMA(1, 0, At, B0); PG8_MMA(1, 1, At, B1); PG8_BAR; PG8_SCHED;
            PG8_LDB(B0, 1, 0); PG8_LDB(B1, 1, 1); PG8_SCHED; PG8_LDA(At, 1, 0); PG8_STAGE_A(PG8_SA(0, 1), 1, a2, o2);
            PG8_WAIT_V(8); PG8_WAIT_L(0); PG8_BAR; PG8_MMA(0, 0, At, B0); PG8_MMA(0, 1, At, B1); PG8_BAR; PG8_SCHED;
            PG8_LDA(At, 1, 1); PG8_STAGE(PG8_SB(1, 0), b3, voffB); PG8_STAGE(PG8_SB(1, 1), b3 + hstep, voffB); PG8_STAGE_A(PG8_SA(1, 0), 0, a3, o2);
            PG8_WAIT_V(8); PG8_WAIT_L(0); PG8_BAR; PG8_MMA(1, 0, At, B0); PG8_MMA(1, 1, At, B1); PG8_BAR; PG8_SCHED;
        }
        if (wr == 0) PG8_BAR;
        if constexpr (!NOEPI) E(acc, cur, wr, wc, fr, fq); else { float d_ = 0.f; _Pragma("unroll") for (int a_ = 0; a_ < 2; ++a_) _Pragma("unroll") for (int b_ = 0; b_ < 2; ++b_) _Pragma("unroll") for (int m_ = 0; m_ < 4; ++m_) _Pragma("unroll") for (int n_ = 0; n_ < 2; ++n_) d_ += acc[a_][b_][m_][n_][0] + acc[a_][b_][m_][n_][3]; if (d_ == 1.2345e30f) ((float*)g.A)[0] = d_; }
#ifdef EXP_EPI2
        if constexpr (Epi::PERM && !GATHER && sizeof(Epi) == 16) { asm volatile("" ::: "memory"); E(acc, cur, wr, wc, fr, fq); }
#endif
        if (!has_next) break;
#pragma unroll
        for (int a = 0; a < 2; ++a)
#pragma unroll
            for (int b = 0; b < 2; ++b)
#pragma unroll
                for (int m = 0; m < 4; ++m)
#pragma unroll
                    for (int n = 0; n < 2; ++n) acc[a][b][m][n] = (f32x4){0.f, 0.f, 0.f, 0.f};
        cur = nxt; cA = nA; cB = nB; ++ui;
        if constexpr (GATHER) { oc[0][0] = on[0][0]; oc[0][1] = on[0][1]; oc[1][0] = on[1][0]; oc[1][1] = on[1][1]; }
        if (wr == 1) PG8_BAR;
    }
    PG8_WAIT_V(0);
    PG8_BAR;
#undef PG8_SA
#undef PG8_SB
#undef PG8_STAGE
#undef PG8_STAGE_A
#undef PG8_GOFF
#undef PG8_LDA
#undef PG8_LDB
#undef PG8_MMA
#undef PG8_WAIT_V
#undef PG8_WAIT_L
#undef PG8_BAR
#undef PG8_SCHED
}

__device__ __forceinline__ u32x4 pack8(const f32x4 a, const f32x4 b) { u32x4 w; w.x = cvt_pk_bf16(a[0], a[1]); w.y = cvt_pk_bf16(a[2], a[3]); w.z = cvt_pk_bf16(b[0], b[1]); w.w = cvt_pk_bf16(b[2], b[3]); return w; }

struct EpiInProj {
    static constexpr bool PERM = true;
    bf16_t* P; const float* rope;
    unsigned* kmax;
    __device__ __forceinline__ void operator()(const f32x4 (&acc)[2][2][4][2], const Unit& u, int wr, int wc, int fr, int fq) const {
        const int pn = u.pn; const bool lat = u.pm < (NLAT / 256);
        const int kind = (pn >= 6 && pn <= 9) ? 2 : (((pn >= 12 && pn <= 15) || (pn >= 20 && pn <= 22)) ? 1 : 0);
        const int row0 = u.pm * BM + wr * 64 + fr;
        if (kind == 0) {
            const int col0 = pn * 256 + wc * 32 + 8 * fq;
#pragma unroll
            for (int ai = 0; ai < 2; ++ai)
#pragma unroll
                for (int m = 0; m < 4; ++m) { bf16_t* rowp = P + (size_t)(row0 + ai * HALF + m * 16) * INW + col0;
#pragma unroll
                    for (int bj = 0; bj < 2; ++bj) *(u32x4*)(rowp + bj * HALF) = pack8(acc[ai][bj][m][0], acc[ai][bj][m][1]); }
        } else {
            const bool k1 = kind == 1; const int nf = k1 ? 32 : 16, pstep = k1 ? 32 : 16;
            const int cu1 = k1 ? pn * 256 + (wc >> 1) * 128 + (wc & 1) * 64 + 8 * fq : pn * 256 + wc * 64 + (fq >> 1) * 32 + 8 * (fq & 1);
            const int i0 = k1 ? 8 * fq : 8 * (fq & 1); const bool colp = k1 ? ((wc & 1) != 0) : ((fq >> 1) != 0);
            const float* TC = k1 ? rope : rope + 2 * 256 * 32; const float* TS = TC + 256 * nf;
            const int trow0 = ((u.pm * BM) & (SEQ - 1)) / 64 + wr;
            f32x4 nc0, nc1, ns0, ns1; float kq = 0.f;
#define RP_LOAD(g_) do { const int pos_ = colp ? (fr + 16 * ((g_) & 3)) : (trow0 + 2 * ((g_) >> 2)); const float* pc_ = TC + pos_ * nf + i0; const float* ps_ = TS + pos_ * nf + i0; \
                nc0 = *(const f32x4*)(pc_); nc1 = *(const f32x4*)(pc_ + 4); ns0 = *(const f32x4*)(ps_); ns1 = *(const f32x4*)(ps_ + 4); } while (0)
            if (lat) RP_LOAD(0);
#pragma unroll
            for (int gidx = 0; gidx < 8; ++gidx) { const int ai = gidx >> 2, m = gidx & 3; const int row = row0 + ai * HALF + m * 16;
                f32x4 a0 = acc[ai][0][m][0], a1 = acc[ai][0][m][1], b0 = acc[ai][1][m][0], b1 = acc[ai][1][m][1];
                if (lat) { const f32x4 c0 = nc0, c1 = nc1, s0 = ns0, s1 = ns1;
                    if (gidx < 7) RP_LOAD(gidx + 1);
                    const f32x4 x0 = a0 * c0 - b0 * s0, x1 = a1 * c1 - b1 * s1, y0 = b0 * c0 + a0 * s0, y1 = b1 * c1 + a1 * s1; a0 = x0; a1 = x1; b0 = y0; b1 = y1; }
                bf16_t* rowp = P + (size_t)row * INW + cu1;
                const u32x4 w0 = pack8(a0, a1), w1 = pack8(b0, b1); *(u32x4*)(rowp) = w0; *(u32x4*)(rowp + pstep) = w1;
                if (pn == 8 || pn == 9) {
                    float q2 = bflo(w0.x) * bflo(w0.x) + bfhi(w0.x) * bfhi(w0.x) + bflo(w0.y) * bflo(w0.y) + bfhi(w0.y) * bfhi(w0.y) + bflo(w0.z) * bflo(w0.z) + bfhi(w0.z) * bfhi(w0.z) + bflo(w0.w) * bflo(w0.w) + bfhi(w0.w) * bfhi(w0.w)
                             + bflo(w1.x) * bflo(w1.x) + bfhi(w1.x) * bfhi(w1.x) + bflo(w1.y) * bflo(w1.y) + bfhi(w1.y) * bfhi(w1.y) + bflo(w1.z) * bflo(w1.z) + bfhi(w1.z) * bfhi(w1.z) + bflo(w1.w) * bflo(w1.w) + bfhi(w1.w) * bfhi(w1.w);
                    q2 += xshf<16>(q2); { auto rr = __builtin_amdgcn_permlane32_swap(__float_as_uint(q2), __float_as_uint(q2), false, false); q2 = __uint_as_float(rr[0]) + __uint_as_float(rr[1]); }
                    kq = fmaxf(kq, q2); } }
            if (pn == 8 || pn == 9) {
                kq = fmaxf(kq, xshf<1>(kq)); kq = fmaxf(kq, xshf<2>(kq)); kq = fmaxf(kq, xshf<4>(kq)); kq = fmaxf(kq, xshf<8>(kq));
                if (fr == 0 && fq == 0) __hip_atomic_fetch_max(kmax + (lat ? (u.pm >> 6) : (u.pm - NLAT / 256)) * 8 + (pn - 8) * 4 + wc, __float_as_uint(kq), __ATOMIC_RELAXED, __HIP_MEMORY_SCOPE_AGENT); }
#undef RP_LOAD
        }
    }
};
struct EpiOutProj {
    static constexpr bool PERM = true;
    const float* xin_f32; const bf16_t* xin_bf; bf16_t* xout_bf; const float* xin_ctx; float* xout_ctx; const float* modl;
    __device__ __forceinline__ void operator()(const f32x4 (&acc)[2][2][4][2], const Unit& u, int wr, int wc, int fr, int fq) const {
        const bool lat = u.pm < (NLAT / 256); const int v = lat ? (u.pm >> 6) : 2;
        const float* g1 = modl + v * 12288 + 2 * DM;
        const int rloc = (lat ? u.pm : (u.pm - NLAT / 256)) * BM + wr * 64 + fr; const int col0 = u.pn * BM + wc * 32 + 8 * fq;
        f32x4 gv[2][2];
#pragma unroll
        for (int bj = 0; bj < 2; ++bj)
#pragma unroll
            for (int n = 0; n < 2; ++n) gv[bj][n] = *(const f32x4*)(g1 + col0 + bj * HALF + 4 * n);
        if (lat && xin_f32 == nullptr) {
#pragma unroll
            for (int ai = 0; ai < 2; ++ai) { u32x4 x[4][2];
#pragma unroll
                for (int m = 0; m < 4; ++m)
#pragma unroll
                    for (int bj = 0; bj < 2; ++bj) x[m][bj] = *(const u32x4*)(xin_bf + (size_t)(rloc + ai * HALF + m * 16) * DM + col0 + bj * HALF);
#pragma unroll
                for (int m = 0; m < 4; ++m)
#pragma unroll
                    for (int bj = 0; bj < 2; ++bj) { asm volatile("" : "+v"(x[m][bj])); const u32x4 w = x[m][bj];
                        const f32x4 x0 = (f32x4){bflo(w.x), bfhi(w.x), bflo(w.y), bfhi(w.y)}, x1 = (f32x4){bflo(w.z), bfhi(w.z), bflo(w.w), bfhi(w.w)};
                        *(u32x4*)(xout_bf + (size_t)(rloc + ai * HALF + m * 16) * DM + col0 + bj * HALF) = pack8(x0 + gv[bj][0] * acc[ai][bj][m][0], x1 + gv[bj][1] * acc[ai][bj][m][1]); }
            }
        } else {
            const float* xi = lat ? xin_f32 : xin_ctx;
#pragma unroll
            for (int ai = 0; ai < 2; ++ai) { f32x4 x[4][2][2];
#pragma unroll
                for (int m = 0; m < 4; ++m)
#pragma unroll
                    for (int bj = 0; bj < 2; ++bj)
#pragma unroll
                        for (int n = 0; n < 2; ++n) x[m][bj][n] = *(const f32x4*)(xi + (size_t)(rloc + ai * HALF + m * 16) * DM + col0 + bj * HALF + 4 * n);
#pragma unroll
                for (int m = 0; m < 4; ++m)
#pragma unroll
                    for (int bj = 0; bj < 2; ++bj) { asm volatile("" : "+v"(x[m][bj][0]), "+v"(x[m][bj][1]));
                        const f32x4 y0 = x[m][bj][0] + gv[bj][0] * acc[ai][bj][m][0], y1 = x[m][bj][1] + gv[bj][1] * acc[ai][bj][m][1]; const size_t off = (size_t)(rloc + ai * HALF + m * 16) * DM + col0 + bj * HALF;
                        if (lat) *(u32x4*)(xout_bf + off) = pack8(y0, y1); else { *(f32x4*)(xout_ctx + off) = y0; *(f32x4*)(xout_ctx + off + 4) = y1; } }
            }
        }
    }
};
struct EpiSwiGLU {
    static constexpr bool PERM = true;
    bf16_t* ACT;
    __device__ __forceinline__ void operator()(const f32x4 (&acc)[2][2][4][2], const Unit& u, int wr, int wc, int fr, int fq) const {
        const int pnl = u.pn & 7; const int row0 = u.pm * BM + wr * 64 + fr; const int col0 = pnl * 128 + wc * 32 + 8 * fq;
#pragma unroll
        for (int ai = 0; ai < 2; ++ai)
#pragma unroll
            for (int m = 0; m < 4; ++m) { f32x4 o[2];
#pragma unroll
                for (int n = 0; n < 2; ++n) { const f32x4 gt = acc[ai][0][m][n], up = acc[ai][1][m][n];
#pragma unroll
                    for (int j = 0; j < 4; ++j) o[n][j] = gt[j] * __builtin_amdgcn_rcpf(1.0f + __builtin_amdgcn_exp2f(-gt[j] * LOG2E)) * up[j]; }
                *(u32x4*)(ACT + (size_t)(row0 + ai * HALF + m * 16) * FF + col0) = pack8(o[0], o[1]); }
    }
};
struct EpiDown {
    static constexpr bool PERM = true;
    bf16_t* Y; const float* gatev;
    __device__ __forceinline__ void operator()(const f32x4 (&acc)[2][2][4][2], const Unit& u, int wr, int wc, int fr, int fq) const {
        const int pnl = u.pn & 7; const int row0 = u.pm * BM + wr * 64 + fr; const int col0 = pnl * 256 + wc * 32 + 8 * fq;
        float gs[2][4];
#pragma unroll
        for (int ai = 0; ai < 2; ++ai)
#pragma unroll
            for (int m = 0; m < 4; ++m) gs[ai][m] = gatev[row0 + ai * HALF + m * 16];
#pragma unroll
        for (int ai = 0; ai < 2; ++ai)
#pragma unroll
            for (int m = 0; m < 4; ++m) { asm volatile("" : "+v"(gs[ai][m]));
#pragma unroll
                for (int bj = 0; bj < 2; ++bj) *(u32x4*)(Y + (size_t)(row0 + ai * HALF + m * 16) * DM + col0 + bj * HALF) = pack8(acc[ai][bj][m][0] * gs[ai][m], acc[ai][bj][m][1] * gs[ai][m]); }
    }
};
}
namespace att {
constexpr int LDP = INW, LDOUT = DM, KVBLK = 64;
constexpr size_t SHM_V = KVBLK * 128 * 2, SHM_K = KVBLK * 128 * 2, SHM_ATTN = 2 * SHM_V + 2 * SHM_K + 8 * 64 * 4;
constexpr size_t QL_OFF = 73728, QL_STRIDE = 272;
constexpr size_t BIAS_OFF = SHM_ATTN;
constexpr float THR_L2 = 8.f * LOG2E;
#define KSWZ(row, colB) ((row) * 256 + ((colB) ^ (((row) & 7) << 4)))
#define SBAR() __builtin_amdgcn_sched_barrier(0)

struct Tiles { const bf16_t* kctx; const bf16_t* klat; long vdelta; int lat0, nt, nctx; };
struct MP {
    bool masked;
    int tq;
    int qr, rs, qc, cs;
    const LAS float* bias;
    float sink_l2;
    float lam, post;
    const float* normg;
};

__device__ __forceinline__ const bf16_t* tile_ptr(const Tiles& T, int j) { return (j < T.nctx) ? T.kctx + (long)j * KVBLK * LDP : T.klat + (long)(T.lat0 + j - T.nctx) * KVBLK * LDP; }

template <int MODE> __device__ __forceinline__ void apply_mask(f32x16& p0, f32x16& p1, int j, const Tiles& T, const MP& mp, int hi) {
  if constexpr (MODE == 1) return;
  if (!mp.masked || j < T.nctx) return;
  const int kt = T.lat0 + j - T.nctx;
  if constexpr (MODE == 2) {
    const int base = kt * KVBLK - mp.tq + 128;
#pragma unroll
    for (int r = 0; r < 16; ++r) { const int kk = crow(r, hi); if ((unsigned)(base + kk) > 256u) p0[r] = NEGBIG; if ((unsigned)(base + kk + 32) > 256u) p1[r] = NEGBIG; }
  }
  if constexpr (MODE == 0) {
    const bool rowok = (unsigned)(kt - mp.rs) < 8u; const LAS float* bp = mp.bias + ((kt - mp.qr + 7) * 31 + 15 - mp.qc + 4 * hi);
    const int t = rowok ? (4 * hi - mp.cs) : 0x40000000;
#pragma unroll
    for (int g = 0; g < 4; ++g) {
#pragma unroll
      for (int rr = 0; rr < 4; ++rr) { const int r = g * 4 + rr; const int c0 = (r & 3) + 8 * (r >> 2);
        const float b0 = bp[c0], b1 = bp[c0 + 32];
        p0[r] = ((unsigned)(t + c0) < 16u) ? p0[r] + b0 : NEGBIG; p1[r] = ((unsigned)(t + c0 + 32) < 16u) ? p1[r] + b1 : NEGBIG; }
      asm volatile("" ::: "memory");
    }
  }
}
template <int MODE> __device__ __forceinline__ void partialSM(f32x16& p0, f32x16& p1, float& m_reg, float& mn, float& alpha, int j, const Tiles& T, const MP& mp, int hi) {
  apply_mask<MODE>(p0, p1, j, T, mp, hi);
  float pmax = p0[0];
#pragma unroll
  for (int r = 1; r < 16; ++r) pmax = fmaxf(pmax, p0[r]);
#pragma unroll
  for (int r = 0; r < 16; ++r) pmax = fmaxf(pmax, p1[r]);
  { auto rr = __builtin_amdgcn_permlane32_swap(__float_as_uint(pmax), __float_as_uint(pmax), false, false);
    pmax = fmaxf(__uint_as_float(rr[0]), __uint_as_float(rr[1])); }
  if (__builtin_expect(__all(pmax - m_reg <= THR_L2), 1)) { mn = m_reg; alpha = 1.f; }
  else { mn = fmaxf(m_reg, pmax); alpha = __builtin_amdgcn_exp2f(m_reg - mn); m_reg = mn; }
#pragma unroll
  for (int r = 0; r < 16; ++r) p0[r] = p0[r] - mn;
#pragma unroll
  for (int r = 0; r < 16; ++r) p1[r] = p1[r] - mn;
#pragma unroll
  for (int r = 0; r < 16; ++r) p0[r] = __builtin_amdgcn_exp2f(p0[r]);
}
__device__ __forceinline__ void finishSM(f32x16& p0, f32x16& p1, float alpha, float& l_reg, bf16x8& pa0, bf16x8& pa1, bf16x8& pa2, bf16x8& pa3) {
#pragma unroll
  for (int r = 0; r < 16; ++r) p1[r] = __builtin_amdgcn_exp2f(p1[r]);
  float ps = 0;
#pragma unroll
  for (int r = 0; r < 16; ++r) ps += p0[r];
#pragma unroll
  for (int r = 0; r < 16; ++r) ps += p1[r];
  { auto rr = __builtin_amdgcn_permlane32_swap(__float_as_uint(ps), __float_as_uint(ps), false, false);
    ps = __uint_as_float(rr[0]) + __uint_as_float(rr[1]); }
  l_reg = l_reg * alpha + ps;
#define PK4(P, BASE, OUT) do { unsigned a0 = cvt_pk_bf16(P[BASE + 0], P[BASE + 1]), a1 = cvt_pk_bf16(P[BASE + 2], P[BASE + 3]);   \
    unsigned b0 = cvt_pk_bf16(P[BASE + 4], P[BASE + 5]), b1 = cvt_pk_bf16(P[BASE + 6], P[BASE + 7]);                              \
    auto r0 = __builtin_amdgcn_permlane32_swap(a0, b0, false, false); auto r1 = __builtin_amdgcn_permlane32_swap(a1, b1, false, false); \
    u32x4 w = {r0[0], r1[0], r0[1], r1[1]}; OUT = *reinterpret_cast<bf16x8*>(&w); } while (0)
  PK4(p0, 0, pa0); PK4(p0, 8, pa1); PK4(p1, 0, pa2); PK4(p1, 8, pa3);
#undef PK4
}
template <int NQ> __device__ __forceinline__ void qkt(f32x16& p0, f32x16& p1, const char* Ks, const bf16x8* qr, int r32, int hi, int cboff) {
  p0 = f32x16{}; p1 = f32x16{};
#pragma unroll
  for (int d0 = 0; d0 < NQ; ++d0) { const int cb = (d0 * 16 + hi * 8) * 2 + cboff;
    bf16x8 b0 = *reinterpret_cast<const bf16x8*>(Ks + KSWZ(r32, cb));
    bf16x8 b1 = *reinterpret_cast<const bf16x8*>(Ks + KSWZ(32 + r32, cb));
    p0 = __builtin_amdgcn_mfma_f32_32x32x16_bf16(b0, qr[d0], p0, 0, 0, 0);
    p1 = __builtin_amdgcn_mfma_f32_32x32x16_bf16(b1, qr[d0], p1, 0, 0, 0); }
}
__device__ __forceinline__ int v_st(int k, int c) { const int kk = (k & ~0xC) | ((k & 4) << 1) | ((k & 8) >> 1); return ((kk >> 3) * 4 + (c >> 5)) * 512 + ((kk & 7) * 32 + (c & 31)) * 2; }
__device__ __forceinline__ int v_rd_base(int lane) { return ((lane & 3) << 3) | (((lane >> 2) & 3) << 6) | (((lane >> 4) & 1) << 5) | (((lane >> 5) & 1) << 8); }
constexpr int v_rd_off(int d0, int ks, int half) { return d0 * 512 + ks * 4096 + half * 2048; }
template <int OFF> __device__ __forceinline__ s16x4 tr_read(int vb) {
  s16x4 r; asm volatile("ds_read_b64_tr_b16 %0, %1 offset:%2" : "=&v"(r) : "v"(vb), "i"(OFF) : "memory"); return r;
}
template <int D0> __device__ __forceinline__ void pv_one(f32x16& od, int vb, bf16x8 pa0, bf16x8 pa1, bf16x8 pa2, bf16x8 pa3) {
  const s16x4 l0 = tr_read<v_rd_off(D0, 0, 0)>(vb), h0 = tr_read<v_rd_off(D0, 0, 1)>(vb), l1 = tr_read<v_rd_off(D0, 1, 0)>(vb), h1 = tr_read<v_rd_off(D0, 1, 1)>(vb);
  const s16x4 l2 = tr_read<v_rd_off(D0, 2, 0)>(vb), h2 = tr_read<v_rd_off(D0, 2, 1)>(vb), l3 = tr_read<v_rd_off(D0, 3, 0)>(vb), h3 = tr_read<v_rd_off(D0, 3, 1)>(vb);
  asm volatile("s_waitcnt lgkmcnt(0)" ::: "memory"); SBAR();
#define PK(L, H) (bf16x8){L[0], L[1], L[2], L[3], H[0], H[1], H[2], H[3]}
  od = __builtin_amdgcn_mfma_f32_32x32x16_bf16(pa0, PK(l0, h0), od, 0, 0, 0);
  od = __builtin_amdgcn_mfma_f32_32x32x16_bf16(pa1, PK(l1, h1), od, 0, 0, 0);
  od = __builtin_amdgcn_mfma_f32_32x32x16_bf16(pa2, PK(l2, h2), od, 0, 0, 0);
  od = __builtin_amdgcn_mfma_f32_32x32x16_bf16(pa3, PK(l3, h3), od, 0, 0, 0);
#undef PK
}
__device__ __forceinline__ void pv_d0(f32x16* o, int vb, bf16x8 pa0, bf16x8 pa1, bf16x8 pa2, bf16x8 pa3) {
  pv_one<0>(o[0], vb, pa0, pa1, pa2, pa3); pv_one<1>(o[1], vb, pa0, pa1, pa2, pa3); pv_one<2>(o[2], vb, pa0, pa1, pa2, pa3); pv_one<3>(o[3], vb, pa0, pa1, pa2, pa3);
}

template <int MODE>
__device__ __forceinline__ void attn_unit_simple(const bf16_t* __restrict__ Qrow0, const Tiles T, bf16_t* __restrict__ Orow0, const MP mp, char* lds, const int tid) {
  const int wid = tid >> 6, lane = tid & 63, r32 = lane & 31, hi = lane >> 5;
  char* V_lds = lds; char* K_lds = lds + 2 * SHM_V;
  float* wsf = (float*)(lds + 2 * SHM_V + 2 * SHM_K) + wid * 64; float* li_l = wsf; float* al_l = wsf + 32;
  float m_reg = NEGBIG, l_reg = 0; f32x16 o[4] = {};
  const int sr = tid >> 4, sc = (tid & 15) * 8, vst0 = v_st(sr, sc), kst0 = KSWZ(sr, sc * 2);
  const int vb0 = (int)(uintptr_t)V_lds + v_rd_base(lane);
  const char* Qr = lds + QL_OFF + (wid * 32 + r32) * QL_STRIDE + hi * 16;
  bf16x8 vs0, vs1, ks0, ks1;
#define SLOAD1(j_) do { const bf16_t* kp_ = tile_ptr(T, (j_)) + (long)sr * LDP + sc; \
    vs0 = *reinterpret_cast<const bf16x8*>(kp_ + T.vdelta); vs1 = *reinterpret_cast<const bf16x8*>(kp_ + T.vdelta + 32L * LDP); \
    ks0 = *reinterpret_cast<const bf16x8*>(kp_); ks1 = *reinterpret_cast<const bf16x8*>(kp_ + 32L * LDP); } while (0)
#define SWRITE1(b) do { *(bf16x8*)(V_lds + (b) * SHM_V + vst0) = vs0; *(bf16x8*)(V_lds + (b) * SHM_V + vst0 + 8192) = vs1; \
    *(bf16x8*)(K_lds + (b) * SHM_K + kst0) = ks0; *(bf16x8*)(K_lds + (b) * SHM_K + kst0 + 8192) = ks1; } while (0)
  const int NT = T.nt;
  __syncthreads();
#pragma unroll
  for (int p = 0; p < 8; ++p) { const int idx = tid + 512 * p; *(bf16x8*)(lds + QL_OFF + (idx >> 4) * QL_STRIDE + (idx & 15) * 16) = *reinterpret_cast<const bf16x8*>(Qrow0 + (long)(idx >> 4) * LDP + (idx & 15) * 8); }
  SLOAD1(0); SWRITE1(0); __syncthreads();
  for (int j = 0; j < NT; ++j) {
    const int buf = j & 1;
    if (j + 1 < NT) SLOAD1(j + 1);
    bool live = true;
    if (mp.masked && j >= T.nctx) { const int kt = T.lat0 + j - T.nctx;
      if constexpr (MODE == 0) live = (unsigned)(kt - mp.rs) < 8u;
      if constexpr (MODE == 2) { const int q0w = __builtin_amdgcn_readfirstlane(mp.tq - r32); live = (kt * KVBLK + 63 >= q0w - 128) && (kt * KVBLK <= q0w + 31 + 128); } }
    if (live) {
    f32x16 p0, p1; float mn, al; bf16x8 pa0, pa1, pa2, pa3;
    { p0 = f32x16{}; p1 = f32x16{}; const char* Ks = K_lds + buf * SHM_K;
#pragma unroll
      for (int d0 = 0; d0 < 8; ++d0) { const int cb = (d0 * 16 + hi * 8) * 2; const bf16x8 q = *reinterpret_cast<const bf16x8*>(Qr + d0 * 32);
        const bf16x8 b0 = *reinterpret_cast<const bf16x8*>(Ks + KSWZ(r32, cb)), b1 = *reinterpret_cast<const bf16x8*>(Ks + KSWZ(32 + r32, cb));
        p0 = __builtin_amdgcn_mfma_f32_32x32x16_bf16(b0, q, p0, 0, 0, 0); p1 = __builtin_amdgcn_mfma_f32_32x32x16_bf16(b1, q, p1, 0, 0, 0); } }
    partialSM<MODE>(p0, p1, m_reg, mn, al, j, T, mp, hi);
    if (__any(al < 1.f)) { if (hi == 0) al_l[r32] = al; asm volatile("s_waitcnt lgkmcnt(0)" ::: "memory");
#pragma unroll
      for (int d = 0; d < 4; ++d)
#pragma unroll
        for (int r = 0; r < 16; ++r) o[d][r] *= al_l[crow(r, hi)]; }
    finishSM(p0, p1, al, l_reg, pa0, pa1, pa2, pa3);
    pv_d0(o, vb0 + buf * (int)SHM_V, pa0, pa1, pa2, pa3);
    }
    if (j + 1 < NT) SWRITE1(buf ^ 1);
    __syncthreads();
  }
  if constexpr (MODE == 2) l_reg += __builtin_amdgcn_exp2f(mp.sink_l2 - m_reg);
  if (hi == 0) li_l[r32] = l_reg; asm volatile("s_waitcnt lgkmcnt(0)" ::: "memory");
  bf16_t* Ow = Orow0 + (long)(wid * 32) * LDOUT;
#pragma unroll
  for (int r = 0; r < 16; ++r) { const int orow = crow(r, hi); const float rl = __builtin_amdgcn_rcpf(li_l[orow]);
#pragma unroll
    for (int d0 = 0; d0 < 4; ++d0) Ow[(long)orow * LDOUT + d0 * 32 + r32] = f2bf(o[d0][r] * rl); }
#undef SLOAD1
#undef SWRITE1
}
__device__ __forceinline__ void qktB(f32x16& p0, f32x16& p1, const char* Ks, const bf16x8* qr, int r32, int hi, int cboff, const f32x16& nb) {
  { const int cb = (hi * 8) * 2 + cboff;
    bf16x8 b0 = *reinterpret_cast<const bf16x8*>(Ks + KSWZ(r32, cb)), b1 = *reinterpret_cast<const bf16x8*>(Ks + KSWZ(32 + r32, cb));
    p0 = __builtin_amdgcn_mfma_f32_32x32x16_bf16(b0, qr[0], nb, 0, 0, 0); p1 = __builtin_amdgcn_mfma_f32_32x32x16_bf16(b1, qr[0], nb, 0, 0, 0); }
#pragma unroll
  for (int d0 = 1; d0 < 4; ++d0) { const int cb = (d0 * 16 + hi * 8) * 2 + cboff;
    bf16x8 b0 = *reinterpret_cast<const bf16x8*>(Ks + KSWZ(r32, cb)), b1 = *reinterpret_cast<const bf16x8*>(Ks + KSWZ(32 + r32, cb));
    p0 = __builtin_amdgcn_mfma_f32_32x32x16_bf16(b0, qr[d0], p0, 0, 0, 0); p1 = __builtin_amdgcn_mfma_f32_32x32x16_bf16(b1, qr[d0], p1, 0, 0, 0); }
}
__device__ __forceinline__ void expA(f32x16& p0) {
#pragma unroll
  for (int r = 0; r < 16; ++r) p0[r] = __builtin_amdgcn_exp2f(p0[r]);
}
__device__ __forceinline__ void finishB(f32x16& p0, f32x16& p1, float& l_reg, bf16x8& pa0, bf16x8& pa1, bf16x8& pa2, bf16x8& pa3) {
#pragma unroll
  for (int r = 0; r < 16; ++r) p1[r] = __builtin_amdgcn_exp2f(p1[r]);
  float ps = 0;
#pragma unroll
  for (int r = 0; r < 16; ++r) ps += p0[r];
#pragma unroll
  for (int r = 0; r < 16; ++r) ps += p1[r];
  l_reg += ps;
#define PK4(P, BASE, OUT) do { unsigned a0 = cvt_pk_bf16(P[BASE + 0], P[BASE + 1]), a1 = cvt_pk_bf16(P[BASE + 2], P[BASE + 3]);   \
    unsigned b0 = cvt_pk_bf16(P[BASE + 4], P[BASE + 5]), b1 = cvt_pk_bf16(P[BASE + 6], P[BASE + 7]);                              \
    auto r0 = __builtin_amdgcn_permlane32_swap(a0, b0, false, false); auto r1 = __builtin_amdgcn_permlane32_swap(a1, b1, false, false); \
    u32x4 w = {r0[0], r1[0], r0[1], r1[1]}; OUT = *reinterpret_cast<bf16x8*>(&w); } while (0)
  PK4(p0, 0, pa0); PK4(p0, 8, pa1); PK4(p1, 0, pa2); PK4(p1, 8, pa3);
#undef PK4
}

typedef short v4i16_t __attribute__((ext_vector_type(4)));
__device__ __forceinline__ s16x4 vtr(int addr) { return __builtin_bit_cast(s16x4, __builtin_amdgcn_ds_read_tr16_b64_v4i16((LAS v4i16_t*)(uintptr_t)(unsigned)addr)); }
template <int D0> __device__ __forceinline__ void pv_one_v(f32x16& od, int vb, bf16x8 pa0, bf16x8 pa1, bf16x8 pa2, bf16x8 pa3) {
  const s16x4 l0 = vtr(vb + v_rd_off(D0, 0, 0)), h0 = vtr(vb + v_rd_off(D0, 0, 1)), l1 = vtr(vb + v_rd_off(D0, 1, 0)), h1 = vtr(vb + v_rd_off(D0, 1, 1));
  const s16x4 l2 = vtr(vb + v_rd_off(D0, 2, 0)), h2 = vtr(vb + v_rd_off(D0, 2, 1)), l3 = vtr(vb + v_rd_off(D0, 3, 0)), h3 = vtr(vb + v_rd_off(D0, 3, 1));
#define PK(L, H) (bf16x8){L[0], L[1], L[2], L[3], H[0], H[1], H[2], H[3]}
  od = __builtin_amdgcn_mfma_f32_32x32x16_bf16(pa0, PK(l0, h0), od, 0, 0, 0);
  od = __builtin_amdgcn_mfma_f32_32x32x16_bf16(pa1, PK(l1, h1), od, 0, 0, 0);
  od = __builtin_amdgcn_mfma_f32_32x32x16_bf16(pa2, PK(l2, h2), od, 0, 0, 0);
  od = __builtin_amdgcn_mfma_f32_32x32x16_bf16(pa3, PK(l3, h3), od, 0, 0, 0);
#undef PK
}
__device__ __forceinline__ void pv_d0_v(f32x16* o, int vb, bf16x8 pa0, bf16x8 pa1, bf16x8 pa2, bf16x8 pa3) {
  pv_one_v<0>(o[0], vb, pa0, pa1, pa2, pa3); pv_one_v<1>(o[1], vb, pa0, pa1, pa2, pa3); pv_one_v<2>(o[2], vb, pa0, pa1, pa2, pa3); pv_one_v<3>(o[3], vb, pa0, pa1, pa2, pa3);
}
__device__ __forceinline__ void glds16(const void* g, unsigned lds_base) {
    unsigned sv; asm volatile("s_mov_b32 %0, m0\n\ts_mov_b32 m0, %2\n\ts_nop 0\n\tglobal_load_lds_dwordx4 %1, off\n\ts_mov_b32 m0, %0" : "=&s"(sv) : "v"(g), "s"(lds_base) : "memory"); }
__device__ __forceinline__ void glds16s(const void* gbase, unsigned voff, unsigned lds_base) {
    unsigned sv; asm volatile("s_mov_b32 %0, m0\n\ts_mov_b32 m0, %3\n\ts_nop 0\n\tglobal_load_lds_dwordx4 %1, %2\n\ts_mov_b32 m0, %0" : "=&s"(sv) : "v"(voff), "s"(gbase), "s"(lds_base) : "memory"); }
__device__ __forceinline__ int v_st_u(int k, int c) { return ((k >> 3) * 4 + (c >> 5)) * 512 + ((k & 7) * 32 + (c & 31)) * 2; }
__device__ __forceinline__ void attn_unit_a2(const bf16_t* __restrict__ Qrow0, const Tiles T, bf16_t* __restrict__ Orow0, const bool masked, const LAS float* bias, const int qr0, char* lds, const int tid) {
  const int wid = __builtin_amdgcn_readfirstlane(tid >> 6), lane = tid & 63, r32 = lane & 31, hi = lane >> 5;
  char* V_lds = lds; char* K_lds = lds + 2 * SHM_V;
  float* wsf = (float*)(lds + 2 * SHM_V + 2 * SHM_K) + wid * 64; float* li_l = wsf; float* al_l = wsf + 32;
  const int rp = wid >> 2, cbk = wid & 3;
  const int qloc = (2 * rp + (r32 >> 4)) * 64 + 16 * cbk + (r32 & 15);
  const int qr = qr0 + 2 * rp + (r32 >> 4), qc = 16 * cbk + (r32 & 15);
  const int rs = qr - 4 < 0 ? 0 : (qr - 4 > 248 ? 248 : qr - 4), cs = qc - 8 < 0 ? 0 : (qc - 8 > 48 ? 48 : qc - 8);
  const int kb = 16 * cbk - 8 < 0 ? 0 : (16 * cbk - 8 > 32 ? 32 : 16 * cbk - 8);
  const int rsa = (qr0 + 2 * rp - 4) < 0 ? 0 : ((qr0 + 2 * rp - 4) > 248 ? 248 : (qr0 + 2 * rp - 4)), rsb = (qr0 + 2 * rp - 3) < 0 ? 0 : ((qr0 + 2 * rp - 3) > 248 ? 248 : (qr0 + 2 * rp - 3));
  float m_reg = NEGBIG, l_reg = 0; f32x16 o[4] = {};
  const int sr = tid >> 4, sc = (tid & 15) * 8, vst0 = v_st_u(sr, sc), kst0 = KSWZ(sr, sc * 2);
  const int vb0 = (int)(uintptr_t)V_lds + v_rd_base(lane);
  const char* Qr = lds + QL_OFF + qloc * QL_STRIDE + hi * 16;
  bf16x8 vs0, vs1, ks0, ks1;
#define SLOAD1(j_) do { const bf16_t* kp_ = tile_ptr(T, (j_)) + (long)sr * LDP + sc; \
    vs0 = *reinterpret_cast<const bf16x8*>(kp_ + T.vdelta); vs1 = *reinterpret_cast<const bf16x8*>(kp_ + T.vdelta + 32L * LDP); \
    ks0 = *reinterpret_cast<const bf16x8*>(kp_); ks1 = *reinterpret_cast<const bf16x8*>(kp_ + 32L * LDP); } while (0)
#define SWRITE1(b) do { *(bf16x8*)(V_lds + (b) * SHM_V + vst0) = vs0; *(bf16x8*)(V_lds + (b) * SHM_V + vst0 + 8192) = vs1; \
    *(bf16x8*)(K_lds + (b) * SHM_K + kst0) = ks0; *(bf16x8*)(K_lds + (b) * SHM_K + kst0 + 8192) = ks1; } while (0)
  const int NT = T.nt;
  __syncthreads();
#pragma unroll
  for (int p = 0; p < 8; ++p) { const int idx = tid + 512 * p; *(bf16x8*)(lds + QL_OFF + (idx >> 4) * QL_STRIDE + (idx & 15) * 16) = *reinterpret_cast<const bf16x8*>(Qrow0 + (long)(idx >> 4) * LDP + (idx & 15) * 8); }
  SLOAD1(0); SWRITE1(0); __syncthreads();
  for (int j = 0; j < NT; ++j) {
    const int buf = j & 1;
    if (j + 1 < NT) SLOAD1(j + 1);
    const bool ctxt = j < T.nctx; const int kr = T.lat0 + j - T.nctx;
    const bool live = ctxt || !masked || ((unsigned)(kr - rsa) < 8u) || ((unsigned)(kr - rsb) < 8u);
    if (live) {
      const int nblk = (ctxt || !masked) ? 2 : 1;
      for (int blk = 0; blk < nblk; ++blk) {
        const int kbb = (ctxt || !masked) ? 32 * blk : kb;
        f32x16 p = {}; const char* Ks = K_lds + buf * SHM_K;
#pragma unroll
        for (int d0 = 0; d0 < 8; ++d0) { const int cb = (d0 * 16 + hi * 8) * 2; const bf16x8 q = *reinterpret_cast<const bf16x8*>(Qr + d0 * 32);
          const bf16x8 b0 = *reinterpret_cast<const bf16x8*>(Ks + KSWZ(kbb + r32, cb)); p = __builtin_amdgcn_mfma_f32_32x32x16_bf16(b0, q, p, 0, 0, 0); }
        if (masked && !ctxt) {
          const bool rowok = (unsigned)(kr - rs) < 8u; const LAS float* bp = bias + ((kr - qr + 7) * 31 + 15 - qc + kbb + 4 * hi);
          const int t = rowok ? (kbb + 4 * hi - cs) : 0x40000000;
#pragma unroll
          for (int r = 0; r < 16; ++r) { const int c0 = (r & 3) + 8 * (r >> 2); const float bv = bp[c0]; p[r] = ((unsigned)(t + c0) < 16u) ? p[r] + bv : NEGBIG; }
        }
        float pmax = p[0];
#pragma unroll
        for (int r = 1; r < 16; ++r) pmax = fmaxf(pmax, p[r]);
        { auto rr = __builtin_amdgcn_permlane32_swap(__float_as_uint(pmax), __float_as_uint(pmax), false, false); pmax = fmaxf(__uint_as_float(rr[0]), __uint_as_float(rr[1])); }
        float mn, al;
        if (__builtin_expect(__all(pmax - m_reg <= THR_L2), 1)) { mn = m_reg; al = 1.f; } else { mn = fmaxf(m_reg, pmax); al = __builtin_amdgcn_exp2f(m_reg - mn); m_reg = mn; }
        float ps = 0.f;
#pragma unroll
        for (int r = 0; r < 16; ++r) { p[r] = __builtin_amdgcn_exp2f(p[r] - mn); ps += p[r]; }
        { auto rr = __builtin_amdgcn_permlane32_swap(__float_as_uint(ps), __float_as_uint(ps), false, false); ps = __uint_as_float(rr[0]) + __uint_as_float(rr[1]); }
        l_reg = l_reg * al + ps;
        if (__any(al < 1.f)) { if (hi == 0) al_l[r32] = al; asm volatile("s_waitcnt lgkmcnt(0)" ::: "memory");
#pragma unroll
          for (int d = 0; d < 4; ++d)
#pragma unroll
            for (int r = 0; r < 16; ++r) o[d][r] *= al_l[crow(r, hi)]; }
        u32x4 w0 = {cvt_pk_bf16(p[0], p[1]), cvt_pk_bf16(p[2], p[3]), cvt_pk_bf16(p[4], p[5]), cvt_pk_bf16(p[6], p[7])}, w1 = {cvt_pk_bf16(p[8], p[9]), cvt_pk_bf16(p[10], p[11]), cvt_pk_bf16(p[12], p[13]), cvt_pk_bf16(p[14], p[15])};
        const bf16x8 pa0 = *reinterpret_cast<bf16x8*>(&w0), pa1 = *reinterpret_cast<bf16x8*>(&w1);
        const int vb = vb0 + buf * (int)SHM_V + (kbb >> 3) * 2048;
#pragma unroll
        for (int d0 = 0; d0 < 4; ++d0) { const s16x4 l0 = vtr(vb + d0 * 512), h0 = vtr(vb + d0 * 512 + 2048), l1 = vtr(vb + d0 * 512 + 4096), h1 = vtr(vb + d0 * 512 + 6144);
          o[d0] = __builtin_amdgcn_mfma_f32_32x32x16_bf16(pa0, (bf16x8){l0[0], l0[1], l0[2], l0[3], h0[0], h0[1], h0[2], h0[3]}, o[d0], 0, 0, 0);
          o[d0] = __builtin_amdgcn_mfma_f32_32x32x16_bf16(pa1, (bf16x8){l1[0], l1[1], l1[2], l1[3], h1[0], h1[1], h1[2], h1[3]}, o[d0], 0, 0, 0); }
      }
    }
    if (j + 1 < NT) SWRITE1(buf ^ 1);
    __syncthreads();
  }
  if (hi == 0) li_l[r32] = l_reg; asm volatile("s_waitcnt lgkmcnt(0)" ::: "memory");
#pragma unroll
  for (int r = 0; r < 16; ++r) { const int i = crow(r, hi); const float rl = __builtin_amdgcn_rcpf(li_l[i]);
    bf16_t* Ow = Orow0 + (long)((2 * rp + (i >> 4)) * 64 + 16 * cbk + (i & 15)) * LDOUT;
#pragma unroll
    for (int d0 = 0; d0 < 4; ++d0) Ow[d0 * 32 + r32] = f2bf(o[d0][r] * rl); }
#undef SLOAD1
#undef SWRITE1
}

#define B3_MF(a, b, c) __builtin_amdgcn_mfma_f32_32x32x16_bf16(a, b, c, 0, 0, 0)
#define B3_PIN(x) asm volatile("" : "+v"(x))
#define B3_WAITBAR(N) asm volatile("s_waitcnt vmcnt(" #N ") lgkmcnt(0)\n\ts_barrier" ::: "memory")
struct TilesB3 { const bf16_t* kctx; const bf16_t* klat; long vdelta; int nt; };
__device__ __forceinline__ void attn_unit_b3(const bf16_t* __restrict__ Qrow0, const TilesB3 T, bf16_t* __restrict__ Orow0, const MP mp, const unsigned* __restrict__ kmax2, char* lds, const int tid) {
  const int wid = __builtin_amdgcn_readfirstlane(tid >> 6), lane = tid & 63, r32 = lane & 31, hi = lane >> 5;
  constexpr int KRING = 0, VRING = 65536, WSF = 131072, SLOT = 16384;
  float* li_l = (float*)(lds + WSF) + wid * 64;
  float l_reg = 0; f32x16 o[4] = {}; bf16x8 qr[4];
  const int qrow = (wid & 3) * 32 + r32, map = wid >> 2, mapoff = map * 64;
  const bf16_t* Qw = Qrow0 + (long)qrow * LDP + mapoff + hi * 8;
#pragma unroll
  for (int d0 = 0; d0 < 4; ++d0) qr[d0] = *reinterpret_cast<const bf16x8*>(Qw + d0 * 16);
  f32x16 nb;
  { float q2 = 0.f;
#pragma unroll
    for (int d0 = 0; d0 < 4; ++d0) { const u32x4 w = *reinterpret_cast<const u32x4*>(&qr[d0]);
      q2 += bflo(w.x) * bflo(w.x) + bfhi(w.x) * bfhi(w.x) + bflo(w.y) * bflo(w.y) + bfhi(w.y) * bfhi(w.y) + bflo(w.z) * bflo(w.z) + bfhi(w.z) * bfhi(w.z) + bflo(w.w) * bflo(w.w) + bfhi(w.w) * bfhi(w.w); }
    { auto rr = __builtin_amdgcn_permlane32_swap(__float_as_uint(q2), __float_as_uint(q2), false, false); q2 = __uint_as_float(rr[0]) + __uint_as_float(rr[1]); }
    const float negb = -sqrtf(q2 * __uint_as_float(kmax2[map])) * 1.0001f;
#pragma unroll
    for (int r = 0; r < 16; ++r) nb[r] = negb; }
  B3_PIN(nb);
  const int rowk = 4 * wid + (lane >> 4); const unsigned koff = (unsigned)(rowk * LDP + (((lane & 15) ^ (rowk & 7)) * 8)) * 2u;
  const int sub0 = 2 * wid + (lane >> 5), key0 = (sub0 >> 2) * 8 + ((lane & 31) >> 2);
  const unsigned voff = (unsigned)(key0 * LDP + (sub0 & 3) * 32 + (lane & 3) * 8) * 2u + (unsigned)(T.vdelta * 2);
  const unsigned lds0 = (unsigned)(uintptr_t)lds; const unsigned kdst = lds0 + KRING + (unsigned)wid * 1024u, vdst = lds0 + VRING + (unsigned)wid * 1024u;
#define B3_TPTR(j_) ((const char*)(((j_) < 4) ? T.kctx + (long)(j_) * 64 * LDP : T.klat + (long)((j_) - 4) * 64 * LDP))
#define B3_DMAK(j_, sl_) do { const char* sp_ = B3_TPTR(j_); glds16s(sp_, koff, (unsigned)__builtin_amdgcn_readfirstlane(kdst + (sl_))); glds16s(sp_ + (size_t)32 * LDP * 2, koff, (unsigned)__builtin_amdgcn_readfirstlane(kdst + (sl_) + 8192)); } while (0)
#define B3_DMAV(j_, sl_) do { const char* sp_ = B3_TPTR(j_); glds16s(sp_, voff, (unsigned)__builtin_amdgcn_readfirstlane(vdst + (sl_))); glds16s(sp_ + (size_t)32 * LDP * 2, voff, (unsigned)__builtin_amdgcn_readfirstlane(vdst + (sl_) + 8192)); } while (0)
  int kro[4];
#pragma unroll
  for (int d0 = 0; d0 < 4; ++d0) kro[d0] = r32 * 256 + (((d0 * 16 + hi * 8) * 2 + mapoff * 2) ^ ((r32 & 7) << 4));
  const LAS char* kring = (const LAS char*)(uintptr_t)(lds0 + KRING);
  const int vbase = (int)lds0 + VRING + v_rd_base(lane);
#define B3_KF(kp_, n_, d0_) (*(const LAS bf16x8*)((kp_) + kro[d0_] + (n_) * 8192))
#define B3_VF(dst_, vp_, g_) do { const s16x4 lo_ = vtr((vp_) + v_rd_off((g_) & 3, (g_) >> 2, 0)), hi_ = vtr((vp_) + v_rd_off((g_) & 3, (g_) >> 2, 1)); dst_ = (bf16x8){lo_[0], lo_[1], lo_[2], lo_[3], hi_[0], hi_[1], hi_[2], hi_[3]}; } while (0)
  const int NT = T.nt;
#define B3_SL(j_) (((j_) & 3) * SLOT)
  f32x16 pA0, pA1, pB0, pB1; bf16x8 pa0, pa1, pa2, pa3;
  __syncthreads();
  B3_DMAK(0, B3_SL(0)); B3_DMAV(0, B3_SL(0)); B3_DMAK(1, B3_SL(1)); B3_DMAK(2, B3_SL(2)); B3_DMAV(1, B3_SL(1));
  B3_WAITBAR(8);
  { const LAS char* kp = kring + B3_SL(0); bf16x8 kf[8];
#pragma unroll
    for (int d0 = 0; d0 < 4; ++d0) { kf[2 * d0] = B3_KF(kp, 0, d0); kf[2 * d0 + 1] = B3_KF(kp, 1, d0); }
    pA0 = B3_MF(kf[0], qr[0], nb); pA1 = B3_MF(kf[1], qr[0], nb); pA0 = B3_MF(kf[2], qr[1], pA0); pA1 = B3_MF(kf[3], qr[1], pA1);
    pA0 = B3_MF(kf[4], qr[2], pA0); pA1 = B3_MF(kf[5], qr[2], pA1); pA0 = B3_MF(kf[6], qr[3], pA0); pA1 = B3_MF(kf[7], qr[3], pA1);
#pragma unroll
    for (int r = 0; r < 16; ++r) { pA0[r] = __builtin_amdgcn_exp2f(pA0[r]); pA1[r] = __builtin_amdgcn_exp2f(pA1[r]); l_reg += pA0[r] + pA1[r]; } }
  B3_WAITBAR(0);
#define B3_GA(MFS, P, i_, CA, CB) do { MFS; CA = cvt_pk_bf16(P[i_], P[(i_) + 1]); CB = cvt_pk_bf16(P[(i_) + 2], P[(i_) + 3]); } while (0)
#define B3_SW(OUT, c0_, c1_, c2_, c3_) do { u32x4 w_ = {c0_, c1_, c2_, c3_}; OUT = *reinterpret_cast<bf16x8*>(&w_); B3_PIN(OUT); } while (0)
#define B3_GB(MFS, X, i_) do { MFS; X[i_] = __builtin_amdgcn_exp2f(X[i_]); X[(i_) + 1] = __builtin_amdgcn_exp2f(X[(i_) + 1]); sacc += X[i_]; sacc += X[(i_) + 1]; B3_PIN(X); B3_PIN(sacc); SBAR(); } while (0)
#define B3_STEP(C0, C1, P0, P1, t_) do { SBAR(); \
    const LAS char* kp_ = kring + B3_SL(t_); const int vp_ = vbase + B3_SL((t_) - 1); bf16x8 kf[8], vf[8]; unsigned c0_, c1_, c2_, c3_; float sacc = 0.f; \
    _Pragma("unroll") for (int d0 = 0; d0 < 4; ++d0) { kf[2 * d0] = B3_KF(kp_, 0, d0); kf[2 * d0 + 1] = B3_KF(kp_, 1, d0); } SBAR(); \
    B3_GA(C0 = B3_MF(kf[0], qr[0], nb), P0, 0, c0_, c1_); SBAR(); \
    B3_GA(C1 = B3_MF(kf[1], qr[0], nb), P0, 4, c2_, c3_); B3_SW(pa0, c0_, c1_, c2_, c3_); SBAR(); \
    B3_GA(C0 = B3_MF(kf[2], qr[1], C0), P0, 8, c0_, c1_); SBAR(); \
    B3_GA(C1 = B3_MF(kf[3], qr[1], C1), P0, 12, c2_, c3_); B3_SW(pa1, c0_, c1_, c2_, c3_); SBAR(); \
    B3_VF(vf[0], vp_, 0); B3_GA(C0 = B3_MF(kf[4], qr[2], C0), P1, 0, c0_, c1_); SBAR(); \
    B3_VF(vf[1], vp_, 1); B3_GA(C1 = B3_MF(kf[5], qr[2], C1), P1, 4, c2_, c3_); B3_SW(pa2, c0_, c1_, c2_, c3_); SBAR(); \
    B3_VF(vf[2], vp_, 2); B3_GA(C0 = B3_MF(kf[6], qr[3], C0), P1, 8, c0_, c1_); SBAR(); \
    B3_VF(vf[3], vp_, 3); B3_GA(C1 = B3_MF(kf[7], qr[3], C1), P1, 12, c2_, c3_); B3_SW(pa3, c0_, c1_, c2_, c3_); SBAR(); \
    B3_VF(vf[4], vp_, 4);  B3_GB(o[0] = B3_MF(pa0, vf[0], o[0]), C0, 0); \
    B3_VF(vf[5], vp_, 5);  B3_GB(o[1] = B3_MF(pa0, vf[1], o[1]), C0, 2); \
    B3_VF(vf[6], vp_, 6);  B3_GB(o[2] = B3_MF(pa0, vf[2], o[2]), C0, 4); \
    B3_VF(vf[7], vp_, 7);  B3_GB(o[3] = B3_MF(pa0, vf[3], o[3]), C0, 6); \
    B3_VF(vf[0], vp_, 8);  B3_GB(o[0] = B3_MF(pa1, vf[4], o[0]), C0, 8); \
    B3_VF(vf[1], vp_, 9);  B3_GB(o[1] = B3_MF(pa1, vf[5], o[1]), C0, 10); \
    B3_VF(vf[2], vp_, 10); B3_GB(o[2] = B3_MF(pa1, vf[6], o[2]), C0, 12); \
    B3_VF(vf[3], vp_, 11); B3_GB(o[3] = B3_MF(pa1, vf[7], o[3]), C0, 14); \
    B3_VF(vf[4], vp_, 12); B3_GB(o[0] = B3_MF(pa2, vf[0], o[0]), C1, 0); \
    B3_VF(vf[5], vp_, 13); B3_GB(o[1] = B3_MF(pa2, vf[1], o[1]), C1, 2); \
    B3_VF(vf[6], vp_, 14); B3_GB(o[2] = B3_MF(pa2, vf[2], o[2]), C1, 4); \
    B3_VF(vf[7], vp_, 15); B3_GB(o[3] = B3_MF(pa2, vf[3], o[3]), C1, 6); \
    B3_GB(o[0] = B3_MF(pa3, vf[4], o[0]), C1, 8); \
    B3_GB(o[1] = B3_MF(pa3, vf[5], o[1]), C1, 10); \
    B3_GB(o[2] = B3_MF(pa3, vf[6], o[2]), C1, 12); \
    B3_GB(o[3] = B3_MF(pa3, vf[7], o[3]), C1, 14); \
    l_reg += sacc; } while (0)
  int t = 1;
  for (; t + 3 < NT; t += 2) {
    B3_DMAK(t + 2, B3_SL(t + 2)); B3_DMAK(t + 3, B3_SL(t + 3)); B3_DMAV(t + 1, B3_SL(t + 1)); B3_DMAV(t + 2, B3_SL(t + 2));
    B3_STEP(pB0, pB1, pA0, pA1, t); B3_STEP(pA0, pA1, pB0, pB1, t + 1);
    B3_WAITBAR(0);
  }
  B3_DMAK(t + 2, B3_SL(t + 2)); B3_DMAV(t + 1, B3_SL(t + 1)); B3_DMAV(t + 2, B3_SL(t + 2));
  B3_STEP(pB0, pB1, pA0, pA1, t); B3_STEP(pA0, pA1, pB0, pB1, t + 1);
  B3_WAITBAR(0);
  B3_STEP(pB0, pB1, pA0, pA1, t + 2);
  { unsigned c[16];
#pragma unroll
    for (int i = 0; i < 8; ++i) { c[i] = cvt_pk_bf16(pB0[2 * i], pB0[2 * i + 1]); c[8 + i] = cvt_pk_bf16(pB1[2 * i], pB1[2 * i + 1]); }
    B3_SW(pa0, c[0], c[1], c[2], c[3]); B3_SW(pa1, c[4], c[5], c[6], c[7]); B3_SW(pa2, c[8], c[9], c[10], c[11]); B3_SW(pa3, c[12], c[13], c[14], c[15]);
    pv_d0_v(o, vbase + B3_SL(NT - 1), pa0, pa1, pa2, pa3); }
#undef B3_STEP
#undef B3_GA
#undef B3_GB
#undef B3_SW
  { auto rr = __builtin_amdgcn_permlane32_swap(__float_as_uint(l_reg), __float_as_uint(l_reg), false, false); l_reg = __uint_as_float(rr[0]) + __uint_as_float(rr[1]); }
  if (hi == 0) li_l[r32] = l_reg; asm volatile("s_waitcnt lgkmcnt(0)" ::: "memory");
#pragma unroll
  for (int r = 0; r < 16; ++r) { const float rl = __builtin_amdgcn_rcpf(li_l[crow(r, hi)]);
#pragma unroll
    for (int d0 = 0; d0 < 4; ++d0) o[d0][r] *= rl; }
  __syncthreads();
  float* X = (float*)lds + (size_t)(wid & 3) * 32 * 128;
  if (wid >= 4) {
#pragma unroll
    for (int d0 = 0; d0 < 4; ++d0)
#pragma unroll
      for (int r = 0; r < 16; ++r) X[crow(r, hi) * 128 + d0 * 32 + r32] = o[d0][r];
  }
  __syncthreads();
  if (wid < 4) {
    float ss[16];
#pragma unroll
    for (int r = 0; r < 16; ++r) { float s = 0.f;
#pragma unroll
      for (int d0 = 0; d0 < 4; ++d0) { const float v = o[d0][r] - mp.lam * X[crow(r, hi) * 128 + d0 * 32 + r32]; o[d0][r] = v; s += v * v; }
      ss[r] = s; }
#pragma unroll
    for (int r = 0; r < 16; ++r) ss[r] = rsqrtf(sum32(ss[r]) * (1.0f / 128.0f) + 1e-6f) * mp.post;
    float gcol[4];
#pragma unroll
    for (int d0 = 0; d0 < 4; ++d0) gcol[d0] = mp.normg[d0 * 32 + r32];
    bf16_t* Ow = Orow0 + (long)(wid * 32) * LDOUT;
#pragma unroll
    for (int r = 0; r < 16; ++r) { const int orow = crow(r, hi);
#pragma unroll
      for (int d0 = 0; d0 < 4; ++d0) Ow[(long)orow * LDOUT + d0 * 32 + r32] = f2bf(o[d0][r] * ss[r] * gcol[d0]); }
  }
}
}
struct Args { const float* in[23]; float* out; unsigned char* ws; int ph_lo, ph_hi; };
typedef const Args __attribute__((address_space(4)))* KArgs;
struct Ctx {
    KArgs ka; LAS unsigned char* lds; char* ldsg; int tid, lane, wave, G, wg;
    __device__ __forceinline__ const float* in(int k) const { return ka->in[k]; }
    __device__ __forceinline__ float* out() const { return ka->out; }
    __device__ __forceinline__ unsigned char* ws() const { return ka->ws; }
    __device__ __forceinline__ float* modp() const { return (float*)(ws() + WS_MODP); }
    __device__ __forceinline__ float* mod() const { return (float*)(ws() + WS_MOD); }
    __device__ __forceinline__ float* misc() const { return (float*)(ws() + WS_MISC); }
    __device__ __forceinline__ float* rope() const { return (float*)(ws() + WS_ROPE); }
    __device__ __forceinline__ float* xc() const { return (float*)(ws() + WS_XC); }
    __device__ __forceinline__ bf16_t* xb() const { return (bf16_t*)(ws() + WS_XB); }
    __device__ __forceinline__ float* aff() const { return (float*)(ws() + WS_AFF); }
    __device__ __forceinline__ int* rowidx() const { return (int*)(ws() + WS_ROWIDX); }
    __device__ __forceinline__ float* gatev() const { return (float*)(ws() + WS_GATEV); }
    __device__ __forceinline__ int* slot() const { return (int*)(ws() + WS_SLOT); }
    __device__ __forceinline__ bf16_t* H() const { return (bf16_t*)(ws() + WS_H); }
    __device__ __forceinline__ bf16_t* P() const { return (bf16_t*)(ws() + WS_P); }
    __device__ __forceinline__ bf16_t* O() const { return (bf16_t*)(ws() + WS_O); }
    __device__ __forceinline__ bf16_t* S() const { return (bf16_t*)(ws() + WS_S); }
    __device__ __forceinline__ bf16_t* U() const { return (bf16_t*)(ws() + WS_H); }
    __device__ __forceinline__ bf16_t* ACT() const { return (bf16_t*)(ws() + WS_P + ACT_OFF); }
    __device__ __forceinline__ bf16_t* Y() const { return (bf16_t*)(ws() + WS_P + Y_OFF); }
    __device__ __forceinline__ bf16_t* w_in_t(int l) const { return (bf16_t*)(ws() + WS_W + (size_t)l * WL_BYTES + WL_IN); }
    __device__ __forceinline__ bf16_t* w_out_t(int l) const { return (bf16_t*)(ws() + WS_W + (size_t)l * WL_BYTES + WL_OUT); }
    __device__ __forceinline__ bf16_t* w_gu_t(int l) const { return (bf16_t*)(ws() + WS_W + (size_t)l * WL_BYTES + WL_GU); }
    __device__ __forceinline__ bf16_t* w_dn_t(int l) const { return (bf16_t*)(ws() + WS_W + (size_t)l * WL_BYTES + WL_DN); }
};
__device__ __forceinline__ int hw_lane() { int l; asm volatile("v_mbcnt_lo_u32_b32 %0, -1, 0\n\tv_mbcnt_hi_u32_b32 %0, -1, %0" : "=v"(l)); return l; }
__device__ __forceinline__ Ctx make_ctx(unsigned char* lds_raw, int wave_s) {
    Ctx F; KArgs p = (KArgs)__builtin_amdgcn_kernarg_segment_ptr(); asm volatile("" : "+s"(p));
    F.ka = p; F.lds = (LAS unsigned char*)lds_raw; F.ldsg = (char*)lds_raw;
    F.lane = hw_lane(); F.wave = wave_s; F.tid = wave_s * 64 + F.lane; F.G = gridDim.x; F.wg = blockIdx.x; return F;
}
enum { I_X = 0, I_C, I_CTX, I_CCTX, I_WMOD, I_BMOD, I_N1G, I_WIN, I_RPB, I_DLAM, I_DNG, I_RDF, I_RDB, I_GNG, I_GNB, I_SINK, I_WOUT, I_N2G, I_WR, I_WG, I_WU, I_WD, I_FNG };

__device__ __forceinline__ void ph_mod_partial(const Ctx& F) {
    const float* c = F.in(I_C); const float* cc = F.in(I_CCTX); const float* wm = F.in(I_WMOD);
    for (int gid = F.wg * 512 + F.tid; gid < 2 * 16 * 3072; gid += F.G * 512) {
        const int cg = gid % 3072, ks = (gid / 3072) % 16, l = gid / (3072 * 16);
        const float* w = wm + (size_t)l * DM * 12288 + (size_t)(ks * 128) * 12288 + cg * 4;
        f32x4 a0 = {0.f, 0.f, 0.f, 0.f}, a1 = a0, a2 = a0;
#pragma unroll 8
        for (int k = 0; k < 128; ++k) { const f32x4 wv = *(const f32x4*)(w + (size_t)k * 12288); const int kk = ks * 128 + k;
            const float s0 = siluf(c[kk]), s1 = siluf(c[DM + kk]), s2 = siluf(cc[kk]); a0 += s0 * wv; a1 += s1 * wv; a2 += s2 * wv; }
        float* o = F.modp() + (size_t)((ks * 2 + l) * 3) * 12288 + cg * 4;
        *(f32x4*)(o) = a0; *(f32x4*)(o + 12288) = a1; *(f32x4*)(o + 2 * 12288) = a2;
    }
}
__device__ __forceinline__ void ph_mod_reduce(const Ctx& F) {
    const int NMOD = 2 * 3 * 12288, NR128 = 256 * 32, NR64 = 256 * 16;
    for (int idx = F.wg * 512 + F.tid; idx < NMOD + NR128 + NR64 + 2; idx += F.G * 512) {
        if (idx < NMOD) { const int l = idx / (3 * 12288), v = (idx / 12288) % 3, col = idx % 12288; float s = F.in(I_BMOD)[l * 12288 + col];
            for (int ks = 0; ks < 16; ++ks) s += F.modp()[(size_t)((ks * 2 + l) * 3 + v) * 12288 + col];
            F.mod()[idx] = s;
        } else if (idx < NMOD + NR128) { const int e = idx - NMOD, pos = e >> 5, i = e & 31; const float inv = powf(10000.0f, -(float)i / 32.0f); const float a = (float)pos * inv;
            F.rope()[e] = cosf(a); F.rope()[NR128 + e] = sinf(a);
        } else if (idx < NMOD + NR128 + NR64) { const int e = idx - NMOD - NR128, pos = e >> 4, i = e & 15; const float inv = powf(10000.0f, -(float)i / 16.0f); const float a = (float)pos * inv;
            F.rope()[2 * NR128 + e] = cosf(a); F.rope()[2 * NR128 + NR64 + e] = sinf(a);
        } else { const int l = idx - (NMOD + NR128 + NR64); const float* dl = F.in(I_DLAM) + l * 4 * 64; float s1 = 0.f, s2 = 0.f;
            for (int i = 0; i < 64; ++i) { s1 += dl[i] * dl[64 + i]; s2 += dl[128 + i] * dl[192 + i]; }
            const float lam_init = 0.8f - 0.6f * expf(-0.3f * (float)l);
            F.misc()[l * 2] = expf(s1) - expf(s2) + lam_init; F.misc()[l * 2 + 1] = lam_init; }
    }
}
__device__ __forceinline__ int inproj_perm(int np) {
    const int pn = np >> 8, p = np & 255;
    if (pn >= 6 && pn <= 9) { const int half = p >> 7, pp = p & 127, sh = pp >> 5, rc = (pp >> 4) & 1, i = pp & 15; return pn * 256 + sh * 64 + rc * 32 + half * 16 + i; }
    if ((pn >= 12 && pn <= 15) || (pn >= 20 && pn <= 22)) { const int half = p >> 7, pp = p & 127, hs = pp >> 6, rc = (pp >> 5) & 1, i = pp & 31; return pn * 256 + hs * 128 + rc * 64 + half * 32 + i; }
    return np;
}
__device__ __forceinline__ float inproj_scale(int col) {
    if (col < C_AK) return 0.08838834764831845f * LOG2E;
    if (col >= C_BQ && col < C_BK) return 0.125f * LOG2E;
    if (col >= C_CK && col < C_CV) return 0.08838834764831845f;
    if (col >= C_DQ && col < C_DK) return 0.08838834764831845f * LOG2E;
    return 1.0f;
}
struct CvTile { const float* src; bf16_t* dst; int nsrc, K, n0, k0, kind; };
__device__ __forceinline__ CvTile cv_tile(const Ctx& F, int t) {
    const int T_IN = 96 * 32, T_OUT = 32 * 32, T_GU = 16 * 32 * 32, T_DN = 16 * 32 * 16, TL = T_IN + T_OUT + T_GU + T_DN;
    const int l = t / TL; int r = t % TL; CvTile c;
    if (r < T_IN) { c.kind = 0; c.n0 = (r % 96) * 64; c.k0 = (r / 96) * 64; c.src = F.in(I_WIN) + (size_t)l * DM * INW; c.nsrc = INW; c.K = DM; c.dst = F.w_in_t(l); }
    else if (r < T_IN + T_OUT) { r -= T_IN; c.kind = 1; c.n0 = (r % 32) * 64; c.k0 = (r / 32) * 64; c.src = F.in(I_WOUT) + (size_t)l * DM * DM; c.nsrc = DM; c.K = DM; c.dst = F.w_out_t(l); }
    else if (r < T_IN + T_OUT + T_GU) { r -= T_IN + T_OUT; c.kind = 2; const int e = r / 1024, rr = r % 1024; c.n0 = (rr % 32) * 64; c.k0 = (rr / 32) * 64;
        const int half = (c.n0 & 255) >> 7; c.src = (half ? F.in(I_WU) : F.in(I_WG)) + (size_t)(l * NE + e) * DM * FF; c.nsrc = FF; c.K = DM; c.dst = F.w_gu_t(l) + (size_t)e * 2048 * DM; }
    else { r -= T_IN + T_OUT + T_GU; c.kind = 3; const int e = r / 512, rr = r % 512; c.n0 = (rr % 32) * 64; c.k0 = (rr / 32) * 64; c.src = F.in(I_WD) + (size_t)(l * NE + e) * FF * DM; c.nsrc = DM; c.K = FF; c.dst = F.w_dn_t(l) + (size_t)e * DM * FF; }
    return c;
}
__device__ __forceinline__ void ph_convert(const Ctx& F) {
    LAS float* tile = (LAS float*)F.lds;
    const int TL = 96 * 32 + 32 * 32 + 16 * 32 * 32 + 16 * 32 * 16, NT = 2 * TL;
    const int tx = F.tid & 63, ty = F.tid >> 6, kx2 = F.tid & 31, ny = F.tid >> 5;
    for (int t0 = F.wg * 4; t0 < NT; t0 += 4 * F.G) {
        float v[4][8]; float sc[4];
#pragma unroll
        for (int u = 0; u < 4; ++u) { const int t = t0 + u; if (t < NT) { const CvTile c = cv_tile(F, t);
            const int np = c.n0 + tx; int scol = np; sc[u] = 1.0f;
            if (c.kind == 0) { scol = inproj_perm(np); sc[u] = inproj_scale(scol); }
            else if (c.kind == 2) { scol = (np >> 8) * 128 + (np & 127); }
#pragma unroll
            for (int i = 0; i < 8; ++i) v[u][i] = c.src[(size_t)(c.k0 + ty + 8 * i) * c.nsrc + scol]; } }
#pragma unroll
        for (int u = 0; u < 4; ++u) { const int t = t0 + u; if (t < NT) {
#pragma unroll
            for (int i = 0; i < 8; ++i) tile[u * (64 * 65) + (ty + 8 * i) * 65 + tx] = v[u][i] * sc[u]; } }
        __syncthreads();
#pragma unroll
        for (int u = 0; u < 4; ++u) { const int t = t0 + u; if (t < NT) { const CvTile c = cv_tile(F, t);
#pragma unroll
            for (int i = 0; i < 4; ++i) { const int nn = ny + 16 * i; const float lo = tile[u * (64 * 65) + (2 * kx2) * 65 + nn], hi = tile[u * (64 * 65) + (2 * kx2 + 1) * 65 + nn];
                *(unsigned*)(c.dst + (size_t)(c.n0 + nn) * c.K + c.k0 + 2 * kx2) = cvt_pk_bf16(lo, hi); } } }
        __syncthreads();
    }
}

__device__ __forceinline__ float wave_sum(float s) { return sum64(s); }
__device__ __forceinline__ void load_x(const Ctx& F, const void* xrow, bool bf, f32x4 (&x)[8]) {
    const int lane = F.lane;
    if (bf) {
#pragma unroll
        for (int j = 0; j < 8; ++j) { const u32x2 w = *(const u32x2*)((const bf16_t*)xrow + j * 256 + lane * 4); x[j] = (f32x4){bflo(w.x), bfhi(w.x), bflo(w.y), bfhi(w.y)}; }
    } else {
#pragma unroll
        for (int j = 0; j < 8; ++j) x[j] = *(const f32x4*)((const float*)xrow + j * 256 + lane * 4);
    }
}
__device__ __forceinline__ void ld_y(const Ctx& F, int s, u32x2 (&w)[8]) {
    const bf16_t* y = F.Y() + (size_t)s * DM + F.lane * 4;
#pragma unroll
    for (int j = 0; j < 8; ++j) w[j] = *(const u32x2*)(y + j * 256);
}
__device__ __forceinline__ void acc_y(f32x4 (&ys)[8], const u32x2 (&w)[8]) {
#pragma unroll
    for (int j = 0; j < 8; ++j) ys[j] += (f32x4){bflo(w[j].x), bfhi(w[j].x), bflo(w[j].y), bfhi(w[j].y)};
}
__device__ __forceinline__ int load_slots(const Ctx& F, int row) { return F.slot()[(size_t)row * NE + (F.lane & 15)]; }
__device__ __forceinline__ void moe_fold2(const Ctx& F, const LAS float* g2, int sva, int svb, f32x4 (&xa)[8], f32x4 (&xb)[8]) {
    f32x4 ya[8], yb[8];
#pragma unroll
    for (int j = 0; j < 8; ++j) { ya[j] = (f32x4){0.f, 0.f, 0.f, 0.f}; yb[j] = (f32x4){0.f, 0.f, 0.f, 0.f}; }
    unsigned ma = (unsigned)__builtin_amdgcn_ballot_w64(sva >= 0) & 0xFFFFu, mb = (unsigned)__builtin_amdgcn_ballot_w64(svb >= 0) & 0xFFFFu;
    while ((ma | mb) != 0u) {
        const bool ha = ma != 0u, hb = mb != 0u; u32x2 wa[8], wb[8];
        if (ha) { const int e = __builtin_ctz(ma); ma &= ma - 1u; ld_y(F, __builtin_amdgcn_readlane(sva, e), wa); }
        if (hb) { const int e = __builtin_ctz(mb); mb &= mb - 1u; ld_y(F, __builtin_amdgcn_readlane(svb, e), wb); }
        if (ha) acc_y(ya, wa);
        if (hb) acc_y(yb, wb);
    }
#pragma unroll
    for (int j = 0; j < 8; ++j) { const f32x4 g = *(const LAS f32x4*)(g2 + j * 256 + F.lane * 4); xa[j] += g * ya[j]; xb[j] += g * yb[j]; }
}
__device__ __forceinline__ float row_rstd(const f32x4 (&x)[8]) {
    float s = 0.f;
#pragma unroll
    for (int j = 0; j < 8; ++j) s += x[j][0] * x[j][0] + x[j][1] * x[j][1] + x[j][2] * x[j][2] + x[j][3] * x[j][3];
    s = wave_sum(s); return rsqrtf(s * (1.0f / DM) + 1e-6f);
}
__device__ __forceinline__ void norm1_row(const Ctx& F, int li, int row, const float* ng, f32x4 (&x)[8]) {
    const bool lat = row < NLAT; const int v = lat ? row / SEQ : 2;
    if (li != 0) {
        if (lat) { bf16_t* xo = F.xb() + (size_t)row * DM;
#pragma unroll
            for (int j = 0; j < 8; ++j) { u32x2 w; w.x = cvt_pk_bf16(x[j][0], x[j][1]); w.y = cvt_pk_bf16(x[j][2], x[j][3]); *(u32x2*)(xo + j * 256 + F.lane * 4) = w;
                x[j] = (f32x4){bflo(w.x), bfhi(w.x), bflo(w.y), bfhi(w.y)}; }
        } else { float* xo = F.xc() + (size_t)(row - NLAT) * DM;
#pragma unroll
            for (int j = 0; j < 8; ++j) *(f32x4*)(xo + j * 256 + F.lane * 4) = x[j]; } }
    const float rs = row_rstd(x);
    const LAS float* gs = (const LAS float*)F.lds + v * (2 * DM); const LAS float* s0p = gs + DM;
    bf16_t* h = F.H() + (size_t)row * DM;
#pragma unroll
    for (int j = 0; j < 8; ++j) { const int c = j * 256 + F.lane * 4; const f32x4 g = *(const LAS f32x4*)(gs + c), s0 = *(const LAS f32x4*)(s0p + c);
        const f32x4 y = x[j] * rs * g + s0; u32x2 w; w.x = cvt_pk_bf16(y[0], y[1]); w.y = cvt_pk_bf16(y[2], y[3]); *(u32x2*)(h + c) = w; }
}
__device__ __forceinline__ const void* norm1_src(const Ctx& F, int li, int row, bool& bf) {
    const bool lat = row < NLAT; bf = (li != 0) && lat;
    if (li == 0) return lat ? (const void*)(F.in(I_X) + (size_t)row * DM) : (const void*)(F.in(I_CTX) + (size_t)(row - NLAT) * DM);
    return lat ? (const void*)(F.xb() + (size_t)row * DM) : (const void*)(F.xc() + (size_t)(row - NLAT) * DM);
}
__device__ __forceinline__ void ph_norm1(const Ctx& F, int li) {
    const float* ng = F.in(I_N1G) + li * DM;
    __syncthreads();
    for (int i = F.tid; i < 3 * DM; i += 512) { const int v = i / DM, c = i - v * DM; const float* sh = F.mod() + (size_t)(li * 3 + v) * 12288;
        ((LAS float*)F.lds)[v * (2 * DM) + c] = ng[c] * (1.0f + sh[DM + c]); ((LAS float*)F.lds)[v * (2 * DM) + DM + c] = sh[c];
        if (li != 0) ((LAS float*)F.lds)[6 * DM + i] = F.mod()[(size_t)((li - 1) * 3 + v) * 12288 + 5 * DM + c]; }
    __syncthreads();
    for (int row = (F.wg * 8 + F.wave) * 2; row < MTOT; row += F.G * 16) {
        f32x4 xa[8], xb[8]; bool bfa, bfb; const void* pa = norm1_src(F, li, row, bfa); const void* pb = norm1_src(F, li, row + 1, bfb);
        int sva = -1, svb = -1; if (li != 0) { sva = load_slots(F, row); svb = load_slots(F, row + 1); }
        load_x(F, pa, bfa, xa); load_x(F, pb, bfb, xb);
        if (li != 0) moe_fold2(F, (const LAS float*)F.lds + 6 * DM + (row < NLAT ? row / SEQ : 2) * DM, sva, svb, xa, xb);
        norm1_row(F, li, row, ng, xa); norm1_row(F, li, row + 1, ng, xb);
    }
}
__device__ __forceinline__ void ph_final(const Ctx& F) {
    __syncthreads();
    for (int i = F.tid; i < 3 * DM; i += 512) ((LAS float*)F.lds)[i] = i < DM ? F.in(I_FNG)[i] : F.mod()[(size_t)(3 + (i / DM - 1)) * 12288 + 5 * DM + (i & (DM - 1))];
    __syncthreads();
    const LAS float* ng = (const LAS float*)F.lds;
    for (int row = (F.wg * 8 + F.wave) * 2; row < NLAT; row += F.G * 16) {
        f32x4 xa[8], xb[8]; const int sva = load_slots(F, row), svb = load_slots(F, row + 1);
        load_x(F, F.xb() + (size_t)row * DM, true, xa); load_x(F, F.xb() + (size_t)(row + 1) * DM, true, xb);
        moe_fold2(F, ng + DM + (row / SEQ) * DM, sva, svb, xa, xb);
        const float ra = row_rstd(xa), rb = row_rstd(xb); float* xr = F.out() + (size_t)row * DM;
#pragma unroll
        for (int j = 0; j < 8; ++j) { const int c = j * 256 + F.lane * 4; const f32x4 g = *(const LAS f32x4*)(ng + c); *(f32x4*)(xr + c) = xa[j] * ra * g; *(f32x4*)(xr + DM + c) = xb[j] * rb * g; }
    }
}
__device__ __forceinline__ void router_reduce_store(float (&v)[16], int lane, float* affrow) {
    float a[8];
#pragma unroll
    for (int i = 0; i < 8; ++i) { auto rr = __builtin_amdgcn_permlane32_swap(__float_as_uint(v[i]), __float_as_uint(v[i + 8]), false, false); a[i] = __uint_as_float(rr[0]) + __uint_as_float(rr[1]); }
    float b[4]; const bool b16 = (lane & 16) != 0;
#pragma unroll
    for (int i = 0; i < 4; ++i) { const float keep = b16 ? a[i + 4] : a[i], send = b16 ? a[i] : a[i + 4]; b[i] = keep + xshf<16>(send); }
    float c[2]; const bool b8 = (lane & 8) != 0;
#pragma unroll
    for (int i = 0; i < 2; ++i) { const float keep = b8 ? b[i + 2] : b[i], send = b8 ? b[i] : b[i + 2]; c[i] = keep + xshf<8>(send); }
    const bool b4 = (lane & 4) != 0; float lg = (b4 ? c[1] : c[0]) + xshf<4>(b4 ? c[0] : c[1]);
    lg += xshf<2>(lg); lg += xshf<1>(lg);
    float mx = lg; mx = fmaxf(mx, xshf<4>(mx)); mx = fmaxf(mx, xshf<8>(mx)); mx = fmaxf(mx, xshf<16>(mx));
    { auto rr = __builtin_amdgcn_permlane32_swap(__float_as_uint(mx), __float_as_uint(mx), false, false); mx = fmaxf(__uint_as_float(rr[0]), __uint_as_float(rr[1])); }
    const float ex = expf(lg - mx); float den = ex; den += xshf<4>(den); den += xshf<8>(den); den += xshf<16>(den);
    { auto rr = __builtin_amdgcn_permlane32_swap(__float_as_uint(den), __float_as_uint(den), false, false); den = __uint_as_float(rr[0]) + __uint_as_float(rr[1]); }
    const int e = ((lane >> 5) & 1) * 8 + ((lane >> 4) & 1) * 4 + ((lane >> 3) & 1) * 2 + ((lane >> 2) & 1);
    if ((lane & 3) == 0) affrow[e] = ex / den;
}
__device__ __forceinline__ void ph_norm2(const Ctx& F, int li, int rbeg, int rend, int wg0, int nwg) {
    const float* ng = F.in(I_N2G) + li * DM; const float* wr = F.in(I_WR) + (size_t)li * DM * NE; LAS float* wl = (LAS float*)F.lds;
    __syncthreads();
    for (int i = F.tid; i < DM * NE; i += 512) { const int k = i >> 4, e = i & 15; wl[e * DM + k] = wr[i]; }
    LAS float* gsl = wl + NE * DM;
    for (int i = F.tid; i < 2 * DM; i += 512) { const int v = (rbeg < NLAT) ? i / DM : 2, c = i & (DM - 1); gsl[i] = ng[c] * (1.0f + F.mod()[(size_t)(li * 3 + v) * 12288 + 4 * DM + c]); }
    __syncthreads();
    for (int row0 = rbeg + ((F.wg - wg0) * 8 + F.wave) * 4; row0 < rend; row0 += nwg * 32) {
        const bool lat = row0 < NLAT; const int v = lat ? row0 / SEQ : 2;
        const float* sh = F.mod() + (size_t)(li * 3 + v) * 12288 + 3 * DM; const LAS float* gsv = gsl + (lat ? v * DM : 0);
        f32x4 x[4][8];
        if (lat) { const bf16_t* xin = F.xb() + (size_t)row0 * DM;
#pragma unroll
            for (int r = 0; r < 4; ++r)
#pragma unroll
                for (int j = 0; j < 8; ++j) { const u32x2 w = *(const u32x2*)(xin + (size_t)r * DM + j * 256 + F.lane * 4); x[r][j] = (f32x4){bflo(w.x), bfhi(w.x), bflo(w.y), bfhi(w.y)}; }
        } else { const float* xin = F.xc() + (size_t)(row0 - NLAT) * DM;
#pragma unroll
            for (int r = 0; r < 4; ++r)
#pragma unroll
                for (int j = 0; j < 8; ++j) x[r][j] = *(const f32x4*)(xin + (size_t)r * DM + j * 256 + F.lane * 4); }
        float rs[4];
#pragma unroll
        for (int r = 0; r < 4; ++r) rs[r] = row_rstd(x[r]);
#pragma unroll
        for (int j = 0; j < 8; ++j) { const int c = j * 256 + F.lane * 4; const f32x4 s0 = *(const f32x4*)(sh + c); const f32x4 gs = *(const LAS f32x4*)(gsv + c);
#pragma unroll
            for (int r = 0; r < 4; ++r) { const f32x4 y = x[r][j] * rs[r] * gs + s0; x[r][j] = y; u32x2 w; w.x = cvt_pk_bf16(y[0], y[1]); w.y = cvt_pk_bf16(y[2], y[3]); *(u32x2*)(F.H() + (size_t)(row0 + r) * DM + c) = w; } }
        float lg[4][16];
#pragma unroll
        for (int e = 0; e < NE; ++e) { f32x2 a0 = {0.f, 0.f}, a1 = {0.f, 0.f}, a2 = {0.f, 0.f}, a3 = {0.f, 0.f};
#pragma unroll
            for (int j = 0; j < 8; ++j) { const f32x4 w = *(const LAS f32x4*)(wl + e * DM + j * 256 + F.lane * 4); const f32x2 wlo = __builtin_shufflevector(w, w, 0, 1), whi = __builtin_shufflevector(w, w, 2, 3);
                a0 += __builtin_shufflevector(x[0][j], x[0][j], 0, 1) * wlo; a0 += __builtin_shufflevector(x[0][j], x[0][j], 2, 3) * whi;
                a1 += __builtin_shufflevector(x[1][j], x[1][j], 0, 1) * wlo; a1 += __builtin_shufflevector(x[1][j], x[1][j], 2, 3) * whi;
                a2 += __builtin_shufflevector(x[2][j], x[2][j], 0, 1) * wlo; a2 += __builtin_shufflevector(x[2][j], x[2][j], 2, 3) * whi;
                a3 += __builtin_shufflevector(x[3][j], x[3][j], 0, 1) * wlo; a3 += __builtin_shufflevector(x[3][j], x[3][j], 2, 3) * whi; }
            float s0 = a0[0] + a0[1], s1 = a1[0] + a1[1], s2 = a2[0] + a2[1], s3 = a3[0] + a3[1];
            asm volatile("" : "+v"(s0), "+v"(s1), "+v"(s2), "+v"(s3) :: "memory"); __builtin_amdgcn_sched_barrier(0);
            lg[0][e] = s0; lg[1][e] = s1; lg[2][e] = s2; lg[3][e] = s3; }
#pragma unroll
        for (int r = 0; r < 4; ++r) router_reduce_store(lg[r], F.lane, F.aff() + (size_t)(row0 + r) * NE);
    }
}

__device__ __forceinline__ void topk_group(const Ctx& F, int N, int k, int row_base  , int e, int out_base  ) {
    LAS unsigned* keys = (LAS unsigned*)F.lds; LAS unsigned* hist = keys + 16384; LAS unsigned* sh = hist + 256;
    const int tid = F.tid;
    __syncthreads();
    for (int i = tid; i < N; i += 512) keys[i] = __float_as_uint(F.aff()[(size_t)(row_base + i) * NE + e]);
    unsigned prefix = 0u, need = (unsigned)k;
    for (int shift = 24; shift >= 0; shift -= 8) {
        if (tid < 256) hist[tid] = 0u;
        __syncthreads();
        for (int i = tid; i < N; i += 512) { const unsigned key = keys[i]; if (shift == 24 || (key >> (shift + 8)) == (prefix >> (shift + 8))) atomicAdd((unsigned*)&hist[(key >> shift) & 255u], 1u); }
        __syncthreads();
        if (tid < 64) {
            const int b0 = 255 - 4 * tid; const unsigned c0 = hist[b0], c1 = hist[b0 - 1], c2 = hist[b0 - 2], c3 = hist[b0 - 3]; const unsigned loc = c0 + c1 + c2 + c3;
            unsigned inc = loc;
#pragma unroll
            for (int o = 1; o < 64; o <<= 1) { const unsigned t = lane_up(inc, tid, o); if (tid >= o) inc += t; }
            const unsigned before = inc - loc;
            if (before < need && need <= inc) { unsigned cum = before; int d;
                if (cum + c0 >= need) d = b0; else { cum += c0; if (cum + c1 >= need) d = b0 - 1; else { cum += c1; if (cum + c2 >= need) d = b0 - 2; else { cum += c2; d = b0 - 3; } } }
                sh[0] = prefix | ((unsigned)d << shift); sh[1] = need - cum; }
        }
        __syncthreads();
        prefix = sh[0]; need = sh[1];
        __syncthreads();
    }
    const int per = N >= 512 ? N / 512 : 1; const int nact = N / per; unsigned cg = 0u, ce = 0u;
    if (tid < nact) for (int i = 0; i < per; ++i) { const unsigned key = keys[tid * per + i]; cg += key > prefix; ce += key == prefix; }
    unsigned pk = cg | (ce << 16), inc = pk;
#pragma unroll
    for (int o = 1; o < 64; o <<= 1) { const unsigned t = lane_up(inc, F.lane, o); if (F.lane >= o) inc += t; }
    if (F.lane == 63) sh[8 + F.wave] = inc;
    __syncthreads();
    unsigned woff = 0u;
    for (int w = 0; w < F.wave; ++w) woff += sh[8 + w];
    const unsigned exc = inc - pk + woff; unsigned gb = exc & 0xffffu, eb = exc >> 16; const unsigned ngt = (unsigned)k - need;
    if (tid < nact) for (int i = 0; i < per; ++i) { const int ti = tid * per + i; const unsigned key = keys[ti]; int s = -1;
        if (key > prefix) { s = (int)gb; ++gb; } else if (key == prefix) { if (eb < need) s = (int)(ngt + eb); ++eb; }
        const int row = row_base + ti;
        if (s >= 0) { F.rowidx()[out_base + s] = row; F.gatev()[out_base + s] = __uint_as_float(key); }
        F.slot()[(size_t)row * NE + e] = s >= 0 ? out_base + s : -1; }
    __syncthreads();
}
__device__ __forceinline__ void ph_topk(const Ctx& F, int li) {
    const int ngroups = (li == 0) ? 64 : 32;
    for (int g = F.wg; g < ngroups; g += F.G) {
        if (g < 32) { const int b = g >> 4, e = g & 15; topk_group(F, SEQ, CAP, b * SEQ, e, g * CAP); }
        else { const int b = (g - 32) >> 4, e = (g - 32) & 15; const int base = NBATCH * NE * CAP + e * 256;
            topk_group(F, LCTX, CAPC, NLAT + b * LCTX, e, base + b * CAPC);
            if (b == 0 && F.tid < 192) { F.rowidx()[base + 64 + F.tid] = 0; F.gatev()[base + 64 + F.tid] = 0.f; } }
    }
}

constexpr size_t CTL_KMAX = 16384;
namespace ret {
constexpr int TS = 136;
constexpr int TILE_B = 128 * TS * 2;
__device__ __forceinline__ float log2_gamma(float decay) { return -log1pf(expf(-decay)) * LOG2E; }
__device__ __forceinline__ int chunk_row0(int b, int c) { return c < 2 ? NLAT + b * LCTX + c * 128 : b * SEQ + (c - 2) * 128; }
__device__ __forceinline__ f32x16 mm_block(const LAS bf16_t* A, int ra, const LAS bf16_t* B, int rb, int r32, int hi, f32x16 acc) {
#pragma unroll
    for (int s = 0; s < 8; ++s) { const bf16x8 a = *(const LAS bf16x8*)(A + (ra + r32) * TS + 16 * s + 8 * hi), b = *(const LAS bf16x8*)(B + (rb + r32) * TS + 16 * s + 8 * hi);
        acc = __builtin_amdgcn_mfma_f32_32x32x16_bf16(a, b, acc, 0, 0, 0); }
    return acc;
}
__device__ __forceinline__ bf16x8 scale8(bf16x8 v, float s) {
    const u32x4 w = *reinterpret_cast<const u32x4*>(&v); u32x4 o;
    o.x = cvt_pk_bf16(bflo(w.x) * s, bfhi(w.x) * s); o.y = cvt_pk_bf16(bflo(w.y) * s, bfhi(w.y) * s); o.z = cvt_pk_bf16(bflo(w.z) * s, bfhi(w.z) * s); o.w = cvt_pk_bf16(bflo(w.w) * s, bfhi(w.w) * s);
    return *reinterpret_cast<const bf16x8*>(&o);
}
__device__ __forceinline__ f32x16 mm_block_rowscaled(const LAS bf16_t* A, int ra, float rowscale, const LAS bf16_t* B, int rb, int r32, int hi, f32x16 acc) {
#pragma unroll
    for (int s = 0; s < 8; ++s) { const bf16x8 a = scale8(*(const LAS bf16x8*)(A + (ra + r32) * TS + 16 * s + 8 * hi), rowscale), b = *(const LAS bf16x8*)(B + (rb + r32) * TS + 16 * s + 8 * hi);
        acc = __builtin_amdgcn_mfma_f32_32x32x16_bf16(a, b, acc, 0, 0, 0); }
    return acc;
}
__device__ __forceinline__ void ld4(const bf16_t* src, int ld, int tid, bf16x8 (&v)[4]) {
#pragma unroll
    for (int p = 0; p < 4; ++p) { const int idx = tid + 512 * p; v[p] = *reinterpret_cast<const bf16x8*>(src + (size_t)(idx >> 4) * ld + (idx & 15) * 8); }
}
__device__ __forceinline__ void st4_nat(LAS bf16_t* dst, int tid, const bf16x8 (&v)[4]) {
#pragma unroll
    for (int p = 0; p < 4; ++p) { const int idx = tid + 512 * p; *(LAS bf16x8*)(dst + (idx >> 4) * TS + (idx & 15) * 8) = v[p]; }
}
__device__ __forceinline__ void st4_tr(LAS bf16_t* dst, int tid, const bf16x8 (&v)[4], float e0, float e1) {
#pragma unroll
    for (int p = 0; p < 4; ++p) { const int idx = tid + 512 * p; const int m = idx >> 4, c0 = (idx & 15) * 8; const float sc = __builtin_amdgcn_exp2f(e0 + e1 * (float)m);
#pragma unroll
        for (int i = 0; i < 8; ++i) dst[(c0 + i) * TS + m] = f2bf(bf2f((bf16_t)v[p][i]) * sc); }
}

__device__ __forceinline__ void st4_vst(LAS bf16_t* dst, int tid, const bf16x8 (&v)[4]) {
#pragma unroll
    for (int p = 0; p < 4; ++p) { const int idx = tid + 512 * p; const int m = idx >> 4, c0 = (idx & 15) * 8; *(LAS bf16x8*)((LAS char*)dst + (m >> 6) * 16384 + att::v_st(m & 63, c0)) = v[p]; }
}
__device__ __forceinline__ void st4_vst_scaled(LAS bf16_t* dst, int tid, const bf16x8 (&v)[4], float e0, float e1) {
#pragma unroll
    for (int p = 0; p < 4; ++p) { const int idx = tid + 512 * p; const int m = idx >> 4, c0 = (idx & 15) * 8; *(LAS bf16x8*)((LAS char*)dst + (m >> 6) * 16384 + att::v_st(m & 63, c0)) = scale8(v[p], __builtin_amdgcn_exp2f(e0 + e1 * (float)m)); }
}
template <int KS> __device__ __forceinline__ bf16x8 trfrag(int base) {
    const s16x4 lo = att::vtr(base + (KS >> 2) * 16384 + att::v_rd_off(0, KS & 3, 0)), hi = att::vtr(base + (KS >> 2) * 16384 + att::v_rd_off(0, KS & 3, 1));
    return (bf16x8){lo[0], lo[1], lo[2], lo[3], hi[0], hi[1], hi[2], hi[3]};
}
__device__ __forceinline__ f32x16 mm_block_trB(const LAS bf16_t* A, int ra, int tb, int r32, int hi, f32x16 acc) {
#define RET_STEP(KS) acc = __builtin_amdgcn_mfma_f32_32x32x16_bf16(*(const LAS bf16x8*)(A + (ra + r32) * TS + 16 * KS + 8 * hi), trfrag<KS>(tb), acc, 0, 0, 0)
    RET_STEP(0); RET_STEP(1); RET_STEP(2); RET_STEP(3); RET_STEP(4); RET_STEP(5); RET_STEP(6); RET_STEP(7);
#undef RET_STEP
    return acc;
}

__device__ __forceinline__ void c1_unit(const Ctx& F, int li, int bh, int c) {
    const int b = bh >> 2, h = bh & 3, tid = F.tid, wid = F.wave, r32 = F.lane & 31, hi = F.lane >> 5;
    LAS bf16_t* TVt = (LAS bf16_t*)F.lds; LAS bf16_t* KF = TVt + 16384; LAS bf16_t* KB = KF + 16384;
    const float lf = log2_gamma(F.in(I_RDF)[li * 4 + h]), lb = log2_gamma(F.in(I_RDB)[li * 4 + h]);
    const bf16_t* base = F.P() + (size_t)chunk_row0(b, c) * INW + h * HD;
    bf16x8 kv[4], vv[4]; ld4(base + C_CK, INW, tid, kv); ld4(base + C_CV, INW, tid, vv);
    __syncthreads();
    st4_vst(TVt, tid, vv); st4_vst_scaled(KF, tid, kv, 127.f * lf, -lf); st4_vst_scaled(KB, tid, kv, 0.f, lb);
    __syncthreads();
    const int dvb = wid >> 1, dk0 = 2 * (wid & 1); const int l0 = (int)(uintptr_t)F.lds + att::v_rd_base(F.lane);
    const int av = l0 + dvb * 512, bf0 = l0 + 32768 + dk0 * 512, bb0 = l0 + 65536 + dk0 * 512;
    f32x16 f0 = {}, f1 = {}, g0 = {}, g1 = {};
#define C1_STEP(KS) do { const bf16x8 a_ = trfrag<KS>(av); f0 = __builtin_amdgcn_mfma_f32_32x32x16_bf16(a_, trfrag<KS>(bf0), f0, 0, 0, 0); f1 = __builtin_amdgcn_mfma_f32_32x32x16_bf16(a_, trfrag<KS>(bf0 + 512), f1, 0, 0, 0); \
        g0 = __builtin_amdgcn_mfma_f32_32x32x16_bf16(a_, trfrag<KS>(bb0), g0, 0, 0, 0); g1 = __builtin_amdgcn_mfma_f32_32x32x16_bf16(a_, trfrag<KS>(bb0 + 512), g1, 0, 0, 0); } while (0)
    C1_STEP(0); C1_STEP(1); C1_STEP(2); C1_STEP(3); C1_STEP(4); C1_STEP(5); C1_STEP(6); C1_STEP(7);
#undef C1_STEP
    bf16_t* Uf = F.U() + ((size_t)(0 * 8 + bh) * NCH + c) * 16384; bf16_t* Ub = F.U() + ((size_t)(1 * 8 + bh) * NCH + c) * 16384;
#pragma unroll
    for (int r = 0; r < 16; ++r) { const int o_ = (dvb * 32 + crow(r, hi)) * 128 + dk0 * 32 + r32; Uf[o_] = f2bf(f0[r]); Uf[o_ + 32] = f2bf(f1[r]); Ub[o_] = f2bf(g0[r]); Ub[o_ + 32] = f2bf(g1[r]); }
}
__device__ __forceinline__ void c2_scan(const Ctx& F, int li) {
    for (int gid = F.wg * 512 + F.tid; gid < 2 * 8 * 16384; gid += F.G * 512) {
        const int dir = gid >> 17, bh = (gid >> 14) & 7, el = gid & 16383, h = bh & 3;
        const float lg = log2_gamma((dir ? F.in(I_RDB) : F.in(I_RDF))[li * 4 + h]); const float cd = __builtin_amdgcn_exp2f(128.f * lg);
        const bf16_t* U = F.U() + (size_t)(dir * 8 + bh) * NCH * 16384 + el; bf16_t* S = F.S() + (size_t)(dir * 8 + bh) * NCH * 16384 + el;
        float s = 0.f;
        if (dir == 0) {
#pragma unroll 8
            for (int c = 0; c < NCH; ++c) { const float u = bf2f(U[(size_t)c * 16384]); S[(size_t)c * 16384] = f2bf(s); s = cd * s + u; }
        } else {
            { const float u1 = bf2f(U[(size_t)1 * 16384]), u0 = bf2f(U[0]); S[(size_t)1 * 16384] = f2bf(0.f); s = u1; S[0] = f2bf(s); s = cd * s + u0; }
#pragma unroll 8
            for (int c = NCH - 1; c >= 2; --c) { const float u = bf2f(U[(size_t)c * 16384]); S[(size_t)c * 16384] = f2bf(s); s = cd * s + u; }
        }
    }
}
__device__ __forceinline__ void c3_unit(const Ctx& F, int li, int bh, int c) {
    const int b = bh >> 2, h = bh & 3, tid = F.tid, wid = F.wave, lane = F.lane, r32 = lane & 31, hi = lane >> 5;
    LAS bf16_t* TQ = (LAS bf16_t*)F.lds; LAS bf16_t* TK = TQ + 128 * TS; LAS bf16_t* TV = TK + 128 * TS; LAS bf16_t* TP = TV + 128 * TS; LAS float* ST = (LAS float*)(TP + 128 * TS);
    const float lf = log2_gamma(F.in(I_RDF)[li * 4 + h]), lb = log2_gamma(F.in(I_RDB)[li * 4 + h]);
    const int row0 = chunk_row0(b, c);
    const bf16_t* base = F.P() + (size_t)row0 * INW + h * HD;
    bf16x8 qv[4], kv[4], vv[4], sf[4], sb[4], gv[4];
    ld4(base + C_CQ, INW, tid, qv); ld4(base + C_CK, INW, tid, kv); ld4(base + C_CV, INW, tid, vv);
    ld4(F.S() + ((size_t)(0 * 8 + bh) * NCH + c) * 16384, 128, tid, sf);
    __syncthreads();
    st4_nat(TQ, tid, qv); st4_nat(TK, tid, kv); st4_vst(TV, tid, vv);
    __syncthreads();
    const int rb = wid >> 1, cb0 = 2 * (wid & 1);
    {
        f32x16 s0 = {}, s1 = {}; s0 = mm_block(TQ, rb * 32, TK, cb0 * 32, r32, hi, s0); s1 = mm_block(TQ, rb * 32, TK, (cb0 + 1) * 32, r32, hi, s1);
#pragma unroll
        for (int r = 0; r < 16; ++r) { const int n = rb * 32 + crow(r, hi);
#pragma unroll
            for (int i = 0; i < 2; ++i) { const int m = (cb0 + i) * 32 + r32; const int d = n - m; float w = __builtin_amdgcn_exp2f((float)d * (d > 0 ? lf : -lb)); w = (d == 0) ? 2.0f : w;
                TP[n * TS + m] = f2bf((i ? s1[r] : s0[r]) * w); } }
    }
    __syncthreads();
    st4_nat(TK, tid, sf);
    asm volatile("" ::: "memory");
    ld4(F.S() + ((size_t)(1 * 8 + bh) * NCH + c) * 16384, 128, tid, sb);
    ld4(base + C_CG, INW, tid, gv);
    __syncthreads();
    const int nrow = rb * 32 + r32;
    f32x16 o0 = {}, o1 = {};
    { const int tvb = (int)(uintptr_t)F.lds + 2 * TILE_B + att::v_rd_base(lane) + cb0 * 512;
      o0 = mm_block_trB(TP, rb * 32, tvb, r32, hi, o0); o1 = mm_block_trB(TP, rb * 32, tvb + 512, r32, hi, o1); }
    { const float qs = __builtin_amdgcn_exp2f((float)(nrow + 1) * lf);
      o0 = mm_block_rowscaled(TQ, rb * 32, qs, TK, cb0 * 32, r32, hi, o0); o1 = mm_block_rowscaled(TQ, rb * 32, qs, TK, (cb0 + 1) * 32, r32, hi, o1); }
    __syncthreads();
    st4_nat(TK, tid, sb);
    __syncthreads();
    { const float qs = __builtin_amdgcn_exp2f((float)(128 - nrow) * lb);
      o0 = mm_block_rowscaled(TQ, rb * 32, qs, TK, cb0 * 32, r32, hi, o0); o1 = mm_block_rowscaled(TQ, rb * 32, qs, TK, (cb0 + 1) * 32, r32, hi, o1); }
#pragma unroll
    for (int r = 0; r < 16; ++r) { float s1 = o0[r] + o1[r], s2 = o0[r] * o0[r] + o1[r] * o1[r];
        s1 = sum32(s1); s2 = sum32(s2);
        if (r32 == 0) { ST[(rb * 32 + crow(r, hi)) * 4 + (wid & 1) * 2] = s1; ST[(rb * 32 + crow(r, hi)) * 4 + (wid & 1) * 2 + 1] = s2; } }
    __syncthreads();
    st4_nat(TQ, tid, gv);
    __syncthreads();
    const float* gg = F.in(I_GNG) + li * 512 + h * HD; const float* gb = F.in(I_GNB) + li * 512 + h * HD;
    float g0 = gg[cb0 * 32 + r32], g1 = gg[(cb0 + 1) * 32 + r32], b0 = gb[cb0 * 32 + r32], b1 = gb[(cb0 + 1) * 32 + r32];
#pragma unroll
    for (int r = 0; r < 16; ++r) { const int n = rb * 32 + crow(r, hi); const f32x4 st = *(const LAS f32x4*)(ST + n * 4);
        const float mean = (st[0] + st[2]) * (1.0f / 128.0f), var = (st[1] + st[3]) * (1.0f / 128.0f) - mean * mean, rstd = rsqrtf(var + 1e-5f);
        bf16_t* op = F.O() + (size_t)(row0 + n) * DM + 1024 + h * HD;
        const float gt0 = bf2f(TQ[n * TS + cb0 * 32 + r32]), gt1 = bf2f(TQ[n * TS + (cb0 + 1) * 32 + r32]);
        op[cb0 * 32 + r32] = f2bf(siluf(gt0) * ((o0[r] - mean) * rstd * g0 + b0)); op[(cb0 + 1) * 32 + r32] = f2bf(siluf(gt1) * ((o1[r] - mean) * rstd * g1 + b1)); }
}
}
__device__ __forceinline__ int clampi(int x, int lo, int hi) { return x < lo ? lo : (x > hi ? hi : x); }
__device__ __forceinline__ void unitA(const Ctx& F, int li, int idx) {
    const bool ctxq = idx >= 512; const int bh = ctxq ? idx - 512 : (idx & 7), qb = ctxq ? 0 : (idx >> 3), b = bh >> 2, h = bh & 3;
    LAS float* biasL = (LAS float*)(F.lds + att::BIAS_OFF);
    __syncthreads();
    { const float* rp = F.in(I_RPB) + (size_t)(li * 4 + h) * 15 * 31; for (int i = F.tid; i < 15 * 31; i += 512) biasL[i] = rp[i] * LOG2E; }
    att::Tiles T; att::MP mp{};
    const bf16_t* ctxrow = F.P() + (size_t)(NLAT + b * LCTX) * INW; const bf16_t* latrow = F.P() + (size_t)(b * SEQ) * INW;
    T.kctx = ctxrow + C_AK + h * HD; T.klat = latrow + C_AK + h * HD; T.vdelta = C_AV - C_AK; T.nctx = 4;
    const int r32 = F.lane & 31;
    const int qr0 = qb * 4; const int lo = clampi(qr0 - 4, 0, 248), hi_ = clampi(qr0 - 1, 0, 248) + 7;
    T.lat0 = lo; T.nt = ctxq ? 4 : 4 + (hi_ - lo + 1);
    const size_t qrow = ctxq ? (size_t)(NLAT + b * LCTX) : (size_t)(b * SEQ + qb * 256);
    att::attn_unit_a2(F.P() + qrow * INW + C_AQ + h * HD, T, F.O() + qrow * DM + h * HD, !ctxq, (const LAS float*)(F.lds + att::BIAS_OFF), qr0, F.ldsg, F.tid);
}
__device__ __forceinline__ void unitD(const Ctx& F, int li, int idx) {
    const bool ctxq = idx >= 512; const int bh = ctxq ? idx - 512 : (idx & 7), qb = ctxq ? 0 : (idx >> 3), b = bh >> 2, h = bh & 3, kv = h >> 1;
    att::Tiles T; att::MP mp{};
    const bf16_t* ctxrow = F.P() + (size_t)(NLAT + b * LCTX) * INW; const bf16_t* latrow = F.P() + (size_t)(b * SEQ) * INW;
    T.kctx = ctxrow + C_DK + kv * HD; T.klat = latrow + C_DK + kv * HD; T.vdelta = C_DV - C_DK; T.nctx = 4;
    mp.sink_l2 = F.in(I_SINK)[li * 4 + h] * LOG2E;
    const int lo = qb * 4 - 2 < 0 ? 0 : qb * 4 - 2, hi_ = qb * 4 + 5 > 255 ? 255 : qb * 4 + 5;
    T.lat0 = lo; T.nt = ctxq ? 4 : 4 + (hi_ - lo + 1); mp.masked = !ctxq; mp.tq = qb * 256 + F.wave * 32 + (F.lane & 31);
    const size_t qrow = ctxq ? (size_t)(NLAT + b * LCTX) : (size_t)(b * SEQ + qb * 256);
    att::attn_unit_simple<2>(F.P() + qrow * INW + C_DQ + h * HD, T, F.O() + qrow * DM + 1536 + h * HD, mp, F.ldsg, F.tid);
}
__device__ __forceinline__ void unitB(const Ctx& F, int li, int idx) {
    const bool ctxq = idx >= 1024; const int j = ctxq ? idx - 1024 : idx; const int bh = j & 7, qb = j >> 3, b = bh >> 2, h = bh & 3;
    att::TilesB3 T; att::MP mp{};
    const bf16_t* ctxrow = F.P() + (size_t)(NLAT + b * LCTX) * INW; const bf16_t* latrow = F.P() + (size_t)(b * SEQ) * INW;
    T.kctx = ctxrow + C_BK + h * HD; T.klat = latrow + C_BK + h * HD; T.vdelta = C_BV - C_BK; T.nt = ctxq ? 4 : 4 + SEQ / 64;
    mp.lam = F.misc()[li * 2]; mp.post = 1.0f - F.misc()[li * 2 + 1]; mp.normg = F.in(I_DNG) + li * HD;
    const size_t qrow = (ctxq ? (size_t)(NLAT + b * LCTX) : (size_t)(b * SEQ)) + (size_t)qb * 128;
    att::attn_unit_b3(F.P() + qrow * INW + C_BQ + h * HD, T, F.O() + qrow * DM + 512 + h * HD, mp, (const unsigned*)(F.ws() + WS_CTL + CTL_KMAX) + li * 16 + b * 8 + h * 2, F.ldsg, F.tid);
}

constexpr int LDS_SCRATCH = 147456, LDS_BYTES = LDS_SCRATCH + 256, IDXL_OFF = 131072;
constexpr int N_PHASES = 23;
__global__ void __launch_bounds__(512, 2) fwd_kernel(Args a) {
    extern __shared__ __attribute__((aligned(16))) unsigned char lds_raw[];
    volatile LAS unsigned* misc = (volatile LAS unsigned*)((LAS unsigned char*)lds_raw + LDS_SCRATCH);
    const int wave_s = __builtin_amdgcn_readfirstlane(threadIdx.x >> 6);
    if (wave_s == 0) { const int l0 = hw_lane(); if (l0 < 4) misc[l0] = 0u; }
    __syncthreads();
    const int lo = a.ph_lo, hi = a.ph_hi;
    const bool use_bar = (hi - lo) > 1;
    XcdBarrier bar; bar.bar = (unsigned*)(a.ws + WS_CTL); bar.x = 0; bar.st = misc;
    if (use_bar) bar = xcd_barrier_post((unsigned*)(a.ws + WS_CTL), misc, wave_s == 0 && hw_lane() == 0);
#define FCTX const Ctx F = make_ctx(lds_raw, wave_s)
#ifndef PHMASK
#define PHMASK 0xFFFFFFFFu
#endif
#define EN(j) (((PHMASK) >> (j)) & 1u)
#ifndef REPMASK
#define REPMASK 0u
#endif
#define NREP(j) ((((REPMASK) >> (j)) & 1u) ? 2 : 1)
#define IN(k) (lo <= (k) && (k) < hi)
#ifdef EXP_BAR2
#define SEAM(k) do { if (IN(k) && IN((k) + 1)) { xcd_barrier(bar, wave_s == 0 && hw_lane() == 0); xcd_barrier(bar, wave_s == 0 && hw_lane() == 0); } } while (0)
#else
#define SEAM(k) do { if (IN(k) && IN((k) + 1)) xcd_barrier(bar, wave_s == 0 && hw_lane() == 0); } while (0)
#endif
    for (int rep_ = 0; rep_ < NREP(0); ++rep_) if (EN(0) && IN(0)) { FCTX; ph_mod_partial(F); } SEAM(0);
    for (int rep_ = 0; rep_ < NREP(1); ++rep_) if (EN(1) && IN(1)) { FCTX; ph_mod_reduce(F); ph_convert(F); } SEAM(1);
    const int F_G = gridDim.x;
    for (int li = 0; li < DEPTH; ++li) {
        const int pb = 2 + li * 10;
        for (int rep_ = 0; rep_ < (li == 0 ? NREP(2) : 1); ++rep_) if (EN(2) && IN(pb + 0)) { FCTX; ph_norm1(F, li); } SEAM(pb + 0);
        const bool split_in = use_bar && EN(3) && EN(4) && IN(pb + 1) && IN(pb + 2) && F_G >= 96;
        for (int rep_ = 0; rep_ < NREP(3); ++rep_) if (EN(3) && IN(pb + 1)) {
            if (split_in) {
                { FCTX; pg8::Gemm g{F.H(), F.w_in_t(li), DM, nullptr}; pg8::EpiInProj E{F.P(), F.rope(), (unsigned*)(F.ws() + WS_CTL + CTL_KMAX) + li * 16};
                  pg8::StaticOrder S; S.init(NLAT / 256, INW / 256, F.G, F.wg); pg8::gemm_phase<pg8::EpiInProj, pg8::StaticOrder, false>(F.lds, g, S, E, nullptr, F.tid); }
                xcd_barrier(bar, wave_s == 0 && hw_lane() == 0);
                if (blockIdx.x < 48) { FCTX; pg8::Gemm g{F.H(), F.w_in_t(li), DM, nullptr}; pg8::EpiInProj E{F.P(), F.rope(), (unsigned*)(F.ws() + WS_CTL + CTL_KMAX) + li * 16};
                  pg8::OffsetOrder S; S.init(NCTX / 256, INW / 256, 48, F.wg); S.pm0 = NLAT / 256; pg8::gemm_phase<pg8::EpiInProj, pg8::OffsetOrder, false>(F.lds, g, S, E, nullptr, F.tid); }
                else { FCTX; for (int idx = F.wg - 48; idx < 8 * (NCH - 2); idx += F.G - 48) ret::c1_unit(F, li, idx & 7, 2 + (idx >> 3)); }
            } else {
                FCTX; pg8::Gemm g{F.H(), F.w_in_t(li), DM, nullptr}; pg8::EpiInProj E{F.P(), F.rope(), (unsigned*)(F.ws() + WS_CTL + CTL_KMAX) + li * 16};
                pg8::StaticOrder S; S.init(MTOT / 256, INW / 256, F.G, F.wg);
#ifdef EXP_NOEPI_REP
                if (rep_ == 1) pg8::gemm_phase<pg8::EpiInProj, pg8::StaticOrder, false, true>(F.lds, g, S, E, nullptr, F.tid); else
#endif
                pg8::gemm_phase<pg8::EpiInProj, pg8::StaticOrder, false>(F.lds, g, S, E, nullptr, F.tid);
            }
        } SEAM(pb + 1);
        for (int rep_ = 0; rep_ < NREP(4); ++rep_) if (EN(4) && IN(pb + 2)) {
            FCTX;
            for (int r2_ = 0; r2_ < NREP(15); ++r2_) if (EN(15)) { if (split_in) { for (int idx = F.wg; idx < 16; idx += F.G) ret::c1_unit(F, li, idx & 7, idx >> 3); } else { for (int idx = F.wg; idx < 8 * NCH; idx += F.G) ret::c1_unit(F, li, idx & 7, idx >> 3); } }
            const int nAD = (li == 0) ? 520 : 512;
            for (int r2_ = 0; r2_ < NREP(13); ++r2_) if (EN(13)) for (int idx = F.wg; idx < nAD; idx += F.G) unitA(F, li, idx);
            for (int r2_ = 0; r2_ < NREP(14); ++r2_) if (EN(14)) for (int idx = F.wg; idx < nAD; idx += F.G) unitD(F, li, idx);
        } SEAM(pb + 2);
        for (int rep_ = 0; rep_ < NREP(5); ++rep_) if (EN(5) && IN(pb + 3)) { FCTX; ret::c2_scan(F, li); } SEAM(pb + 3);
        for (int rep_ = 0; rep_ < NREP(6); ++rep_) if (EN(6) && IN(pb + 4)) {
            FCTX; const int nB = (li == 0) ? 1040 : 1024;
            if (EN(16)) for (int idx = F.wg; idx < nB; idx += F.G) unitB(F, li, idx);
            for (int r2_ = 0; r2_ < NREP(17); ++r2_) if (EN(17)) for (int idx = F.wg; idx < nB; idx += F.G) { if (idx < 1024) ret::c3_unit(F, li, idx & 7, 2 + (idx >> 3)); else ret::c3_unit(F, li, (idx - 1024) & 7, (idx - 1024) >> 3); }
        } SEAM(pb + 4);
        const bool split_out = use_bar && li == 0 && EN(7) && EN(8) && IN(pb + 5) && IN(pb + 6) && F_G >= 64;
        for (int rep_ = 0; rep_ < (li == 0 ? NREP(7) : 1); ++rep_) if (EN(7) && IN(pb + 5)) {
            FCTX; pg8::Gemm g{F.O(), F.w_out_t(li), DM, nullptr};
            pg8::EpiOutProj E{li == 0 ? F.in(I_X) : nullptr, F.xb(), F.xb(), F.in(I_CTX), F.xc(), F.mod() + (size_t)li * 3 * 12288};
            pg8::StaticOrder S; S.init((li == 0 && !split_out) ? MTOT / 256 : NLAT / 256, DM / 256, F.G, F.wg);
            pg8::gemm_phase<pg8::EpiOutProj, pg8::StaticOrder, false>(F.lds, g, S, E, nullptr, F.tid);
        } SEAM(pb + 5);
        for (int rep_ = 0; rep_ < NREP(8); ++rep_) if (EN(8) && IN(pb + 6)) {
            if (split_out) {
                if (blockIdx.x < 16) { FCTX; pg8::Gemm g{F.O(), F.w_out_t(li), DM, nullptr}; pg8::EpiOutProj E{F.in(I_X), F.xb(), F.xb(), F.in(I_CTX), F.xc(), F.mod() + (size_t)li * 3 * 12288};
                    pg8::OffsetOrder S; S.init(NCTX / 256, DM / 256, 16, F.wg); S.pm0 = NLAT / 256; pg8::gemm_phase<pg8::EpiOutProj, pg8::OffsetOrder, false>(F.lds, g, S, E, nullptr, F.tid); }
                else { FCTX; ph_norm2(F, li, 0, NLAT, 16, F.G - 16); }
                xcd_barrier(bar, wave_s == 0 && hw_lane() == 0);
                if (blockIdx.x < 16) { FCTX; ph_norm2(F, li, NLAT, MTOT, 0, 16); }
            } else { FCTX; ph_norm2(F, li, 0, NLAT, 0, F.G); if (li == 0) ph_norm2(F, li, NLAT, MTOT, 0, F.G); }
        } SEAM(pb + 6);
        for (int rep_ = 0; rep_ < NREP(9); ++rep_) if (EN(9) && IN(pb + 7)) { FCTX; ph_topk(F, li); } SEAM(pb + 7);
        for (int rep_ = 0; rep_ < NREP(10); ++rep_) if (EN(10) && IN(pb + 8)) {
            FCTX; pg8::Gemm g{F.H(), F.w_gu_t(li), DM, F.rowidx()}; pg8::MoeOrder S; S.init(li == 0 ? 272 : 256, 8, F.G, F.wg); pg8::EpiSwiGLU E{F.ACT()};
            pg8::gemm_phase<pg8::EpiSwiGLU, pg8::MoeOrder, true>(F.lds, g, S, E, (LAS int*)(F.lds + IDXL_OFF), F.tid);
        } SEAM(pb + 8);
        for (int rep_ = 0; rep_ < NREP(11); ++rep_) if (EN(11) && IN(pb + 9)) {
            FCTX; pg8::Gemm g{F.ACT(), F.w_dn_t(li), FF, nullptr}; pg8::MoeOrder S; S.init(li == 0 ? 272 : 256, 8, F.G, F.wg); pg8::EpiDown E{F.Y(), F.gatev()};
            pg8::gemm_phase<pg8::EpiDown, pg8::MoeOrder, false>(F.lds, g, S, E, nullptr, F.tid);
        } SEAM(pb + 9);
    }
    for (int rep_ = 0; rep_ < NREP(12); ++rep_) if (EN(12) && IN(22)) { FCTX; ph_final(F); }
#undef IN
#undef SEAM
#undef FCTX
}

#ifndef N_LAUNCHES
#define N_LAUNCHES 1
#endif
extern "C" void kernel_launch(void* const* d_in, const int* in_sizes, int n_in, void* d_out, int out_size, void* d_ws, size_t ws_size, hipStream_t stream) {
    static int grid = 0;
    if (grid == 0) {
        if (n_in != 23 || out_size != NLAT * DM || ws_size < WS_END) { fprintf(stderr, "kernel_launch: unexpected shapes: n_in %d out %d ws %zu (need %zu)\n", n_in, out_size, ws_size, (size_t)WS_END); grid = -1; return; }
        int dev = 0, cus = 0, per_cu = 0;
        if (hipGetDevice(&dev) != hipSuccess || hipDeviceGetAttribute(&cus, hipDeviceAttributeMultiprocessorCount, dev) != hipSuccess) { grid = -1; return; }
        if (hipFuncSetAttribute((const void*)fwd_kernel, hipFuncAttributeMaxDynamicSharedMemorySize, LDS_BYTES) != hipSuccess) { fprintf(stderr, "kernel_launch: hipFuncSetAttribute failed\n"); grid = -1; return; }
        if (hipOccupancyMaxActiveBlocksPerMultiprocessor(&per_cu, (const void*)fwd_kernel, 512, LDS_BYTES) != hipSuccess || per_cu < 1) fprintf(stderr, "kernel_launch: occupancy query says %d\n", per_cu);
        (void)hipGetLastError();
        grid = cus;
    }
    if (grid < 0) return;
    hipMemsetAsync((char*)d_ws + WS_CTL, 0, CTL_BYTES, stream);
    Args a{};
    for (int i = 0; i < 23; ++i) a.in[i] = (const float*)d_in[i];
    a.out = (float*)d_out; a.ws = (unsigned char*)d_ws;
    for (int k = 0; k < N_LAUNCHES; ++k) {
        a.ph_lo = (N_LAUNCHES == 1) ? 0 : k; a.ph_hi = (N_LAUNCHES == 1) ? N_PHASES : k + 1;
        hipLaunchKernelGGL(fwd_kernel, dim3(grid), dim3(512), LDS_BYTES, stream, a);
    }
    const hipError_t le = hipPeekAtLastError();
    if (le != hipSuccess) fprintf(stderr, "kernel_launch: launch failed: %s\n", hipGetErrorName(le));
}
```

```cpp
#include <hip/hip_runtime.h>
#include <cstdio>
#include <cstdint>

#define LAS __attribute__((address_space(3)))
typedef unsigned short bf16_t;
typedef short bf16x8 __attribute__((ext_vector_type(8)));
typedef short s16x4 __attribute__((ext_vector_type(4)));
typedef float f32x4 __attribute__((ext_vector_type(4)));
typedef float f32x2 __attribute__((ext_vector_type(2)));
typedef float f32x16 __attribute__((ext_vector_type(16)));
typedef unsigned u32x4 __attribute__((ext_vector_type(4)));
typedef unsigned u32x2 __attribute__((ext_vector_type(2)));

constexpr int DM = 2048, NBATCH = 2, SEQ = 16384, LCTX = 256, DEPTH = 2;
constexpr int NLAT = NBATCH * SEQ;
constexpr int NCTX = NBATCH * LCTX;
constexpr int MTOT = NLAT + NCTX;
constexpr int INW = 6144;
constexpr int HD = 128;
constexpr int NE = 16, FF = 1024, CAP = 2048, CAPC = 32;
constexpr int MOE_ROWS = NBATCH * NE * CAP + NE * 256;
constexpr int NCH = 130;
constexpr int C_AQ = 0, C_AK = 512, C_AV = 1024, C_BQ = 1536, C_BK = 2048, C_BV = 2560, C_CQ = 3072, C_CK = 3584, C_CV = 4096, C_CG = 4608, C_DQ = 5120, C_DK = 5632, C_DV = 5888;
constexpr float LOG2E = 1.4426950408889634f;
constexpr float NEGBIG = -1e30f;

constexpr size_t al256(size_t x) { return (x + 255) / 256 * 256; }
constexpr size_t WS_CTL = 0;
constexpr size_t CTL_BYTES = 65536;
constexpr size_t WS_MODP = WS_CTL + CTL_BYTES;
constexpr size_t WS_MOD = WS_MODP + al256((size_t)16 * 2 * 3 * 12288 * 4);
constexpr size_t WS_MISC = WS_MOD + al256((size_t)2 * 3 * 12288 * 4);
constexpr size_t WS_ROPE = WS_MISC + 256;
constexpr size_t WS_XC = WS_ROPE + al256((size_t)(256 * 32 * 2 + 256 * 16 * 2) * 4);
constexpr size_t WS_AFF = WS_XC + al256((size_t)NCTX * DM * 4);
constexpr size_t WS_ROWIDX = WS_AFF + al256((size_t)MTOT * NE * 4);
constexpr size_t WS_GATEV = WS_ROWIDX + al256((size_t)MOE_ROWS * 4);
constexpr size_t WS_SLOT = WS_GATEV + al256((size_t)MOE_ROWS * 4);
constexpr size_t WS_H = WS_SLOT + al256((size_t)MTOT * NE * 4);
constexpr size_t H_BYTES = (size_t)MTOT * DM * 2;
constexpr size_t WS_P = WS_H + al256(H_BYTES);
constexpr size_t P_BYTES = (size_t)MTOT * INW * 2;
constexpr size_t WS_O = WS_P + al256(P_BYTES);
constexpr size_t WS_S = WS_O + al256(H_BYTES);
constexpr size_t S_BYTES = (size_t)2 * 8 * NCH * 16384 * 2;
constexpr size_t WS_W = WS_S + al256(S_BYTES);
constexpr size_t W_IN_B = (size_t)INW * DM * 2, W_OUT_B = (size_t)DM * DM * 2, W_GU_B = (size_t)NE * 2048 * DM * 2, W_DN_B = (size_t)NE * DM * FF * 2;
constexpr size_t WL_IN = 0, WL_OUT = WL_IN + W_IN_B, WL_GU = WL_OUT + W_OUT_B, WL_DN = WL_GU + W_GU_B, WL_BYTES = WL_DN + W_DN_B;
constexpr size_t WS_XB = WS_W + 2 * WL_BYTES;
constexpr size_t WS_END = WS_XB + al256((size_t)NLAT * DM * 2);
constexpr size_t ACT_OFF = 0;
constexpr size_t Y_OFF = al256((size_t)MOE_ROWS * FF * 2);
static_assert(Y_OFF + (size_t)MOE_ROWS * DM * 2 <= al256(P_BYTES) + H_BYTES, "Y must fit in P + O");
static_assert((size_t)2 * 8 * NCH * 16384 * 2 <= (size_t)NLAT * DM * 2, "retention U (bf16) must fit in the latent part of H");

__device__ __forceinline__ unsigned cvt_pk_bf16(float lo, float hi) { unsigned r; asm volatile("v_cvt_pk_bf16_f32 %0, %1, %2" : "=v"(r) : "v"(lo), "v"(hi)); return r; }
__device__ __forceinline__ bf16_t f2bf(float f) { return (bf16_t)(cvt_pk_bf16(f, 0.f) & 0xffffu); }
__device__ __forceinline__ float bf2f(bf16_t b) { return __uint_as_float(((unsigned)b) << 16); }
__device__ __forceinline__ float bflo(unsigned w) { return __uint_as_float(w << 16); }
__device__ __forceinline__ float bfhi(unsigned w) { return __uint_as_float(w & 0xffff0000u); }
__device__ __forceinline__ float siluf(float x) { return x / (1.0f + __expf(-x)); }
template <int M> __device__ __forceinline__ float xshf(float v) { return __int_as_float(__builtin_amdgcn_ds_swizzle(__float_as_int(v), (M << 10) | 0x1f)); }
__device__ __forceinline__ float sum32(float s) { s += xshf<1>(s); s += xshf<2>(s); s += xshf<4>(s); s += xshf<8>(s); s += xshf<16>(s); return s; }
__device__ __forceinline__ float sum64(float s) { s = sum32(s); auto rr = __builtin_amdgcn_permlane32_swap(__float_as_uint(s), __float_as_uint(s), false, false); return __uint_as_float(rr[0]) + __uint_as_float(rr[1]); }
__device__ __forceinline__ unsigned lane_up(unsigned v, int lane, int o) { return (unsigned)__builtin_amdgcn_ds_bpermute((lane - o) << 2, (int)v); }
__device__ __forceinline__ int crow(int r, int hi) { return (r & 3) + 8 * (r >> 2) + 4 * hi; }

#define XB_TMO      128
#define XB_XCNT(j)  (256  + 64 * (j))
#define XB_XSUB(j)  (1280 + 64 * (j))
#define XB_XGEN(j)  (2304 + 64 * (j))
#define XB_TOP      3328
#define XB_TOPGEN   3392
#define XCD_BAR_WORDS 3456
#define XB_SPIN_CAP (1u << 24)
__device__ __forceinline__ unsigned xb_ld(unsigned* p)              { return __hip_atomic_load(p, __ATOMIC_RELAXED, __HIP_MEMORY_SCOPE_AGENT); }
__device__ __forceinline__ unsigned xb_add(unsigned* p, unsigned v) { return __hip_atomic_fetch_add(p, v, __ATOMIC_RELAXED, __HIP_MEMORY_SCOPE_AGENT); }
__device__ __forceinline__ unsigned xb_xcc_id() { return (unsigned)__builtin_amdgcn_s_getreg((3 << 11) | 20) & 0xFu; }
#define XB_SPIN(cond, bar) do { unsigned _sp = 0; while (cond) { __builtin_amdgcn_s_sleep(1); \
    if ((++_sp & 255u) == 0u) { if (xb_ld(&(bar)[XB_TMO])) break; if (_sp > XB_SPIN_CAP) { atomicAdd(&(bar)[XB_TMO], 1u); break; } } } } while (0)
struct XcdBarrier { unsigned* bar; unsigned x; volatile LAS unsigned* st; };
__device__ __forceinline__ XcdBarrier xcd_barrier_post(unsigned* bar, volatile LAS unsigned* st, bool leader) {
    XcdBarrier b; b.bar = bar; b.x = xb_xcc_id(); b.st = st;
    if (leader) (void)xb_add(&bar[XB_XCNT(b.x)], 1u);
    return b;
}
__device__ __forceinline__ void xcd_barrier_complete(unsigned* bar, unsigned x, unsigned& nloc, unsigned& nx) {
    const unsigned G = gridDim.x * gridDim.y * gridDim.z;
    unsigned sum, cnt, mine, sp = 0u;
    for (;;) {
        sum = 0u; cnt = 0u; mine = 0u;
#pragma unroll
        for (unsigned j = 0; j < 16; ++j) { const unsigned c = xb_ld(&bar[XB_XCNT(j)]); sum += c; cnt += (c > 0u) ? 1u : 0u; mine = (j == x) ? c : mine; }
        if (sum == G) break;
        __builtin_amdgcn_s_sleep(1);
        if ((++sp & 255u) == 0u) { if (xb_ld(&bar[XB_TMO])) break; if (sp > XB_SPIN_CAP) { atomicAdd(&bar[XB_TMO], 1u); break; } }
    }
    nloc = mine > 0u ? mine : 1u; nx = cnt > 0u ? cnt : 1u;
}
__device__ __forceinline__ void xcd_barrier(const XcdBarrier& b, bool leader) {
    asm volatile("s_waitcnt vmcnt(0)" ::: "memory");
    __syncthreads();
    if (leader) {
        unsigned* bar = b.bar;
        __builtin_amdgcn_s_waitcnt(0);
        unsigned nloc = b.st[0], nx = b.st[1];
        if (nloc == 0u) { xcd_barrier_complete(bar, b.x, nloc, nx); b.st[0] = nloc; b.st[1] = nx; }
        const unsigned old = xb_add(&bar[XB_XSUB(b.x)], 1u);
        const unsigned gen = old / nloc;
        if (old + 1u == (gen + 1u) * nloc) {
            __builtin_amdgcn_fence(__ATOMIC_RELEASE, "agent");
            asm volatile("s_waitcnt vmcnt(0)" ::: "memory");
            const unsigned og = xb_add(&bar[XB_TOP], 1u);
            const unsigned tg = og / nx;
            if (og + 1u == (tg + 1u) * nx) xb_add(&bar[XB_TOPGEN], 1u);
            else XB_SPIN(xb_ld(&bar[XB_TOPGEN]) == tg, bar);
            __builtin_amdgcn_fence(__ATOMIC_ACQUIRE, "agent");
            xb_add(&bar[XB_XGEN(b.x)], 1u);
            asm volatile("s_waitcnt vmcnt(0)" ::: "memory");
        } else {
            XB_SPIN(xb_ld(&bar[XB_XGEN(b.x)]) == gen, bar);
            __builtin_amdgcn_fence(__ATOMIC_ACQUIRE, "agent");
            asm volatile("s_waitcnt vmcnt(0)" ::: "memory");
        }
    }
    __syncthreads();
}
namespace pg8 {
constexpr int BM = 256, BK = 64, HALF = 128, HTB = HALF * BK * 2, STAGE_BYTES = 8 * HTB, NXCD = 8, WGM = 8;
__host__ __device__ __forceinline__ int lds_byte(int r, int c) { const int st = (r >> 4) * 2 + (c >> 5), rr = r & 15, cc = c & 31, ob = rr * 64 + cc * 2; return st * 1024 + (ob ^ (((ob >> 9) & 1) << 5)); }
__host__ __device__ __forceinline__ void stage_rc(int b, int& R, int& C) { const int st = b / 1024, sb = b % 1024, swz = sb ^ (((sb >> 9) & 1) << 5); R = (st >> 1) * 16 + swz / 64; C = (st & 1) * 32 + (swz % 64) / 2; }
__host__ __device__ __forceinline__ int perm32(int rho) { const int n = rho >> 4, i = rho & 15; return 8 * (i >> 2) + 4 * n + (i & 3); }

struct Unit { int pm, pn; };
struct Gemm { const bf16_t* A; const bf16_t* Bt; int K; const int* rowidx; };

struct StaticOrder {
    int nM, nN, nwg, G, c;
    __device__ void init(int nM_, int nN_, int G_, int c_) { nM = nM_; nN = nN_; nwg = nM * nN; G = G_; c = c_; }
    __device__ bool next(int i, Unit& u) const {
        const long L = (long)i * G + c; if (L >= nwg) return false;
        int wgid = (int)L; { const int q = nwg / NXCD, r = nwg % NXCD, xcd = wgid % NXCD, off = wgid / NXCD; wgid = (xcd < r ? xcd * (q + 1) : r * (q + 1) + (xcd - r) * q) + off; }
        const int nig = WGM * nN, gid = wgid / nig, fm = gid * WGM, gsz = (nM - fm) < WGM ? (nM - fm) : WGM;
        u.pm = fm + ((wgid % nig) % gsz); u.pn = (wgid % nig) / gsz; return true;
    }
};
struct OffsetOrder : StaticOrder {
    int pm0;
    __device__ bool next(int i, Unit& u) const { if (!StaticOrder::next(i, u)) return false; u.pm += pm0; return true; }
};
__device__ __forceinline__ int moe_expert_of_tile(int pm) { return pm < 256 ? ((pm >> 3) & 15) : (pm - 256); }
struct MoeOrder : StaticOrder {
    __device__ bool next(int i, Unit& u) const { if (!StaticOrder::next(i, u)) return false; u.pn += moe_expert_of_tile(u.pm) * 8; return true; }
};

template <class Epi, class Sched, bool GATHER, bool NOEPI = false>
__device__ __forceinline__ void gemm_phase(LAS unsigned char* lds, const Gemm g, const Sched& S, const Epi& E, LAS int* idxl, const int tid) {
    const int wid = __builtin_amdgcn_readfirstlane(tid >> 6), lane = tid & 63, wr = wid >> 2, wc = wid & 3, fr = lane & 15, fq = lane >> 4;
    const int K = g.K, nt = K / BK;
    unsigned voffA[2], voffB[2]; int RA[2];
#pragma unroll
    for (int i = 0; i < 2; ++i) { int R, C; stage_rc(tid * 16 + i * 8192, R, C); const int Rb = Epi::PERM ? ((R & ~31) + perm32(R & 31)) : R;
        voffA[i] = (unsigned)(R * K + C) * 2u; voffB[i] = (unsigned)(Rb * K + C) * 2u; RA[i] = R; if (GATHER) voffA[i] = (unsigned)C * 2u; }
    const size_t kstep = (size_t)(BK * 2);
    const size_t hstep = (size_t)HALF * K * 2;
    const size_t tstep = 2 * hstep;
    const unsigned ldsw = (unsigned)wid * 1024u;
    const int aoff = lds_byte(wr * 64 + fr, fq * 8), boff = lds_byte(wc * 32 + fr, fq * 8);
#define PG8_SA(b, h) (((b) * 2 + (h)) * HTB)
#define PG8_SB(b, h) ((4 + (b) * 2 + (h)) * HTB)
#define PG8_STAGE(bufoff, gbase, voff) do { _Pragma("unroll") for (int _i = 0; _i < 2; ++_i) \
        __builtin_amdgcn_global_load_lds((const unsigned*)((const char*)(gbase) + (voff)[_i]), (LAS unsigned*)(lds + (bufoff) + ldsw + _i * 8192), 16, 0, 0); } while (0)
#define PG8_STAGE_A(bufoff, h, pA, offs) do { _Pragma("unroll") for (int _i = 0; _i < 2; ++_i) { const char* _p; \
        if constexpr (GATHER) _p = (const char*)(pA) + (offs)[h][_i]; else _p = (const char*)(pA) + (size_t)(h) * hstep + voffA[_i]; \
        __builtin_amdgcn_global_load_lds((const unsigned*)_p, (LAS unsigned*)(lds + (bufoff) + ldsw + _i * 8192), 16, 0, 0); } } while (0)
#define PG8_LDA(dst, b, h) do { _Pragma("unroll") for (int m = 0; m < 4; ++m) _Pragma("unroll") for (int k = 0; k < 2; ++k) dst[m][k] = *(const LAS bf16x8*)(lds + PG8_SA(b, h) + aoff + m * 2048 + k * 1024); } while (0)
#define PG8_LDB(dst, b, h) do { _Pragma("unroll") for (int n = 0; n < 2; ++n) _Pragma("unroll") for (int k = 0; k < 2; ++k) dst[n][k] = *(const LAS bf16x8*)(lds + PG8_SB(b, h) + boff + n * 2048 + k * 1024); } while (0)
#define PG8_MMA(ai, bj, At, Bt) do { __builtin_amdgcn_s_setprio(1); _Pragma("unroll") for (int m = 0; m < 4; ++m) _Pragma("unroll") for (int n = 0; n < 2; ++n) _Pragma("unroll") for (int k = 0; k < 2; ++k) \
        acc[ai][bj][m][n] = __builtin_amdgcn_mfma_f32_16x16x32_bf16(Bt[n][k], At[m][k], acc[ai][bj][m][n], 0, 0, 0); __builtin_amdgcn_s_setprio(0); } while (0)
#define PG8_WAIT_V(n) asm volatile("s_waitcnt vmcnt(" #n ")" ::: "memory")
#define PG8_WAIT_L(n) asm volatile("s_waitcnt lgkmcnt(" #n ")" ::: "memory")
#define PG8_BAR __builtin_amdgcn_s_barrier()
#define PG8_SCHED __builtin_amdgcn_sched_barrier(0)
    Unit cur, nxt; int ui = 0;
    if (!S.next(0, cur)) return;
    f32x4 acc[2][2][4][2];
#pragma unroll
    for (int a = 0; a < 2; ++a)
#pragma unroll
        for (int b = 0; b < 2; ++b)
#pragma unroll
            for (int m = 0; m < 4; ++m)
#pragma unroll
                for (int n = 0; n < 2; ++n) acc[a][b][m][n] = (f32x4){0.f, 0.f, 0.f, 0.f};
    bf16x8 At[4][2], B0[2][2], B1[2][2];
    unsigned oc[2][2] = {{0u, 0u}, {0u, 0u}}, on[2][2] = {{0u, 0u}, {0u, 0u}};
#define PG8_GOFF(dst, ui_) do { if constexpr (GATHER) { _Pragma("unroll") for (int _h = 0; _h < 2; ++_h) _Pragma("unroll") for (int _i = 0; _i < 2; ++_i) \
        dst[_h][_i] = (unsigned)idxl[(ui_) * BM + _h * HALF + RA[_i]] * (unsigned)(K * 2) + voffA[_i]; } } while (0)
    if constexpr (GATHER) {
        for (int i = 0; i < 16; ++i) { Unit uu; if (!S.next(i, uu)) break; if (tid < BM) idxl[i * BM + tid] = g.rowidx[uu.pm * BM + tid]; }
        __syncthreads();
    }
    PG8_GOFF(oc, 0);
    const char* cA = GATHER ? (const char*)g.A : (const char*)g.A + (size_t)cur.pm * tstep; const char* cB = (const char*)g.Bt + (size_t)cur.pn * tstep;
    PG8_STAGE(PG8_SB(0, 0), cB, voffB); PG8_STAGE(PG8_SB(0, 1), cB + hstep, voffB); PG8_STAGE_A(PG8_SA(0, 0), 0, cA, oc); PG8_STAGE_A(PG8_SA(0, 1), 1, cA, oc);
    if (wr == 1) PG8_BAR;
    PG8_WAIT_V(2); PG8_BAR;
    PG8_STAGE(PG8_SB(1, 0), cB + kstep, voffB); PG8_STAGE_A(PG8_SA(1, 0), 0, cA + kstep, oc); PG8_STAGE(PG8_SB(1, 1), cB + hstep + kstep, voffB);
    PG8_WAIT_V(6); PG8_BAR;
    for (;;) {
        const bool has_next = S.next(ui + 1, nxt);
        if (has_next) PG8_GOFF(on, ui + 1); else { if constexpr (GATHER) { on[0][0] = oc[0][0]; on[0][1] = oc[0][1]; on[1][0] = oc[1][0]; on[1][1] = oc[1][1]; } }
        const char* nA = GATHER ? (const char*)g.A : (has_next ? (const char*)g.A + (size_t)nxt.pm * tstep : cA);
        const char* nB = has_next ? (const char*)g.Bt + (size_t)nxt.pn * tstep : cB;
        for (int t = 0; t < nt; t += 2) {
            const bool last = (t == nt - 2);
            const char* a1 = cA + (size_t)(t + 1) * kstep;
            const char* a2 = last ? nA : cA + (size_t)(t + 2) * kstep; const char* b2 = last ? nB : cB + (size_t)(t + 2) * kstep;
            const char* a3 = a2 + kstep; const char* b3 = b2 + kstep;
            unsigned o2[2][2];
#pragma unroll
            for (int _h = 0; _h < 2; ++_h)
#pragma unroll
                for (int _i = 0; _i < 2; ++_i) o2[_h][_i] = last ? on[_h][_i] : oc[_h][_i];
            PG8_LDB(B0, 0, 0); PG8_LDB(B1, 0, 1); PG8_SCHED; PG8_LDA(At, 0, 0); PG8_STAGE_A(PG8_SA(1, 1), 1, a1, oc);
            PG8_WAIT_V(8); PG8_WAIT_L(0); PG8_BAR; PG8_MMA(0, 0, At, B0); PG8_MMA(0, 1, At, B1); PG8_BAR; PG8_SCHED;
            PG8_LDA(At, 0, 1); PG8_STAGE(PG8_SB(0, 0), b2, voffB); PG8_STAGE(PG8_SB(0, 1), b2 + hstep, voffB); PG8_STAGE_A(PG8_SA(0, 0), 0, a2, o2);
            PG8_WAIT_V(8); PG8_WAIT_L(0); PG8_BAR; PG8_MMA(1, 0, At, B0); PG8_MMA(1, 1, At, B1); PG8_BAR; PG8_SCHED;
            PG8_LDB(B0, 1, 0); PG8_LDB(B1, 1, 1); PG8_SCHED; PG8_LDA(At, 1, 0); PG8_STAGE_A(PG8_SA(0, 1), 1, a2, o2);
            PG8_WAIT_V(8); PG8_WAIT_L(0); PG8_BAR; PG8_MMA(0, 0, At, B0); PG8_MMA(0, 1, At, B1); PG8_BAR; PG8_SCHED;
            PG8_LDA(At, 1, 1); PG8_STAGE(PG8_SB(1, 0), b3, voffB); PG8_STAGE(PG8_SB(1, 1), b3 + hstep, voffB); PG8_STAGE_A(PG8_SA(1, 0), 0, a3, o2);
            PG8_WAIT_V(8); PG8_WAIT_L(0); PG8_BAR; PG8_MMA(1, 0, At, B0); PG8_MMA(1, 1, At, B1); PG8_BAR; PG8_SCHED;
        }
        if (wr == 0) PG8_BAR;
        if constexpr (!NOEPI) E(acc, cur, wr, wc, fr, fq); else { float d_ = 0.f; _Pragma("unroll") for (int a_ = 0; a_ < 2; ++a_) _Pragma("unroll") for (int b_ = 0; b_ < 2; ++b_) _Pragma("unroll") for (int m_ = 0; m_ < 4; ++m_) _Pragma("unroll") for (int n_ = 0; n_ < 2; ++n_) d_ += acc[a_][b_][m_][n_][0] + acc[a_][b_][m_][n_][3]; if (d_ == 1.2345e30f) ((float*)g.A)[0] = d_; }
#ifdef EXP_EPI2
        if constexpr (Epi::PERM && !GATHER && sizeof(Epi) == 16) { asm volatile("" ::: "memory"); E(acc, cur, wr, wc, fr, fq); }
#endif
        if (!has_next) break;
#pragma unroll
        for (int a = 0; a < 2; ++a)
#pragma unroll
            for (int b = 0; b < 2; ++b)
#pragma unroll
                for (int m = 0; m < 4; ++m)
#pragma unroll
                    for (int n = 0; n < 2; ++n) acc[a][b][m][n] = (f32x4){0.f, 0.f, 0.f, 0.f};
        cur = nxt; cA = nA; cB = nB; ++ui;
        if constexpr (GATHER) { oc[0][0] = on[0][0]; oc[0][1] = on[0][1]; oc[1][0] = on[1][0]; oc[1][1] = on[1][1]; }
        if (wr == 1) PG8_BAR;
    }
    PG8_WAIT_V(0);
    PG8_BAR;
#undef PG8_SA
#undef PG8_SB
#undef PG8_STAGE
#undef PG8_STAGE_A
#undef PG8_GOFF
#undef PG8_LDA
#undef PG8_LDB
#undef PG8_MMA
#undef PG8_WAIT_V
#undef PG8_WAIT_L
#undef PG8_BAR
#undef PG8_SCHED
}

__device__ __forceinline__ u32x4 pack8(const f32x4 a, const f32x4 b) { u32x4 w; w.x = cvt_pk_bf16(a[0], a[1]); w.y = cvt_pk_bf16(a[2], a[3]); w.z = cvt_pk_bf16(b[0], b[1]); w.w = cvt_pk_bf16(b[2], b[3]); return w; }

struct EpiInProj {
    static constexpr bool PERM = true;
    bf16_t* P; const float* rope;
    unsigned* kmax;
    unsigned* kmaxAD;
    __device__ __forceinline__ void operator()(const f32x4 (&acc)[2][2][4][2], const Unit& u, int wr, int wc, int fr, int fq) const {
        const int pn = u.pn; const bool lat = u.pm < (NLAT / 256);
        const int kind = (pn >= 6 && pn <= 9) ? 2 : (((pn >= 12 && pn <= 15) || (pn >= 20 && pn <= 22)) ? 1 : 0);
        const int row0 = u.pm * BM + wr * 64 + fr;
        if (kind == 0) {
            const int col0 = pn * 256 + wc * 32 + 8 * fq; const bool kA = (pn == 2 || pn == 3); float kqa[2] = {0.f, 0.f};
#pragma unroll
            for (int ai = 0; ai < 2; ++ai)
#pragma unroll
                for (int m = 0; m < 4; ++m) { bf16_t* rowp = P + (size_t)(row0 + ai * HALF + m * 16) * INW + col0;
#pragma unroll
                    for (int bj = 0; bj < 2; ++bj) { const u32x4 w = pack8(acc[ai][bj][m][0], acc[ai][bj][m][1]); *(u32x4*)(rowp + bj * HALF) = w;
                        if (kA) { float q2 = bflo(w.x) * bflo(w.x) + bfhi(w.x) * bfhi(w.x) + bflo(w.y) * bflo(w.y) + bfhi(w.y) * bfhi(w.y) + bflo(w.z) * bflo(w.z) + bfhi(w.z) * bfhi(w.z) + bflo(w.w) * bflo(w.w) + bfhi(w.w) * bfhi(w.w);
                            q2 += xshf<16>(q2); { auto rr = __builtin_amdgcn_permlane32_swap(__float_as_uint(q2), __float_as_uint(q2), false, false); q2 = __uint_as_float(rr[0]) + __uint_as_float(rr[1]); }
                            kqa[bj] = fmaxf(kqa[bj], q2); } } }
            if (kA) {
#pragma unroll
                for (int bj = 0; bj < 2; ++bj) { float kq = kqa[bj]; kq = fmaxf(kq, xshf<1>(kq)); kq = fmaxf(kq, xshf<2>(kq)); kq = fmaxf(kq, xshf<4>(kq)); kq = fmaxf(kq, xshf<8>(kq));
                    if (fr == 0 && fq == 0) __hip_atomic_fetch_max(kmaxAD + (lat ? (u.pm >> 6) : (u.pm - NLAT / 256)) * 16 + ((pn - 2) * 2 + bj) * 4 + wc, __float_as_uint(kq), __ATOMIC_RELAXED, __HIP_MEMORY_SCOPE_AGENT); } }
        } else {
            const bool k1 = kind == 1; const int nf = k1 ? 32 : 16, pstep = k1 ? 32 : 16;
            const int cu1 = k1 ? pn * 256 + (wc >> 1) * 128 + (wc & 1) * 64 + 8 * fq : pn * 256 + wc * 64 + (fq >> 1) * 32 + 8 * (fq & 1);
            const int i0 = k1 ? 8 * fq : 8 * (fq & 1); const bool colp = k1 ? ((wc & 1) != 0) : ((fq >> 1) != 0);
            const float* TC = k1 ? rope : rope + 2 * 256 * 32; const float* TS = TC + 256 * nf;
            const int trow0 = ((u.pm * BM) & (SEQ - 1)) / 64 + wr;
            f32x4 nc0, nc1, ns0, ns1; float kq = 0.f;
#define RP_LOAD(g_) do { const int pos_ = colp ? (fr + 16 * ((g_) & 3)) : (trow0 + 2 * ((g_) >> 2)); const float* pc_ = TC + pos_ * nf + i0; const float* ps_ = TS + pos_ * nf + i0; \
                nc0 = *(const f32x4*)(pc_); nc1 = *(const f32x4*)(pc_ + 4); ns0 = *(const f32x4*)(ps_); ns1 = *(const f32x4*)(ps_ + 4); } while (0)
            if (lat) RP_LOAD(0);
#pragma unroll
            for (int gidx = 0; gidx < 8; ++gidx) { const int ai = gidx >> 2, m = gidx & 3; const int row = row0 + ai * HALF + m * 16;
                f32x4 a0 = acc[ai][0][m][0], a1 = acc[ai][0][m][1], b0 = acc[ai][1][m][0], b1 = acc[ai][1][m][1];
                if (lat) { const f32x4 c0 = nc0, c1 = nc1, s0 = ns0, s1 = ns1;
                    if (gidx < 7) RP_LOAD(gidx + 1);
                    const f32x4 x0 = a0 * c0 - b0 * s0, x1 = a1 * c1 - b1 * s1, y0 = b0 * c0 + a0 * s0, y1 = b1 * c1 + a1 * s1; a0 = x0; a1 = x1; b0 = y0; b1 = y1; }
                bf16_t* rowp = P + (size_t)row * INW + cu1;
                const u32x4 w0 = pack8(a0, a1), w1 = pack8(b0, b1); *(u32x4*)(rowp) = w0; *(u32x4*)(rowp + pstep) = w1;
                if (pn == 8 || pn == 9 || pn == 22) {
                    float q2 = bflo(w0.x) * bflo(w0.x) + bfhi(w0.x) * bfhi(w0.x) + bflo(w0.y) * bflo(w0.y) + bfhi(w0.y) * bfhi(w0.y) + bflo(w0.z) * bflo(w0.z) + bfhi(w0.z) * bfhi(w0.z) + bflo(w0.w) * bflo(w0.w) + bfhi(w0.w) * bfhi(w0.w)
                             + bflo(w1.x) * bflo(w1.x) + bfhi(w1.x) * bfhi(w1.x) + bflo(w1.y) * bflo(w1.y) + bfhi(w1.y) * bfhi(w1.y) + bflo(w1.z) * bflo(w1.z) + bfhi(w1.z) * bfhi(w1.z) + bflo(w1.w) * bflo(w1.w) + bfhi(w1.w) * bfhi(w1.w);
                    q2 += xshf<16>(q2); { auto rr = __builtin_amdgcn_permlane32_swap(__float_as_uint(q2), __float_as_uint(q2), false, false); q2 = __uint_as_float(rr[0]) + __uint_as_float(rr[1]); }
                    kq = fmaxf(kq, q2); } }
            if (pn == 8 || pn == 9 || pn == 22) {
                kq = fmaxf(kq, xshf<1>(kq)); kq = fmaxf(kq, xshf<2>(kq)); kq = fmaxf(kq, xshf<4>(kq)); kq = fmaxf(kq, xshf<8>(kq));
                if (fr == 0 && fq == 0) __hip_atomic_fetch_max(pn == 22 ? kmaxAD + 32 + (lat ? (u.pm >> 6) : (u.pm - NLAT / 256)) * 4 + wc : kmax + (lat ? (u.pm >> 6) : (u.pm - NLAT / 256)) * 8 + (pn - 8) * 4 + wc, __float_as_uint(kq), __ATOMIC_RELAXED, __HIP_MEMORY_SCOPE_AGENT); }
#undef RP_LOAD
        }
    }
};
struct EpiOutProj {
    static constexpr bool PERM = true;
    const float* xin_f32; const bf16_t* xin_bf; bf16_t* xout_bf; const float* xin_ctx; float* xout_ctx; const float* modl;
    __device__ __forceinline__ void operator()(const f32x4 (&acc)[2][2][4][2], const Unit& u, int wr, int wc, int fr, int fq) const {
        const bool lat = u.pm < (NLAT / 256); const int v = lat ? (u.pm >> 6) : 2;
        const float* g1 = modl + v * 12288 + 2 * DM;
        const int rloc = (lat ? u.pm : (u.pm - NLAT / 256)) * BM + wr * 64 + fr; const int col0 = u.pn * BM + wc * 32 + 8 * fq;
        f32x4 gv[2][2];
#pragma unroll
        for (int bj = 0; bj < 2; ++bj)
#pragma unroll
            for (int n = 0; n < 2; ++n) gv[bj][n] = *(const f32x4*)(g1 + col0 + bj * HALF + 4 * n);
        if (lat && xin_f32 == nullptr) {
#pragma unroll
            for (int ai = 0; ai < 2; ++ai) { u32x4 x[4][2];
#pragma unroll
                for (int m = 0; m < 4; ++m)
#pragma unroll
                    for (int bj = 0; bj < 2; ++bj) x[m][bj] = *(const u32x4*)(xin_bf + (size_t)(rloc + ai * HALF + m * 16) * DM + col0 + bj * HALF);
#pragma unroll
                for (int m = 0; m < 4; ++m)
#pragma unroll
                    for (int bj = 0; bj < 2; ++bj) { asm volatile("" : "+v"(x[m][bj])); const u32x4 w = x[m][bj];
                        const f32x4 x0 = (f32x4){bflo(w.x), bfhi(w.x), bflo(w.y), bfhi(w.y)}, x1 = (f32x4){bflo(w.z), bfhi(w.z), bflo(w.w), bfhi(w.w)};
                        *(u32x4*)(xout_bf + (size_t)(rloc + ai * HALF + m * 16) * DM + col0 + bj * HALF) = pack8(x0 + gv[bj][0] * acc[ai][bj][m][0], x1 + gv[bj][1] * acc[ai][bj][m][1]); }
            }
        } else {
            const float* xi = lat ? xin_f32 : xin_ctx;
#pragma unroll
            for (int ai = 0; ai < 2; ++ai) { f32x4 x[4][2][2];
#pragma unroll
                for (int m = 0; m < 4; ++m)
#pragma unroll
                    for (int bj = 0; bj < 2; ++bj)
#pragma unroll
                        for (int n = 0; n < 2; ++n) x[m][bj][n] = *(const f32x4*)(xi + (size_t)(rloc + ai * HALF + m * 16) * DM + col0 + bj * HALF + 4 * n);
#pragma unroll
                for (int m = 0; m < 4; ++m)
#pragma unroll
                    for (int bj = 0; bj < 2; ++bj) { asm volatile("" : "+v"(x[m][bj][0]), "+v"(x[m][bj][1]));
                        const f32x4 y0 = x[m][bj][0] + gv[bj][0] * acc[ai][bj][m][0], y1 = x[m][bj][1] + gv[bj][1] * acc[ai][bj][m][1]; const size_t off = (size_t)(rloc + ai * HALF + m * 16) * DM + col0 + bj * HALF;
                        if (lat) *(u32x4*)(xout_bf + off) = pack8(y0, y1); else { *(f32x4*)(xout_ctx + off) = y0; *(f32x4*)(xout_ctx + off + 4) = y1; } }
            }
        }
    }
};
struct EpiSwiGLU {
    static constexpr bool PERM = true;
    bf16_t* ACT;
    __device__ __forceinline__ void operator()(const f32x4 (&acc)[2][2][4][2], const Unit& u, int wr, int wc, int fr, int fq) const {
        const int pnl = u.pn & 7; const int row0 = u.pm * BM + wr * 64 + fr; const int col0 = pnl * 128 + wc * 32 + 8 * fq;
#pragma unroll
        for (int ai = 0; ai < 2; ++ai)
#pragma unroll
            for (int m = 0; m < 4; ++m) { f32x4 o[2];
#pragma unroll
                for (int n = 0; n < 2; ++n) { const f32x4 gt = acc[ai][0][m][n], up = acc[ai][1][m][n];
#pragma unroll
                    for (int j = 0; j < 4; ++j) o[n][j] = gt[j] * __builtin_amdgcn_rcpf(1.0f + __builtin_amdgcn_exp2f(-gt[j] * LOG2E)) * up[j]; }
                *(u32x4*)(ACT + (size_t)(row0 + ai * HALF + m * 16) * FF + col0) = pack8(o[0], o[1]); }
    }
};
struct EpiDown {
    static constexpr bool PERM = true;
    bf16_t* Y; const float* gatev;
    __device__ __forceinline__ void operator()(const f32x4 (&acc)[2][2][4][2], const Unit& u, int wr, int wc, int fr, int fq) const {
        const int pnl = u.pn & 7; const int row0 = u.pm * BM + wr * 64 + fr; const int col0 = pnl * 256 + wc * 32 + 8 * fq;
        float gs[2][4];
#pragma unroll
        for (int ai = 0; ai < 2; ++ai)
#pragma unroll
            for (int m = 0; m < 4; ++m) gs[ai][m] = gatev[row0 + ai * HALF + m * 16];
#pragma unroll
        for (int ai = 0; ai < 2; ++ai)
#pragma unroll
            for (int m = 0; m < 4; ++m) { asm volatile("" : "+v"(gs[ai][m]));
#pragma unroll
                for (int bj = 0; bj < 2; ++bj) *(u32x4*)(Y + (size_t)(row0 + ai * HALF + m * 16) * DM + col0 + bj * HALF) = pack8(acc[ai][bj][m][0] * gs[ai][m], acc[ai][bj][m][1] * gs[ai][m]); }
    }
};
}
namespace att {
constexpr int LDP = INW, LDOUT = DM, KVBLK = 64;
constexpr size_t SHM_V = KVBLK * 128 * 2, SHM_K = KVBLK * 128 * 2, SHM_ATTN = 2 * SHM_V + 2 * SHM_K + 8 * 64 * 4;
constexpr size_t QL_OFF = 73728, QL_STRIDE = 272;
constexpr size_t BIAS_OFF = SHM_ATTN;
constexpr float THR_L2 = 8.f * LOG2E;
#define KSWZ(row, colB) ((row) * 256 + ((colB) ^ (((row) & 7) << 4)))
#define SBAR() __builtin_amdgcn_sched_barrier(0)

struct Tiles { const bf16_t* kctx; const bf16_t* klat; long vdelta; int lat0, nt, nctx; };
struct MP {
    bool masked;
    int tq;
    int qr, rs, qc, cs;
    const LAS float* bias;
    float sink_l2;
    float lam, post;
    const float* normg;
};

__device__ __forceinline__ const bf16_t* tile_ptr(const Tiles& T, int j) { return (j < T.nctx) ? T.kctx + (long)j * KVBLK * LDP : T.klat + (long)(T.lat0 + j - T.nctx) * KVBLK * LDP; }

template <int MODE> __device__ __forceinline__ void apply_mask(f32x16& p0, f32x16& p1, int j, const Tiles& T, const MP& mp, int hi) {
  if constexpr (MODE == 1) return;
  if (!mp.masked || j < T.nctx) return;
  const int kt = T.lat0 + j - T.nctx;
  if constexpr (MODE == 2) {
    const int base = kt * KVBLK - mp.tq + 128;
#pragma unroll
    for (int r = 0; r < 16; ++r) { const int kk = crow(r, hi); if ((unsigned)(base + kk) > 256u) p0[r] = NEGBIG; if ((unsigned)(base + kk + 32) > 256u) p1[r] = NEGBIG; }
  }
  if constexpr (MODE == 0) {
    const bool rowok = (unsigned)(kt - mp.rs) < 8u; const LAS float* bp = mp.bias + ((kt - mp.qr + 7) * 31 + 15 - mp.qc + 4 * hi);
    const int t = rowok ? (4 * hi - mp.cs) : 0x40000000;
#pragma unroll
    for (int g = 0; g < 4; ++g) {
#pragma unroll
      for (int rr = 0; rr < 4; ++rr) { const int r = g * 4 + rr; const int c0 = (r & 3) + 8 * (r >> 2);
        const float b0 = bp[c0], b1 = bp[c0 + 32];
        p0[r] = ((unsigned)(t + c0) < 16u) ? p0[r] + b0 : NEGBIG; p1[r] = ((unsigned)(t + c0 + 32) < 16u) ? p1[r] + b1 : NEGBIG; }
      asm volatile("" ::: "memory");
    }
  }
}
template <int MODE> __device__ __forceinline__ void partialSM(f32x16& p0, f32x16& p1, float& m_reg, float& mn, float& alpha, int j, const Tiles& T, const MP& mp, int hi) {
  apply_mask<MODE>(p0, p1, j, T, mp, hi);
  float pmax = p0[0];
#pragma unroll
  for (int r = 1; r < 16; ++r) pmax = fmaxf(pmax, p0[r]);
#pragma unroll
  for (int r = 0; r < 16; ++r) pmax = fmaxf(pmax, p1[r]);
  { auto rr = __builtin_amdgcn_permlane32_swap(__float_as_uint(pmax), __float_as_uint(pmax), false, false);
    pmax = fmaxf(__uint_as_float(rr[0]), __uint_as_float(rr[1])); }
  if (__builtin_expect(__all(pmax - m_reg <= THR_L2), 1)) { mn = m_reg; alpha = 1.f; }
  else { mn = fmaxf(m_reg, pmax); alpha = __builtin_amdgcn_exp2f(m_reg - mn); m_reg = mn; }
#pragma unroll
  for (int r = 0; r < 16; ++r) p0[r] = p0[r] - mn;
#pragma unroll
  for (int r = 0; r < 16; ++r) p1[r] = p1[r] - mn;
#pragma unroll
  for (int r = 0; r < 16; ++r) p0[r] = __builtin_amdgcn_exp2f(p0[r]);
}
__device__ __forceinline__ void finishSM(f32x16& p0, f32x16& p1, float alpha, float& l_reg, bf16x8& pa0, bf16x8& pa1, bf16x8& pa2, bf16x8& pa3) {
#pragma unroll
  for (int r = 0; r < 16; ++r) p1[r] = __builtin_amdgcn_exp2f(p1[r]);
  float ps = 0;
#pragma unroll
  for (int r = 0; r < 16; ++r) ps += p0[r];
#pragma unroll
  for (int r = 0; r < 16; ++r) ps += p1[r];
  { auto rr = __builtin_amdgcn_permlane32_swap(__float_as_uint(ps), __float_as_uint(ps), false, false);
    ps = __uint_as_float(rr[0]) + __uint_as_float(rr[1]); }
  l_reg = l_reg * alpha + ps;
#define PK4(P, BASE, OUT) do { unsigned a0 = cvt_pk_bf16(P[BASE + 0], P[BASE + 1]), a1 = cvt_pk_bf16(P[BASE + 2], P[BASE + 3]);   \
    unsigned b0 = cvt_pk_bf16(P[BASE + 4], P[BASE + 5]), b1 = cvt_pk_bf16(P[BASE + 6], P[BASE + 7]);                              \
    auto r0 = __builtin_amdgcn_permlane32_swap(a0, b0, false, false); auto r1 = __builtin_amdgcn_permlane32_swap(a1, b1, false, false); \
    u32x4 w = {r0[0], r1[0], r0[1], r1[1]}; OUT = *reinterpret_cast<bf16x8*>(&w); } while (0)
  PK4(p0, 0, pa0); PK4(p0, 8, pa1); PK4(p1, 0, pa2); PK4(p1, 8, pa3);
#undef PK4
}
template <int NQ> __device__ __forceinline__ void qkt(f32x16& p0, f32x16& p1, const char* Ks, const bf16x8* qr, int r32, int hi, int cboff) {
  p0 = f32x16{}; p1 = f32x16{};
#pragma unroll
  for (int d0 = 0; d0 < NQ; ++d0) { const int cb = (d0 * 16 + hi * 8) * 2 + cboff;
    bf16x8 b0 = *reinterpret_cast<const bf16x8*>(Ks + KSWZ(r32, cb));
    bf16x8 b1 = *reinterpret_cast<const bf16x8*>(Ks + KSWZ(32 + r32, cb));
    p0 = __builtin_amdgcn_mfma_f32_32x32x16_bf16(b0, qr[d0], p0, 0, 0, 0);
    p1 = __builtin_amdgcn_mfma_f32_32x32x16_bf16(b1, qr[d0], p1, 0, 0, 0); }
}
__device__ __forceinline__ int v_st(int k, int c) { const int kk = (k & ~0xC) | ((k & 4) << 1) | ((k & 8) >> 1); return ((kk >> 3) * 4 + (c >> 5)) * 512 + ((kk & 7) * 32 + (c & 31)) * 2; }
__device__ __forceinline__ int v_rd_base(int lane) { return ((lane & 3) << 3) | (((lane >> 2) & 3) << 6) | (((lane >> 4) & 1) << 5) | (((lane >> 5) & 1) << 8); }
constexpr int v_rd_off(int d0, int ks, int half) { return d0 * 512 + ks * 4096 + half * 2048; }
template <int OFF> __device__ __forceinline__ s16x4 tr_read(int vb) {
  s16x4 r; asm volatile("ds_read_b64_tr_b16 %0, %1 offset:%2" : "=&v"(r) : "v"(vb), "i"(OFF) : "memory"); return r;
}
template <int D0> __device__ __forceinline__ void pv_one(f32x16& od, int vb, bf16x8 pa0, bf16x8 pa1, bf16x8 pa2, bf16x8 pa3) {
  const s16x4 l0 = tr_read<v_rd_off(D0, 0, 0)>(vb), h0 = tr_read<v_rd_off(D0, 0, 1)>(vb), l1 = tr_read<v_rd_off(D0, 1, 0)>(vb), h1 = tr_read<v_rd_off(D0, 1, 1)>(vb);
  const s16x4 l2 = tr_read<v_rd_off(D0, 2, 0)>(vb), h2 = tr_read<v_rd_off(D0, 2, 1)>(vb), l3 = tr_read<v_rd_off(D0, 3, 0)>(vb), h3 = tr_read<v_rd_off(D0, 3, 1)>(vb);
  asm volatile("s_waitcnt lgkmcnt(0)" ::: "memory"); SBAR();
#define PK(L, H) (bf16x8){L[0], L[1], L[2], L[3], H[0], H[1], H[2], H[3]}
  od = __builtin_amdgcn_mfma_f32_32x32x16_bf16(pa0, PK(l0, h0), od, 0, 0, 0);
  od = __builtin_amdgcn_mfma_f32_32x32x16_bf16(pa1, PK(l1, h1), od, 0, 0, 0);
  od = __builtin_amdgcn_mfma_f32_32x32x16_bf16(pa2, PK(l2, h2), od, 0, 0, 0);
  od = __builtin_amdgcn_mfma_f32_32x32x16_bf16(pa3, PK(l3, h3), od, 0, 0, 0);
#undef PK
}
__device__ __forceinline__ void pv_d0(f32x16* o, int vb, bf16x8 pa0, bf16x8 pa1, bf16x8 pa2, bf16x8 pa3) {
  pv_one<0>(o[0], vb, pa0, pa1, pa2, pa3); pv_one<1>(o[1], vb, pa0, pa1, pa2, pa3); pv_one<2>(o[2], vb, pa0, pa1, pa2, pa3); pv_one<3>(o[3], vb, pa0, pa1, pa2, pa3);
}

template <int MODE>
__device__ __forceinline__ void attn_unit_simple(const bf16_t* __restrict__ Qrow0, const Tiles T, bf16_t* __restrict__ Orow0, const MP mp, char* lds, const int tid) {
  const int wid = tid >> 6, lane = tid & 63, r32 = lane & 31, hi = lane >> 5;
  char* V_lds = lds; char* K_lds = lds + 2 * SHM_V;
  float* wsf = (float*)(lds + 2 * SHM_V + 2 * SHM_K) + wid * 64; float* li_l = wsf; float* al_l = wsf + 32;
  float m_reg = NEGBIG, l_reg = 0; f32x16 o[4] = {};
  const int sr = tid >> 4, sc = (tid & 15) * 8, vst0 = v_st(sr, sc), kst0 = KSWZ(sr, sc * 2);
  const int vb0 = (int)(uintptr_t)V_lds + v_rd_base(lane);
  const char* Qr = lds + QL_OFF + (wid * 32 + r32) * QL_STRIDE + hi * 16;
  bf16x8 vs0, vs1, ks0, ks1;
#define SLOAD1(j_) do { const bf16_t* kp_ = tile_ptr(T, (j_)) + (long)sr * LDP + sc; \
    vs0 = *reinterpret_cast<const bf16x8*>(kp_ + T.vdelta); vs1 = *reinterpret_cast<const bf16x8*>(kp_ + T.vdelta + 32L * LDP); \
    ks0 = *reinterpret_cast<const bf16x8*>(kp_); ks1 = *reinterpret_cast<const bf16x8*>(kp_ + 32L * LDP); } while (0)
#define SWRITE1(b) do { *(bf16x8*)(V_lds + (b) * SHM_V + vst0) = vs0; *(bf16x8*)(V_lds + (b) * SHM_V + vst0 + 8192) = vs1; \
    *(bf16x8*)(K_lds + (b) * SHM_K + kst0) = ks0; *(bf16x8*)(K_lds + (b) * SHM_K + kst0 + 8192) = ks1; } while (0)
  const int NT = T.nt;
  __syncthreads();
#pragma unroll
  for (int p = 0; p < 8; ++p) { const int idx = tid + 512 * p; *(bf16x8*)(lds + QL_OFF + (idx >> 4) * QL_STRIDE + (idx & 15) * 16) = *reinterpret_cast<const bf16x8*>(Qrow0 + (long)(idx >> 4) * LDP + (idx & 15) * 8); }
  SLOAD1(0); SWRITE1(0); __syncthreads();
  for (int j = 0; j < NT; ++j) {
    const int buf = j & 1;
    if (j + 1 < NT) SLOAD1(j + 1);
    bool live = true;
    if (mp.masked && j >= T.nctx) { const int kt = T.lat0 + j - T.nctx;
      if constexpr (MODE == 0) live = (unsigned)(kt - mp.rs) < 8u;
      if constexpr (MODE == 2) { const int q0w = __builtin_amdgcn_readfirstlane(mp.tq - r32); live = (kt * KVBLK + 63 >= q0w - 128) && (kt * KVBLK <= q0w + 31 + 128); } }
    if (live) {
    f32x16 p0, p1; float mn, al; bf16x8 pa0, pa1, pa2, pa3;
    { p0 = f32x16{}; p1 = f32x16{}; const char* Ks = K_lds + buf * SHM_K;
#pragma unroll
      for (int d0 = 0; d0 < 8; ++d0) { const int cb = (d0 * 16 + hi * 8) * 2; const bf16x8 q = *reinterpret_cast<const bf16x8*>(Qr + d0 * 32);
        const bf16x8 b0 = *reinterpret_cast<const bf16x8*>(Ks + KSWZ(r32, cb)), b1 = *reinterpret_cast<const bf16x8*>(Ks + KSWZ(32 + r32, cb));
        p0 = __builtin_amdgcn_mfma_f32_32x32x16_bf16(b0, q, p0, 0, 0, 0); p1 = __builtin_amdgcn_mfma_f32_32x32x16_bf16(b1, q, p1, 0, 0, 0); } }
    partialSM<MODE>(p0, p1, m_reg, mn, al, j, T, mp, hi);
    if (__any(al < 1.f)) { if (hi == 0) al_l[r32] = al; asm volatile("s_waitcnt lgkmcnt(0)" ::: "memory");
#pragma unroll
      for (int d = 0; d < 4; ++d)
#pragma unroll
        for (int r = 0; r < 16; ++r) o[d][r] *= al_l[crow(r, hi)]; }
    finishSM(p0, p1, al, l_reg, pa0, pa1, pa2, pa3);
    pv_d0(o, vb0 + buf * (int)SHM_V, pa0, pa1, pa2, pa3);
    }
    if (j + 1 < NT) SWRITE1(buf ^ 1);
    __syncthreads();
  }
  if constexpr (MODE == 2) l_reg += __builtin_amdgcn_exp2f(mp.sink_l2 - m_reg);
  if (hi == 0) li_l[r32] = l_reg; asm volatile("s_waitcnt lgkmcnt(0)" ::: "memory");
  bf16_t* Ow = Orow0 + (long)(wid * 32) * LDOUT;
#pragma unroll
  for (int r = 0; r < 16; ++r) { const int orow = crow(r, hi); const float rl = __builtin_amdgcn_rcpf(li_l[orow]);
#pragma unroll
    for (int d0 = 0; d0 < 4; ++d0) Ow[(long)orow * LDOUT + d0 * 32 + r32] = f2bf(o[d0][r] * rl); }
#undef SLOAD1
#undef SWRITE1
}
__device__ __forceinline__ void qktB(f32x16& p0, f32x16& p1, const char* Ks, const bf16x8* qr, int r32, int hi, int cboff, const f32x16& nb) {
  { const int cb = (hi * 8) * 2 + cboff;
    bf16x8 b0 = *reinterpret_cast<const bf16x8*>(Ks + KSWZ(r32, cb)), b1 = *reinterpret_cast<const bf16x8*>(Ks + KSWZ(32 + r32, cb));
    p0 = __builtin_amdgcn_mfma_f32_32x32x16_bf16(b0, qr[0], nb, 0, 0, 0); p1 = __builtin_amdgcn_mfma_f32_32x32x16_bf16(b1, qr[0], nb, 0, 0, 0); }
#pragma unroll
  for (int d0 = 1; d0 < 4; ++d0) { const int cb = (d0 * 16 + hi * 8) * 2 + cboff;
    bf16x8 b0 = *reinterpret_cast<const bf16x8*>(Ks + KSWZ(r32, cb)), b1 = *reinterpret_cast<const bf16x8*>(Ks + KSWZ(32 + r32, cb));
    p0 = __builtin_amdgcn_mfma_f32_32x32x16_bf16(b0, qr[d0], p0, 0, 0, 0); p1 = __builtin_amdgcn_mfma_f32_32x32x16_bf16(b1, qr[d0], p1, 0, 0, 0); }
}
__device__ __forceinline__ void expA(f32x16& p0) {
#pragma unroll
  for (int r = 0; r < 16; ++r) p0[r] = __builtin_amdgcn_exp2f(p0[r]);
}
__device__ __forceinline__ void finishB(f32x16& p0, f32x16& p1, float& l_reg, bf16x8& pa0, bf16x8& pa1, bf16x8& pa2, bf16x8& pa3) {
#pragma unroll
  for (int r = 0; r < 16; ++r) p1[r] = __builtin_amdgcn_exp2f(p1[r]);
  float ps = 0;
#pragma unroll
  for (int r = 0; r < 16; ++r) ps += p0[r];
#pragma unroll
  for (int r = 0; r < 16; ++r) ps += p1[r];
  l_reg += ps;
#define PK4(P, BASE, OUT) do { unsigned a0 = cvt_pk_bf16(P[BASE + 0], P[BASE + 1]), a1 = cvt_pk_bf16(P[BASE + 2], P[BASE + 3]);   \
    unsigned b0 = cvt_pk_bf16(P[BASE + 4], P[BASE + 5]), b1 = cvt_pk_bf16(P[BASE + 6], P[BASE + 7]);                              \
    auto r0 = __builtin_amdgcn_permlane32_swap(a0, b0, false, false); auto r1 = __builtin_amdgcn_permlane32_swap(a1, b1, false, false); \
    u32x4 w = {r0[0], r1[0], r0[1], r1[1]}; OUT = *reinterpret_cast<bf16x8*>(&w); } while (0)
  PK4(p0, 0, pa0); PK4(p0, 8, pa1); PK4(p1, 0, pa2); PK4(p1, 8, pa3);
#undef PK4
}

typedef short v4i16_t __attribute__((ext_vector_type(4)));
__device__ __forceinline__ s16x4 vtr(int addr) { return __builtin_bit_cast(s16x4, __builtin_amdgcn_ds_read_tr16_b64_v4i16((LAS v4i16_t*)(uintptr_t)(unsigned)addr)); }
template <int D0> __device__ __forceinline__ void pv_one_v(f32x16& od, int vb, bf16x8 pa0, bf16x8 pa1, bf16x8 pa2, bf16x8 pa3) {
  const s16x4 l0 = vtr(vb + v_rd_off(D0, 0, 0)), h0 = vtr(vb + v_rd_off(D0, 0, 1)), l1 = vtr(vb + v_rd_off(D0, 1, 0)), h1 = vtr(vb + v_rd_off(D0, 1, 1));
  const s16x4 l2 = vtr(vb + v_rd_off(D0, 2, 0)), h2 = vtr(vb + v_rd_off(D0, 2, 1)), l3 = vtr(vb + v_rd_off(D0, 3, 0)), h3 = vtr(vb + v_rd_off(D0, 3, 1));
#define PK(L, H) (bf16x8){L[0], L[1], L[2], L[3], H[0], H[1], H[2], H[3]}
  od = __builtin_amdgcn_mfma_f32_32x32x16_bf16(pa0, PK(l0, h0), od, 0, 0, 0);
  od = __builtin_amdgcn_mfma_f32_32x32x16_bf16(pa1, PK(l1, h1), od, 0, 0, 0);
  od = __builtin_amdgcn_mfma_f32_32x32x16_bf16(pa2, PK(l2, h2), od, 0, 0, 0);
  od = __builtin_amdgcn_mfma_f32_32x32x16_bf16(pa3, PK(l3, h3), od, 0, 0, 0);
#undef PK
}
__device__ __forceinline__ void pv_d0_v(f32x16* o, int vb, bf16x8 pa0, bf16x8 pa1, bf16x8 pa2, bf16x8 pa3) {
  pv_one_v<0>(o[0], vb, pa0, pa1, pa2, pa3); pv_one_v<1>(o[1], vb, pa0, pa1, pa2, pa3); pv_one_v<2>(o[2], vb, pa0, pa1, pa2, pa3); pv_one_v<3>(o[3], vb, pa0, pa1, pa2, pa3);
}
__device__ __forceinline__ void glds16(const void* g, unsigned lds_base) {
    unsigned sv; asm volatile("s_mov_b32 %0, m0\n\ts_mov_b32 m0, %2\n\ts_nop 0\n\tglobal_load_lds_dwordx4 %1, off\n\ts_mov_b32 m0, %0" : "=&s"(sv) : "v"(g), "s"(lds_base) : "memory"); }
__device__ __forceinline__ void glds16s(const void* gbase, unsigned voff, unsigned lds_base) {
    unsigned sv; asm volatile("s_mov_b32 %0, m0\n\ts_mov_b32 m0, %3\n\ts_nop 0\n\tglobal_load_lds_dwordx4 %1, %2\n\ts_mov_b32 m0, %0" : "=&s"(sv) : "v"(voff), "s"(gbase), "s"(lds_base) : "memory"); }
__device__ __forceinline__ int v_st_u(int k, int c) { return ((k >> 3) * 4 + (c >> 5)) * 512 + ((k & 7) * 32 + (c & 31)) * 2; }
__device__ __forceinline__ void attn_unit_a2(const bf16_t* __restrict__ Qrow0, const Tiles T, bf16_t* __restrict__ Orow0, const bool masked, const LAS float* bias, const int qr0, char* lds, const int tid, const float kb2, const float bmax) {
  const int wid = __builtin_amdgcn_readfirstlane(tid >> 6), lane = tid & 63, r32 = lane & 31, hi = lane >> 5;
  char* V_lds = lds; char* K_lds = lds + 2 * SHM_V;
  float* wsf = (float*)(lds + 2 * SHM_V + 2 * SHM_K) + wid * 64; float* li_l = wsf; float* al_l = wsf + 32;
  const int rp = wid >> 2, cbk = wid & 3;
  const int qloc = (2 * rp + (r32 >> 4)) * 64 + 16 * cbk + (r32 & 15);
  const int qr = qr0 + 2 * rp + (r32 >> 4), qc = 16 * cbk + (r32 & 15);
  const int rs = qr - 4 < 0 ? 0 : (qr - 4 > 248 ? 248 : qr - 4), cs = qc - 8 < 0 ? 0 : (qc - 8 > 48 ? 48 : qc - 8);
  const int kb = 16 * cbk - 8 < 0 ? 0 : (16 * cbk - 8 > 32 ? 32 : 16 * cbk - 8);
  const int rsa = (qr0 + 2 * rp - 4) < 0 ? 0 : ((qr0 + 2 * rp - 4) > 248 ? 248 : (qr0 + 2 * rp - 4)), rsb = (qr0 + 2 * rp - 3) < 0 ? 0 : ((qr0 + 2 * rp - 3) > 248 ? 248 : (qr0 + 2 * rp - 3));
  float l_reg = 0; f32x16 o[4] = {};
  const int sr = tid >> 4, sc = (tid & 15) * 8, vst0 = v_st_u(sr, sc), kst0 = KSWZ(sr, sc * 2);
  const int vb0 = (int)(uintptr_t)V_lds + v_rd_base(lane);
  const char* Qr = lds + QL_OFF + qloc * QL_STRIDE + hi * 16;
  bf16x8 vs0, vs1, ks0, ks1;
#define SLOAD1(j_) do { const bf16_t* kp_ = tile_ptr(T, (j_)) + (long)sr * LDP + sc; \
    vs0 = *reinterpret_cast<const bf16x8*>(kp_ + T.vdelta); vs1 = *reinterpret_cast<const bf16x8*>(kp_ + T.vdelta + 32L * LDP); \
    ks0 = *reinterpret_cast<const bf16x8*>(kp_); ks1 = *reinterpret_cast<const bf16x8*>(kp_ + 32L * LDP); } while (0)
#define SWRITE1(b) do { *(bf16x8*)(V_lds + (b) * SHM_V + vst0) = vs0; *(bf16x8*)(V_lds + (b) * SHM_V + vst0 + 8192) = vs1; \
    *(bf16x8*)(K_lds + (b) * SHM_K + kst0) = ks0; *(bf16x8*)(K_lds + (b) * SHM_K + kst0 + 8192) = ks1; } while (0)
  const int NT = T.nt;
  __syncthreads();
#pragma unroll
  for (int p = 0; p < 8; ++p) { const int idx = tid + 512 * p; *(bf16x8*)(lds + QL_OFF + (idx >> 4) * QL_STRIDE + (idx & 15) * 16) = *reinterpret_cast<const bf16x8*>(Qrow0 + (long)(idx >> 4) * LDP + (idx & 15) * 8); }
  SLOAD1(0); SWRITE1(0); __syncthreads();
  f32x16 nbv;
  { float q2 = 0.f;
#pragma unroll
    for (int d0 = 0; d0 < 8; ++d0) { const bf16x8 q = *reinterpret_cast<const bf16x8*>(Qr + d0 * 32); const u32x4 w = *reinterpret_cast<const u32x4*>(&q);
      q2 += bflo(w.x) * bflo(w.x) + bfhi(w.x) * bfhi(w.x) + bflo(w.y) * bflo(w.y) + bfhi(w.y) * bfhi(w.y) + bflo(w.z) * bflo(w.z) + bfhi(w.z) * bfhi(w.z) + bflo(w.w) * bflo(w.w) + bfhi(w.w) * bfhi(w.w); }
    { auto rr = __builtin_amdgcn_permlane32_swap(__float_as_uint(q2), __float_as_uint(q2), false, false); q2 = __uint_as_float(rr[0]) + __uint_as_float(rr[1]); }
    const float negb = -(sqrtf(q2 * kb2) * 1.0001f + bmax);
#pragma unroll
    for (int r = 0; r < 16; ++r) nbv[r] = negb; }
  for (int j = 0; j < NT; ++j) {
    const int buf = j & 1;
    if (j + 1 < NT) SLOAD1(j + 1);
    const bool ctxt = j < T.nctx; const int kr = T.lat0 + j - T.nctx;
    const bool live = ctxt || !masked || ((unsigned)(kr - rsa) < 8u) || ((unsigned)(kr - rsb) < 8u);
    if (live) {
      const int nblk = (ctxt || !masked) ? 2 : 1;
      for (int blk = 0; blk < nblk; ++blk) {
        const int kbb = (ctxt || !masked) ? 32 * blk : kb;
        f32x16 p = nbv; const char* Ks = K_lds + buf * SHM_K;
#pragma unroll
        for (int d0 = 0; d0 < 8; ++d0) { const int cb = (d0 * 16 + hi * 8) * 2; const bf16x8 q = *reinterpret_cast<const bf16x8*>(Qr + d0 * 32);
          const bf16x8 b0 = *reinterpret_cast<const bf16x8*>(Ks + KSWZ(kbb + r32, cb)); p = __builtin_amdgcn_mfma_f32_32x32x16_bf16(b0, q, p, 0, 0, 0); }
        if (masked && !ctxt) {
          const bool rowok = (unsigned)(kr - rs) < 8u; const LAS float* bp = bias + ((kr - qr + 7) * 31 + 15 - qc + kbb + 4 * hi);
          const int t = rowok ? (kbb + 4 * hi - cs) : 0x40000000;
          float bv[16];
#pragma unroll
          for (int r = 0; r < 16; ++r) bv[r] = bp[(r & 3) + 8 * (r >> 2)];
#pragma unroll
          for (int r = 0; r < 16; ++r) { const int c0 = (r & 3) + 8 * (r >> 2); p[r] = ((unsigned)(t + c0) < 16u) ? p[r] + bv[r] : NEGBIG; }
        }
        float ps = 0.f;
#pragma unroll
        for (int r = 0; r < 16; ++r) { p[r] = __builtin_amdgcn_exp2f(p[r]); ps += p[r]; }
        l_reg += ps;
        u32x4 w0 = {cvt_pk_bf16(p[0], p[1]), cvt_pk_bf16(p[2], p[3]), cvt_pk_bf16(p[4], p[5]), cvt_pk_bf16(p[6], p[7])}, w1 = {cvt_pk_bf16(p[8], p[9]), cvt_pk_bf16(p[10], p[11]), cvt_pk_bf16(p[12], p[13]), cvt_pk_bf16(p[14], p[15])};
        const bf16x8 pa0 = *reinterpret_cast<bf16x8*>(&w0), pa1 = *reinterpret_cast<bf16x8*>(&w1);
        const int vb = vb0 + buf * (int)SHM_V + (kbb >> 3) * 2048;
#pragma unroll
        for (int d0 = 0; d0 < 4; ++d0) { const s16x4 l0 = vtr(vb + d0 * 512), h0 = vtr(vb + d0 * 512 + 2048), l1 = vtr(vb + d0 * 512 + 4096), h1 = vtr(vb + d0 * 512 + 6144);
          o[d0] = __builtin_amdgcn_mfma_f32_32x32x16_bf16(pa0, (bf16x8){l0[0], l0[1], l0[2], l0[3], h0[0], h0[1], h0[2], h0[3]}, o[d0], 0, 0, 0);
          o[d0] = __builtin_amdgcn_mfma_f32_32x32x16_bf16(pa1, (bf16x8){l1[0], l1[1], l1[2], l1[3], h1[0], h1[1], h1[2], h1[3]}, o[d0], 0, 0, 0); }
      }
    }
    if (j + 1 < NT) SWRITE1(buf ^ 1);
    __syncthreads();
  }
  { auto rr = __builtin_amdgcn_permlane32_swap(__float_as_uint(l_reg), __float_as_uint(l_reg), false, false); l_reg = __uint_as_float(rr[0]) + __uint_as_float(rr[1]); }
  if (hi == 0) li_l[r32] = l_reg; asm volatile("s_waitcnt lgkmcnt(0)" ::: "memory");
#pragma unroll
  for (int r = 0; r < 16; ++r) { const int i = crow(r, hi); const float rl = __builtin_amdgcn_rcpf(li_l[i]);
    bf16_t* Ow = Orow0 + (long)((2 * rp + (i >> 4)) * 64 + 16 * cbk + (i & 15)) * LDOUT;
#pragma unroll
    for (int d0 = 0; d0 < 4; ++d0) Ow[d0 * 32 + r32] = f2bf(o[d0][r] * rl); }
#undef SLOAD1
#undef SWRITE1
}

#define B3_MF(a, b, c) __builtin_amdgcn_mfma_f32_32x32x16_bf16(a, b, c, 0, 0, 0)
#define B3_PIN(x) asm volatile("" : "+v"(x))
#define B3_WAITBAR(N) asm volatile("s_waitcnt vmcnt(" #N ") lgkmcnt(0)\n\ts_barrier" ::: "memory")
struct TilesB3 { const bf16_t* kctx; const bf16_t* klat; long vdelta; int nt; };
__device__ __forceinline__ void attn_unit_b3(const bf16_t* __restrict__ Qrow0, const TilesB3 T, bf16_t* __restrict__ Orow0, const MP mp, const unsigned* __restrict__ kmax2, char* lds, const int tid) {
  const int wid = __builtin_amdgcn_readfirstlane(tid >> 6), lane = tid & 63, r32 = lane & 31, hi = lane >> 5;
  constexpr int KRING = 0, VRING = 65536, WSF = 131072, SLOT = 16384;
  float* li_l = (float*)(lds + WSF) + wid * 64;
  float l_reg = 0; f32x16 o[4] = {}; bf16x8 qr[4];
  const int qrow = (wid & 3) * 32 + r32, map = wid >> 2, mapoff = map * 64;
  const bf16_t* Qw = Qrow0 + (long)qrow * LDP + mapoff + hi * 8;
#pragma unroll
  for (int d0 = 0; d0 < 4; ++d0) qr[d0] = *reinterpret_cast<const bf16x8*>(Qw + d0 * 16);
  f32x16 nb;
  { float q2 = 0.f;
#pragma unroll
    for (int d0 = 0; d0 < 4; ++d0) { const u32x4 w = *reinterpret_cast<const u32x4*>(&qr[d0]);
      q2 += bflo(w.x) * bflo(w.x) + bfhi(w.x) * bfhi(w.x) + bflo(w.y) * bflo(w.y) + bfhi(w.y) * bfhi(w.y) + bflo(w.z) * bflo(w.z) + bfhi(w.z) * bfhi(w.z) + bflo(w.w) * bflo(w.w) + bfhi(w.w) * bfhi(w.w); }
    { auto rr = __builtin_amdgcn_permlane32_swap(__float_as_uint(q2), __float_as_uint(q2), false, false); q2 = __uint_as_float(rr[0]) + __uint_as_float(rr[1]); }
    const float negb = -sqrtf(q2 * __uint_as_float(kmax2[map])) * 1.0001f;
#pragma unroll
    for (int r = 0; r < 16; ++r) nb[r] = negb; }
  B3_PIN(nb);
  const int rowk = 4 * wid + (lane >> 4); const unsigned koff = (unsigned)(rowk * LDP + (((lane & 15) ^ (rowk & 7)) * 8)) * 2u;
  const int sub0 = 2 * wid + (lane >> 5), key0 = (sub0 >> 2) * 8 + ((lane & 31) >> 2);
  const unsigned voff = (unsigned)(key0 * LDP + (sub0 & 3) * 32 + (lane & 3) * 8) * 2u + (unsigned)(T.vdelta * 2);
  const unsigned lds0 = (unsigned)(uintptr_t)lds; const unsigned kdst = lds0 + KRING + (unsigned)wid * 1024u, vdst = lds0 + VRING + (unsigned)wid * 1024u;
#define B3_TPTR(j_) ((const char*)(((j_) < 4) ? T.kctx + (long)(j_) * 64 * LDP : T.klat + (long)((j_) - 4) * 64 * LDP))
#define B3_DMAK(j_, sl_) do { const char* sp_ = B3_TPTR(j_); glds16s(sp_, koff, (unsigned)__builtin_amdgcn_readfirstlane(kdst + (sl_))); glds16s(sp_ + (size_t)32 * LDP * 2, koff, (unsigned)__builtin_amdgcn_readfirstlane(kdst + (sl_) + 8192)); } while (0)
#define B3_DMAV(j_, sl_) do { const char* sp_ = B3_TPTR(j_); glds16s(sp_, voff, (unsigned)__builtin_amdgcn_readfirstlane(vdst + (sl_))); glds16s(sp_ + (size_t)32 * LDP * 2, voff, (unsigned)__builtin_amdgcn_readfirstlane(vdst + (sl_) + 8192)); } while (0)
  int kro[4];
#pragma unroll
  for (int d0 = 0; d0 < 4; ++d0) kro[d0] = r32 * 256 + (((d0 * 16 + hi * 8) * 2 + mapoff * 2) ^ ((r32 & 7) << 4));
  const LAS char* kring = (const LAS char*)(uintptr_t)(lds0 + KRING);
  const int vbase = (int)lds0 + VRING + v_rd_base(lane);
#define B3_KF(kp_, n_, d0_) (*(const LAS bf16x8*)((kp_) + kro[d0_] + (n_) * 8192))
#define B3_VF(dst_, vp_, g_) do { const s16x4 lo_ = vtr((vp_) + v_rd_off((g_) & 3, (g_) >> 2, 0)), hi_ = vtr((vp_) + v_rd_off((g_) & 3, (g_) >> 2, 1)); dst_ = (bf16x8){lo_[0], lo_[1], lo_[2], lo_[3], hi_[0], hi_[1], hi_[2], hi_[3]}; } while (0)
  const int NT = T.nt;
#define B3_SL(j_) (((j_) & 3) * SLOT)
  f32x16 pA0, pA1, pB0, pB1; bf16x8 pa0, pa1, pa2, pa3;
  __syncthreads();
  B3_DMAK(0, B3_SL(0)); B3_DMAV(0, B3_SL(0)); B3_DMAK(1, B3_SL(1)); B3_DMAK(2, B3_SL(2)); B3_DMAV(1, B3_SL(1));
  B3_WAITBAR(8);
  { const LAS char* kp = kring + B3_SL(0); bf16x8 kf[8];
#pragma unroll
    for (int d0 = 0; d0 < 4; ++d0) { kf[2 * d0] = B3_KF(kp, 0, d0); kf[2 * d0 + 1] = B3_KF(kp, 1, d0); }
    pA0 = B3_MF(kf[0], qr[0], nb); pA1 = B3_MF(kf[1], qr[0], nb); pA0 = B3_MF(kf[2], qr[1], pA0); pA1 = B3_MF(kf[3], qr[1], pA1);
    pA0 = B3_MF(kf[4], qr[2], pA0); pA1 = B3_MF(kf[5], qr[2], pA1); pA0 = B3_MF(kf[6], qr[3], pA0); pA1 = B3_MF(kf[7], qr[3], pA1);
#pragma unroll
    for (int r = 0; r < 16; ++r) { pA0[r] = __builtin_amdgcn_exp2f(pA0[r]); pA1[r] = __builtin_amdgcn_exp2f(pA1[r]); l_reg += pA0[r] + pA1[r]; } }
  B3_WAITBAR(0);
#define B3_GA(MFS, P, i_, CA, CB) do { MFS; CA = cvt_pk_bf16(P[i_], P[(i_) + 1]); CB = cvt_pk_bf16(P[(i_) + 2], P[(i_) + 3]); } while (0)
#define B3_SW(OUT, c0_, c1_, c2_, c3_) do { u32x4 w_ = {c0_, c1_, c2_, c3_}; OUT = *reinterpret_cast<bf16x8*>(&w_); B3_PIN(OUT); } while (0)
#define B3_GB(MFS, X, i_) do { MFS; X[i_] = __builtin_amdgcn_exp2f(X[i_]); X[(i_) + 1] = __builtin_amdgcn_exp2f(X[(i_) + 1]); sacc += X[i_]; sacc += X[(i_) + 1]; B3_PIN(X); B3_PIN(sacc); SBAR(); } while (0)
#define B3_STEP(C0, C1, P0, P1, t_) do { SBAR(); \
    const LAS char* kp_ = kring + B3_SL(t_); const int vp_ = vbase + B3_SL((t_) - 1); bf16x8 kf[8], vf[8]; unsigned c0_, c1_, c2_, c3_; float sacc = 0.f; \
    _Pragma("unroll") for (int d0 = 0; d0 < 4; ++d0) { kf[2 * d0] = B3_KF(kp_, 0, d0); kf[2 * d0 + 1] = B3_KF(kp_, 1, d0); } SBAR(); \
    B3_GA(C0 = B3_MF(kf[0], qr[0], nb), P0, 0, c0_, c1_); SBAR(); \
    B3_GA(C1 = B3_MF(kf[1], qr[0], nb), P0, 4, c2_, c3_); B3_SW(pa0, c0_, c1_, c2_, c3_); SBAR(); \
    B3_GA(C0 = B3_MF(kf[2], qr[1], C0), P0, 8, c0_, c1_); SBAR(); \
    B3_GA(C1 = B3_MF(kf[3], qr[1], C1), P0, 12, c2_, c3_); B3_SW(pa1, c0_, c1_, c2_, c3_); SBAR(); \
    B3_VF(vf[0], vp_, 0); B3_GA(C0 = B3_MF(kf[4], qr[2], C0), P1, 0, c0_, c1_); SBAR(); \
    B3_VF(vf[1], vp_, 1); B3_GA(C1 = B3_MF(kf[5], qr[2], C1), P1, 4, c2_, c3_); B3_SW(pa2, c0_, c1_, c2_, c3_); SBAR(); \
    B3_VF(vf[2], vp_, 2); B3_GA(C0 = B3_MF(kf[6], qr[3], C0), P1, 8, c0_, c1_); SBAR(); \
    B3_VF(vf[3], vp_, 3); B3_GA(C1 = B3_MF(kf[7], qr[3], C1), P1, 12, c2_, c3_); B3_SW(pa3, c0_, c1_, c2_, c3_); SBAR(); \
    B3_VF(vf[4], vp_, 4);  B3_GB(o[0] = B3_MF(pa0, vf[0], o[0]), C0, 0); \
    B3_VF(vf[5], vp_, 5);  B3_GB(o[1] = B3_MF(pa0, vf[1], o[1]), C0, 2); \
    B3_VF(vf[6], vp_, 6);  B3_GB(o[2] = B3_MF(pa0, vf[2], o[2]), C0, 4); \
    B3_VF(vf[7], vp_, 7);  B3_GB(o[3] = B3_MF(pa0, vf[3], o[3]), C0, 6); \
    B3_VF(vf[0], vp_, 8);  B3_GB(o[0] = B3_MF(pa1, vf[4], o[0]), C0, 8); \
    B3_VF(vf[1], vp_, 9);  B3_GB(o[1] = B3_MF(pa1, vf[5], o[1]), C0, 10); \
    B3_VF(vf[2], vp_, 10); B3_GB(o[2] = B3_MF(pa1, vf[6], o[2]), C0, 12); \
    B3_VF(vf[3], vp_, 11); B3_GB(o[3] = B3_MF(pa1, vf[7], o[3]), C0, 14); \
    B3_VF(vf[4], vp_, 12); B3_GB(o[0] = B3_MF(pa2, vf[0], o[0]), C1, 0); \
    B3_VF(vf[5], vp_, 13); B3_GB(o[1] = B3_MF(pa2, vf[1], o[1]), C1, 2); \
    B3_VF(vf[6], vp_, 14); B3_GB(o[2] = B3_MF(pa2, vf[2], o[2]), C1, 4); \
    B3_VF(vf[7], vp_, 15); B3_GB(o[3] = B3_MF(pa2, vf[3], o[3]), C1, 6); \
    B3_GB(o[0] = B3_MF(pa3, vf[4], o[0]), C1, 8); \
    B3_GB(o[1] = B3_MF(pa3, vf[5], o[1]), C1, 10); \
    B3_GB(o[2] = B3_MF(pa3, vf[6], o[2]), C1, 12); \
    B3_GB(o[3] = B3_MF(pa3, vf[7], o[3]), C1, 14); \
    l_reg += sacc; } while (0)
  int t = 1;
  for (; t + 3 < NT; t += 2) {
    B3_DMAK(t + 2, B3_SL(t + 2)); B3_DMAK(t + 3, B3_SL(t + 3)); B3_DMAV(t + 1, B3_SL(t + 1)); B3_DMAV(t + 2, B3_SL(t + 2));
    B3_STEP(pB0, pB1, pA0, pA1, t); B3_STEP(pA0, pA1, pB0, pB1, t + 1);
    B3_WAITBAR(0);
  }
  B3_DMAK(t + 2, B3_SL(t + 2)); B3_DMAV(t + 1, B3_SL(t + 1)); B3_DMAV(t + 2, B3_SL(t + 2));
  B3_STEP(pB0, pB1, pA0, pA1, t); B3_STEP(pA0, pA1, pB0, pB1, t + 1);
  B3_WAITBAR(0);
  B3_STEP(pB0, pB1, pA0, pA1, t + 2);
  { unsigned c[16];
#pragma unroll
    for (int i = 0; i < 8; ++i) { c[i] = cvt_pk_bf16(pB0[2 * i], pB0[2 * i + 1]); c[8 + i] = cvt_pk_bf16(pB1[2 * i], pB1[2 * i + 1]); }
    B3_SW(pa0, c[0], c[1], c[2], c[3]); B3_SW(pa1, c[4], c[5], c[6], c[7]); B3_SW(pa2, c[8], c[9], c[10], c[11]); B3_SW(pa3, c[12], c[13], c[14], c[15]);
    pv_d0_v(o, vbase + B3_SL(NT - 1), pa0, pa1, pa2, pa3); }
#undef B3_STEP
#undef B3_GA
#undef B3_GB
#undef B3_SW
  { auto rr = __builtin_amdgcn_permlane32_swap(__float_as_uint(l_reg), __float_as_uint(l_reg), false, false); l_reg = __uint_as_float(rr[0]) + __uint_as_float(rr[1]); }
  if (hi == 0) li_l[r32] = l_reg; asm volatile("s_waitcnt lgkmcnt(0)" ::: "memory");
#pragma unroll
  for (int r = 0; r < 16; ++r) { const float rl = __builtin_amdgcn_rcpf(li_l[crow(r, hi)]);
#pragma unroll
    for (int d0 = 0; d0 < 4; ++d0) o[d0][r] *= rl; }
  __syncthreads();
  float* X = (float*)lds + (size_t)(wid & 3) * 32 * 128;
  if (wid >= 4) {
#pragma unroll
    for (int d0 = 0; d0 < 4; ++d0)
#pragma unroll
      for (int r = 0; r < 16; ++r) X[crow(r, hi) * 128 + d0 * 32 + r32] = o[d0][r];
  }
  __syncthreads();
  if (wid < 4) {
    float ss[16];
#pragma unroll
    for (int r = 0; r < 16; ++r) { float s = 0.f;
#pragma unroll
      for (int d0 = 0; d0 < 4; ++d0) { const float v = o[d0][r] - mp.lam * X[crow(r, hi) * 128 + d0 * 32 + r32]; o[d0][r] = v; s += v * v; }
      ss[r] = s; }
#pragma unroll
    for (int r = 0; r < 16; ++r) ss[r] = rsqrtf(sum32(ss[r]) * (1.0f / 128.0f) + 1e-6f) * mp.post;
    float gcol[4];
#pragma unroll
    for (int d0 = 0; d0 < 4; ++d0) gcol[d0] = mp.normg[d0 * 32 + r32];
    bf16_t* Ow = Orow0 + (long)(wid * 32) * LDOUT;
#pragma unroll
    for (int r = 0; r < 16; ++r) { const int orow = crow(r, hi);
#pragma unroll
      for (int d0 = 0; d0 < 4; ++d0) Ow[(long)orow * LDOUT + d0 * 32 + r32] = f2bf(o[d0][r] * ss[r] * gcol[d0]); }
  }
}
}
struct Args { const float* in[23]; float* out; unsigned char* ws; int ph_lo, ph_hi; };
typedef const Args __attribute__((address_space(4)))* KArgs;
struct Ctx {
    KArgs ka; LAS unsigned char* lds; char* ldsg; int tid, lane, wave, G, wg;
    __device__ __forceinline__ const float* in(int k) const { return ka->in[k]; }
    __device__ __forceinline__ float* out() const { return ka->out; }
    __device__ __forceinline__ unsigned char* ws() const { return ka->ws; }
    __device__ __forceinline__ float* modp() const { return (float*)(ws() + WS_MODP); }
    __device__ __forceinline__ float* mod() const { return (float*)(ws() + WS_MOD); }
    __device__ __forceinline__ float* misc() const { return (float*)(ws() + WS_MISC); }
    __device__ __forceinline__ float* rope() const { return (float*)(ws() + WS_ROPE); }
    __device__ __forceinline__ float* xc() const { return (float*)(ws() + WS_XC); }
    __device__ __forceinline__ bf16_t* xb() const { return (bf16_t*)(ws() + WS_XB); }
    __device__ __forceinline__ float* aff() const { return (float*)(ws() + WS_AFF); }
    __device__ __forceinline__ int* rowidx() const { return (int*)(ws() + WS_ROWIDX); }
    __device__ __forceinline__ float* gatev() const { return (float*)(ws() + WS_GATEV); }
    __device__ __forceinline__ int* slot() const { return (int*)(ws() + WS_SLOT); }
    __device__ __forceinline__ bf16_t* H() const { return (bf16_t*)(ws() + WS_H); }
    __device__ __forceinline__ bf16_t* P() const { return (bf16_t*)(ws() + WS_P); }
    __device__ __forceinline__ bf16_t* O() const { return (bf16_t*)(ws() + WS_O); }
    __device__ __forceinline__ bf16_t* S() const { return (bf16_t*)(ws() + WS_S); }
    __device__ __forceinline__ bf16_t* U() const { return (bf16_t*)(ws() + WS_H); }
    __device__ __forceinline__ bf16_t* ACT() const { return (bf16_t*)(ws() + WS_P + ACT_OFF); }
    __device__ __forceinline__ bf16_t* Y() const { return (bf16_t*)(ws() + WS_P + Y_OFF); }
    __device__ __forceinline__ bf16_t* w_in_t(int l) const { return (bf16_t*)(ws() + WS_W + (size_t)l * WL_BYTES + WL_IN); }
    __device__ __forceinline__ bf16_t* w_out_t(int l) const { return (bf16_t*)(ws() + WS_W + (size_t)l * WL_BYTES + WL_OUT); }
    __device__ __forceinline__ bf16_t* w_gu_t(int l) const { return (bf16_t*)(ws() + WS_W + (size_t)l * WL_BYTES + WL_GU); }
    __device__ __forceinline__ bf16_t* w_dn_t(int l) const { return (bf16_t*)(ws() + WS_W + (size_t)l * WL_BYTES + WL_DN); }
};
__device__ __forceinline__ int hw_lane() { int l; asm volatile("v_mbcnt_lo_u32_b32 %0, -1, 0\n\tv_mbcnt_hi_u32_b32 %0, -1, %0" : "=v"(l)); return l; }
__device__ __forceinline__ Ctx make_ctx(unsigned char* lds_raw, int wave_s) {
    Ctx F; KArgs p = (KArgs)__builtin_amdgcn_kernarg_segment_ptr(); asm volatile("" : "+s"(p));
    F.ka = p; F.lds = (LAS unsigned char*)lds_raw; F.ldsg = (char*)lds_raw;
    F.lane = hw_lane(); F.wave = wave_s; F.tid = wave_s * 64 + F.lane; F.G = gridDim.x; F.wg = blockIdx.x; return F;
}
enum { I_X = 0, I_C, I_CTX, I_CCTX, I_WMOD, I_BMOD, I_N1G, I_WIN, I_RPB, I_DLAM, I_DNG, I_RDF, I_RDB, I_GNG, I_GNB, I_SINK, I_WOUT, I_N2G, I_WR, I_WG, I_WU, I_WD, I_FNG };

__device__ __forceinline__ void ph_mod_partial(const Ctx& F) {
    const float* c = F.in(I_C); const float* cc = F.in(I_CCTX); const float* wm = F.in(I_WMOD);
    for (int gid = F.wg * 512 + F.tid; gid < 2 * 16 * 3072; gid += F.G * 512) {
        const int cg = gid % 3072, ks = (gid / 3072) % 16, l = gid / (3072 * 16);
        const float* w = wm + (size_t)l * DM * 12288 + (size_t)(ks * 128) * 12288 + cg * 4;
        f32x4 a0 = {0.f, 0.f, 0.f, 0.f}, a1 = a0, a2 = a0;
#pragma unroll 8
        for (int k = 0; k < 128; ++k) { const f32x4 wv = *(const f32x4*)(w + (size_t)k * 12288); const int kk = ks * 128 + k;
            const float s0 = siluf(c[kk]), s1 = siluf(c[DM + kk]), s2 = siluf(cc[kk]); a0 += s0 * wv; a1 += s1 * wv; a2 += s2 * wv; }
        float* o = F.modp() + (size_t)((ks * 2 + l) * 3) * 12288 + cg * 4;
        *(f32x4*)(o) = a0; *(f32x4*)(o + 12288) = a1; *(f32x4*)(o + 2 * 12288) = a2;
    }
}
__device__ __forceinline__ void ph_mod_reduce(const Ctx& F) {
    const int NMOD = 2 * 3 * 12288, NR128 = 256 * 32, NR64 = 256 * 16;
    for (int idx = F.wg * 512 + F.tid; idx < NMOD + NR128 + NR64 + 2 + 8; idx += F.G * 512) {
        if (idx < NMOD) { const int l = idx / (3 * 12288), v = (idx / 12288) % 3, col = idx % 12288; float s = F.in(I_BMOD)[l * 12288 + col];
            for (int ks = 0; ks < 16; ++ks) s += F.modp()[(size_t)((ks * 2 + l) * 3 + v) * 12288 + col];
            F.mod()[idx] = s;
        } else if (idx < NMOD + NR128) { const int e = idx - NMOD, pos = e >> 5, i = e & 31; const float inv = powf(10000.0f, -(float)i / 32.0f); const float a = (float)pos * inv;
            F.rope()[e] = cosf(a); F.rope()[NR128 + e] = sinf(a);
        } else if (idx < NMOD + NR128 + NR64) { const int e = idx - NMOD - NR128, pos = e >> 4, i = e & 15; const float inv = powf(10000.0f, -(float)i / 16.0f); const float a = (float)pos * inv;
            F.rope()[2 * NR128 + e] = cosf(a); F.rope()[2 * NR128 + NR64 + e] = sinf(a);
        } else if (idx >= NMOD + NR128 + NR64 + 2) { const int lh = idx - (NMOD + NR128 + NR64 + 2); const float* rp = F.in(I_RPB) + (size_t)lh * 15 * 31; float m = 0.f;
            for (int i = 0; i < 15 * 31; ++i) m = fmaxf(m, rp[i]);
            F.misc()[8 + lh] = m * LOG2E;
        } else { const int l = idx - (NMOD + NR128 + NR64); const float* dl = F.in(I_DLAM) + l * 4 * 64; float s1 = 0.f, s2 = 0.f;
            for (int i = 0; i < 64; ++i) { s1 += dl[i] * dl[64 + i]; s2 += dl[128 + i] * dl[192 + i]; }
            const float lam_init = 0.8f - 0.6f * expf(-0.3f * (float)l);
            F.misc()[l * 2] = expf(s1) - expf(s2) + lam_init; F.misc()[l * 2 + 1] = lam_init; }
    }
}
__device__ __forceinline__ int inproj_perm(int np) {
    const int pn = np >> 8, p = np & 255;
    if (pn >= 6 && pn <= 9) { const int half = p >> 7, pp = p & 127, sh = pp >> 5, rc = (pp >> 4) & 1, i = pp & 15; return pn * 256 + sh * 64 + rc * 32 + half * 16 + i; }
    if ((pn >= 12 && pn <= 15) || (pn >= 20 && pn <= 22)) { const int half = p >> 7, pp = p & 127, hs = pp >> 6, rc = (pp >> 5) & 1, i = pp & 31; return pn * 256 + hs * 128 + rc * 64 + half * 32 + i; }
    return np;
}
__device__ __forceinline__ float inproj_scale(int col) {
    if (col < C_AK) return 0.08838834764831845f * LOG2E;
    if (col >= C_BQ && col < C_BK) return 0.125f * LOG2E;
    if (col >= C_CK && col < C_CV) return 0.08838834764831845f;
    if (col >= C_DQ && col < C_DK) return 0.08838834764831845f * LOG2E;
    return 1.0f;
}
struct CvTile { const float* src; bf16_t* dst; int nsrc, K, n0, k0, kind; };
__device__ __forceinline__ CvTile cv_tile(const Ctx& F, int t) {
    const int T_IN = 96 * 32, T_OUT = 32 * 32, T_GU = 16 * 32 * 32, T_DN = 16 * 32 * 16, TL = T_IN + T_OUT + T_GU + T_DN;
    const int l = t / TL; int r = t % TL; CvTile c;
    if (r < T_IN) { c.kind = 0; c.n0 = (r % 96) * 64; c.k0 = (r / 96) * 64; c.src = F.in(I_WIN) + (size_t)l * DM * INW; c.nsrc = INW; c.K = DM; c.dst = F.w_in_t(l); }
    else if (r < T_IN + T_OUT) { r -= T_IN; c.kind = 1; c.n0 = (r % 32) * 64; c.k0 = (r / 32) * 64; c.src = F.in(I_WOUT) + (size_t)l * DM * DM; c.nsrc = DM; c.K = DM; c.dst = F.w_out_t(l); }
    else if (r < T_IN + T_OUT + T_GU) { r -= T_IN + T_OUT; c.kind = 2; const int e = r / 1024, rr = r % 1024; c.n0 = (rr % 32) * 64; c.k0 = (rr / 32) * 64;
        const int half = (c.n0 & 255) >> 7; c.src = (half ? F.in(I_WU) : F.in(I_WG)) + (size_t)(l * NE + e) * DM * FF; c.nsrc = FF; c.K = DM; c.dst = F.w_gu_t(l) + (size_t)e * 2048 * DM; }
    else { r -= T_IN + T_OUT + T_GU; c.kind = 3; const int e = r / 512, rr = r % 512; c.n0 = (rr % 32) * 64; c.k0 = (rr / 32) * 64; c.src = F.in(I_WD) + (size_t)(l * NE + e) * FF * DM; c.nsrc = DM; c.K = FF; c.dst = F.w_dn_t(l) + (size_t)e * DM * FF; }
    return c;
}
__device__ __forceinline__ void ph_convert(const Ctx& F) {
    LAS float* tile = (LAS float*)F.lds;
    const int TL = 96 * 32 + 32 * 32 + 16 * 32 * 32 + 16 * 32 * 16, NT = 2 * TL;
    const int tx = F.tid & 63, ty = F.tid >> 6, kx2 = F.tid & 31, ny = F.tid >> 5;
    float v[4][8]; float sc[4];
#define CV_LOAD(t0_) do { _Pragma("unroll") for (int u = 0; u < 4; ++u) { const int t = (t0_) + u; if (t < NT) { const CvTile c = cv_tile(F, t); \
            const int np = c.n0 + tx; int scol = np; sc[u] = 1.0f; \
            if (c.kind == 0) { scol = inproj_perm(np); sc[u] = inproj_scale(scol); } else if (c.kind == 2) { scol = (np >> 8) * 128 + (np & 127); } \
            _Pragma("unroll") for (int i = 0; i < 8; ++i) v[u][i] = c.src[(size_t)(c.k0 + ty + 8 * i) * c.nsrc + scol]; } } } while (0)
    int t0 = F.wg * 4;
    __syncthreads();
    if (t0 < NT) CV_LOAD(t0);
    for (; t0 < NT; t0 += 4 * F.G) {
#pragma unroll
        for (int u = 0; u < 4; ++u) { const int t = t0 + u; if (t < NT) {
#pragma unroll
            for (int i = 0; i < 8; ++i) tile[u * (64 * 65) + (ty + 8 * i) * 65 + tx] = v[u][i] * sc[u]; } }
        if (t0 + 4 * F.G < NT) CV_LOAD(t0 + 4 * F.G);
        asm volatile("s_waitcnt lgkmcnt(0)" ::: "memory"); __builtin_amdgcn_s_barrier();
#pragma unroll
        for (int u = 0; u < 4; ++u) { const int t = t0 + u; if (t < NT) { const CvTile c = cv_tile(F, t);
#pragma unroll
            for (int i = 0; i < 4; ++i) { const int nn = ny + 16 * i; const float lo = tile[u * (64 * 65) + (2 * kx2) * 65 + nn], hi = tile[u * (64 * 65) + (2 * kx2 + 1) * 65 + nn];
                *(unsigned*)(c.dst + (size_t)(c.n0 + nn) * c.K + c.k0 + 2 * kx2) = cvt_pk_bf16(lo, hi); } } }
        asm volatile("s_waitcnt lgkmcnt(0)" ::: "memory"); __builtin_amdgcn_s_barrier();
    }
#undef CV_LOAD
    __syncthreads();
}

__device__ __forceinline__ float wave_sum(float s) { return sum64(s); }
__device__ __forceinline__ void load_x(const Ctx& F, const void* xrow, bool bf, f32x4 (&x)[8]) {
    const int lane = F.lane;
    if (bf) {
#pragma unroll
        for (int j = 0; j < 8; ++j) { const u32x2 w = *(const u32x2*)((const bf16_t*)xrow + j * 256 + lane * 4); x[j] = (f32x4){bflo(w.x), bfhi(w.x), bflo(w.y), bfhi(w.y)}; }
    } else {
#pragma unroll
        for (int j = 0; j < 8; ++j) x[j] = *(const f32x4*)((const float*)xrow + j * 256 + lane * 4);
    }
}
__device__ __forceinline__ void ld_y(const Ctx& F, int s, u32x2 (&w)[8]) {
    const bf16_t* y = F.Y() + (size_t)s * DM + F.lane * 4;
#pragma unroll
    for (int j = 0; j < 8; ++j) w[j] = *(const u32x2*)(y + j * 256);
}
__device__ __forceinline__ void acc_y(f32x4 (&ys)[8], const u32x2 (&w)[8]) {
#pragma unroll
    for (int j = 0; j < 8; ++j) ys[j] += (f32x4){bflo(w[j].x), bfhi(w[j].x), bflo(w[j].y), bfhi(w[j].y)};
}
__device__ __forceinline__ int load_slots(const Ctx& F, int row) { return F.slot()[(size_t)row * NE + (F.lane & 15)]; }
__device__ __forceinline__ void moe_fold2(const Ctx& F, const LAS float* g2, int sva, int svb, f32x4 (&xa)[8], f32x4 (&xb)[8]) {
    f32x4 ya[8], yb[8];
#pragma unroll
    for (int j = 0; j < 8; ++j) { ya[j] = (f32x4){0.f, 0.f, 0.f, 0.f}; yb[j] = (f32x4){0.f, 0.f, 0.f, 0.f}; }
    unsigned ma = (unsigned)__builtin_amdgcn_ballot_w64(sva >= 0) & 0xFFFFu, mb = (unsigned)__builtin_amdgcn_ballot_w64(svb >= 0) & 0xFFFFu;
    while ((ma | mb) != 0u) {
        const bool ha = ma != 0u, hb = mb != 0u; u32x2 wa[8], wb[8];
        if (ha) { const int e = __builtin_ctz(ma); ma &= ma - 1u; ld_y(F, __builtin_amdgcn_readlane(sva, e), wa); }
        if (hb) { const int e = __builtin_ctz(mb); mb &= mb - 1u; ld_y(F, __builtin_amdgcn_readlane(svb, e), wb); }
        if (ha) acc_y(ya, wa);
        if (hb) acc_y(yb, wb);
    }
#pragma unroll
    for (int j = 0; j < 8; ++j) { const f32x4 g = *(const LAS f32x4*)(g2 + j * 256 + F.lane * 4); xa[j] += g * ya[j]; xb[j] += g * yb[j]; }
}
__device__ __forceinline__ float row_rstd(const f32x4 (&x)[8]) {
    float s = 0.f;
#pragma unroll
    for (int j = 0; j < 8; ++j) s += x[j][0] * x[j][0] + x[j][1] * x[j][1] + x[j][2] * x[j][2] + x[j][3] * x[j][3];
    s = wave_sum(s); return rsqrtf(s * (1.0f / DM) + 1e-6f);
}
__device__ __forceinline__ void norm1_row(const Ctx& F, int li, int row, const float* ng, f32x4 (&x)[8]) {
    const bool lat = row < NLAT; const int v = lat ? row / SEQ : 2;
    if (li != 0) {
        if (lat) { bf16_t* xo = F.xb() + (size_t)row * DM;
#pragma unroll
            for (int j = 0; j < 8; ++j) { u32x2 w; w.x = cvt_pk_bf16(x[j][0], x[j][1]); w.y = cvt_pk_bf16(x[j][2], x[j][3]); *(u32x2*)(xo + j * 256 + F.lane * 4) = w;
                x[j] = (f32x4){bflo(w.x), bfhi(w.x), bflo(w.y), bfhi(w.y)}; }
        } else { float* xo = F.xc() + (size_t)(row - NLAT) * DM;
#pragma unroll
            for (int j = 0; j < 8; ++j) *(f32x4*)(xo + j * 256 + F.lane * 4) = x[j]; } }
    const float rs = row_rstd(x);
    const LAS float* gs = (const LAS float*)F.lds + v * (2 * DM); const LAS float* s0p = gs + DM;
    bf16_t* h = F.H() + (size_t)row * DM;
#pragma unroll
    for (int j = 0; j < 8; ++j) { const int c = j * 256 + F.lane * 4; const f32x4 g = *(const LAS f32x4*)(gs + c), s0 = *(const LAS f32x4*)(s0p + c);
        const f32x4 y = x[j] * rs * g + s0; u32x2 w; w.x = cvt_pk_bf16(y[0], y[1]); w.y = cvt_pk_bf16(y[2], y[3]); *(u32x2*)(h + c) = w; }
}
__device__ __forceinline__ const void* norm1_src(const Ctx& F, int li, int row, bool& bf) {
    const bool lat = row < NLAT; bf = (li != 0) && lat;
    if (li == 0) return lat ? (const void*)(F.in(I_X) + (size_t)row * DM) : (const void*)(F.in(I_CTX) + (size_t)(row - NLAT) * DM);
    return lat ? (const void*)(F.xb() + (size_t)row * DM) : (const void*)(F.xc() + (size_t)(row - NLAT) * DM);
}
__device__ __forceinline__ void ph_norm1(const Ctx& F, int li) {
    const float* ng = F.in(I_N1G) + li * DM;
    __syncthreads();
    for (int i = F.tid; i < 3 * DM; i += 512) { const int v = i / DM, c = i - v * DM; const float* sh = F.mod() + (size_t)(li * 3 + v) * 12288;
        ((LAS float*)F.lds)[v * (2 * DM) + c] = ng[c] * (1.0f + sh[DM + c]); ((LAS float*)F.lds)[v * (2 * DM) + DM + c] = sh[c];
        if (li != 0) ((LAS float*)F.lds)[6 * DM + i] = F.mod()[(size_t)((li - 1) * 3 + v) * 12288 + 5 * DM + c]; }
    __syncthreads();
    for (int row = (F.wg * 8 + F.wave) * 2; row < MTOT; row += F.G * 16) {
        f32x4 xa[8], xb[8]; bool bfa, bfb; const void* pa = norm1_src(F, li, row, bfa); const void* pb = norm1_src(F, li, row + 1, bfb);
        int sva = -1, svb = -1; if (li != 0) { sva = load_slots(F, row); svb = load_slots(F, row + 1); }
        load_x(F, pa, bfa, xa); load_x(F, pb, bfb, xb);
        if (li != 0) moe_fold2(F, (const LAS float*)F.lds + 6 * DM + (row < NLAT ? row / SEQ : 2) * DM, sva, svb, xa, xb);
        norm1_row(F, li, row, ng, xa); norm1_row(F, li, row + 1, ng, xb);
    }
}
__device__ __forceinline__ void ph_final(const Ctx& F) {
    __syncthreads();
    for (int i = F.tid; i < 3 * DM; i += 512) ((LAS float*)F.lds)[i] = i < DM ? F.in(I_FNG)[i] : F.mod()[(size_t)(3 + (i / DM - 1)) * 12288 + 5 * DM + (i & (DM - 1))];
    __syncthreads();
    const LAS float* ng = (const LAS float*)F.lds;
    for (int row = (F.wg * 8 + F.wave) * 2; row < NLAT; row += F.G * 16) {
        f32x4 xa[8], xb[8]; const int sva = load_slots(F, row), svb = load_slots(F, row + 1);
        load_x(F, F.xb() + (size_t)row * DM, true, xa); load_x(F, F.xb() + (size_t)(row + 1) * DM, true, xb);
        moe_fold2(F, ng + DM + (row / SEQ) * DM, sva, svb, xa, xb);
        const float ra = row_rstd(xa), rb = row_rstd(xb); float* xr = F.out() + (size_t)row * DM;
#pragma unroll
        for (int j = 0; j < 8; ++j) { const int c = j * 256 + F.lane * 4; const f32x4 g = *(const LAS f32x4*)(ng + c); *(f32x4*)(xr + c) = xa[j] * ra * g; *(f32x4*)(xr + DM + c) = xb[j] * rb * g; }
    }
}
__device__ __forceinline__ void router_reduce_store(float (&v)[16], int lane, float* affrow) {
    float a[8];
#pragma unroll
    for (int i = 0; i < 8; ++i) { auto rr = __builtin_amdgcn_permlane32_swap(__float_as_uint(v[i]), __float_as_uint(v[i + 8]), false, false); a[i] = __uint_as_float(rr[0]) + __uint_as_float(rr[1]); }
    float b[4]; const bool b16 = (lane & 16) != 0;
#pragma unroll
    for (int i = 0; i < 4; ++i) { const float keep = b16 ? a[i + 4] : a[i], send = b16 ? a[i] : a[i + 4]; b[i] = keep + xshf<16>(send); }
    float c[2]; const bool b8 = (lane & 8) != 0;
#pragma unroll
    for (int i = 0; i < 2; ++i) { const float keep = b8 ? b[i + 2] : b[i], send = b8 ? b[i] : b[i + 2]; c[i] = keep + xshf<8>(send); }
    const bool b4 = (lane & 4) != 0; float lg = (b4 ? c[1] : c[0]) + xshf<4>(b4 ? c[0] : c[1]);
    lg += xshf<2>(lg); lg += xshf<1>(lg);
    float mx = lg; mx = fmaxf(mx, xshf<4>(mx)); mx = fmaxf(mx, xshf<8>(mx)); mx = fmaxf(mx, xshf<16>(mx));
    { auto rr = __builtin_amdgcn_permlane32_swap(__float_as_uint(mx), __float_as_uint(mx), false, false); mx = fmaxf(__uint_as_float(rr[0]), __uint_as_float(rr[1])); }
    const float ex = expf(lg - mx); float den = ex; den += xshf<4>(den); den += xshf<8>(den); den += xshf<16>(den);
    { auto rr = __builtin_amdgcn_permlane32_swap(__float_as_uint(den), __float_as_uint(den), false, false); den = __uint_as_float(rr[0]) + __uint_as_float(rr[1]); }
    const int e = ((lane >> 5) & 1) * 8 + ((lane >> 4) & 1) * 4 + ((lane >> 3) & 1) * 2 + ((lane >> 2) & 1);
    if ((lane & 3) == 0) affrow[e] = ex / den;
}
__device__ __forceinline__ void ph_norm2(const Ctx& F, int li, int rbeg, int rend, int wg0, int nwg) {
    const float* ng = F.in(I_N2G) + li * DM; const float* wr = F.in(I_WR) + (size_t)li * DM * NE; LAS float* wl = (LAS float*)F.lds;
    __syncthreads();
    int ts_ = F.tid; asm volatile("" : "+v"(ts_));
    for (int h = 0; h < 2; ++h) { f32x4 wv[8];
#pragma unroll
      for (int q = 0; q < 8; ++q) wv[q] = *(const f32x4*)(wr + (size_t)(ts_ + 512 * (h * 8 + q)) * 4);
#pragma unroll
      for (int q = 0; q < 8; ++q) { const int i4 = ts_ + 512 * (h * 8 + q), k = i4 >> 2, e0 = (i4 & 3) * 4; wl[(e0 + 0) * DM + k] = wv[q][0]; wl[(e0 + 1) * DM + k] = wv[q][1]; wl[(e0 + 2) * DM + k] = wv[q][2]; wl[(e0 + 3) * DM + k] = wv[q][3]; } }
    LAS float* gsl = wl + NE * DM;
    for (int i = F.tid; i < 2 * DM; i += 512) { const int v = (rbeg < NLAT) ? i / DM : 2, c = i & (DM - 1); gsl[i] = ng[c] * (1.0f + F.mod()[(size_t)(li * 3 + v) * 12288 + 4 * DM + c]); }
    __syncthreads();
    for (int row0 = rbeg + ((F.wg - wg0) * 8 + F.wave) * 4; row0 < rend; row0 += nwg * 32) {
        const bool lat = row0 < NLAT; const int v = lat ? row0 / SEQ : 2;
        const float* sh = F.mod() + (size_t)(li * 3 + v) * 12288 + 3 * DM; const LAS float* gsv = gsl + (lat ? v * DM : 0);
        f32x4 x[4][8];
        if (lat) { const bf16_t* xin = F.xb() + (size_t)row0 * DM;
#pragma unroll
            for (int r = 0; r < 4; ++r)
#pragma unroll
                for (int j = 0; j < 8; ++j) { const u32x2 w = *(const u32x2*)(xin + (size_t)r * DM + j * 256 + F.lane * 4); x[r][j] = (f32x4){bflo(w.x), bfhi(w.x), bflo(w.y), bfhi(w.y)}; }
        } else { const float* xin = F.xc() + (size_t)(row0 - NLAT) * DM;
#pragma unroll
            for (int r = 0; r < 4; ++r)
#pragma unroll
                for (int j = 0; j < 8; ++j) x[r][j] = *(const f32x4*)(xin + (size_t)r * DM + j * 256 + F.lane * 4); }
        float rs[4];
#pragma unroll
        for (int r = 0; r < 4; ++r) rs[r] = row_rstd(x[r]);
#pragma unroll
        for (int j = 0; j < 8; ++j) { const int c = j * 256 + F.lane * 4; const f32x4 s0 = *(const f32x4*)(sh + c); const f32x4 gs = *(const LAS f32x4*)(gsv + c);
#pragma unroll
            for (int r = 0; r < 4; ++r) { const f32x4 y = x[r][j] * rs[r] * gs + s0; x[r][j] = y; u32x2 w; w.x = cvt_pk_bf16(y[0], y[1]); w.y = cvt_pk_bf16(y[2], y[3]); *(u32x2*)(F.H() + (size_t)(row0 + r) * DM + c) = w; } }
        float lg[4][16];
#pragma unroll
        for (int e = 0; e < NE; ++e) { f32x2 a0 = {0.f, 0.f}, a1 = {0.f, 0.f}, a2 = {0.f, 0.f}, a3 = {0.f, 0.f};
#pragma unroll
            for (int j = 0; j < 8; ++j) { const f32x4 w = *(const LAS f32x4*)(wl + e * DM + j * 256 + F.lane * 4); const f32x2 wlo = __builtin_shufflevector(w, w, 0, 1), whi = __builtin_shufflevector(w, w, 2, 3);
                a0 += __builtin_shufflevector(x[0][j], x[0][j], 0, 1) * wlo; a0 += __builtin_shufflevector(x[0][j], x[0][j], 2, 3) * whi;
                a1 += __builtin_shufflevector(x[1][j], x[1][j], 0, 1) * wlo; a1 += __builtin_shufflevector(x[1][j], x[1][j], 2, 3) * whi;
                a2 += __builtin_shufflevector(x[2][j], x[2][j], 0, 1) * wlo; a2 += __builtin_shufflevector(x[2][j], x[2][j], 2, 3) * whi;
                a3 += __builtin_shufflevector(x[3][j], x[3][j], 0, 1) * wlo; a3 += __builtin_shufflevector(x[3][j], x[3][j], 2, 3) * whi; }
            float s0 = a0[0] + a0[1], s1 = a1[0] + a1[1], s2 = a2[0] + a2[1], s3 = a3[0] + a3[1];
            asm volatile("" : "+v"(s0), "+v"(s1), "+v"(s2), "+v"(s3) :: "memory"); __builtin_amdgcn_sched_barrier(0);
            lg[0][e] = s0; lg[1][e] = s1; lg[2][e] = s2; lg[3][e] = s3; }
#pragma unroll
        for (int r = 0; r < 4; ++r) router_reduce_store(lg[r], F.lane, F.aff() + (size_t)(row0 + r) * NE);
    }
}

__device__ __forceinline__ void topk_group(const Ctx& F, int N, int k, int row_base  , int e, int out_base  ) {
    LAS unsigned* keys = (LAS unsigned*)F.lds; LAS unsigned* hist = keys + 16384; LAS unsigned* sh = hist + 256;
    const int tid = F.tid;
    __syncthreads();
    for (int i = tid; i < N; i += 512) keys[i] = __float_as_uint(F.aff()[(size_t)(row_base + i) * NE + e]);
    unsigned prefix = 0u, need = (unsigned)k;
    for (int shift = 24; shift >= 0; shift -= 8) {
        if (tid < 256) hist[tid] = 0u;
        __syncthreads();
        for (int i = tid; i < N; i += 512) { const unsigned key = keys[i]; if (shift == 24 || (key >> (shift + 8)) == (prefix >> (shift + 8))) atomicAdd((unsigned*)&hist[(key >> shift) & 255u], 1u); }
        __syncthreads();
        if (tid < 64) {
            const int b0 = 255 - 4 * tid; const unsigned c0 = hist[b0], c1 = hist[b0 - 1], c2 = hist[b0 - 2], c3 = hist[b0 - 3]; const unsigned loc = c0 + c1 + c2 + c3;
            unsigned inc = loc;
#pragma unroll
            for (int o = 1; o < 64; o <<= 1) { const unsigned t = lane_up(inc, tid, o); if (tid >= o) inc += t; }
            const unsigned before = inc - loc;
            if (before < need && need <= inc) { unsigned cum = before; int d;
                if (cum + c0 >= need) d = b0; else { cum += c0; if (cum + c1 >= need) d = b0 - 1; else { cum += c1; if (cum + c2 >= need) d = b0 - 2; else { cum += c2; d = b0 - 3; } } }
                sh[0] = prefix | ((unsigned)d << shift); sh[1] = need - cum; }
        }
        __syncthreads();
        prefix = sh[0]; need = sh[1];
        __syncthreads();
    }
    const int per = N >= 512 ? N / 512 : 1; const int nact = N / per; unsigned cg = 0u, ce = 0u;
    if (tid < nact) for (int i = 0; i < per; ++i) { const unsigned key = keys[tid * per + i]; cg += key > prefix; ce += key == prefix; }
    unsigned pk = cg | (ce << 16), inc = pk;
#pragma unroll
    for (int o = 1; o < 64; o <<= 1) { const unsigned t = lane_up(inc, F.lane, o); if (F.lane >= o) inc += t; }
    if (F.lane == 63) sh[8 + F.wave] = inc;
    __syncthreads();
    unsigned woff = 0u;
    for (int w = 0; w < F.wave; ++w) woff += sh[8 + w];
    const unsigned exc = inc - pk + woff; unsigned gb = exc & 0xffffu, eb = exc >> 16; const unsigned ngt = (unsigned)k - need;
    if (tid < nact) for (int i = 0; i < per; ++i) { const int ti = tid * per + i; const unsigned key = keys[ti]; int s = -1;
        if (key > prefix) { s = (int)gb; ++gb; } else if (key == prefix) { if (eb < need) s = (int)(ngt + eb); ++eb; }
        const int row = row_base + ti;
        if (s >= 0) { F.rowidx()[out_base + s] = row; F.gatev()[out_base + s] = __uint_as_float(key); }
        F.slot()[(size_t)row * NE + e] = s >= 0 ? out_base + s : -1; }
    __syncthreads();
}
__device__ __forceinline__ void ph_topk(const Ctx& F, int li) {
    const int ngroups = (li == 0) ? 64 : 32;
    for (int g = F.wg; g < ngroups; g += F.G) {
        if (g < 32) { const int b = g >> 4, e = g & 15; topk_group(F, SEQ, CAP, b * SEQ, e, g * CAP); }
        else { const int b = (g - 32) >> 4, e = (g - 32) & 15; const int base = NBATCH * NE * CAP + e * 256;
            topk_group(F, LCTX, CAPC, NLAT + b * LCTX, e, base + b * CAPC);
            if (b == 0 && F.tid < 192) { F.rowidx()[base + 64 + F.tid] = 0; F.gatev()[base + 64 + F.tid] = 0.f; } }
    }
}

constexpr size_t CTL_KMAX = 16384;
namespace ret {
constexpr int TS = 136;
constexpr int TILE_B = 128 * TS * 2;
__device__ __forceinline__ float log2_gamma(float decay) { return -log1pf(expf(-decay)) * LOG2E; }
__device__ __forceinline__ int chunk_row0(int b, int c) { return c < 2 ? NLAT + b * LCTX + c * 128 : b * SEQ + (c - 2) * 128; }
__device__ __forceinline__ f32x16 mm_block(const LAS bf16_t* A, int ra, const LAS bf16_t* B, int rb, int r32, int hi, f32x16 acc) {
#pragma unroll
    for (int s = 0; s < 8; ++s) { const bf16x8 a = *(const LAS bf16x8*)(A + (ra + r32) * TS + 16 * s + 8 * hi), b = *(const LAS bf16x8*)(B + (rb + r32) * TS + 16 * s + 8 * hi);
        acc = __builtin_amdgcn_mfma_f32_32x32x16_bf16(a, b, acc, 0, 0, 0); }
    return acc;
}
__device__ __forceinline__ bf16x8 scale8(bf16x8 v, float s) {
    const u32x4 w = *reinterpret_cast<const u32x4*>(&v); u32x4 o;
    o.x = cvt_pk_bf16(bflo(w.x) * s, bfhi(w.x) * s); o.y = cvt_pk_bf16(bflo(w.y) * s, bfhi(w.y) * s); o.z = cvt_pk_bf16(bflo(w.z) * s, bfhi(w.z) * s); o.w = cvt_pk_bf16(bflo(w.w) * s, bfhi(w.w) * s);
    return *reinterpret_cast<const bf16x8*>(&o);
}
__device__ __forceinline__ f32x16 mm_block_rowscaled(const LAS bf16_t* A, int ra, float rowscale, const LAS bf16_t* B, int rb, int r32, int hi, f32x16 acc) {
#pragma unroll
    for (int s = 0; s < 8; ++s) { const bf16x8 a = scale8(*(const LAS bf16x8*)(A + (ra + r32) * TS + 16 * s + 8 * hi), rowscale), b = *(const LAS bf16x8*)(B + (rb + r32) * TS + 16 * s + 8 * hi);
        acc = __builtin_amdgcn_mfma_f32_32x32x16_bf16(a, b, acc, 0, 0, 0); }
    return acc;
}
__device__ __forceinline__ void ld4(const bf16_t* src, int ld, int tid, bf16x8 (&v)[4]) {
#pragma unroll
    for (int p = 0; p < 4; ++p) { const int idx = tid + 512 * p; v[p] = *reinterpret_cast<const bf16x8*>(src + (size_t)(idx >> 4) * ld + (idx & 15) * 8); }
}
__device__ __forceinline__ void st4_nat(LAS bf16_t* dst, int tid, const bf16x8 (&v)[4]) {
#pragma unroll
    for (int p = 0; p < 4; ++p) { const int idx = tid + 512 * p; *(LAS bf16x8*)(dst + (idx >> 4) * TS + (idx & 15) * 8) = v[p]; }
}
__device__ __forceinline__ void st4_tr(LAS bf16_t* dst, int tid, const bf16x8 (&v)[4], float e0, float e1) {
#pragma unroll
    for (int p = 0; p < 4; ++p) { const int idx = tid + 512 * p; const int m = idx >> 4, c0 = (idx & 15) * 8; const float sc = __builtin_amdgcn_exp2f(e0 + e1 * (float)m);
#pragma unroll
        for (int i = 0; i < 8; ++i) dst[(c0 + i) * TS + m] = f2bf(bf2f((bf16_t)v[p][i]) * sc); }
}

__device__ __forceinline__ void st4_vst(LAS bf16_t* dst, int tid, const bf16x8 (&v)[4]) {
#pragma unroll
    for (int p = 0; p < 4; ++p) { const int idx = tid + 512 * p; const int m = idx >> 4, c0 = (idx & 15) * 8; *(LAS bf16x8*)((LAS char*)dst + (m >> 6) * 16384 + att::v_st(m & 63, c0)) = v[p]; }
}
__device__ __forceinline__ void st4_vst_scaled(LAS bf16_t* dst, int tid, const bf16x8 (&v)[4], float e0, float e1) {
#pragma unroll
    for (int p = 0; p < 4; ++p) { const int idx = tid + 512 * p; const int m = idx >> 4, c0 = (idx & 15) * 8; *(LAS bf16x8*)((LAS char*)dst + (m >> 6) * 16384 + att::v_st(m & 63, c0)) = scale8(v[p], __builtin_amdgcn_exp2f(e0 + e1 * (float)m)); }
}
template <int KS> __device__ __forceinline__ bf16x8 trfrag(int base) {
    const s16x4 lo = att::vtr(base + (KS >> 2) * 16384 + att::v_rd_off(0, KS & 3, 0)), hi = att::vtr(base + (KS >> 2) * 16384 + att::v_rd_off(0, KS & 3, 1));
    return (bf16x8){lo[0], lo[1], lo[2], lo[3], hi[0], hi[1], hi[2], hi[3]};
}
__device__ __forceinline__ f32x16 mm_block_trB(const LAS bf16_t* A, int ra, int tb, int r32, int hi, f32x16 acc) {
#define RET_STEP(KS) acc = __builtin_amdgcn_mfma_f32_32x32x16_bf16(*(const LAS bf16x8*)(A + (ra + r32) * TS + 16 * KS + 8 * hi), trfrag<KS>(tb), acc, 0, 0, 0)
    RET_STEP(0); RET_STEP(1); RET_STEP(2); RET_STEP(3); RET_STEP(4); RET_STEP(5); RET_STEP(6); RET_STEP(7);
#undef RET_STEP
    return acc;
}

__device__ __forceinline__ void c1_unit(const Ctx& F, int li, int bh, int c) {
    const int b = bh >> 2, h = bh & 3, tid = F.tid, wid = F.wave, r32 = F.lane & 31, hi = F.lane >> 5;
    LAS bf16_t* TVt = (LAS bf16_t*)F.lds; LAS bf16_t* KF = TVt + 16384; LAS bf16_t* KB = KF + 16384;
    const float lf = log2_gamma(F.in(I_RDF)[li * 4 + h]), lb = log2_gamma(F.in(I_RDB)[li * 4 + h]);
    const bf16_t* base = F.P() + (size_t)chunk_row0(b, c) * INW + h * HD;
    bf16x8 kv[4], vv[4]; ld4(base + C_CK, INW, tid, kv); ld4(base + C_CV, INW, tid, vv);
    __syncthreads();
    st4_vst(TVt, tid, vv); st4_vst_scaled(KF, tid, kv, 127.f * lf, -lf); st4_vst_scaled(KB, tid, kv, 0.f, lb);
    __syncthreads();
    const int dvb = wid >> 1, dk0 = 2 * (wid & 1); const int l0 = (int)(uintptr_t)F.lds + att::v_rd_base(F.lane);
    const int av = l0 + dvb * 512, bf0 = l0 + 32768 + dk0 * 512, bb0 = l0 + 65536 + dk0 * 512;
    f32x16 f0 = {}, f1 = {}, g0 = {}, g1 = {};
#define C1_STEP(KS) do { const bf16x8 a_ = trfrag<KS>(av); f0 = __builtin_amdgcn_mfma_f32_32x32x16_bf16(a_, trfrag<KS>(bf0), f0, 0, 0, 0); f1 = __builtin_amdgcn_mfma_f32_32x32x16_bf16(a_, trfrag<KS>(bf0 + 512), f1, 0, 0, 0); \
        g0 = __builtin_amdgcn_mfma_f32_32x32x16_bf16(a_, trfrag<KS>(bb0), g0, 0, 0, 0); g1 = __builtin_amdgcn_mfma_f32_32x32x16_bf16(a_, trfrag<KS>(bb0 + 512), g1, 0, 0, 0); } while (0)
    C1_STEP(0); C1_STEP(1); C1_STEP(2); C1_STEP(3); C1_STEP(4); C1_STEP(5); C1_STEP(6); C1_STEP(7);
#undef C1_STEP
    bf16_t* Uf = F.U() + ((size_t)(0 * 8 + bh) * NCH + c) * 16384; bf16_t* Ub = F.U() + ((size_t)(1 * 8 + bh) * NCH + c) * 16384;
#pragma unroll
    for (int r = 0; r < 16; ++r) { const int o_ = (dvb * 32 + crow(r, hi)) * 128 + dk0 * 32 + r32; Uf[o_] = f2bf(f0[r]); Uf[o_ + 32] = f2bf(f1[r]); Ub[o_] = f2bf(g0[r]); Ub[o_ + 32] = f2bf(g1[r]); }
}
__device__ __forceinline__ void c2_scan(const Ctx& F, int li) {
    for (int gid = F.wg * 512 + F.tid; gid < 2 * 8 * 16384; gid += F.G * 512) {
        const int dir = gid >> 17, bh = (gid >> 14) & 7, el = gid & 16383, h = bh & 3;
        const float lg = log2_gamma((dir ? F.in(I_RDB) : F.in(I_RDF))[li * 4 + h]); const float cd = __builtin_amdgcn_exp2f(128.f * lg);
        const bf16_t* U = F.U() + (size_t)(dir * 8 + bh) * NCH * 16384 + el; bf16_t* S = F.S() + (size_t)(dir * 8 + bh) * NCH * 16384 + el;
        float s = 0.f;
        if (dir == 0) {
#pragma unroll 8
            for (int c = 0; c < NCH; ++c) { const float u = bf2f(U[(size_t)c * 16384]); S[(size_t)c * 16384] = f2bf(s); s = cd * s + u; }
        } else {
            { const float u1 = bf2f(U[(size_t)1 * 16384]), u0 = bf2f(U[0]); S[(size_t)1 * 16384] = f2bf(0.f); s = u1; S[0] = f2bf(s); s = cd * s + u0; }
#pragma unroll 8
            for (int c = NCH - 1; c >= 2; --c) { const float u = bf2f(U[(size_t)c * 16384]); S[(size_t)c * 16384] = f2bf(s); s = cd * s + u; }
        }
    }
}
__device__ __forceinline__ void c3_unit(const Ctx& F, int li, int bh, int c) {
    int tid_ = F.tid, lane_ = F.lane; asm volatile("" : "+v"(tid_), "+v"(lane_));
    const int b = bh >> 2, h = bh & 3, tid = tid_, wid = F.wave, lane = lane_, r32 = lane & 31, hi = lane >> 5;
    LAS bf16_t* TQ = (LAS bf16_t*)F.lds; LAS bf16_t* TK = TQ + 128 * TS; LAS bf16_t* TV = TK + 128 * TS; LAS bf16_t* TP = TV + 128 * TS; LAS float* ST = (LAS float*)(TP + 128 * TS);
    const float lf = log2_gamma(F.in(I_RDF)[li * 4 + h]), lb = log2_gamma(F.in(I_RDB)[li * 4 + h]);
    const int row0 = chunk_row0(b, c);
    const bf16_t* base = F.P() + (size_t)row0 * INW + h * HD;
    bf16x8 qv[4], kv[4], vv[4], sf[4], sb[4], gv[4];
    ld4(base + C_CQ, INW, tid, qv); ld4(base + C_CK, INW, tid, kv); ld4(base + C_CV, INW, tid, vv);
    ld4(F.S() + ((size_t)(0 * 8 + bh) * NCH + c) * 16384, 128, tid, sf);
    __syncthreads();
    st4_nat(TQ, tid, qv); st4_nat(TK, tid, kv); st4_vst(TV, tid, vv);
    __syncthreads();
    const int rb = wid >> 1, cb0 = 2 * (wid & 1);
    {
        f32x16 s0 = {}, s1 = {}; s0 = mm_block(TQ, rb * 32, TK, cb0 * 32, r32, hi, s0); s1 = mm_block(TQ, rb * 32, TK, (cb0 + 1) * 32, r32, hi, s1);
#pragma unroll
        for (int r = 0; r < 16; ++r) { const int n = rb * 32 + crow(r, hi);
#pragma unroll
            for (int i = 0; i < 2; ++i) { const int m = (cb0 + i) * 32 + r32; const int d = n - m; float w = __builtin_amdgcn_exp2f((float)d * (d > 0 ? lf : -lb)); w = (d == 0) ? 2.0f : w;
                TP[n * TS + m] = f2bf((i ? s1[r] : s0[r]) * w); } }
    }
    __syncthreads();
    st4_nat(TK, tid, sf);
    asm volatile("" ::: "memory");
    ld4(F.S() + ((size_t)(1 * 8 + bh) * NCH + c) * 16384, 128, tid, sb);
    ld4(base + C_CG, INW, tid, gv);
    __syncthreads();
    const int nrow = rb * 32 + r32;
    f32x16 o0 = {}, o1 = {};
    { const int tvb = (int)(uintptr_t)F.lds + 2 * TILE_B + att::v_rd_base(lane) + cb0 * 512;
      o0 = mm_block_trB(TP, rb * 32, tvb, r32, hi, o0); o1 = mm_block_trB(TP, rb * 32, tvb + 512, r32, hi, o1); }
    { const float qs = __builtin_amdgcn_exp2f((float)(nrow + 1) * lf);
      o0 = mm_block_rowscaled(TQ, rb * 32, qs, TK, cb0 * 32, r32, hi, o0); o1 = mm_block_rowscaled(TQ, rb * 32, qs, TK, (cb0 + 1) * 32, r32, hi, o1); }
    __syncthreads();
    st4_nat(TK, tid, sb);
    __syncthreads();
    { const float qs = __builtin_amdgcn_exp2f((float)(128 - nrow) * lb);
      o0 = mm_block_rowscaled(TQ, rb * 32, qs, TK, cb0 * 32, r32, hi, o0); o1 = mm_block_rowscaled(TQ, rb * 32, qs, TK, (cb0 + 1) * 32, r32, hi, o1); }
#pragma unroll
    for (int r = 0; r < 16; ++r) { float s1 = o0[r] + o1[r], s2 = o0[r] * o0[r] + o1[r] * o1[r];
        s1 = sum32(s1); s2 = sum32(s2);
        if (r32 == 0) { ST[(rb * 32 + crow(r, hi)) * 4 + (wid & 1) * 2] = s1; ST[(rb * 32 + crow(r, hi)) * 4 + (wid & 1) * 2 + 1] = s2; } }
    __syncthreads();
    st4_nat(TQ, tid, gv);
    __syncthreads();
    const float* gg = F.in(I_GNG) + li * 512 + h * HD; const float* gb = F.in(I_GNB) + li * 512 + h * HD;
    float g0 = gg[cb0 * 32 + r32], g1 = gg[(cb0 + 1) * 32 + r32], b0 = gb[cb0 * 32 + r32], b1 = gb[(cb0 + 1) * 32 + r32];
#pragma unroll
    for (int r = 0; r < 16; ++r) { const int n = rb * 32 + crow(r, hi); const f32x4 st = *(const LAS f32x4*)(ST + n * 4);
        const float mean = (st[0] + st[2]) * (1.0f / 128.0f), var = (st[1] + st[3]) * (1.0f / 128.0f) - mean * mean, rstd = rsqrtf(var + 1e-5f);
        bf16_t* op = F.O() + (size_t)(row0 + n) * DM + 1024 + h * HD;
        const float gt0 = bf2f(TQ[n * TS + cb0 * 32 + r32]), gt1 = bf2f(TQ[n * TS + (cb0 + 1) * 32 + r32]);
        op[cb0 * 32 + r32] = f2bf(siluf(gt0) * ((o0[r] - mean) * rstd * g0 + b0)); op[(cb0 + 1) * 32 + r32] = f2bf(siluf(gt1) * ((o1[r] - mean) * rstd * g1 + b1)); }
}
}
__device__ __forceinline__ int clampi(int x, int lo, int hi) { return x < lo ? lo : (x > hi ? hi : x); }
__device__ __forceinline__ void unitA(const Ctx& F, int li, int idx) {
    const bool ctxq = idx >= 512; const int bh = ctxq ? idx - 512 : (idx & 7), qb = ctxq ? 0 : (idx >> 3), b = bh >> 2, h = bh & 3;
    LAS float* biasL = (LAS float*)(F.lds + att::BIAS_OFF);
    __syncthreads();
    { const float* rp = F.in(I_RPB) + (size_t)(li * 4 + h) * 15 * 31; for (int i = F.tid; i < 15 * 31; i += 512) biasL[i] = rp[i] * LOG2E; }
    att::Tiles T; att::MP mp{};
    const bf16_t* ctxrow = F.P() + (size_t)(NLAT + b * LCTX) * INW; const bf16_t* latrow = F.P() + (size_t)(b * SEQ) * INW;
    T.kctx = ctxrow + C_AK + h * HD; T.klat = latrow + C_AK + h * HD; T.vdelta = C_AV - C_AK; T.nctx = 4;
    const int r32 = F.lane & 31;
    const int qr0 = qb * 4; const int lo = clampi(qr0 - 4, 0, 248), hi_ = clampi(qr0 - 1, 0, 248) + 7;
    T.lat0 = lo; T.nt = ctxq ? 4 : 4 + (hi_ - lo + 1);
    const size_t qrow = ctxq ? (size_t)(NLAT + b * LCTX) : (size_t)(b * SEQ + qb * 256);
    const unsigned* kmA = (const unsigned*)(F.ws() + WS_CTL + CTL_KMAX) + 64 + li * 64 + b * 16 + h * 4;
    const float kb2 = __uint_as_float(kmA[0]) + __uint_as_float(kmA[1]) + __uint_as_float(kmA[2]) + __uint_as_float(kmA[3]);
    att::attn_unit_a2(F.P() + qrow * INW + C_AQ + h * HD, T, F.O() + qrow * DM + h * HD, !ctxq, (const LAS float*)(F.lds + att::BIAS_OFF), qr0, F.ldsg, F.tid, kb2, F.misc()[8 + li * 4 + h]);
}
__device__ __forceinline__ void unitD(const Ctx& F, int li, int idx) {
    const bool ctxq = idx >= 512; const int bh = ctxq ? idx - 512 : (idx & 7), qb = ctxq ? 0 : (idx >> 3), b = bh >> 2, h = bh & 3, kv = h >> 1;
    att::Tiles T; att::MP mp{};
    const bf16_t* ctxrow = F.P() + (size_t)(NLAT + b * LCTX) * INW; const bf16_t* latrow = F.P() + (size_t)(b * SEQ) * INW;
    T.kctx = ctxrow + C_DK + kv * HD; T.klat = latrow + C_DK + kv * HD; T.vdelta = C_DV - C_DK; T.nctx = 4;
    mp.sink_l2 = F.in(I_SINK)[li * 4 + h] * LOG2E;
    const int lo = qb * 4 - 2 < 0 ? 0 : qb * 4 - 2, hi_ = qb * 4 + 5 > 255 ? 255 : qb * 4 + 5;
    T.lat0 = lo; T.nt = ctxq ? 4 : 4 + (hi_ - lo + 1); mp.masked = !ctxq; mp.tq = qb * 256 + F.wave * 32 + (F.lane & 31);
    const size_t qrow = ctxq ? (size_t)(NLAT + b * LCTX) : (size_t)(b * SEQ + qb * 256);
    att::attn_unit_simple<2>(F.P() + qrow * INW + C_DQ + h * HD, T, F.O() + qrow * DM + 1536 + h * HD, mp, F.ldsg, F.tid);
}
__device__ __forceinline__ void unitB(const Ctx& F, int li, int idx) {
    const bool ctxq = idx >= 1024; const int j = ctxq ? idx - 1024 : idx; const int bh = j & 7, qb = j >> 3, b = bh >> 2, h = bh & 3;
    att::TilesB3 T; att::MP mp{};
    const bf16_t* ctxrow = F.P() + (size_t)(NLAT + b * LCTX) * INW; const bf16_t* latrow = F.P() + (size_t)(b * SEQ) * INW;
    T.kctx = ctxrow + C_BK + h * HD; T.klat = latrow + C_BK + h * HD; T.vdelta = C_BV - C_BK; T.nt = ctxq ? 4 : 4 + SEQ / 64;
    mp.lam = F.misc()[li * 2]; mp.post = 1.0f - F.misc()[li * 2 + 1]; mp.normg = F.in(I_DNG) + li * HD;
    const size_t qrow = (ctxq ? (size_t)(NLAT + b * LCTX) : (size_t)(b * SEQ)) + (size_t)qb * 128;
    att::attn_unit_b3(F.P() + qrow * INW + C_BQ + h * HD, T, F.O() + qrow * DM + 512 + h * HD, mp, (const unsigned*)(F.ws() + WS_CTL + CTL_KMAX) + li * 16 + b * 8 + h * 2, F.ldsg, F.tid);
}

#define DYN_UNITS(ctr_, n_, slot_, BODY) do { unsigned nx_ = 0u; if (F.tid == 0) nx_ = __hip_atomic_fetch_add((ctr_), 1u, __ATOMIC_RELAXED, __HIP_MEMORY_SCOPE_AGENT); \
    for (;;) { __syncthreads(); if (F.tid == 0) (slot_)[0] = nx_; __syncthreads(); const int idx = (int)__builtin_amdgcn_readfirstlane((slot_)[0]); if (idx >= (n_)) break; \
        if (F.tid == 0) nx_ = __hip_atomic_fetch_add((ctr_), 1u, __ATOMIC_RELAXED, __HIP_MEMORY_SCOPE_AGENT); BODY } } while (0)
constexpr size_t CTL_DYN = 32768;
constexpr int LDS_SCRATCH = 147456, LDS_BYTES = LDS_SCRATCH + 256, IDXL_OFF = 131072;
constexpr int N_PHASES = 23;
__global__ void __launch_bounds__(512, 2) fwd_kernel(Args a) {
    extern __shared__ __attribute__((aligned(16))) unsigned char lds_raw[];
    volatile LAS unsigned* misc = (volatile LAS unsigned*)((LAS unsigned char*)lds_raw + LDS_SCRATCH);
    const int wave_s = __builtin_amdgcn_readfirstlane(threadIdx.x >> 6);
    if (wave_s == 0) { const int l0 = hw_lane(); if (l0 < 4) misc[l0] = 0u; }
    __syncthreads();
    const int lo = a.ph_lo, hi = a.ph_hi;
#ifdef DIAG_BARWAIT
    unsigned barwait_ = 0u;
#endif
    const bool use_bar = (hi - lo) > 1;
    XcdBarrier bar; bar.bar = (unsigned*)(a.ws + WS_CTL); bar.x = 0; bar.st = misc;
    if (use_bar) bar = xcd_barrier_post((unsigned*)(a.ws + WS_CTL), misc, wave_s == 0 && hw_lane() == 0);
#define FCTX const Ctx F = make_ctx(lds_raw, wave_s)
#ifndef PHMASK
#define PHMASK 0xFFFFFFFFu
#endif
#define EN(j) (((PHMASK) >> (j)) & 1u)
#ifndef REPMASK
#define REPMASK 0u
#endif
#define NREP(j) ((((REPMASK) >> (j)) & 1u) ? 2 : 1)
#define IN(k) (lo <= (k) && (k) < hi)
#ifdef EXP_BAR2
#define SEAM(k) do { if (IN(k) && IN((k) + 1)) { xcd_barrier(bar, wave_s == 0 && hw_lane() == 0); xcd_barrier(bar, wave_s == 0 && hw_lane() == 0); } } while (0)
#else
#ifdef DIAG_BARWAIT
#define SEAM(k) do { if (IN(k) && IN((k) + 1)) { const unsigned long long w0_ = wall_clock64(); xcd_barrier(bar, wave_s == 0 && hw_lane() == 0); if ((DIAG_SEAMS >> (k)) & 1u) barwait_ += (unsigned)(wall_clock64() - w0_); } } while (0)
#else
#define SEAM(k) do { if (IN(k) && IN((k) + 1)) xcd_barrier(bar, wave_s == 0 && hw_lane() == 0); } while (0)
#endif
#endif
    for (int rep_ = 0; rep_ < NREP(0); ++rep_) if (EN(0) && IN(0)) { FCTX; ph_mod_partial(F); } SEAM(0);
    for (int rep_ = 0; rep_ < NREP(1); ++rep_) if (EN(1) && IN(1)) { FCTX; ph_mod_reduce(F); ph_convert(F); } SEAM(1);
    const int F_G = gridDim.x;
    for (int li = 0; li < DEPTH; ++li) {
        const int pb = 2 + li * 10;
        for (int rep_ = 0; rep_ < (li == 0 ? NREP(2) : 1); ++rep_) if (EN(2) && IN(pb + 0)) { FCTX; ph_norm1(F, li); } SEAM(pb + 0);
        const bool split_in = use_bar && EN(3) && EN(4) && IN(pb + 1) && IN(pb + 2) && F_G >= 96;
        for (int rep_ = 0; rep_ < NREP(3); ++rep_) if (EN(3) && IN(pb + 1)) {
            if (split_in) {
                { FCTX; pg8::Gemm g{F.H(), F.w_in_t(li), DM, nullptr}; pg8::EpiInProj E{F.P(), F.rope(), (unsigned*)(F.ws() + WS_CTL + CTL_KMAX) + li * 16, (unsigned*)(F.ws() + WS_CTL + CTL_KMAX) + 64 + li * 64};
                  pg8::StaticOrder S; S.init(NLAT / 256, INW / 256, F.G, F.wg); pg8::gemm_phase<pg8::EpiInProj, pg8::StaticOrder, false>(F.lds, g, S, E, nullptr, F.tid); }
                xcd_barrier(bar, wave_s == 0 && hw_lane() == 0);
                if (blockIdx.x < 48) { FCTX; pg8::Gemm g{F.H(), F.w_in_t(li), DM, nullptr}; pg8::EpiInProj E{F.P(), F.rope(), (unsigned*)(F.ws() + WS_CTL + CTL_KMAX) + li * 16, (unsigned*)(F.ws() + WS_CTL + CTL_KMAX) + 64 + li * 64};
                  pg8::OffsetOrder S; S.init(NCTX / 256, INW / 256, 48, F.wg); S.pm0 = NLAT / 256; pg8::gemm_phase<pg8::EpiInProj, pg8::OffsetOrder, false>(F.lds, g, S, E, nullptr, F.tid); }
                else { FCTX; for (int idx = F.wg - 48; idx < 8 * (NCH - 2); idx += F.G - 48) ret::c1_unit(F, li, idx & 7, 2 + (idx >> 3)); }
            } else {
                FCTX; pg8::Gemm g{F.H(), F.w_in_t(li), DM, nullptr}; pg8::EpiInProj E{F.P(), F.rope(), (unsigned*)(F.ws() + WS_CTL + CTL_KMAX) + li * 16, (unsigned*)(F.ws() + WS_CTL + CTL_KMAX) + 64 + li * 64};
                pg8::StaticOrder S; S.init(MTOT / 256, INW / 256, F.G, F.wg);
#ifdef EXP_NOEPI_REP
                if (rep_ == 1) pg8::gemm_phase<pg8::EpiInProj, pg8::StaticOrder, false, true>(F.lds, g, S, E, nullptr, F.tid); else
#endif
                pg8::gemm_phase<pg8::EpiInProj, pg8::StaticOrder, false>(F.lds, g, S, E, nullptr, F.tid);
            }
        } SEAM(pb + 1);
        for (int rep_ = 0; rep_ < NREP(4); ++rep_) if (EN(4) && IN(pb + 2)) {
            FCTX;
            for (int r2_ = 0; r2_ < NREP(15); ++r2_) if (EN(15)) { if (split_in) { for (int idx = (F.wg + F.G - 120) % F.G; idx < 16; idx += F.G) ret::c1_unit(F, li, idx & 7, idx >> 3); }   else { for (int idx = F.wg; idx < 8 * NCH; idx += F.G) ret::c1_unit(F, li, idx & 7, idx >> 3); } }
            const int nAD = (li == 0) ? 520 : 512;
            for (int r2_ = 0; r2_ < NREP(13); ++r2_) if (EN(13)) for (int idx = (F.wg + 8) % F.G; idx < nAD; idx += F.G) unitA(F, li, idx);
            for (int r2_ = 0; r2_ < NREP(14); ++r2_) if (EN(14)) for (int idx = F.wg; idx < nAD; idx += F.G) unitD(F, li, idx);
        } SEAM(pb + 2);
        for (int rep_ = 0; rep_ < NREP(5); ++rep_) if (EN(5) && IN(pb + 3)) { FCTX; ret::c2_scan(F, li); } SEAM(pb + 3);
        for (int rep_ = 0; rep_ < NREP(6); ++rep_) if (EN(6) && IN(pb + 4)) {
            FCTX; const int nB = (li == 0) ? 1040 : 1024;
            if (EN(16)) for (int idx = F.wg; idx < nB; idx += F.G) unitB(F, li, idx);
            if (EN(17)) { if (use_bar) { unsigned* ctr = (unsigned*)(F.ws() + WS_CTL + CTL_DYN) + (li * 4 + 1) * 64; volatile LAS unsigned* slot = misc + 8;
                    DYN_UNITS(ctr, nB, slot, { if (idx < 1024) ret::c3_unit(F, li, idx & 7, 2 + (idx >> 3)); else ret::c3_unit(F, li, (idx - 1024) & 7, (idx - 1024) >> 3); }); }
                else for (int idx = F.wg; idx < nB; idx += F.G) { if (idx < 1024) ret::c3_unit(F, li, idx & 7, 2 + (idx >> 3)); else ret::c3_unit(F, li, (idx - 1024) & 7, (idx - 1024) >> 3); } }
        } SEAM(pb + 4);
        const bool split_out = use_bar && li == 0 && EN(7) && EN(8) && IN(pb + 5) && IN(pb + 6) && F_G >= 64;
        for (int rep_ = 0; rep_ < (li == 0 ? NREP(7) : 1); ++rep_) if (EN(7) && IN(pb + 5)) {
            FCTX; pg8::Gemm g{F.O(), F.w_out_t(li), DM, nullptr};
            pg8::EpiOutProj E{li == 0 ? F.in(I_X) : nullptr, F.xb(), F.xb(), F.in(I_CTX), F.xc(), F.mod() + (size_t)li * 3 * 12288};
            pg8::StaticOrder S; S.init((li == 0 && !split_out) ? MTOT / 256 : NLAT / 256, DM / 256, F.G, F.wg);
            pg8::gemm_phase<pg8::EpiOutProj, pg8::StaticOrder, false>(F.lds, g, S, E, nullptr, F.tid);
        } SEAM(pb + 5);
        for (int rep_ = 0; rep_ < NREP(8); ++rep_) if (EN(8) && IN(pb + 6)) {
            if (split_out) {
                if (blockIdx.x < 16) { FCTX; pg8::Gemm g{F.O(), F.w_out_t(li), DM, nullptr}; pg8::EpiOutProj E{F.in(I_X), F.xb(), F.xb(), F.in(I_CTX), F.xc(), F.mod() + (size_t)li * 3 * 12288};
                    pg8::OffsetOrder S; S.init(NCTX / 256, DM / 256, 16, F.wg); S.pm0 = NLAT / 256; pg8::gemm_phase<pg8::EpiOutProj, pg8::OffsetOrder, false>(F.lds, g, S, E, nullptr, F.tid); }
                else { FCTX; ph_norm2(F, li, 0, NLAT, 16, F.G - 16); }
                xcd_barrier(bar, wave_s == 0 && hw_lane() == 0);
                if (blockIdx.x < 16) { FCTX; ph_norm2(F, li, NLAT, MTOT, 0, 16); }
            } else { FCTX; ph_norm2(F, li, 0, NLAT, 0, F.G); if (li == 0) ph_norm2(F, li, NLAT, MTOT, 0, F.G); }
        } SEAM(pb + 6);
        for (int rep_ = 0; rep_ < NREP(9); ++rep_) if (EN(9) && IN(pb + 7)) { FCTX; ph_topk(F, li); } SEAM(pb + 7);
        for (int rep_ = 0; rep_ < NREP(10); ++rep_) if (EN(10) && IN(pb + 8)) {
            FCTX; pg8::Gemm g{F.H(), F.w_gu_t(li), DM, F.rowidx()}; pg8::MoeOrder S; S.init(li == 0 ? 272 : 256, 8, F.G, F.wg); pg8::EpiSwiGLU E{F.ACT()};
            pg8::gemm_phase<pg8::EpiSwiGLU, pg8::MoeOrder, true>(F.lds, g, S, E, (LAS int*)(F.lds + IDXL_OFF), F.tid);
        } SEAM(pb + 8);
        for (int rep_ = 0; rep_ < NREP(11); ++rep_) if (EN(11) && IN(pb + 9)) {
            FCTX; pg8::Gemm g{F.ACT(), F.w_dn_t(li), FF, nullptr}; pg8::MoeOrder S; S.init(li == 0 ? 272 : 256, 8, F.G, F.wg); pg8::EpiDown E{F.Y(), F.gatev()};
            pg8::gemm_phase<pg8::EpiDown, pg8::MoeOrder, false>(F.lds, g, S, E, nullptr, F.tid);
        } SEAM(pb + 9);
    }
    for (int rep_ = 0; rep_ < NREP(12); ++rep_) if (EN(12) && IN(22)) { FCTX; ph_final(F); }
#ifdef DIAG_BARWAIT
    if (blockIdx.x == DIAG_WG && wave_s == 0 && hw_lane() == 0 && barwait_ > (unsigned)DIAG_BARWAIT) a.out[(size_t)DIAG_WG * 3] += 1000.0f;
#endif
#undef IN
#undef SEAM
#undef FCTX
}

#ifndef N_LAUNCHES
#define N_LAUNCHES 1
#endif
extern "C" void kernel_launch(void* const* d_in, const int* in_sizes, int n_in, void* d_out, int out_size, void* d_ws, size_t ws_size, hipStream_t stream) {
    static int grid = 0;
    if (grid == 0) {
        if (n_in != 23 || out_size != NLAT * DM || ws_size < WS_END) { fprintf(stderr, "kernel_launch: unexpected shapes: n_in %d out %d ws %zu (need %zu)\n", n_in, out_size, ws_size, (size_t)WS_END); grid = -1; return; }
        int dev = 0, cus = 0, per_cu = 0;
        if (hipGetDevice(&dev) != hipSuccess || hipDeviceGetAttribute(&cus, hipDeviceAttributeMultiprocessorCount, dev) != hipSuccess) { grid = -1; return; }
        if (hipFuncSetAttribute((const void*)fwd_kernel, hipFuncAttributeMaxDynamicSharedMemorySize, LDS_BYTES) != hipSuccess) { fprintf(stderr, "kernel_launch: hipFuncSetAttribute failed\n"); grid = -1; return; }
        if (hipOccupancyMaxActiveBlocksPerMultiprocessor(&per_cu, (const void*)fwd_kernel, 512, LDS_BYTES) != hipSuccess || per_cu < 1) fprintf(stderr, "kernel_launch: occupancy query says %d\n", per_cu);
        (void)hipGetLastError();
        grid = cus;
    }
    if (grid < 0) return;
    hipMemsetAsync((char*)d_ws + WS_CTL, 0, CTL_BYTES, stream);
    Args a{};
    for (int i = 0; i < 23; ++i) a.in[i] = (const float*)d_in[i];
    a.out = (float*)d_out; a.ws = (unsigned char*)d_ws;
    for (int k = 0; k < N_LAUNCHES; ++k) {
        a.ph_lo = (N_LAUNCHES == 1) ? 0 : k; a.ph_hi = (N_LAUNCHES == 1) ? N_PHASES : k + 1;
        hipLaunchKernelGGL(fwd_kernel, dim3(grid), dim3(512), LDS_BYTES, stream, a);
    }
    const hipError_t le = hipPeekAtLastError();
    if (le != hipSuccess) fprintf(stderr, "kernel_launch: launch failed: %s\n", hipGetErrorName(le));
}
```

```cpp
#include <hip/hip_runtime.h>
#include <cstdio>
#include <cstdint>

#define LAS __attribute__((address_space(3)))
typedef unsigned short bf16_t;
typedef short bf16x8 __attribute__((ext_vector_type(8)));
typedef short s16x4 __attribute__((ext_vector_type(4)));
typedef float f32x4 __attribute__((ext_vector_type(4)));
typedef float f32x2 __attribute__((ext_vector_type(2)));
typedef float f32x16 __attribute__((ext_vector_type(16)));
typedef unsigned u32x4 __attribute__((ext_vector_type(4)));
typedef unsigned u32x2 __attribute__((ext_vector_type(2)));

constexpr int DM = 2048, NBATCH = 2, SEQ = 16384, LCTX = 256, DEPTH = 2;
constexpr int NLAT = NBATCH * SEQ;
constexpr int NCTX = NBATCH * LCTX;
constexpr int MTOT = NLAT + NCTX;
constexpr int INW = 6144;
constexpr int HD = 128;
constexpr int NE = 16, FF = 1024, CAP = 2048, CAPC = 32;
constexpr int MOE_ROWS = NBATCH * NE * CAP + NE * 256;
constexpr int NCH = 130;
constexpr int C_AQ = 0, C_AK = 512, C_AV = 1024, C_BQ = 1536, C_BK = 2048, C_BV = 2560, C_CQ = 3072, C_CK = 3584, C_CV = 4096, C_CG = 4608, C_DQ = 5120, C_DK = 5632, C_DV = 5888;
constexpr float LOG2E = 1.4426950408889634f;
constexpr float NEGBIG = -1e30f;

constexpr size_t al256(size_t x) { return (x + 255) / 256 * 256; }
constexpr size_t WS_CTL = 0;
constexpr size_t CTL_BYTES = 65536;
constexpr size_t WS_MODP = WS_CTL + CTL_BYTES;
constexpr size_t WS_MOD = WS_MODP + al256((size_t)16 * 2 * 3 * 12288 * 4);
constexpr size_t WS_MISC = WS_MOD + al256((size_t)2 * 3 * 12288 * 4);
constexpr size_t WS_ROPE = WS_MISC + 256;
constexpr size_t WS_XC = WS_ROPE + al256((size_t)(256 * 32 * 2 + 256 * 16 * 2) * 4);
constexpr size_t WS_AFF = WS_XC + al256((size_t)NCTX * DM * 4);
constexpr size_t WS_ROWIDX = WS_AFF + al256((size_t)MTOT * NE * 4);
constexpr size_t WS_GATEV = WS_ROWIDX + al256((size_t)MOE_ROWS * 4);
constexpr size_t WS_SLOT = WS_GATEV + al256((size_t)MOE_ROWS * 4);
constexpr size_t WS_H = WS_SLOT + al256((size_t)MTOT * NE * 4);
constexpr size_t H_BYTES = (size_t)MTOT * DM * 2;
constexpr size_t WS_P = WS_H + al256(H_BYTES);
constexpr size_t P_BYTES = (size_t)MTOT * INW * 2;
constexpr size_t WS_O = WS_P + al256(P_BYTES);
constexpr size_t WS_S = WS_O + al256(H_BYTES);
constexpr size_t S_BYTES = (size_t)2 * 8 * NCH * 16384 * 2;
constexpr size_t WS_W = WS_S + al256(S_BYTES);
constexpr size_t W_IN_B = (size_t)INW * DM * 2, W_OUT_B = (size_t)DM * DM * 2, W_GU_B = (size_t)NE * 2048 * DM * 2, W_DN_B = (size_t)NE * DM * FF * 2;
constexpr size_t WL_IN = 0, WL_OUT = WL_IN + W_IN_B, WL_GU = WL_OUT + W_OUT_B, WL_DN = WL_GU + W_GU_B, WL_BYTES = WL_DN + W_DN_B;
constexpr size_t WS_XB = WS_W + 2 * WL_BYTES;
constexpr size_t WS_END = WS_XB + al256((size_t)NLAT * DM * 2);
constexpr size_t ACT_OFF = 0;
constexpr size_t Y_OFF = al256((size_t)MOE_ROWS * FF * 2);
static_assert(Y_OFF + (size_t)MOE_ROWS * DM * 2 <= al256(P_BYTES) + H_BYTES, "Y must fit in P + O");
static_assert((size_t)2 * 8 * NCH * 16384 * 2 <= (size_t)NLAT * DM * 2, "retention U (bf16) must fit in the latent part of H");

__device__ __forceinline__ unsigned cvt_pk_bf16(float lo, float hi) { unsigned r; asm volatile("v_cvt_pk_bf16_f32 %0, %1, %2" : "=v"(r) : "v"(lo), "v"(hi)); return r; }
__device__ __forceinline__ bf16_t f2bf(float f) { return (bf16_t)(cvt_pk_bf16(f, 0.f) & 0xffffu); }
__device__ __forceinline__ float bf2f(bf16_t b) { return __uint_as_float(((unsigned)b) << 16); }
__device__ __forceinline__ float bflo(unsigned w) { return __uint_as_float(w << 16); }
__device__ __forceinline__ float bfhi(unsigned w) { return __uint_as_float(w & 0xffff0000u); }
__device__ __forceinline__ float siluf(float x) { return x / (1.0f + __expf(-x)); }
template <int M> __device__ __forceinline__ float xshf(float v) { return __int_as_float(__builtin_amdgcn_ds_swizzle(__float_as_int(v), (M << 10) | 0x1f)); }
__device__ __forceinline__ float sum32(float s) { s += xshf<1>(s); s += xshf<2>(s); s += xshf<4>(s); s += xshf<8>(s); s += xshf<16>(s); return s; }
__device__ __forceinline__ float sum64(float s) { s = sum32(s); auto rr = __builtin_amdgcn_permlane32_swap(__float_as_uint(s), __float_as_uint(s), false, false); return __uint_as_float(rr[0]) + __uint_as_float(rr[1]); }
__device__ __forceinline__ unsigned lane_up(unsigned v, int lane, int o) { return (unsigned)__builtin_amdgcn_ds_bpermute((lane - o) << 2, (int)v); }
__device__ __forceinline__ int crow(int r, int hi) { return (r & 3) + 8 * (r >> 2) + 4 * hi; }

#define XB_TMO      128
#define XB_XCNT(j)  (256  + 64 * (j))
#define XB_XSUB(j)  (1280 + 64 * (j))
#define XB_XGEN(j)  (2304 + 64 * (j))
#define XB_TOP      3328
#define XB_TOPGEN   3392
#define XCD_BAR_WORDS 3456
#define XB_SPIN_CAP (1u << 24)
__device__ __forceinline__ unsigned xb_ld(unsigned* p)              { return __hip_atomic_load(p, __ATOMIC_RELAXED, __HIP_MEMORY_SCOPE_AGENT); }
__device__ __forceinline__ unsigned xb_add(unsigned* p, unsigned v) { return __hip_atomic_fetch_add(p, v, __ATOMIC_RELAXED, __HIP_MEMORY_SCOPE_AGENT); }
__device__ __forceinline__ unsigned xb_xcc_id() { return (unsigned)__builtin_amdgcn_s_getreg((3 << 11) | 20) & 0xFu; }
#define XB_SPIN(cond, bar) do { unsigned _sp = 0; while (cond) { __builtin_amdgcn_s_sleep(1); \
    if ((++_sp & 255u) == 0u) { if (xb_ld(&(bar)[XB_TMO])) break; if (_sp > XB_SPIN_CAP) { atomicAdd(&(bar)[XB_TMO], 1u); break; } } } } while (0)
struct XcdBarrier { unsigned* bar; unsigned x; volatile LAS unsigned* st; };
__device__ __forceinline__ XcdBarrier xcd_barrier_post(unsigned* bar, volatile LAS unsigned* st, bool leader) {
    XcdBarrier b; b.bar = bar; b.x = xb_xcc_id(); b.st = st;
    if (leader) (void)xb_add(&bar[XB_XCNT(b.x)], 1u);
    return b;
}
__device__ __forceinline__ void xcd_barrier_complete(unsigned* bar, unsigned x, unsigned& nloc, unsigned& nx) {
    const unsigned G = gridDim.x * gridDim.y * gridDim.z;
    unsigned sum, cnt, mine, sp = 0u;
    for (;;) {
        sum = 0u; cnt = 0u; mine = 0u;
#pragma unroll
        for (unsigned j = 0; j < 16; ++j) { const unsigned c = xb_ld(&bar[XB_XCNT(j)]); sum += c; cnt += (c > 0u) ? 1u : 0u; mine = (j == x) ? c : mine; }
        if (sum == G) break;
        __builtin_amdgcn_s_sleep(1);
        if ((++sp & 255u) == 0u) { if (xb_ld(&bar[XB_TMO])) break; if (sp > XB_SPIN_CAP) { atomicAdd(&bar[XB_TMO], 1u); break; } }
    }
    nloc = mine > 0u ? mine : 1u; nx = cnt > 0u ? cnt : 1u;
}
__device__ __forceinline__ void xcd_barrier(const XcdBarrier& b, bool leader) {
    asm volatile("s_waitcnt vmcnt(0)" ::: "memory");
    __syncthreads();
    if (leader) {
        unsigned* bar = b.bar;
        __builtin_amdgcn_s_waitcnt(0);
        unsigned nloc = b.st[0], nx = b.st[1];
        if (nloc == 0u) { xcd_barrier_complete(bar, b.x, nloc, nx); b.st[0] = nloc; b.st[1] = nx; }
        const unsigned old = xb_add(&bar[XB_XSUB(b.x)], 1u);
        const unsigned gen = old / nloc;
        if (old + 1u == (gen + 1u) * nloc) {
            __builtin_amdgcn_fence(__ATOMIC_RELEASE, "agent");
            asm volatile("s_waitcnt vmcnt(0)" ::: "memory");
            const unsigned og = xb_add(&bar[XB_TOP], 1u);
            const unsigned tg = og / nx;
            if (og + 1u == (tg + 1u) * nx) xb_add(&bar[XB_TOPGEN], 1u);
            else XB_SPIN(xb_ld(&bar[XB_TOPGEN]) == tg, bar);
            __builtin_amdgcn_fence(__ATOMIC_ACQUIRE, "agent");
            xb_add(&bar[XB_XGEN(b.x)], 1u);
            asm volatile("s_waitcnt vmcnt(0)" ::: "memory");
        } else {
            XB_SPIN(xb_ld(&bar[XB_XGEN(b.x)]) == gen, bar);
            __builtin_amdgcn_fence(__ATOMIC_ACQUIRE, "agent");
            asm volatile("s_waitcnt vmcnt(0)" ::: "memory");
        }
    }
    __syncthreads();
}
namespace pg8 {
constexpr int BM = 256, BK = 64, HALF = 128, HTB = HALF * BK * 2, STAGE_BYTES = 8 * HTB, NXCD = 8, WGM = 8;
__host__ __device__ __forceinline__ int lds_byte(int r, int c) { const int st = (r >> 4) * 2 + (c >> 5), rr = r & 15, cc = c & 31, ob = rr * 64 + cc * 2; return st * 1024 + (ob ^ (((ob >> 9) & 1) << 5)); }
__host__ __device__ __forceinline__ void stage_rc(int b, int& R, int& C) { const int st = b / 1024, sb = b % 1024, swz = sb ^ (((sb >> 9) & 1) << 5); R = (st >> 1) * 16 + swz / 64; C = (st & 1) * 32 + (swz % 64) / 2; }
__host__ __device__ __forceinline__ int perm32(int rho) { const int n = rho >> 4, i = rho & 15; return 8 * (i >> 2) + 4 * n + (i & 3); }

struct Unit { int pm, pn; };
struct Gemm { const bf16_t* A; const bf16_t* Bt; int K; const int* rowidx; };

struct StaticOrder {
    int nM, nN, nwg, G, c;
    __device__ void init(int nM_, int nN_, int G_, int c_) { nM = nM_; nN = nN_; nwg = nM * nN; G = G_; c = c_; }
    __device__ bool next(int i, Unit& u) const {
        const long L = (long)i * G + c; if (L >= nwg) return false;
        int wgid = (int)L; { const int q = nwg / NXCD, r = nwg % NXCD, xcd = wgid % NXCD, off = wgid / NXCD; wgid = (xcd < r ? xcd * (q + 1) : r * (q + 1) + (xcd - r) * q) + off; }
        const int nig = WGM * nN, gid = wgid / nig, fm = gid * WGM, gsz = (nM - fm) < WGM ? (nM - fm) : WGM;
        u.pm = fm + ((wgid % nig) % gsz); u.pn = (wgid % nig) / gsz; return true;
    }
};
struct OffsetOrder : StaticOrder {
    int pm0;
    __device__ bool next(int i, Unit& u) const { if (!StaticOrder::next(i, u)) return false; u.pm += pm0; return true; }
};
__device__ __forceinline__ int moe_expert_of_tile(int pm) { return pm < 256 ? ((pm >> 3) & 15) : (pm - 256); }
struct MoeOrder : StaticOrder {
    __device__ bool next(int i, Unit& u) const { if (!StaticOrder::next(i, u)) return false; u.pn += moe_expert_of_tile(u.pm) * 8; return true; }
};

template <class Epi, class Sched, bool GATHER, bool NOEPI = false>
__device__ __forceinline__ void gemm_phase(LAS unsigned char* lds, const Gemm g, const Sched& S, const Epi& E, LAS int* idxl, const int tid) {
    const int wid = __builtin_amdgcn_readfirstlane(tid >> 6), lane = tid & 63, wr = wid >> 2, wc = wid & 3, fr = lane & 15, fq = lane >> 4;
    const int K = g.K, nt = K / BK;
    unsigned voffA[2], voffB[2]; int RA[2];
#pragma unroll
    for (int i = 0; i < 2; ++i) { int R, C; stage_rc(tid * 16 + i * 8192, R, C); const int Rb = Epi::PERM ? ((R & ~31) + perm32(R & 31)) : R;
        voffA[i] = (unsigned)(R * K + C) * 2u; voffB[i] = (unsigned)(Rb * K + C) * 2u; RA[i] = R; if (GATHER) voffA[i] = (unsigned)C * 2u; }
    const size_t kstep = (size_t)(BK * 2);
    const size_t hstep = (size_t)HALF * K * 2;
    const size_t tstep = 2 * hstep;
    const unsigned ldsw = (unsigned)wid * 1024u;
    const int aoff = lds_byte(wr * 64 + fr, fq * 8), boff = lds_byte(wc * 32 + fr, fq * 8);
#define PG8_SA(b, h) (((b) * 2 + (h)) * HTB)
#define PG8_SB(b, h) ((4 + (b) * 2 + (h)) * HTB)
#define PG8_STAGE(bufoff, gbase, voff) do { _Pragma("unroll") for (int _i = 0; _i < 2; ++_i) \
        __builtin_amdgcn_global_load_lds((const unsigned*)((const char*)(gbase) + (voff)[_i]), (LAS unsigned*)(lds + (bufoff) + ldsw + _i * 8192), 16, 0, 0); } while (0)
#define PG8_STAGE_A(bufoff, h, pA, offs) do { _Pragma("unroll") for (int _i = 0; _i < 2; ++_i) { const char* _p; \
        if constexpr (GATHER) _p = (const char*)(pA) + (offs)[h][_i]; else _p = (const char*)(pA) + (size_t)(h) * hstep + voffA[_i]; \
        __builtin_amdgcn_global_load_lds((const unsigned*)_p, (LAS unsigned*)(lds + (bufoff) + ldsw + _i * 8192), 16, 0, 0); } } while (0)
#define PG8_LDA(dst, b, h) do { _Pragma("unroll") for (int m = 0; m < 4; ++m) _Pragma("unroll") for (int k = 0; k < 2; ++k) dst[m][k] = *(const LAS bf16x8*)(lds + PG8_SA(b, h) + aoff + m * 2048 + k * 1024); } while (0)
#define PG8_LDB(dst, b, h) do { _Pragma("unroll") for (int n = 0; n < 2; ++n) _Pragma("unroll") for (int k = 0; k < 2; ++k) dst[n][k] = *(const LAS bf16x8*)(lds + PG8_SB(b, h) + boff + n * 2048 + k * 1024); } while (0)
#define PG8_MMA(ai, bj, At, Bt) do { __builtin_amdgcn_s_setprio(1); _Pragma("unroll") for (int m = 0; m < 4; ++m) _Pragma("unroll") for (int n = 0; n < 2; ++n) _Pragma("unroll") for (int k = 0; k < 2; ++k) \
        acc[ai][bj][m][n] = __builtin_amdgcn_mfma_f32_16x16x32_bf16(Bt[n][k], At[m][k], acc[ai][bj][m][n], 0, 0, 0); __builtin_amdgcn_s_setprio(0); } while (0)
#define PG8_WAIT_V(n) asm volatile("s_waitcnt vmcnt(" #n ")" ::: "memory")
#define PG8_WAIT_L(n) asm volatile("s_waitcnt lgkmcnt(" #n ")" ::: "memory")
#define PG8_BAR __builtin_amdgcn_s_barrier()
#define PG8_SCHED __builtin_amdgcn_sched_barrier(0)
    Unit cur, nxt; int ui = 0;
    if (!S.next(0, cur)) return;
    f32x4 acc[2][2][4][2];
#pragma unroll
    for (int a = 0; a < 2; ++a)
#pragma unroll
        for (int b = 0; b < 2; ++b)
#pragma unroll
            for (int m = 0; m < 4; ++m)
#pragma unroll
                for (int n = 0; n < 2; ++n) acc[a][b][m][n] = (f32x4){0.f, 0.f, 0.f, 0.f};
    bf16x8 At[4][2], B0[2][2], B1[2][2];
    unsigned oc[2][2] = {{0u, 0u}, {0u, 0u}}, on[2][2] = {{0u, 0u}, {0u, 0u}};
#define PG8_GOFF(dst, ui_) do { if constexpr (GATHER) { _Pragma("unroll") for (int _h = 0; _h < 2; ++_h) _Pragma("unroll") for (int _i = 0; _i < 2; ++_i) \
        dst[_h][_i] = (unsigned)idxl[(ui_) * BM + _h * HALF + RA[_i]] * (unsigned)(K * 2) + voffA[_i]; } } while (0)
    if constexpr (GATHER) {
        for (int i = 0; i < 16; ++i) { Unit uu; if (!S.next(i, uu)) break; if (tid < BM) idxl[i * BM + tid] = g.rowidx[uu.pm * BM + tid]; }
        __syncthreads();
    }
    PG8_GOFF(oc, 0);
    const char* cA = GATHER ? (const char*)g.A : (const char*)g.A + (size_t)cur.pm * tstep; const char* cB = (const char*)g.Bt + (size_t)cur.pn * tstep;
    PG8_STAGE(PG8_SB(0, 0), cB, voffB); PG8_STAGE(PG8_SB(0, 1), cB + hstep, voffB); PG8_STAGE_A(PG8_SA(0, 0), 0, cA, oc); PG8_STAGE_A(PG8_SA(0, 1), 1, cA, oc);
    if (wr == 1) PG8_BAR;
    PG8_WAIT_V(2); PG8_BAR;
    PG8_STAGE(PG8_SB(1, 0), cB + kstep, voffB); PG8_STAGE_A(PG8_SA(1, 0), 0, cA + kstep, oc); PG8_STAGE(PG8_SB(1, 1), cB + hstep + kstep, voffB);
    PG8_WAIT_V(6); PG8_BAR;
    for (;;) {
        const bool has_next = S.next(ui + 1, nxt);
        if (has_next) PG8_GOFF(on, ui + 1); else { if constexpr (GATHER) { on[0][0] = oc[0][0]; on[0][1] = oc[0][1]; on[1][0] = oc[1][0]; on[1][1] = oc[1][1]; } }
        const char* nA = GATHER ? (const char*)g.A : (has_next ? (const char*)g.A + (size_t)nxt.pm * tstep : cA);
        const char* nB = has_next ? (const char*)g.Bt + (size_t)nxt.pn * tstep : cB;
        for (int t = 0; t < nt; t += 2) {
            const bool last = (t == nt - 2);
            const char* a1 = cA + (size_t)(t + 1) * kstep;
            const char* a2 = last ? nA : cA + (size_t)(t + 2) * kstep; const char* b2 = last ? nB : cB + (size_t)(t + 2) * kstep;
            const char* a3 = a2 + kstep; const char* b3 = b2 + kstep;
            unsigned o2[2][2];
#pragma unroll
            for (int _h = 0; _h < 2; ++_h)
#pragma unroll
                for (int _i = 0; _i < 2; ++_i) o2[_h][_i] = last ? on[_h][_i] : oc[_h][_i];
            PG8_LDB(B0, 0, 0); PG8_LDB(B1, 0, 1); PG8_SCHED; PG8_LDA(At, 0, 0); PG8_STAGE_A(PG8_SA(1, 1), 1, a1, oc);
            PG8_WAIT_V(8); PG8_WAIT_L(0); PG8_BAR; PG8_MMA(0, 0, At, B0); PG8_MMA(0, 1, At, B1); PG8_BAR; PG8_SCHED;
            PG8_LDA(At, 0, 1); PG8_STAGE(PG8_SB(0, 0), b2, voffB); PG8_STAGE(PG8_SB(0, 1), b2 + hstep, voffB); PG8_STAGE_A(PG8_SA(0, 0), 0, a2, o2);
            PG8_WAIT_V(8); PG8_WAIT_L(0); PG8_BAR; PG8_MMA(1, 0, At, B0); PG8_MMA(1, 1, At, B1); PG8_BAR; PG8_SCHED;
            PG8_LDB(B0, 1, 0); PG8_LDB(B1, 1, 1); PG8_SCHED; PG8_LDA(At, 1, 0); PG8_STAGE_A(PG8_SA(0, 1), 1, a2, o2);
            PG8_WAIT_V(8); PG8_WAIT_L(0); PG8_BAR; PG8_MMA(0, 0, At, B0); PG8_MMA(0, 1, At, B1); PG8_BAR; PG8_SCHED;
            PG8_LDA(At, 1, 1); PG8_STAGE(PG8_SB(1, 0), b3, voffB); PG8_STAGE(PG8_SB(1, 1), b3 + hstep, voffB); PG8_STAGE_A(PG8_SA(1, 0), 0, a3, o2);
            PG8_WAIT_V(8); PG8_WAIT_L(0); PG8_BAR; PG8_MMA(1, 0, At, B0); PG8_MMA(1, 1, At, B1); PG8_BAR; PG8_SCHED;
        }
        if (wr == 0) PG8_BAR;
        if constexpr (!NOEPI) E(acc, cur, wr, wc, fr, fq); else { float d_ = 0.f; _Pragma("unroll") for (int a_ = 0; a_ < 2; ++a_) _Pragma("unroll") for (int b_ = 0; b_ < 2; ++b_) _Pragma("unroll") for (int m_ = 0; m_ < 4; ++m_) _Pragma("unroll") for (int n_ = 0; n_ < 2; ++n_) d_ += acc[a_][b_][m_][n_][0] + acc[a_][b_][m_][n_][3]; if (d_ == 1.2345e30f) ((float*)g.A)[0] = d_; }
#ifdef EXP_EPI2
        if constexpr (Epi::PERM && !GATHER && sizeof(Epi) == 16) { asm volatile("" ::: "memory"); E(acc, cur, wr, wc, fr, fq); }
#endif
        if (!has_next) break;
#pragma unroll
        for (int a = 0; a < 2; ++a)
#pragma unroll
            for (int b = 0; b < 2; ++b)
#pragma unroll
                for (int m = 0; m < 4; ++m)
#pragma unroll
                    for (int n = 0; n < 2; ++n) acc[a][b][m][n] = (f32x4){0.f, 0.f, 0.f, 0.f};
        cur = nxt; cA = nA; cB = nB; ++ui;
        if constexpr (GATHER) { oc[0][0] = on[0][0]; oc[0][1] = on[0][1]; oc[1][0] = on[1][0]; oc[1][1] = on[1][1]; }
        if (wr == 1) PG8_BAR;
    }
    PG8_WAIT_V(0);
    PG8_BAR;
#undef PG8_SA
#undef PG8_SB
#undef PG8_STAGE
#undef PG8_STAGE_A
#undef PG8_GOFF
#undef PG8_LDA
#undef PG8_LDB
#undef PG8_MMA
#undef PG8_WAIT_V
#undef PG8_WAIT_L
#undef PG8_BAR
#undef PG8_SCHED
}

__device__ __forceinline__ u32x4 pack8(const f32x4 a, const f32x4 b) { u32x4 w; w.x = cvt_pk_bf16(a[0], a[1]); w.y = cvt_pk_bf16(a[2], a[3]); w.z = cvt_pk_bf16(b[0], b[1]); w.w = cvt_pk_bf16(b[2], b[3]); return w; }

struct EpiInProj {
    static constexpr bool PERM = true;
    bf16_t* P; const float* rope;
    unsigned* kmax;
    unsigned* kmaxAD;
    __device__ __forceinline__ void operator()(const f32x4 (&acc)[2][2][4][2], const Unit& u, int wr, int wc, int fr, int fq) const {
        const int pn = u.pn; const bool lat = u.pm < (NLAT / 256);
        const int kind = (pn >= 6 && pn <= 9) ? 2 : (((pn >= 12 && pn <= 15) || (pn >= 20 && pn <= 22)) ? 1 : 0);
        const int row0 = u.pm * BM + wr * 64 + fr;
        if (kind == 0) {
            const int col0 = pn * 256 + wc * 32 + 8 * fq;
            if (pn == 2 || pn == 3) {
                float kqa[2] = {0.f, 0.f};
#pragma unroll
                for (int ai = 0; ai < 2; ++ai)
#pragma unroll
                    for (int m = 0; m < 4; ++m) { bf16_t* rowp = P + (size_t)(row0 + ai * HALF + m * 16) * INW + col0;
#pragma unroll
                        for (int bj = 0; bj < 2; ++bj) { const u32x4 w = pack8(acc[ai][bj][m][0], acc[ai][bj][m][1]); *(u32x4*)(rowp + bj * HALF) = w;
                            float q2 = bflo(w.x) * bflo(w.x) + bfhi(w.x) * bfhi(w.x) + bflo(w.y) * bflo(w.y) + bfhi(w.y) * bfhi(w.y) + bflo(w.z) * bflo(w.z) + bfhi(w.z) * bfhi(w.z) + bflo(w.w) * bflo(w.w) + bfhi(w.w) * bfhi(w.w);
                            q2 += xshf<16>(q2); { auto rr = __builtin_amdgcn_permlane32_swap(__float_as_uint(q2), __float_as_uint(q2), false, false); q2 = __uint_as_float(rr[0]) + __uint_as_float(rr[1]); }
                            kqa[bj] = fmaxf(kqa[bj], q2); } }
#pragma unroll
                for (int bj = 0; bj < 2; ++bj) { float kq = kqa[bj]; kq = fmaxf(kq, xshf<1>(kq)); kq = fmaxf(kq, xshf<2>(kq)); kq = fmaxf(kq, xshf<4>(kq)); kq = fmaxf(kq, xshf<8>(kq));
                    if (fr == 0 && fq == 0) __hip_atomic_fetch_max(kmaxAD + (lat ? (u.pm >> 6) : (u.pm - NLAT / 256)) * 16 + ((pn - 2) * 2 + bj) * 4 + wc, __float_as_uint(kq), __ATOMIC_RELAXED, __HIP_MEMORY_SCOPE_AGENT); }
            } else {
#pragma unroll
            for (int ai = 0; ai < 2; ++ai)
#pragma unroll
                for (int m = 0; m < 4; ++m) { bf16_t* rowp = P + (size_t)(row0 + ai * HALF + m * 16) * INW + col0;
#pragma unroll
                    for (int bj = 0; bj < 2; ++bj) *(u32x4*)(rowp + bj * HALF) = pack8(acc[ai][bj][m][0], acc[ai][bj][m][1]); }
            }
        } else {
            const bool k1 = kind == 1; const int nf = k1 ? 32 : 16, pstep = k1 ? 32 : 16;
            const int cu1 = k1 ? pn * 256 + (wc >> 1) * 128 + (wc & 1) * 64 + 8 * fq : pn * 256 + wc * 64 + (fq >> 1) * 32 + 8 * (fq & 1);
            const int i0 = k1 ? 8 * fq : 8 * (fq & 1); const bool colp = k1 ? ((wc & 1) != 0) : ((fq >> 1) != 0);
            const float* TC = k1 ? rope : rope + 2 * 256 * 32; const float* TS = TC + 256 * nf;
            const int trow0 = ((u.pm * BM) & (SEQ - 1)) / 64 + wr;
            f32x4 nc0, nc1, ns0, ns1; float kq = 0.f;
#define RP_LOAD(g_) do { const int pos_ = colp ? (fr + 16 * ((g_) & 3)) : (trow0 + 2 * ((g_) >> 2)); const float* pc_ = TC + pos_ * nf + i0; const float* ps_ = TS + pos_ * nf + i0; \
                nc0 = *(const f32x4*)(pc_); nc1 = *(const f32x4*)(pc_ + 4); ns0 = *(const f32x4*)(ps_); ns1 = *(const f32x4*)(ps_ + 4); } while (0)
            if (lat) RP_LOAD(0);
#pragma unroll
            for (int gidx = 0; gidx < 8; ++gidx) { const int ai = gidx >> 2, m = gidx & 3; const int row = row0 + ai * HALF + m * 16;
                f32x4 a0 = acc[ai][0][m][0], a1 = acc[ai][0][m][1], b0 = acc[ai][1][m][0], b1 = acc[ai][1][m][1];
                if (lat) { const f32x4 c0 = nc0, c1 = nc1, s0 = ns0, s1 = ns1;
                    if (gidx < 7) RP_LOAD(gidx + 1);
                    const f32x4 x0 = a0 * c0 - b0 * s0, x1 = a1 * c1 - b1 * s1, y0 = b0 * c0 + a0 * s0, y1 = b1 * c1 + a1 * s1; a0 = x0; a1 = x1; b0 = y0; b1 = y1; }
                bf16_t* rowp = P + (size_t)row * INW + cu1;
                const u32x4 w0 = pack8(a0, a1), w1 = pack8(b0, b1); *(u32x4*)(rowp) = w0; *(u32x4*)(rowp + pstep) = w1;
                if (pn == 8 || pn == 9 || pn == 22) {
                    float q2 = bflo(w0.x) * bflo(w0.x) + bfhi(w0.x) * bfhi(w0.x) + bflo(w0.y) * bflo(w0.y) + bfhi(w0.y) * bfhi(w0.y) + bflo(w0.z) * bflo(w0.z) + bfhi(w0.z) * bfhi(w0.z) + bflo(w0.w) * bflo(w0.w) + bfhi(w0.w) * bfhi(w0.w)
                             + bflo(w1.x) * bflo(w1.x) + bfhi(w1.x) * bfhi(w1.x) + bflo(w1.y) * bflo(w1.y) + bfhi(w1.y) * bfhi(w1.y) + bflo(w1.z) * bflo(w1.z) + bfhi(w1.z) * bfhi(w1.z) + bflo(w1.w) * bflo(w1.w) + bfhi(w1.w) * bfhi(w1.w);
                    q2 += xshf<16>(q2); { auto rr = __builtin_amdgcn_permlane32_swap(__float_as_uint(q2), __float_as_uint(q2), false, false); q2 = __uint_as_float(rr[0]) + __uint_as_float(rr[1]); }
                    kq = fmaxf(kq, q2); } }
            if (pn == 8 || pn == 9 || pn == 22) {
                kq = fmaxf(kq, xshf<1>(kq)); kq = fmaxf(kq, xshf<2>(kq)); kq = fmaxf(kq, xshf<4>(kq)); kq = fmaxf(kq, xshf<8>(kq));
                if (fr == 0 && fq == 0) __hip_atomic_fetch_max(pn == 22 ? kmaxAD + 32 + (lat ? (u.pm >> 6) : (u.pm - NLAT / 256)) * 4 + wc : kmax + (lat ? (u.pm >> 6) : (u.pm - NLAT / 256)) * 8 + (pn - 8) * 4 + wc, __float_as_uint(kq), __ATOMIC_RELAXED, __HIP_MEMORY_SCOPE_AGENT); }
#undef RP_LOAD
        }
    }
};
struct EpiOutProj {
    static constexpr bool PERM = true;
    const float* xin_f32; const bf16_t* xin_bf; bf16_t* xout_bf; const float* xin_ctx; float* xout_ctx; const float* modl;
    __device__ __forceinline__ void operator()(const f32x4 (&acc)[2][2][4][2], const Unit& u, int wr, int wc, int fr, int fq) const {
        const bool lat = u.pm < (NLAT / 256); const int v = lat ? (u.pm >> 6) : 2;
        const float* g1 = modl + v * 12288 + 2 * DM;
        const int rloc = (lat ? u.pm : (u.pm - NLAT / 256)) * BM + wr * 64 + fr; const int col0 = u.pn * BM + wc * 32 + 8 * fq;
        f32x4 gv[2][2];
#pragma unroll
        for (int bj = 0; bj < 2; ++bj)
#pragma unroll
            for (int n = 0; n < 2; ++n) gv[bj][n] = *(const f32x4*)(g1 + col0 + bj * HALF + 4 * n);
        if (lat && xin_f32 == nullptr) {
#pragma unroll
            for (int ai = 0; ai < 2; ++ai) { u32x4 x[4][2];
#pragma unroll
                for (int m = 0; m < 4; ++m)
#pragma unroll
                    for (int bj = 0; bj < 2; ++bj) x[m][bj] = *(const u32x4*)(xin_bf + (size_t)(rloc + ai * HALF + m * 16) * DM + col0 + bj * HALF);
#pragma unroll
                for (int m = 0; m < 4; ++m)
#pragma unroll
                    for (int bj = 0; bj < 2; ++bj) { asm volatile("" : "+v"(x[m][bj])); const u32x4 w = x[m][bj];
                        const f32x4 x0 = (f32x4){bflo(w.x), bfhi(w.x), bflo(w.y), bfhi(w.y)}, x1 = (f32x4){bflo(w.z), bfhi(w.z), bflo(w.w), bfhi(w.w)};
                        *(u32x4*)(xout_bf + (size_t)(rloc + ai * HALF + m * 16) * DM + col0 + bj * HALF) = pack8(x0 + gv[bj][0] * acc[ai][bj][m][0], x1 + gv[bj][1] * acc[ai][bj][m][1]); }
            }
        } else {
            const float* xi = lat ? xin_f32 : xin_ctx;
#pragma unroll
            for (int ai = 0; ai < 2; ++ai) { f32x4 x[4][2][2];
#pragma unroll
                for (int m = 0; m < 4; ++m)
#pragma unroll
                    for (int bj = 0; bj < 2; ++bj)
#pragma unroll
                        for (int n = 0; n < 2; ++n) x[m][bj][n] = *(const f32x4*)(xi + (size_t)(rloc + ai * HALF + m * 16) * DM + col0 + bj * HALF + 4 * n);
#pragma unroll
                for (int m = 0; m < 4; ++m)
#pragma unroll
                    for (int bj = 0; bj < 2; ++bj) { asm volatile("" : "+v"(x[m][bj][0]), "+v"(x[m][bj][1]));
                        const f32x4 y0 = x[m][bj][0] + gv[bj][0] * acc[ai][bj][m][0], y1 = x[m][bj][1] + gv[bj][1] * acc[ai][bj][m][1]; const size_t off = (size_t)(rloc + ai * HALF + m * 16) * DM + col0 + bj * HALF;
                        if (lat) *(u32x4*)(xout_bf + off) = pack8(y0, y1); else { *(f32x4*)(xout_ctx + off) = y0; *(f32x4*)(xout_ctx + off + 4) = y1; } }
            }
        }
    }
};
struct EpiSwiGLU {
    static constexpr bool PERM = true;
    bf16_t* ACT;
    __device__ __forceinline__ void operator()(const f32x4 (&acc)[2][2][4][2], const Unit& u, int wr, int wc, int fr, int fq) const {
        const int pnl = u.pn & 7; const int row0 = u.pm * BM + wr * 64 + fr; const int col0 = pnl * 128 + wc * 32 + 8 * fq;
#pragma unroll
        for (int ai = 0; ai < 2; ++ai)
#pragma unroll
            for (int m = 0; m < 4; ++m) { f32x4 o[2];
#pragma unroll
                for (int n = 0; n < 2; ++n) { const f32x4 gt = acc[ai][0][m][n], up = acc[ai][1][m][n];
#pragma unroll
                    for (int j = 0; j < 4; ++j) o[n][j] = gt[j] * __builtin_amdgcn_rcpf(1.0f + __builtin_amdgcn_exp2f(-gt[j] * LOG2E)) * up[j]; }
                *(u32x4*)(ACT + (size_t)(row0 + ai * HALF + m * 16) * FF + col0) = pack8(o[0], o[1]); }
    }
};
struct EpiDown {
    static constexpr bool PERM = true;
    bf16_t* Y; const float* gatev;
    __device__ __forceinline__ void operator()(const f32x4 (&acc)[2][2][4][2], const Unit& u, int wr, int wc, int fr, int fq) const {
        const int pnl = u.pn & 7; const int row0 = u.pm * BM + wr * 64 + fr; const int col0 = pnl * 256 + wc * 32 + 8 * fq;
        float gs[2][4];
#pragma unroll
        for (int ai = 0; ai < 2; ++ai)
#pragma unroll
            for (int m = 0; m < 4; ++m) gs[ai][m] = gatev[row0 + ai * HALF + m * 16];
#pragma unroll
        for (int ai = 0; ai < 2; ++ai)
#pragma unroll
            for (int m = 0; m < 4; ++m) { asm volatile("" : "+v"(gs[ai][m]));
#pragma unroll
                for (int bj = 0; bj < 2; ++bj) *(u32x4*)(Y + (size_t)(row0 + ai * HALF + m * 16) * DM + col0 + bj * HALF) = pack8(acc[ai][bj][m][0] * gs[ai][m], acc[ai][bj][m][1] * gs[ai][m]); }
    }
};
}
namespace att {
constexpr int LDP = INW, LDOUT = DM, KVBLK = 64;
constexpr size_t SHM_V = KVBLK * 128 * 2, SHM_K = KVBLK * 128 * 2, SHM_ATTN = 2 * SHM_V + 2 * SHM_K + 8 * 64 * 4;
constexpr size_t QL_OFF = 73728, QL_STRIDE = 272;
constexpr size_t BIAS_OFF = SHM_ATTN;
constexpr float THR_L2 = 8.f * LOG2E;
#define KSWZ(row, colB) ((row) * 256 + ((colB) ^ (((row) & 7) << 4)))
#define SBAR() __builtin_amdgcn_sched_barrier(0)

struct Tiles { const bf16_t* kctx; const bf16_t* klat; long vdelta; int lat0, nt, nctx; };
struct MP {
    bool masked;
    int tq;
    int qr, rs, qc, cs;
    const LAS float* bias;
    float sink_l2;
    float lam, post;
    const float* normg;
};

__device__ __forceinline__ const bf16_t* tile_ptr(const Tiles& T, int j) { return (j < T.nctx) ? T.kctx + (long)j * KVBLK * LDP : T.klat + (long)(T.lat0 + j - T.nctx) * KVBLK * LDP; }

template <int MODE> __device__ __forceinline__ void apply_mask(f32x16& p0, f32x16& p1, int j, const Tiles& T, const MP& mp, int hi) {
  if constexpr (MODE == 1) return;
  if (!mp.masked || j < T.nctx) return;
  const int kt = T.lat0 + j - T.nctx;
  if constexpr (MODE == 2) {
    const int base = kt * KVBLK - mp.tq + 128;
#pragma unroll
    for (int r = 0; r < 16; ++r) { const int kk = crow(r, hi); if ((unsigned)(base + kk) > 256u) p0[r] = NEGBIG; if ((unsigned)(base + kk + 32) > 256u) p1[r] = NEGBIG; }
  }
  if constexpr (MODE == 0) {
    const bool rowok = (unsigned)(kt - mp.rs) < 8u; const LAS float* bp = mp.bias + ((kt - mp.qr + 7) * 31 + 15 - mp.qc + 4 * hi);
    const int t = rowok ? (4 * hi - mp.cs) : 0x40000000;
#pragma unroll
    for (int g = 0; g < 4; ++g) {
#pragma unroll
      for (int rr = 0; rr < 4; ++rr) { const int r = g * 4 + rr; const int c0 = (r & 3) + 8 * (r >> 2);
        const float b0 = bp[c0], b1 = bp[c0 + 32];
        p0[r] = ((unsigned)(t + c0) < 16u) ? p0[r] + b0 : NEGBIG; p1[r] = ((unsigned)(t + c0 + 32) < 16u) ? p1[r] + b1 : NEGBIG; }
      asm volatile("" ::: "memory");
    }
  }
}
template <int MODE> __device__ __forceinline__ void partialSM(f32x16& p0, f32x16& p1, float& m_reg, float& mn, float& alpha, int j, const Tiles& T, const MP& mp, int hi) {
  apply_mask<MODE>(p0, p1, j, T, mp, hi);
  float pmax = p0[0];
#pragma unroll
  for (int r = 1; r < 16; ++r) pmax = fmaxf(pmax, p0[r]);
#pragma unroll
  for (int r = 0; r < 16; ++r) pmax = fmaxf(pmax, p1[r]);
  { auto rr = __builtin_amdgcn_permlane32_swap(__float_as_uint(pmax), __float_as_uint(pmax), false, false);
    pmax = fmaxf(__uint_as_float(rr[0]), __uint_as_float(rr[1])); }
  if (__builtin_expect(__all(pmax - m_reg <= THR_L2), 1)) { mn = m_reg; alpha = 1.f; }
  else { mn = fmaxf(m_reg, pmax); alpha = __builtin_amdgcn_exp2f(m_reg - mn); m_reg = mn; }
#pragma unroll
  for (int r = 0; r < 16; ++r) p0[r] = p0[r] - mn;
#pragma unroll
  for (int r = 0; r < 16; ++r) p1[r] = p1[r] - mn;
#pragma unroll
  for (int r = 0; r < 16; ++r) p0[r] = __builtin_amdgcn_exp2f(p0[r]);
}
__device__ __forceinline__ void finishSM(f32x16& p0, f32x16& p1, float alpha, float& l_reg, bf16x8& pa0, bf16x8& pa1, bf16x8& pa2, bf16x8& pa3) {
#pragma unroll
  for (int r = 0; r < 16; ++r) p1[r] = __builtin_amdgcn_exp2f(p1[r]);
  float ps = 0;
#pragma unroll
  for (int r = 0; r < 16; ++r) ps += p0[r];
#pragma unroll
  for (int r = 0; r < 16; ++r) ps += p1[r];
  { auto rr = __builtin_amdgcn_permlane32_swap(__float_as_uint(ps), __float_as_uint(ps), false, false);
    ps = __uint_as_float(rr[0]) + __uint_as_float(rr[1]); }
  l_reg = l_reg * alpha + ps;
#define PK4(P, BASE, OUT) do { unsigned a0 = cvt_pk_bf16(P[BASE + 0], P[BASE + 1]), a1 = cvt_pk_bf16(P[BASE + 2], P[BASE + 3]);   \
    unsigned b0 = cvt_pk_bf16(P[BASE + 4], P[BASE + 5]), b1 = cvt_pk_bf16(P[BASE + 6], P[BASE + 7]);                              \
    auto r0 = __builtin_amdgcn_permlane32_swap(a0, b0, false, false); auto r1 = __builtin_amdgcn_permlane32_swap(a1, b1, false, false); \
    u32x4 w = {r0[0], r1[0], r0[1], r1[1]}; OUT = *reinterpret_cast<bf16x8*>(&w); } while (0)
  PK4(p0, 0, pa0); PK4(p0, 8, pa1); PK4(p1, 0, pa2); PK4(p1, 8, pa3);
#undef PK4
}
template <int NQ> __device__ __forceinline__ void qkt(f32x16& p0, f32x16& p1, const char* Ks, const bf16x8* qr, int r32, int hi, int cboff) {
  p0 = f32x16{}; p1 = f32x16{};
#pragma unroll
  for (int d0 = 0; d0 < NQ; ++d0) { const int cb = (d0 * 16 + hi * 8) * 2 + cboff;
    bf16x8 b0 = *reinterpret_cast<const bf16x8*>(Ks + KSWZ(r32, cb));
    bf16x8 b1 = *reinterpret_cast<const bf16x8*>(Ks + KSWZ(32 + r32, cb));
    p0 = __builtin_amdgcn_mfma_f32_32x32x16_bf16(b0, qr[d0], p0, 0, 0, 0);
    p1 = __builtin_amdgcn_mfma_f32_32x32x16_bf16(b1, qr[d0], p1, 0, 0, 0); }
}
__device__ __forceinline__ int v_st(int k, int c) { const int kk = (k & ~0xC) | ((k & 4) << 1) | ((k & 8) >> 1); return ((kk >> 3) * 4 + (c >> 5)) * 512 + ((kk & 7) * 32 + (c & 31)) * 2; }
__device__ __forceinline__ int v_rd_base(int lane) { return ((lane & 3) << 3) | (((lane >> 2) & 3) << 6) | (((lane >> 4) & 1) << 5) | (((lane >> 5) & 1) << 8); }
constexpr int v_rd_off(int d0, int ks, int half) { return d0 * 512 + ks * 4096 + half * 2048; }
template <int OFF> __device__ __forceinline__ s16x4 tr_read(int vb) {
  s16x4 r; asm volatile("ds_read_b64_tr_b16 %0, %1 offset:%2" : "=&v"(r) : "v"(vb), "i"(OFF) : "memory"); return r;
}
template <int D0> __device__ __forceinline__ void pv_one(f32x16& od, int vb, bf16x8 pa0, bf16x8 pa1, bf16x8 pa2, bf16x8 pa3) {
  const s16x4 l0 = tr_read<v_rd_off(D0, 0, 0)>(vb), h0 = tr_read<v_rd_off(D0, 0, 1)>(vb), l1 = tr_read<v_rd_off(D0, 1, 0)>(vb), h1 = tr_read<v_rd_off(D0, 1, 1)>(vb);
  const s16x4 l2 = tr_read<v_rd_off(D0, 2, 0)>(vb), h2 = tr_read<v_rd_off(D0, 2, 1)>(vb), l3 = tr_read<v_rd_off(D0, 3, 0)>(vb), h3 = tr_read<v_rd_off(D0, 3, 1)>(vb);
  asm volatile("s_waitcnt lgkmcnt(0)" ::: "memory"); SBAR();
#define PK(L, H) (bf16x8){L[0], L[1], L[2], L[3], H[0], H[1], H[2], H[3]}
  od = __builtin_amdgcn_mfma_f32_32x32x16_bf16(pa0, PK(l0, h0), od, 0, 0, 0);
  od = __builtin_amdgcn_mfma_f32_32x32x16_bf16(pa1, PK(l1, h1), od, 0, 0, 0);
  od = __builtin_amdgcn_mfma_f32_32x32x16_bf16(pa2, PK(l2, h2), od, 0, 0, 0);
  od = __builtin_amdgcn_mfma_f32_32x32x16_bf16(pa3, PK(l3, h3), od, 0, 0, 0);
#undef PK
}
__device__ __forceinline__ void pv_d0(f32x16* o, int vb, bf16x8 pa0, bf16x8 pa1, bf16x8 pa2, bf16x8 pa3) {
  pv_one<0>(o[0], vb, pa0, pa1, pa2, pa3); pv_one<1>(o[1], vb, pa0, pa1, pa2, pa3); pv_one<2>(o[2], vb, pa0, pa1, pa2, pa3); pv_one<3>(o[3], vb, pa0, pa1, pa2, pa3);
}

template <int MODE>
__device__ __forceinline__ void attn_unit_simple(const bf16_t* __restrict__ Qrow0, const Tiles T, bf16_t* __restrict__ Orow0, const MP mp, char* lds, const int tid) {
  const int wid = tid >> 6, lane = tid & 63, r32 = lane & 31, hi = lane >> 5;
  char* V_lds = lds; char* K_lds = lds + 2 * SHM_V;
  float* wsf = (float*)(lds + 2 * SHM_V + 2 * SHM_K) + wid * 64; float* li_l = wsf; float* al_l = wsf + 32;
  float m_reg = NEGBIG, l_reg = 0; f32x16 o[4] = {};
  const int sr = tid >> 4, sc = (tid & 15) * 8, vst0 = v_st(sr, sc), kst0 = KSWZ(sr, sc * 2);
  const int vb0 = (int)(uintptr_t)V_lds + v_rd_base(lane);
  const char* Qr = lds + QL_OFF + (wid * 32 + r32) * QL_STRIDE + hi * 16;
  bf16x8 vs0, vs1, ks0, ks1;
#define SLOAD1(j_) do { const bf16_t* kp_ = tile_ptr(T, (j_)) + (long)sr * LDP + sc; \
    vs0 = *reinterpret_cast<const bf16x8*>(kp_ + T.vdelta); vs1 = *reinterpret_cast<const bf16x8*>(kp_ + T.vdelta + 32L * LDP); \
    ks0 = *reinterpret_cast<const bf16x8*>(kp_); ks1 = *reinterpret_cast<const bf16x8*>(kp_ + 32L * LDP); } while (0)
#define SWRITE1(b) do { *(bf16x8*)(V_lds + (b) * SHM_V + vst0) = vs0; *(bf16x8*)(V_lds + (b) * SHM_V + vst0 + 8192) = vs1; \
    *(bf16x8*)(K_lds + (b) * SHM_K + kst0) = ks0; *(bf16x8*)(K_lds + (b) * SHM_K + kst0 + 8192) = ks1; } while (0)
  const int NT = T.nt;
  __syncthreads();
#pragma unroll
  for (int p = 0; p < 8; ++p) { const int idx = tid + 512 * p; *(bf16x8*)(lds + QL_OFF + (idx >> 4) * QL_STRIDE + (idx & 15) * 16) = *reinterpret_cast<const bf16x8*>(Qrow0 + (long)(idx >> 4) * LDP + (idx & 15) * 8); }
  SLOAD1(0); SWRITE1(0); __syncthreads();
  for (int j = 0; j < NT; ++j) {
    const int buf = j & 1;
    if (j + 1 < NT) SLOAD1(j + 1);
    bool live = true;
    if (mp.masked && j >= T.nctx) { const int kt = T.lat0 + j - T.nctx;
      if constexpr (MODE == 0) live = (unsigned)(kt - mp.rs) < 8u;
      if constexpr (MODE == 2) { const int q0w = __builtin_amdgcn_readfirstlane(mp.tq - r32); live = (kt * KVBLK + 63 >= q0w - 128) && (kt * KVBLK <= q0w + 31 + 128); } }
    if (live) {
    f32x16 p0, p1; float mn, al; bf16x8 pa0, pa1, pa2, pa3;
    { p0 = f32x16{}; p1 = f32x16{}; const char* Ks = K_lds + buf * SHM_K;
#pragma unroll
      for (int d0 = 0; d0 < 8; ++d0) { const int cb = (d0 * 16 + hi * 8) * 2; const bf16x8 q = *reinterpret_cast<const bf16x8*>(Qr + d0 * 32);
        const bf16x8 b0 = *reinterpret_cast<const bf16x8*>(Ks + KSWZ(r32, cb)), b1 = *reinterpret_cast<const bf16x8*>(Ks + KSWZ(32 + r32, cb));
        p0 = __builtin_amdgcn_mfma_f32_32x32x16_bf16(b0, q, p0, 0, 0, 0); p1 = __builtin_amdgcn_mfma_f32_32x32x16_bf16(b1, q, p1, 0, 0, 0); } }
    partialSM<MODE>(p0, p1, m_reg, mn, al, j, T, mp, hi);
    if (__any(al < 1.f)) { if (hi == 0) al_l[r32] = al; asm volatile("s_waitcnt lgkmcnt(0)" ::: "memory");
#pragma unroll
      for (int d = 0; d < 4; ++d)
#pragma unroll
        for (int r = 0; r < 16; ++r) o[d][r] *= al_l[crow(r, hi)]; }
    finishSM(p0, p1, al, l_reg, pa0, pa1, pa2, pa3);
    pv_d0(o, vb0 + buf * (int)SHM_V, pa0, pa1, pa2, pa3);
    }
    if (j + 1 < NT) SWRITE1(buf ^ 1);
    __syncthreads();
  }
  if constexpr (MODE == 2) l_reg += __builtin_amdgcn_exp2f(mp.sink_l2 - m_reg);
  if (hi == 0) li_l[r32] = l_reg; asm volatile("s_waitcnt lgkmcnt(0)" ::: "memory");
  bf16_t* Ow = Orow0 + (long)(wid * 32) * LDOUT;
#pragma unroll
  for (int r = 0; r < 16; ++r) { const int orow = crow(r, hi); const float rl = __builtin_amdgcn_rcpf(li_l[orow]);
#pragma unroll
    for (int d0 = 0; d0 < 4; ++d0) Ow[(long)orow * LDOUT + d0 * 32 + r32] = f2bf(o[d0][r] * rl); }
#undef SLOAD1
#undef SWRITE1
}
__device__ __forceinline__ void qktB(f32x16& p0, f32x16& p1, const char* Ks, const bf16x8* qr, int r32, int hi, int cboff, const f32x16& nb) {
  { const int cb = (hi * 8) * 2 + cboff;
    bf16x8 b0 = *reinterpret_cast<const bf16x8*>(Ks + KSWZ(r32, cb)), b1 = *reinterpret_cast<const bf16x8*>(Ks + KSWZ(32 + r32, cb));
    p0 = __builtin_amdgcn_mfma_f32_32x32x16_bf16(b0, qr[0], nb, 0, 0, 0); p1 = __builtin_amdgcn_mfma_f32_32x32x16_bf16(b1, qr[0], nb, 0, 0, 0); }
#pragma unroll
  for (int d0 = 1; d0 < 4; ++d0) { const int cb = (d0 * 16 + hi * 8) * 2 + cboff;
    bf16x8 b0 = *reinterpret_cast<const bf16x8*>(Ks + KSWZ(r32, cb)), b1 = *reinterpret_cast<const bf16x8*>(Ks + KSWZ(32 + r32, cb));
    p0 = __builtin_amdgcn_mfma_f32_32x32x16_bf16(b0, qr[d0], p0, 0, 0, 0); p1 = __builtin_amdgcn_mfma_f32_32x32x16_bf16(b1, qr[d0], p1, 0, 0, 0); }
}
__device__ __forceinline__ void expA(f32x16& p0) {
#pragma unroll
  for (int r = 0; r < 16; ++r) p0[r] = __builtin_amdgcn_exp2f(p0[r]);
}
__device__ __forceinline__ void finishB(f32x16& p0, f32x16& p1, float& l_reg, bf16x8& pa0, bf16x8& pa1, bf16x8& pa2, bf16x8& pa3) {
#pragma unroll
  for (int r = 0; r < 16; ++r) p1[r] = __builtin_amdgcn_exp2f(p1[r]);
  float ps = 0;
#pragma unroll
  for (int r = 0; r < 16; ++r) ps += p0[r];
#pragma unroll
  for (int r = 0; r < 16; ++r) ps += p1[r];
  l_reg += ps;
#define PK4(P, BASE, OUT) do { unsigned a0 = cvt_pk_bf16(P[BASE + 0], P[BASE + 1]), a1 = cvt_pk_bf16(P[BASE + 2], P[BASE + 3]);   \
    unsigned b0 = cvt_pk_bf16(P[BASE + 4], P[BASE + 5]), b1 = cvt_pk_bf16(P[BASE + 6], P[BASE + 7]);                              \
    auto r0 = __builtin_amdgcn_permlane32_swap(a0, b0, false, false); auto r1 = __builtin_amdgcn_permlane32_swap(a1, b1, false, false); \
    u32x4 w = {r0[0], r1[0], r0[1], r1[1]}; OUT = *reinterpret_cast<bf16x8*>(&w); } while (0)
  PK4(p0, 0, pa0); PK4(p0, 8, pa1); PK4(p1, 0, pa2); PK4(p1, 8, pa3);
#undef PK4
}

typedef short v4i16_t __attribute__((ext_vector_type(4)));
__device__ __forceinline__ s16x4 vtr(int addr) { return __builtin_bit_cast(s16x4, __builtin_amdgcn_ds_read_tr16_b64_v4i16((LAS v4i16_t*)(uintptr_t)(unsigned)addr)); }
template <int D0> __device__ __forceinline__ void pv_one_v(f32x16& od, int vb, bf16x8 pa0, bf16x8 pa1, bf16x8 pa2, bf16x8 pa3) {
  const s16x4 l0 = vtr(vb + v_rd_off(D0, 0, 0)), h0 = vtr(vb + v_rd_off(D0, 0, 1)), l1 = vtr(vb + v_rd_off(D0, 1, 0)), h1 = vtr(vb + v_rd_off(D0, 1, 1));
  const s16x4 l2 = vtr(vb + v_rd_off(D0, 2, 0)), h2 = vtr(vb + v_rd_off(D0, 2, 1)), l3 = vtr(vb + v_rd_off(D0, 3, 0)), h3 = vtr(vb + v_rd_off(D0, 3, 1));
#define PK(L, H) (bf16x8){L[0], L[1], L[2], L[3], H[0], H[1], H[2], H[3]}
  od = __builtin_amdgcn_mfma_f32_32x32x16_bf16(pa0, PK(l0, h0), od, 0, 0, 0);
  od = __builtin_amdgcn_mfma_f32_32x32x16_bf16(pa1, PK(l1, h1), od, 0, 0, 0);
  od = __builtin_amdgcn_mfma_f32_32x32x16_bf16(pa2, PK(l2, h2), od, 0, 0, 0);
  od = __builtin_amdgcn_mfma_f32_32x32x16_bf16(pa3, PK(l3, h3), od, 0, 0, 0);
#undef PK
}
__device__ __forceinline__ void pv_d0_v(f32x16* o, int vb, bf16x8 pa0, bf16x8 pa1, bf16x8 pa2, bf16x8 pa3) {
  pv_one_v<0>(o[0], vb, pa0, pa1, pa2, pa3); pv_one_v<1>(o[1], vb, pa0, pa1, pa2, pa3); pv_one_v<2>(o[2], vb, pa0, pa1, pa2, pa3); pv_one_v<3>(o[3], vb, pa0, pa1, pa2, pa3);
}
__device__ __forceinline__ void glds16(const void* g, unsigned lds_base) {
    unsigned sv; asm volatile("s_mov_b32 %0, m0\n\ts_mov_b32 m0, %2\n\ts_nop 0\n\tglobal_load_lds_dwordx4 %1, off\n\ts_mov_b32 m0, %0" : "=&s"(sv) : "v"(g), "s"(lds_base) : "memory"); }
__device__ __forceinline__ void glds16s(const void* gbase, unsigned voff, unsigned lds_base) {
    unsigned sv; asm volatile("s_mov_b32 %0, m0\n\ts_mov_b32 m0, %3\n\ts_nop 0\n\tglobal_load_lds_dwordx4 %1, %2\n\ts_mov_b32 m0, %0" : "=&s"(sv) : "v"(voff), "s"(gbase), "s"(lds_base) : "memory"); }
__device__ __forceinline__ int v_st_u(int k, int c) { return ((k >> 3) * 4 + (c >> 5)) * 512 + ((k & 7) * 32 + (c & 31)) * 2; }
__device__ __forceinline__ void attn_unit_a2(const bf16_t* __restrict__ Qrow0, const Tiles T, bf16_t* __restrict__ Orow0, const bool masked, const LAS float* bias, const int qr0, char* lds, const int tid, const float kb2, const float bmax) {
  const int wid = __builtin_amdgcn_readfirstlane(tid >> 6), lane = tid & 63, r32 = lane & 31, hi = lane >> 5;
  char* V_lds = lds; char* K_lds = lds + 2 * SHM_V;
  float* wsf = (float*)(lds + 2 * SHM_V + 2 * SHM_K) + wid * 64; float* li_l = wsf; float* al_l = wsf + 32;
  const int rp = wid >> 2, cbk = wid & 3;
  const int qloc = (2 * rp + (r32 >> 4)) * 64 + 16 * cbk + (r32 & 15);
  const int qr = qr0 + 2 * rp + (r32 >> 4), qc = 16 * cbk + (r32 & 15);
  const int rs = qr - 4 < 0 ? 0 : (qr - 4 > 248 ? 248 : qr - 4), cs = qc - 8 < 0 ? 0 : (qc - 8 > 48 ? 48 : qc - 8);
  const int kb = 16 * cbk - 8 < 0 ? 0 : (16 * cbk - 8 > 32 ? 32 : 16 * cbk - 8);
  const int rsa = (qr0 + 2 * rp - 4) < 0 ? 0 : ((qr0 + 2 * rp - 4) > 248 ? 248 : (qr0 + 2 * rp - 4)), rsb = (qr0 + 2 * rp - 3) < 0 ? 0 : ((qr0 + 2 * rp - 3) > 248 ? 248 : (qr0 + 2 * rp - 3));
  float l_reg = 0; f32x16 o[4] = {};
  const int sr = tid >> 4, sc = (tid & 15) * 8, vst0 = v_st_u(sr, sc), kst0 = KSWZ(sr, sc * 2);
  const int vb0 = (int)(uintptr_t)V_lds + v_rd_base(lane);
  const char* Qr = lds + QL_OFF + qloc * QL_STRIDE + hi * 16;
  bf16x8 vs0, vs1, ks0, ks1;
#define SLOAD1(j_) do { const bf16_t* kp_ = tile_ptr(T, (j_)) + (long)sr * LDP + sc; \
    vs0 = *reinterpret_cast<const bf16x8*>(kp_ + T.vdelta); vs1 = *reinterpret_cast<const bf16x8*>(kp_ + T.vdelta + 32L * LDP); \
    ks0 = *reinterpret_cast<const bf16x8*>(kp_); ks1 = *reinterpret_cast<const bf16x8*>(kp_ + 32L * LDP); } while (0)
#define SWRITE1(b) do { *(bf16x8*)(V_lds + (b) * SHM_V + vst0) = vs0; *(bf16x8*)(V_lds + (b) * SHM_V + vst0 + 8192) = vs1; \
    *(bf16x8*)(K_lds + (b) * SHM_K + kst0) = ks0; *(bf16x8*)(K_lds + (b) * SHM_K + kst0 + 8192) = ks1; } while (0)
  const int NT = T.nt;
  __syncthreads();
#pragma unroll
  for (int p = 0; p < 8; ++p) { const int idx = tid + 512 * p; *(bf16x8*)(lds + QL_OFF + (idx >> 4) * QL_STRIDE + (idx & 15) * 16) = *reinterpret_cast<const bf16x8*>(Qrow0 + (long)(idx >> 4) * LDP + (idx & 15) * 8); }
  SLOAD1(0); SWRITE1(0); __syncthreads();
  f32x16 nbv;
  { float q2 = 0.f;
#pragma unroll
    for (int d0 = 0; d0 < 8; ++d0) { const bf16x8 q = *reinterpret_cast<const bf16x8*>(Qr + d0 * 32); const u32x4 w = *reinterpret_cast<const u32x4*>(&q);
      q2 += bflo(w.x) * bflo(w.x) + bfhi(w.x) * bfhi(w.x) + bflo(w.y) * bflo(w.y) + bfhi(w.y) * bfhi(w.y) + bflo(w.z) * bflo(w.z) + bfhi(w.z) * bfhi(w.z) + bflo(w.w) * bflo(w.w) + bfhi(w.w) * bfhi(w.w); }
    { auto rr = __builtin_amdgcn_permlane32_swap(__float_as_uint(q2), __float_as_uint(q2), false, false); q2 = __uint_as_float(rr[0]) + __uint_as_float(rr[1]); }
    const float negb = -(sqrtf(q2 * kb2) * 1.0001f + bmax);
#pragma unroll
    for (int r = 0; r < 16; ++r) nbv[r] = negb; }
  for (int j = 0; j < NT; ++j) {
    const int buf = j & 1;
    if (j + 1 < NT) SLOAD1(j + 1);
    const bool ctxt = j < T.nctx; const int kr = T.lat0 + j - T.nctx;
    const bool live = ctxt || !masked || ((unsigned)(kr - rsa) < 8u) || ((unsigned)(kr - rsb) < 8u);
    if (live) {
      const int nblk = (ctxt || !masked) ? 2 : 1;
      for (int blk = 0; blk < nblk; ++blk) {
        const int kbb = (ctxt || !masked) ? 32 * blk : kb;
        f32x16 p = nbv; const char* Ks = K_lds + buf * SHM_K;
#pragma unroll
        for (int d0 = 0; d0 < 8; ++d0) { const int cb = (d0 * 16 + hi * 8) * 2; const bf16x8 q = *reinterpret_cast<const bf16x8*>(Qr + d0 * 32);
          const bf16x8 b0 = *reinterpret_cast<const bf16x8*>(Ks + KSWZ(kbb + r32, cb)); p = __builtin_amdgcn_mfma_f32_32x32x16_bf16(b0, q, p, 0, 0, 0); }
        if (masked && !ctxt) {
          const bool rowok = (unsigned)(kr - rs) < 8u; const LAS float* bp = bias + ((kr - qr + 7) * 31 + 15 - qc + kbb + 4 * hi);
          const int t = rowok ? (kbb + 4 * hi - cs) : 0x40000000;
          float bv[16];
#pragma unroll
          for (int r = 0; r < 16; ++r) bv[r] = bp[(r & 3) + 8 * (r >> 2)];
#pragma unroll
          for (int r = 0; r < 16; ++r) { const int c0 = (r & 3) + 8 * (r >> 2); p[r] = ((unsigned)(t + c0) < 16u) ? p[r] + bv[r] : NEGBIG; }
        }
        float ps = 0.f;
#pragma unroll
        for (int r = 0; r < 16; ++r) { p[r] = __builtin_amdgcn_exp2f(p[r]); ps += p[r]; }
        l_reg += ps;
        u32x4 w0 = {cvt_pk_bf16(p[0], p[1]), cvt_pk_bf16(p[2], p[3]), cvt_pk_bf16(p[4], p[5]), cvt_pk_bf16(p[6], p[7])}, w1 = {cvt_pk_bf16(p[8], p[9]), cvt_pk_bf16(p[10], p[11]), cvt_pk_bf16(p[12], p[13]), cvt_pk_bf16(p[14], p[15])};
        const bf16x8 pa0 = *reinterpret_cast<bf16x8*>(&w0), pa1 = *reinterpret_cast<bf16x8*>(&w1);
        const int vb = vb0 + buf * (int)SHM_V + (kbb >> 3) * 2048;
#pragma unroll
        for (int d0 = 0; d0 < 4; ++d0) { const s16x4 l0 = vtr(vb + d0 * 512), h0 = vtr(vb + d0 * 512 + 2048), l1 = vtr(vb + d0 * 512 + 4096), h1 = vtr(vb + d0 * 512 + 6144);
          o[d0] = __builtin_amdgcn_mfma_f32_32x32x16_bf16(pa0, (bf16x8){l0[0], l0[1], l0[2], l0[3], h0[0], h0[1], h0[2], h0[3]}, o[d0], 0, 0, 0);
          o[d0] = __builtin_amdgcn_mfma_f32_32x32x16_bf16(pa1, (bf16x8){l1[0], l1[1], l1[2], l1[3], h1[0], h1[1], h1[2], h1[3]}, o[d0], 0, 0, 0); }
      }
    }
    if (j + 1 < NT) SWRITE1(buf ^ 1);
    __syncthreads();
  }
  { auto rr = __builtin_amdgcn_permlane32_swap(__float_as_uint(l_reg), __float_as_uint(l_reg), false, false); l_reg = __uint_as_float(rr[0]) + __uint_as_float(rr[1]); }
  if (hi == 0) li_l[r32] = l_reg; asm volatile("s_waitcnt lgkmcnt(0)" ::: "memory");
#pragma unroll
  for (int r = 0; r < 16; ++r) { const int i = crow(r, hi); const float rl = __builtin_amdgcn_rcpf(li_l[i]);
    bf16_t* Ow = Orow0 + (long)((2 * rp + (i >> 4)) * 64 + 16 * cbk + (i & 15)) * LDOUT;
#pragma unroll
    for (int d0 = 0; d0 < 4; ++d0) Ow[d0 * 32 + r32] = f2bf(o[d0][r] * rl); }
#undef SLOAD1
#undef SWRITE1
}

#define B3_MF(a, b, c) __builtin_amdgcn_mfma_f32_32x32x16_bf16(a, b, c, 0, 0, 0)
#define B3_PIN(x) asm volatile("" : "+v"(x))
#define B3_WAITBAR(N) asm volatile("s_waitcnt vmcnt(" #N ") lgkmcnt(0)\n\ts_barrier" ::: "memory")
struct TilesB3 { const bf16_t* kctx; const bf16_t* klat; long vdelta; int nt; };
__device__ __forceinline__ void attn_unit_b3(const bf16_t* __restrict__ Qrow0, const TilesB3 T, bf16_t* __restrict__ Orow0, const MP mp, const unsigned* __restrict__ kmax2, char* lds, const int tid) {
  const int wid = __builtin_amdgcn_readfirstlane(tid >> 6), lane = tid & 63, r32 = lane & 31, hi = lane >> 5;
  constexpr int KRING = 0, VRING = 65536, WSF = 131072, SLOT = 16384;
  float* li_l = (float*)(lds + WSF) + wid * 64;
  float l_reg = 0; f32x16 o[4] = {}; bf16x8 qr[4];
  const int qrow = (wid & 3) * 32 + r32, map = wid >> 2, mapoff = map * 64;
  const bf16_t* Qw = Qrow0 + (long)qrow * LDP + mapoff + hi * 8;
#pragma unroll
  for (int d0 = 0; d0 < 4; ++d0) qr[d0] = *reinterpret_cast<const bf16x8*>(Qw + d0 * 16);
  f32x16 nb;
  { float q2 = 0.f;
#pragma unroll
    for (int d0 = 0; d0 < 4; ++d0) { const u32x4 w = *reinterpret_cast<const u32x4*>(&qr[d0]);
      q2 += bflo(w.x) * bflo(w.x) + bfhi(w.x) * bfhi(w.x) + bflo(w.y) * bflo(w.y) + bfhi(w.y) * bfhi(w.y) + bflo(w.z) * bflo(w.z) + bfhi(w.z) * bfhi(w.z) + bflo(w.w) * bflo(w.w) + bfhi(w.w) * bfhi(w.w); }
    { auto rr = __builtin_amdgcn_permlane32_swap(__float_as_uint(q2), __float_as_uint(q2), false, false); q2 = __uint_as_float(rr[0]) + __uint_as_float(rr[1]); }
    const float negb = -sqrtf(q2 * __uint_as_float(kmax2[map])) * 1.0001f;
#pragma unroll
    for (int r = 0; r < 16; ++r) nb[r] = negb; }
  B3_PIN(nb);
  const int rowk = 4 * wid + (lane >> 4); const unsigned koff = (unsigned)(rowk * LDP + (((lane & 15) ^ (rowk & 7)) * 8)) * 2u;
  const int sub0 = 2 * wid + (lane >> 5), key0 = (sub0 >> 2) * 8 + ((lane & 31) >> 2);
  const unsigned voff = (unsigned)(key0 * LDP + (sub0 & 3) * 32 + (lane & 3) * 8) * 2u + (unsigned)(T.vdelta * 2);
  const unsigned lds0 = (unsigned)(uintptr_t)lds; const unsigned kdst = lds0 + KRING + (unsigned)wid * 1024u, vdst = lds0 + VRING + (unsigned)wid * 1024u;
#define B3_TPTR(j_) ((const char*)(((j_) < 4) ? T.kctx + (long)(j_) * 64 * LDP : T.klat + (long)((j_) - 4) * 64 * LDP))
#define B3_DMAK(j_, sl_) do { const char* sp_ = B3_TPTR(j_); glds16s(sp_, koff, (unsigned)__builtin_amdgcn_readfirstlane(kdst + (sl_))); glds16s(sp_ + (size_t)32 * LDP * 2, koff, (unsigned)__builtin_amdgcn_readfirstlane(kdst + (sl_) + 8192)); } while (0)
#define B3_DMAV(j_, sl_) do { const char* sp_ = B3_TPTR(j_); glds16s(sp_, voff, (unsigned)__builtin_amdgcn_readfirstlane(vdst + (sl_))); glds16s(sp_ + (size_t)32 * LDP * 2, voff, (unsigned)__builtin_amdgcn_readfirstlane(vdst + (sl_) + 8192)); } while (0)
  int kro[4];
#pragma unroll
  for (int d0 = 0; d0 < 4; ++d0) kro[d0] = r32 * 256 + (((d0 * 16 + hi * 8) * 2 + mapoff * 2) ^ ((r32 & 7) << 4));
  const LAS char* kring = (const LAS char*)(uintptr_t)(lds0 + KRING);
  const int vbase = (int)lds0 + VRING + v_rd_base(lane);
#define B3_KF(kp_, n_, d0_) (*(const LAS bf16x8*)((kp_) + kro[d0_] + (n_) * 8192))
#define B3_VF(dst_, vp_, g_) do { const s16x4 lo_ = vtr((vp_) + v_rd_off((g_) & 3, (g_) >> 2, 0)), hi_ = vtr((vp_) + v_rd_off((g_) & 3, (g_) >> 2, 1)); dst_ = (bf16x8){lo_[0], lo_[1], lo_[2], lo_[3], hi_[0], hi_[1], hi_[2], hi_[3]}; } while (0)
  const int NT = T.nt;
#define B3_SL(j_) (((j_) & 3) * SLOT)
  f32x16 pA0, pA1, pB0, pB1; bf16x8 pa0, pa1, pa2, pa3;
  __syncthreads();
  B3_DMAK(0, B3_SL(0)); B3_DMAV(0, B3_SL(0)); B3_DMAK(1, B3_SL(1)); B3_DMAK(2, B3_SL(2)); B3_DMAV(1, B3_SL(1));
  B3_WAITBAR(8);
  { const LAS char* kp = kring + B3_SL(0); bf16x8 kf[8];
#pragma unroll
    for (int d0 = 0; d0 < 4; ++d0) { kf[2 * d0] = B3_KF(kp, 0, d0); kf[2 * d0 + 1] = B3_KF(kp, 1, d0); }
    pA0 = B3_MF(kf[0], qr[0], nb); pA1 = B3_MF(kf[1], qr[0], nb); pA0 = B3_MF(kf[2], qr[1], pA0); pA1 = B3_MF(kf[3], qr[1], pA1);
    pA0 = B3_MF(kf[4], qr[2], pA0); pA1 = B3_MF(kf[5], qr[2], pA1); pA0 = B3_MF(kf[6], qr[3], pA0); pA1 = B3_MF(kf[7], qr[3], pA1);
#pragma unroll
    for (int r = 0; r < 16; ++r) { pA0[r] = __builtin_amdgcn_exp2f(pA0[r]); pA1[r] = __builtin_amdgcn_exp2f(pA1[r]); l_reg += pA0[r] + pA1[r]; } }
  B3_WAITBAR(0);
#define B3_GA(MFS, P, i_, CA, CB) do { MFS; CA = cvt_pk_bf16(P[i_], P[(i_) + 1]); CB = cvt_pk_bf16(P[(i_) + 2], P[(i_) + 3]); } while (0)
#define B3_SW(OUT, c0_, c1_, c2_, c3_) do { u32x4 w_ = {c0_, c1_, c2_, c3_}; OUT = *reinterpret_cast<bf16x8*>(&w_); B3_PIN(OUT); } while (0)
#define B3_GB(MFS, X, i_) do { MFS; X[i_] = __builtin_amdgcn_exp2f(X[i_]); X[(i_) + 1] = __builtin_amdgcn_exp2f(X[(i_) + 1]); sacc += X[i_]; sacc += X[(i_) + 1]; B3_PIN(X); B3_PIN(sacc); SBAR(); } while (0)
#define B3_STEP(C0, C1, P0, P1, t_) do { SBAR(); \
    const LAS char* kp_ = kring + B3_SL(t_); const int vp_ = vbase + B3_SL((t_) - 1); bf16x8 kf[8], vf[8]; unsigned c0_, c1_, c2_, c3_; float sacc = 0.f; \
    _Pragma("unroll") for (int d0 = 0; d0 < 4; ++d0) { kf[2 * d0] = B3_KF(kp_, 0, d0); kf[2 * d0 + 1] = B3_KF(kp_, 1, d0); } SBAR(); \
    B3_GA(C0 = B3_MF(kf[0], qr[0], nb), P0, 0, c0_, c1_); SBAR(); \
    B3_GA(C1 = B3_MF(kf[1], qr[0], nb), P0, 4, c2_, c3_); B3_SW(pa0, c0_, c1_, c2_, c3_); SBAR(); \
    B3_GA(C0 = B3_MF(kf[2], qr[1], C0), P0, 8, c0_, c1_); SBAR(); \
    B3_GA(C1 = B3_MF(kf[3], qr[1], C1), P0, 12, c2_, c3_); B3_SW(pa1, c0_, c1_, c2_, c3_); SBAR(); \
    B3_VF(vf[0], vp_, 0); B3_GA(C0 = B3_MF(kf[4], qr[2], C0), P1, 0, c0_, c1_); SBAR(); \
    B3_VF(vf[1], vp_, 1); B3_GA(C1 = B3_MF(kf[5], qr[2], C1), P1, 4, c2_, c3_); B3_SW(pa2, c0_, c1_, c2_, c3_); SBAR(); \
    B3_VF(vf[2], vp_, 2); B3_GA(C0 = B3_MF(kf[6], qr[3], C0), P1, 8, c0_, c1_); SBAR(); \
    B3_VF(vf[3], vp_, 3); B3_GA(C1 = B3_MF(kf[7], qr[3], C1), P1, 12, c2_, c3_); B3_SW(pa3, c0_, c1_, c2_, c3_); SBAR(); \
    B3_VF(vf[4], vp_, 4);  B3_GB(o[0] = B3_MF(pa0, vf[0], o[0]), C0, 0); \
    B3_VF(vf[5], vp_, 5);  B3_GB(o[1] = B3_MF(pa0, vf[1], o[1]), C0, 2); \
    B3_VF(vf[6], vp_, 6);  B3_GB(o[2] = B3_MF(pa0, vf[2], o[2]), C0, 4); \
    B3_VF(vf[7], vp_, 7);  B3_GB(o[3] = B3_MF(pa0, vf[3], o[3]), C0, 6); \
    B3_VF(vf[0], vp_, 8);  B3_GB(o[0] = B3_MF(pa1, vf[4], o[0]), C0, 8); \
    B3_VF(vf[1], vp_, 9);  B3_GB(o[1] = B3_MF(pa1, vf[5], o[1]), C0, 10); \
    B3_VF(vf[2], vp_, 10); B3_GB(o[2] = B3_MF(pa1, vf[6], o[2]), C0, 12); \
    B3_VF(vf[3], vp_, 11); B3_GB(o[3] = B3_MF(pa1, vf[7], o[3]), C0, 14); \
    B3_VF(vf[4], vp_, 12); B3_GB(o[0] = B3_MF(pa2, vf[0], o[0]), C1, 0); \
    B3_VF(vf[5], vp_, 13); B3_GB(o[1] = B3_MF(pa2, vf[1], o[1]), C1, 2); \
    B3_VF(vf[6], vp_, 14); B3_GB(o[2] = B3_MF(pa2, vf[2], o[2]), C1, 4); \
    B3_VF(vf[7], vp_, 15); B3_GB(o[3] = B3_MF(pa2, vf[3], o[3]), C1, 6); \
    B3_GB(o[0] = B3_MF(pa3, vf[4], o[0]), C1, 8); \
    B3_GB(o[1] = B3_MF(pa3, vf[5], o[1]), C1, 10); \
    B3_GB(o[2] = B3_MF(pa3, vf[6], o[2]), C1, 12); \
    B3_GB(o[3] = B3_MF(pa3, vf[7], o[3]), C1, 14); \
    l_reg += sacc; } while (0)
  int t = 1;
  for (; t + 3 < NT; t += 2) {
    B3_DMAK(t + 2, B3_SL(t + 2)); B3_DMAK(t + 3, B3_SL(t + 3)); B3_DMAV(t + 1, B3_SL(t + 1)); B3_DMAV(t + 2, B3_SL(t + 2));
    B3_STEP(pB0, pB1, pA0, pA1, t); B3_STEP(pA0, pA1, pB0, pB1, t + 1);
    B3_WAITBAR(0);
  }
  B3_DMAK(t + 2, B3_SL(t + 2)); B3_DMAV(t + 1, B3_SL(t + 1)); B3_DMAV(t + 2, B3_SL(t + 2));
  B3_STEP(pB0, pB1, pA0, pA1, t); B3_STEP(pA0, pA1, pB0, pB1, t + 1);
  B3_WAITBAR(0);
  B3_STEP(pB0, pB1, pA0, pA1, t + 2);
  { unsigned c[16];
#pragma unroll
    for (int i = 0; i < 8; ++i) { c[i] = cvt_pk_bf16(pB0[2 * i], pB0[2 * i + 1]); c[8 + i] = cvt_pk_bf16(pB1[2 * i], pB1[2 * i + 1]); }
    B3_SW(pa0, c[0], c[1], c[2], c[3]); B3_SW(pa1, c[4], c[5], c[6], c[7]); B3_SW(pa2, c[8], c[9], c[10], c[11]); B3_SW(pa3, c[12], c[13], c[14], c[15]);
    pv_d0_v(o, vbase + B3_SL(NT - 1), pa0, pa1, pa2, pa3); }
#undef B3_STEP
#undef B3_GA
#undef B3_GB
#undef B3_SW
  { auto rr = __builtin_amdgcn_permlane32_swap(__float_as_uint(l_reg), __float_as_uint(l_reg), false, false); l_reg = __uint_as_float(rr[0]) + __uint_as_float(rr[1]); }
  if (hi == 0) li_l[r32] = l_reg; asm volatile("s_waitcnt lgkmcnt(0)" ::: "memory");
#pragma unroll
  for (int r = 0; r < 16; ++r) { const float rl = __builtin_amdgcn_rcpf(li_l[crow(r, hi)]);
#pragma unroll
    for (int d0 = 0; d0 < 4; ++d0) o[d0][r] *= rl; }
  __syncthreads();
  float* X = (float*)lds + (size_t)(wid & 3) * 32 * 128;
  if (wid >= 4) {
#pragma unroll
    for (int d0 = 0; d0 < 4; ++d0)
#pragma unroll
      for (int r = 0; r < 16; ++r) X[crow(r, hi) * 128 + d0 * 32 + r32] = o[d0][r];
  }
  __syncthreads();
  if (wid < 4) {
    float ss[16];
#pragma unroll
    for (int r = 0; r < 16; ++r) { float s = 0.f;
#pragma unroll
      for (int d0 = 0; d0 < 4; ++d0) { const float v = o[d0][r] - mp.lam * X[crow(r, hi) * 128 + d0 * 32 + r32]; o[d0][r] = v; s += v * v; }
      ss[r] = s; }
#pragma unroll
    for (int r = 0; r < 16; ++r) ss[r] = rsqrtf(sum32(ss[r]) * (1.0f / 128.0f) + 1e-6f) * mp.post;
    float gcol[4];
#pragma unroll
    for (int d0 = 0; d0 < 4; ++d0) gcol[d0] = mp.normg[d0 * 32 + r32];
    bf16_t* Ow = Orow0 + (long)(wid * 32) * LDOUT;
#pragma unroll
    for (int r = 0; r < 16; ++r) { const int orow = crow(r, hi);
#pragma unroll
      for (int d0 = 0; d0 < 4; ++d0) Ow[(long)orow * LDOUT + d0 * 32 + r32] = f2bf(o[d0][r] * ss[r] * gcol[d0]); }
  }
}
}
struct Args { const float* in[23]; float* out; unsigned char* ws; int ph_lo, ph_hi; };
typedef const Args __attribute__((address_space(4)))* KArgs;
struct Ctx {
    KArgs ka; LAS unsigned char* lds; char* ldsg; int tid, lane, wave, G, wg;
    __device__ __forceinline__ const float* in(int k) const { return ka->in[k]; }
    __device__ __forceinline__ float* out() const { return ka->out; }
    __device__ __forceinline__ unsigned char* ws() const { return ka->ws; }
    __device__ __forceinline__ float* modp() const { return (float*)(ws() + WS_MODP); }
    __device__ __forceinline__ float* mod() const { return (float*)(ws() + WS_MOD); }
    __device__ __forceinline__ float* misc() const { return (float*)(ws() + WS_MISC); }
    __device__ __forceinline__ float* rope() const { return (float*)(ws() + WS_ROPE); }
    __device__ __forceinline__ float* xc() const { return (float*)(ws() + WS_XC); }
    __device__ __forceinline__ bf16_t* xb() const { return (bf16_t*)(ws() + WS_XB); }
    __device__ __forceinline__ float* aff() const { return (float*)(ws() + WS_AFF); }
    __device__ __forceinline__ int* rowidx() const { return (int*)(ws() + WS_ROWIDX); }
    __device__ __forceinline__ float* gatev() const { return (float*)(ws() + WS_GATEV); }
    __device__ __forceinline__ int* slot() const { return (int*)(ws() + WS_SLOT); }
    __device__ __forceinline__ bf16_t* H() const { return (bf16_t*)(ws() + WS_H); }
    __device__ __forceinline__ bf16_t* P() const { return (bf16_t*)(ws() + WS_P); }
    __device__ __forceinline__ bf16_t* O() const { return (bf16_t*)(ws() + WS_O); }
    __device__ __forceinline__ bf16_t* S() const { return (bf16_t*)(ws() + WS_S); }
    __device__ __forceinline__ bf16_t* U() const { return (bf16_t*)(ws() + WS_H); }
    __device__ __forceinline__ bf16_t* ACT() const { return (bf16_t*)(ws() + WS_P + ACT_OFF); }
    __device__ __forceinline__ bf16_t* Y() const { return (bf16_t*)(ws() + WS_P + Y_OFF); }
    __device__ __forceinline__ bf16_t* w_in_t(int l) const { return (bf16_t*)(ws() + WS_W + (size_t)l * WL_BYTES + WL_IN); }
    __device__ __forceinline__ bf16_t* w_out_t(int l) const { return (bf16_t*)(ws() + WS_W + (size_t)l * WL_BYTES + WL_OUT); }
    __device__ __forceinline__ bf16_t* w_gu_t(int l) const { return (bf16_t*)(ws() + WS_W + (size_t)l * WL_BYTES + WL_GU); }
    __device__ __forceinline__ bf16_t* w_dn_t(int l) const { return (bf16_t*)(ws() + WS_W + (size_t)l * WL_BYTES + WL_DN); }
};
__device__ __forceinline__ int hw_lane() { int l; asm volatile("v_mbcnt_lo_u32_b32 %0, -1, 0\n\tv_mbcnt_hi_u32_b32 %0, -1, %0" : "=v"(l)); return l; }
__device__ __forceinline__ Ctx make_ctx(unsigned char* lds_raw, int wave_s) {
    Ctx F; KArgs p = (KArgs)__builtin_amdgcn_kernarg_segment_ptr(); asm volatile("" : "+s"(p));
    F.ka = p; F.lds = (LAS unsigned char*)lds_raw; F.ldsg = (char*)lds_raw;
    F.lane = hw_lane(); F.wave = wave_s; F.tid = wave_s * 64 + F.lane; F.G = gridDim.x; F.wg = blockIdx.x; return F;
}
enum { I_X = 0, I_C, I_CTX, I_CCTX, I_WMOD, I_BMOD, I_N1G, I_WIN, I_RPB, I_DLAM, I_DNG, I_RDF, I_RDB, I_GNG, I_GNB, I_SINK, I_WOUT, I_N2G, I_WR, I_WG, I_WU, I_WD, I_FNG };

__device__ __forceinline__ void ph_mod_partial(const Ctx& F) {
    const float* c = F.in(I_C); const float* cc = F.in(I_CCTX); const float* wm = F.in(I_WMOD);
    for (int gid = F.wg * 512 + F.tid; gid < 2 * 16 * 3072; gid += F.G * 512) {
        const int cg = gid % 3072, ks = (gid / 3072) % 16, l = gid / (3072 * 16);
        const float* w = wm + (size_t)l * DM * 12288 + (size_t)(ks * 128) * 12288 + cg * 4;
        f32x4 a0 = {0.f, 0.f, 0.f, 0.f}, a1 = a0, a2 = a0;
#pragma unroll 8
        for (int k = 0; k < 128; ++k) { const f32x4 wv = *(const f32x4*)(w + (size_t)k * 12288); const int kk = ks * 128 + k;
            const float s0 = siluf(c[kk]), s1 = siluf(c[DM + kk]), s2 = siluf(cc[kk]); a0 += s0 * wv; a1 += s1 * wv; a2 += s2 * wv; }
        float* o = F.modp() + (size_t)((ks * 2 + l) * 3) * 12288 + cg * 4;
        *(f32x4*)(o) = a0; *(f32x4*)(o + 12288) = a1; *(f32x4*)(o + 2 * 12288) = a2;
    }
}
__device__ __forceinline__ void ph_mod_reduce(const Ctx& F) {
    const int NMOD = 2 * 3 * 12288, NR128 = 256 * 32, NR64 = 256 * 16;
    for (int idx = F.wg * 512 + F.tid; idx < NMOD + NR128 + NR64 + 2 + 8; idx += F.G * 512) {
        if (idx < NMOD) { const int l = idx / (3 * 12288), v = (idx / 12288) % 3, col = idx % 12288; float s = F.in(I_BMOD)[l * 12288 + col];
            for (int ks = 0; ks < 16; ++ks) s += F.modp()[(size_t)((ks * 2 + l) * 3 + v) * 12288 + col];
            F.mod()[idx] = s;
        } else if (idx < NMOD + NR128) { const int e = idx - NMOD, pos = e >> 5, i = e & 31; const float inv = powf(10000.0f, -(float)i / 32.0f); const float a = (float)pos * inv;
            F.rope()[e] = cosf(a); F.rope()[NR128 + e] = sinf(a);
        } else if (idx < NMOD + NR128 + NR64) { const int e = idx - NMOD - NR128, pos = e >> 4, i = e & 15; const float inv = powf(10000.0f, -(float)i / 16.0f); const float a = (float)pos * inv;
            F.rope()[2 * NR128 + e] = cosf(a); F.rope()[2 * NR128 + NR64 + e] = sinf(a);
        } else if (idx >= NMOD + NR128 + NR64 + 2) { const int lh = idx - (NMOD + NR128 + NR64 + 2); const float* rp = F.in(I_RPB) + (size_t)lh * 15 * 31; float m = 0.f;
            for (int i = 0; i < 15 * 31; ++i) m = fmaxf(m, rp[i]);
            F.misc()[8 + lh] = m * LOG2E;
        } else { const int l = idx - (NMOD + NR128 + NR64); const float* dl = F.in(I_DLAM) + l * 4 * 64; float s1 = 0.f, s2 = 0.f;
            for (int i = 0; i < 64; ++i) { s1 += dl[i] * dl[64 + i]; s2 += dl[128 + i] * dl[192 + i]; }
            const float lam_init = 0.8f - 0.6f * expf(-0.3f * (float)l);
            F.misc()[l * 2] = expf(s1) - expf(s2) + lam_init; F.misc()[l * 2 + 1] = lam_init; }
    }
}
__device__ __forceinline__ int inproj_perm(int np) {
    const int pn = np >> 8, p = np & 255;
    if (pn >= 6 && pn <= 9) { const int half = p >> 7, pp = p & 127, sh = pp >> 5, rc = (pp >> 4) & 1, i = pp & 15; return pn * 256 + sh * 64 + rc * 32 + half * 16 + i; }
    if ((pn >= 12 && pn <= 15) || (pn >= 20 && pn <= 22)) { const int half = p >> 7, pp = p & 127, hs = pp >> 6, rc = (pp >> 5) & 1, i = pp & 31; return pn * 256 + hs * 128 + rc * 64 + half * 32 + i; }
    return np;
}
__device__ __forceinline__ float inproj_scale(int col) {
    if (col < C_AK) return 0.08838834764831845f * LOG2E;
    if (col >= C_BQ && col < C_BK) return 0.125f * LOG2E;
    if (col >= C_CK && col < C_CV) return 0.08838834764831845f;
    if (col >= C_DQ && col < C_DK) return 0.08838834764831845f * LOG2E;
    return 1.0f;
}
struct CvTile { const float* src; bf16_t* dst; int nsrc, K, n0, k0, kind; };
__device__ __forceinline__ CvTile cv_tile(const Ctx& F, int t) {
    const int T_IN = 96 * 32, T_OUT = 32 * 32, T_GU = 16 * 32 * 32, T_DN = 16 * 32 * 16, TL = T_IN + T_OUT + T_GU + T_DN;
    const int l = t / TL; int r = t % TL; CvTile c;
    if (r < T_IN) { c.kind = 0; c.n0 = (r % 96) * 64; c.k0 = (r / 96) * 64; c.src = F.in(I_WIN) + (size_t)l * DM * INW; c.nsrc = INW; c.K = DM; c.dst = F.w_in_t(l); }
    else if (r < T_IN + T_OUT) { r -= T_IN; c.kind = 1; c.n0 = (r % 32) * 64; c.k0 = (r / 32) * 64; c.src = F.in(I_WOUT) + (size_t)l * DM * DM; c.nsrc = DM; c.K = DM; c.dst = F.w_out_t(l); }
    else if (r < T_IN + T_OUT + T_GU) { r -= T_IN + T_OUT; c.kind = 2; const int e = r / 1024, rr = r % 1024; c.n0 = (rr % 32) * 64; c.k0 = (rr / 32) * 64;
        const int half = (c.n0 & 255) >> 7; c.src = (half ? F.in(I_WU) : F.in(I_WG)) + (size_t)(l * NE + e) * DM * FF; c.nsrc = FF; c.K = DM; c.dst = F.w_gu_t(l) + (size_t)e * 2048 * DM; }
    else { r -= T_IN + T_OUT + T_GU; c.kind = 3; const int e = r / 512, rr = r % 512; c.n0 = (rr % 32) * 64; c.k0 = (rr / 32) * 64; c.src = F.in(I_WD) + (size_t)(l * NE + e) * FF * DM; c.nsrc = DM; c.K = FF; c.dst = F.w_dn_t(l) + (size_t)e * DM * FF; }
    return c;
}
__device__ __forceinline__ void ph_convert(const Ctx& F) {
    LAS float* tile = (LAS float*)F.lds;
    const int TL = 96 * 32 + 32 * 32 + 16 * 32 * 32 + 16 * 32 * 16, NT = 2 * TL;
    const int tx = F.tid & 63, ty = F.tid >> 6, kx2 = F.tid & 31, ny = F.tid >> 5;
    float v[4][8]; float sc[4];
#define CV_LOAD(t0_) do { _Pragma("unroll") for (int u = 0; u < 4; ++u) { const int t = (t0_) + u; if (t < NT) { const CvTile c = cv_tile(F, t); \
            const int np = c.n0 + tx; int scol = np; sc[u] = 1.0f; \
            if (c.kind == 0) { scol = inproj_perm(np); sc[u] = inproj_scale(scol); } else if (c.kind == 2) { scol = (np >> 8) * 128 + (np & 127); } \
            _Pragma("unroll") for (int i = 0; i < 8; ++i) v[u][i] = c.src[(size_t)(c.k0 + ty + 8 * i) * c.nsrc + scol]; } } } while (0)
    int t0 = F.wg * 4;
    __syncthreads();
    if (t0 < NT) CV_LOAD(t0);
    for (; t0 < NT; t0 += 4 * F.G) {
#pragma unroll
        for (int u = 0; u < 4; ++u) { const int t = t0 + u; if (t < NT) {
#pragma unroll
            for (int i = 0; i < 8; ++i) tile[u * (64 * 65) + (ty + 8 * i) * 65 + tx] = v[u][i] * sc[u]; } }
        if (t0 + 4 * F.G < NT) CV_LOAD(t0 + 4 * F.G);
        asm volatile("s_waitcnt lgkmcnt(0)" ::: "memory"); __builtin_amdgcn_s_barrier();
#pragma unroll
        for (int u = 0; u < 4; ++u) { const int t = t0 + u; if (t < NT) { const CvTile c = cv_tile(F, t);
#pragma unroll
            for (int i = 0; i < 4; ++i) { const int nn = ny + 16 * i; const float lo = tile[u * (64 * 65) + (2 * kx2) * 65 + nn], hi = tile[u * (64 * 65) + (2 * kx2 + 1) * 65 + nn];
                *(unsigned*)(c.dst + (size_t)(c.n0 + nn) * c.K + c.k0 + 2 * kx2) = cvt_pk_bf16(lo, hi); } } }
        asm volatile("s_waitcnt lgkmcnt(0)" ::: "memory"); __builtin_amdgcn_s_barrier();
    }
#undef CV_LOAD
    __syncthreads();
}

__device__ __forceinline__ float wave_sum(float s) { return sum64(s); }
__device__ __forceinline__ void load_x(const Ctx& F, const void* xrow, bool bf, f32x4 (&x)[8]) {
    const int lane = F.lane;
    if (bf) {
#pragma unroll
        for (int j = 0; j < 8; ++j) { const u32x2 w = *(const u32x2*)((const bf16_t*)xrow + j * 256 + lane * 4); x[j] = (f32x4){bflo(w.x), bfhi(w.x), bflo(w.y), bfhi(w.y)}; }
    } else {
#pragma unroll
        for (int j = 0; j < 8; ++j) x[j] = *(const f32x4*)((const float*)xrow + j * 256 + lane * 4);
    }
}
__device__ __forceinline__ void ld_y(const Ctx& F, int s, u32x2 (&w)[8]) {
    const bf16_t* y = F.Y() + (size_t)s * DM + F.lane * 4;
#pragma unroll
    for (int j = 0; j < 8; ++j) w[j] = *(const u32x2*)(y + j * 256);
}
__device__ __forceinline__ void acc_y(f32x4 (&ys)[8], const u32x2 (&w)[8]) {
#pragma unroll
    for (int j = 0; j < 8; ++j) ys[j] += (f32x4){bflo(w[j].x), bfhi(w[j].x), bflo(w[j].y), bfhi(w[j].y)};
}
__device__ __forceinline__ int load_slots(const Ctx& F, int row) { return F.slot()[(size_t)row * NE + (F.lane & 15)]; }
__device__ __forceinline__ void moe_fold2(const Ctx& F, const LAS float* g2, int sva, int svb, f32x4 (&xa)[8], f32x4 (&xb)[8]) {
    f32x4 ya[8], yb[8];
#pragma unroll
    for (int j = 0; j < 8; ++j) { ya[j] = (f32x4){0.f, 0.f, 0.f, 0.f}; yb[j] = (f32x4){0.f, 0.f, 0.f, 0.f}; }
    unsigned ma = (unsigned)__builtin_amdgcn_ballot_w64(sva >= 0) & 0xFFFFu, mb = (unsigned)__builtin_amdgcn_ballot_w64(svb >= 0) & 0xFFFFu;
    while ((ma | mb) != 0u) {
        const bool ha = ma != 0u, hb = mb != 0u; u32x2 wa[8], wb[8];
        if (ha) { const int e = __builtin_ctz(ma); ma &= ma - 1u; ld_y(F, __builtin_amdgcn_readlane(sva, e), wa); }
        if (hb) { const int e = __builtin_ctz(mb); mb &= mb - 1u; ld_y(F, __builtin_amdgcn_readlane(svb, e), wb); }
        if (ha) acc_y(ya, wa);
        if (hb) acc_y(yb, wb);
    }
#pragma unroll
    for (int j = 0; j < 8; ++j) { const f32x4 g = *(const LAS f32x4*)(g2 + j * 256 + F.lane * 4); xa[j] += g * ya[j]; xb[j] += g * yb[j]; }
}
__device__ __forceinline__ float row_rstd(const f32x4 (&x)[8]) {
    float s = 0.f;
#pragma unroll
    for (int j = 0; j < 8; ++j) s += x[j][0] * x[j][0] + x[j][1] * x[j][1] + x[j][2] * x[j][2] + x[j][3] * x[j][3];
    s = wave_sum(s); return rsqrtf(s * (1.0f / DM) + 1e-6f);
}
__device__ __forceinline__ void norm1_row(const Ctx& F, int li, int row, const float* ng, f32x4 (&x)[8]) {
    const bool lat = row < NLAT; const int v = lat ? row / SEQ : 2;
    if (li != 0) {
        if (lat) { bf16_t* xo = F.xb() + (size_t)row * DM;
#pragma unroll
            for (int j = 0; j < 8; ++j) { u32x2 w; w.x = cvt_pk_bf16(x[j][0], x[j][1]); w.y = cvt_pk_bf16(x[j][2], x[j][3]); *(u32x2*)(xo + j * 256 + F.lane * 4) = w;
                x[j] = (f32x4){bflo(w.x), bfhi(w.x), bflo(w.y), bfhi(w.y)}; }
        } else { float* xo = F.xc() + (size_t)(row - NLAT) * DM;
#pragma unroll
            for (int j = 0; j < 8; ++j) *(f32x4*)(xo + j * 256 + F.lane * 4) = x[j]; } }
    const float rs = row_rstd(x);
    const LAS float* gs = (const LAS float*)F.lds + v * (2 * DM); const LAS float* s0p = gs + DM;
    bf16_t* h = F.H() + (size_t)row * DM;
#pragma unroll
    for (int j = 0; j < 8; ++j) { const int c = j * 256 + F.lane * 4; const f32x4 g = *(const LAS f32x4*)(gs + c), s0 = *(const LAS f32x4*)(s0p + c);
        const f32x4 y = x[j] * rs * g + s0; u32x2 w; w.x = cvt_pk_bf16(y[0], y[1]); w.y = cvt_pk_bf16(y[2], y[3]); *(u32x2*)(h + c) = w; }
}
__device__ __forceinline__ const void* norm1_src(const Ctx& F, int li, int row, bool& bf) {
    const bool lat = row < NLAT; bf = (li != 0) && lat;
    if (li == 0) return lat ? (const void*)(F.in(I_X) + (size_t)row * DM) : (const void*)(F.in(I_CTX) + (size_t)(row - NLAT) * DM);
    return lat ? (const void*)(F.xb() + (size_t)row * DM) : (const void*)(F.xc() + (size_t)(row - NLAT) * DM);
}
__device__ __forceinline__ void ph_norm1(const Ctx& F, int li) {
    const float* ng = F.in(I_N1G) + li * DM;
    __syncthreads();
    for (int i = F.tid; i < 3 * DM; i += 512) { const int v = i / DM, c = i - v * DM; const float* sh = F.mod() + (size_t)(li * 3 + v) * 12288;
        ((LAS float*)F.lds)[v * (2 * DM) + c] = ng[c] * (1.0f + sh[DM + c]); ((LAS float*)F.lds)[v * (2 * DM) + DM + c] = sh[c];
        if (li != 0) ((LAS float*)F.lds)[6 * DM + i] = F.mod()[(size_t)((li - 1) * 3 + v) * 12288 + 5 * DM + c]; }
    __syncthreads();
    for (int row = (F.wg * 8 + F.wave) * 2; row < MTOT; row += F.G * 16) {
        f32x4 xa[8], xb[8]; bool bfa, bfb; const void* pa = norm1_src(F, li, row, bfa); const void* pb = norm1_src(F, li, row + 1, bfb);
        int sva = -1, svb = -1; if (li != 0) { sva = load_slots(F, row); svb = load_slots(F, row + 1); }
        load_x(F, pa, bfa, xa); load_x(F, pb, bfb, xb);
        if (li != 0) moe_fold2(F, (const LAS float*)F.lds + 6 * DM + (row < NLAT ? row / SEQ : 2) * DM, sva, svb, xa, xb);
        norm1_row(F, li, row, ng, xa); norm1_row(F, li, row + 1, ng, xb);
    }
}
__device__ __forceinline__ void ph_final(const Ctx& F) {
    __syncthreads();
    for (int i = F.tid; i < 3 * DM; i += 512) ((LAS float*)F.lds)[i] = i < DM ? F.in(I_FNG)[i] : F.mod()[(size_t)(3 + (i / DM - 1)) * 12288 + 5 * DM + (i & (DM - 1))];
    __syncthreads();
    const LAS float* ng = (const LAS float*)F.lds;
    for (int row = (F.wg * 8 + F.wave) * 2; row < NLAT; row += F.G * 16) {
        f32x4 xa[8], xb[8]; const int sva = load_slots(F, row), svb = load_slots(F, row + 1);
        load_x(F, F.xb() + (size_t)row * DM, true, xa); load_x(F, F.xb() + (size_t)(row + 1) * DM, true, xb);
        moe_fold2(F, ng + DM + (row / SEQ) * DM, sva, svb, xa, xb);
        const float ra = row_rstd(xa), rb = row_rstd(xb); float* xr = F.out() + (size_t)row * DM;
#pragma unroll
        for (int j = 0; j < 8; ++j) { const int c = j * 256 + F.lane * 4; const f32x4 g = *(const LAS f32x4*)(ng + c); *(f32x4*)(xr + c) = xa[j] * ra * g; *(f32x4*)(xr + DM + c) = xb[j] * rb * g; }
    }
}
__device__ __forceinline__ void router_reduce_store(float (&v)[16], int lane, float* affrow) {
    float a[8];
#pragma unroll
    for (int i = 0; i < 8; ++i) { auto rr = __builtin_amdgcn_permlane32_swap(__float_as_uint(v[i]), __float_as_uint(v[i + 8]), false, false); a[i] = __uint_as_float(rr[0]) + __uint_as_float(rr[1]); }
    float b[4]; const bool b16 = (lane & 16) != 0;
#pragma unroll
    for (int i = 0; i < 4; ++i) { const float keep = b16 ? a[i + 4] : a[i], send = b16 ? a[i] : a[i + 4]; b[i] = keep + xshf<16>(send); }
    float c[2]; const bool b8 = (lane & 8) != 0;
#pragma unroll
    for (int i = 0; i < 2; ++i) { const float keep = b8 ? b[i + 2] : b[i], send = b8 ? b[i] : b[i + 2]; c[i] = keep + xshf<8>(send); }
    const bool b4 = (lane & 4) != 0; float lg = (b4 ? c[1] : c[0]) + xshf<4>(b4 ? c[0] : c[1]);
    lg += xshf<2>(lg); lg += xshf<1>(lg);
    float mx = lg; mx = fmaxf(mx, xshf<4>(mx)); mx = fmaxf(mx, xshf<8>(mx)); mx = fmaxf(mx, xshf<16>(mx));
    { auto rr = __builtin_amdgcn_permlane32_swap(__float_as_uint(mx), __float_as_uint(mx), false, false); mx = fmaxf(__uint_as_float(rr[0]), __uint_as_float(rr[1])); }
    const float ex = expf(lg - mx); float den = ex; den += xshf<4>(den); den += xshf<8>(den); den += xshf<16>(den);
    { auto rr = __builtin_amdgcn_permlane32_swap(__float_as_uint(den), __float_as_uint(den), false, false); den = __uint_as_float(rr[0]) + __uint_as_float(rr[1]); }
    const int e = ((lane >> 5) & 1) * 8 + ((lane >> 4) & 1) * 4 + ((lane >> 3) & 1) * 2 + ((lane >> 2) & 1);
    if ((lane & 3) == 0) affrow[e] = ex / den;
}
__device__ __forceinline__ void ph_norm2(const Ctx& F, int li, int rbeg, int rend, int wg0, int nwg) {
    const float* ng = F.in(I_N2G) + li * DM; const float* wr = F.in(I_WR) + (size_t)li * DM * NE; LAS float* wl = (LAS float*)F.lds;
    __syncthreads();
    int ts_ = F.tid; asm volatile("" : "+v"(ts_));
    for (int h = 0; h < 2; ++h) { f32x4 wv[8];
#pragma unroll
      for (int q = 0; q < 8; ++q) wv[q] = *(const f32x4*)(wr + (size_t)(ts_ + 512 * (h * 8 + q)) * 4);
#pragma unroll
      for (int q = 0; q < 8; ++q) { const int i4 = ts_ + 512 * (h * 8 + q), k = i4 >> 2, e0 = (i4 & 3) * 4; wl[(e0 + 0) * DM + k] = wv[q][0]; wl[(e0 + 1) * DM + k] = wv[q][1]; wl[(e0 + 2) * DM + k] = wv[q][2]; wl[(e0 + 3) * DM + k] = wv[q][3]; } }
    LAS float* gsl = wl + NE * DM;
    for (int i = F.tid; i < 2 * DM; i += 512) { const int v = (rbeg < NLAT) ? i / DM : 2, c = i & (DM - 1); gsl[i] = ng[c] * (1.0f + F.mod()[(size_t)(li * 3 + v) * 12288 + 4 * DM + c]); }
    __syncthreads();
    for (int row0 = rbeg + ((F.wg - wg0) * 8 + F.wave) * 4; row0 < rend; row0 += nwg * 32) {
        const bool lat = row0 < NLAT; const int v = lat ? row0 / SEQ : 2;
        const float* sh = F.mod() + (size_t)(li * 3 + v) * 12288 + 3 * DM; const LAS float* gsv = gsl + (lat ? v * DM : 0);
        f32x4 x[4][8];
        if (lat) { const bf16_t* xin = F.xb() + (size_t)row0 * DM;
#pragma unroll
            for (int r = 0; r < 4; ++r)
#pragma unroll
                for (int j = 0; j < 8; ++j) { const u32x2 w = *(const u32x2*)(xin + (size_t)r * DM + j * 256 + F.lane * 4); x[r][j] = (f32x4){bflo(w.x), bfhi(w.x), bflo(w.y), bfhi(w.y)}; }
        } else { const float* xin = F.xc() + (size_t)(row0 - NLAT) * DM;
#pragma unroll
            for (int r = 0; r < 4; ++r)
#pragma unroll
                for (int j = 0; j < 8; ++j) x[r][j] = *(const f32x4*)(xin + (size_t)r * DM + j * 256 + F.lane * 4); }
        float rs[4];
#pragma unroll
        for (int r = 0; r < 4; ++r) rs[r] = row_rstd(x[r]);
#pragma unroll
        for (int j = 0; j < 8; ++j) { const int c = j * 256 + F.lane * 4; const f32x4 s0 = *(const f32x4*)(sh + c); const f32x4 gs = *(const LAS f32x4*)(gsv + c);
#pragma unroll
            for (int r = 0; r < 4; ++r) { const f32x4 y = x[r][j] * rs[r] * gs + s0; x[r][j] = y; u32x2 w; w.x = cvt_pk_bf16(y[0], y[1]); w.y = cvt_pk_bf16(y[2], y[3]); *(u32x2*)(F.H() + (size_t)(row0 + r) * DM + c) = w; } }
        float lg[4][16];
#pragma unroll
        for (int e = 0; e < NE; ++e) { f32x2 a0 = {0.f, 0.f}, a1 = {0.f, 0.f}, a2 = {0.f, 0.f}, a3 = {0.f, 0.f};
#pragma unroll
            for (int j = 0; j < 8; ++j) { const f32x4 w = *(const LAS f32x4*)(wl + e * DM + j * 256 + F.lane * 4); const f32x2 wlo = __builtin_shufflevector(w, w, 0, 1), whi = __builtin_shufflevector(w, w, 2, 3);
                a0 += __builtin_shufflevector(x[0][j], x[0][j], 0, 1) * wlo; a0 += __builtin_shufflevector(x[0][j], x[0][j], 2, 3) * whi;
                a1 += __builtin_shufflevector(x[1][j], x[1][j], 0, 1) * wlo; a1 += __builtin_shufflevector(x[1][j], x[1][j], 2, 3) * whi;
                a2 += __builtin_shufflevector(x[2][j], x[2][j], 0, 1) * wlo; a2 += __builtin_shufflevector(x[2][j], x[2][j], 2, 3) * whi;
                a3 += __builtin_shufflevector(x[3][j], x[3][j], 0, 1) * wlo; a3 += __builtin_shufflevector(x[3][j], x[3][j], 2, 3) * whi; }
            float s0 = a0[0] + a0[1], s1 = a1[0] + a1[1], s2 = a2[0] + a2[1], s3 = a3[0] + a3[1];
            asm volatile("" : "+v"(s0), "+v"(s1), "+v"(s2), "+v"(s3) :: "memory"); __builtin_amdgcn_sched_barrier(0);
            lg[0][e] = s0; lg[1][e] = s1; lg[2][e] = s2; lg[3][e] = s3; }
#pragma unroll
        for (int r = 0; r < 4; ++r) router_reduce_store(lg[r], F.lane, F.aff() + (size_t)(row0 + r) * NE);
    }
}

__device__ __forceinline__ void topk_group(const Ctx& F, int N, int k, int row_base  , int e, int out_base  ) {
    LAS unsigned* keys = (LAS unsigned*)F.lds; LAS unsigned* hist = keys + 16384; LAS unsigned* sh = hist + 256;
    const int tid = F.tid;
    __syncthreads();
    for (int i = tid; i < N; i += 512) keys[i] = __float_as_uint(F.aff()[(size_t)(row_base + i) * NE + e]);
    unsigned prefix = 0u, need = (unsigned)k;
    for (int shift = 24; shift >= 0; shift -= 8) {
        if (tid < 256) hist[tid] = 0u;
        __syncthreads();
        for (int i = tid; i < N; i += 512) { const unsigned key = keys[i]; if (shift == 24 || (key >> (shift + 8)) == (prefix >> (shift + 8))) atomicAdd((unsigned*)&hist[(key >> shift) & 255u], 1u); }
        __syncthreads();
        if (tid < 64) {
            const int b0 = 255 - 4 * tid; const unsigned c0 = hist[b0], c1 = hist[b0 - 1], c2 = hist[b0 - 2], c3 = hist[b0 - 3]; const unsigned loc = c0 + c1 + c2 + c3;
            unsigned inc = loc;
#pragma unroll
            for (int o = 1; o < 64; o <<= 1) { const unsigned t = lane_up(inc, tid, o); if (tid >= o) inc += t; }
            const unsigned before = inc - loc;
            if (before < need && need <= inc) { unsigned cum = before; int d;
                if (cum + c0 >= need) d = b0; else { cum += c0; if (cum + c1 >= need) d = b0 - 1; else { cum += c1; if (cum + c2 >= need) d = b0 - 2; else { cum += c2; d = b0 - 3; } } }
                sh[0] = prefix | ((unsigned)d << shift); sh[1] = need - cum; }
        }
        __syncthreads();
        prefix = sh[0]; need = sh[1];
        __syncthreads();
    }
    const int per = N >= 512 ? N / 512 : 1; const int nact = N / per; unsigned cg = 0u, ce = 0u;
    if (tid < nact) for (int i = 0; i < per; ++i) { const unsigned key = keys[tid * per + i]; cg += key > prefix; ce += key == prefix; }
    unsigned pk = cg | (ce << 16), inc = pk;
#pragma unroll
    for (int o = 1; o < 64; o <<= 1) { const unsigned t = lane_up(inc, F.lane, o); if (F.lane >= o) inc += t; }
    if (F.lane == 63) sh[8 + F.wave] = inc;
    __syncthreads();
    unsigned woff = 0u;
    for (int w = 0; w < F.wave; ++w) woff += sh[8 + w];
    const unsigned exc = inc - pk + woff; unsigned gb = exc & 0xffffu, eb = exc >> 16; const unsigned ngt = (unsigned)k - need;
    if (tid < nact) for (int i = 0; i < per; ++i) { const int ti = tid * per + i; const unsigned key = keys[ti]; int s = -1;
        if (key > prefix) { s = (int)gb; ++gb; } else if (key == prefix) { if (eb < need) s = (int)(ngt + eb); ++eb; }
        const int row = row_base + ti;
        if (s >= 0) { F.rowidx()[out_base + s] = row; F.gatev()[out_base + s] = __uint_as_float(key); }
        F.slot()[(size_t)row * NE + e] = s >= 0 ? out_base + s : -1; }
    __syncthreads();
}
__device__ __forceinline__ void ph_topk(const Ctx& F, int li) {
    const int ngroups = (li == 0) ? 64 : 32;
    for (int g = F.wg; g < ngroups; g += F.G) {
        if (g < 32) { const int b = g >> 4, e = g & 15; topk_group(F, SEQ, CAP, b * SEQ, e, g * CAP); }
        else { const int b = (g - 32) >> 4, e = (g - 32) & 15; const int base = NBATCH * NE * CAP + e * 256;
            topk_group(F, LCTX, CAPC, NLAT + b * LCTX, e, base + b * CAPC);
            if (b == 0 && F.tid < 192) { F.rowidx()[base + 64 + F.tid] = 0; F.gatev()[base + 64 + F.tid] = 0.f; } }
    }
}

constexpr size_t CTL_KMAX = 16384;
namespace ret {
constexpr int TS = 136;
constexpr int TILE_B = 128 * TS * 2;
__device__ __forceinline__ float log2_gamma(float decay) { return -log1pf(expf(-decay)) * LOG2E; }
__device__ __forceinline__ int chunk_row0(int b, int c) { return c < 2 ? NLAT + b * LCTX + c * 128 : b * SEQ + (c - 2) * 128; }
__device__ __forceinline__ f32x16 mm_block(const LAS bf16_t* A, int ra, const LAS bf16_t* B, int rb, int r32, int hi, f32x16 acc) {
#pragma unroll
    for (int s = 0; s < 8; ++s) { const bf16x8 a = *(const LAS bf16x8*)(A + (ra + r32) * TS + 16 * s + 8 * hi), b = *(const LAS bf16x8*)(B + (rb + r32) * TS + 16 * s + 8 * hi);
        acc = __builtin_amdgcn_mfma_f32_32x32x16_bf16(a, b, acc, 0, 0, 0); }
    return acc;
}
__device__ __forceinline__ bf16x8 scale8(bf16x8 v, float s) {
    const u32x4 w = *reinterpret_cast<const u32x4*>(&v); u32x4 o;
    o.x = cvt_pk_bf16(bflo(w.x) * s, bfhi(w.x) * s); o.y = cvt_pk_bf16(bflo(w.y) * s, bfhi(w.y) * s); o.z = cvt_pk_bf16(bflo(w.z) * s, bfhi(w.z) * s); o.w = cvt_pk_bf16(bflo(w.w) * s, bfhi(w.w) * s);
    return *reinterpret_cast<const bf16x8*>(&o);
}
__device__ __forceinline__ f32x16 mm_block_rowscaled(const LAS bf16_t* A, int ra, float rowscale, const LAS bf16_t* B, int rb, int r32, int hi, f32x16 acc) {
#pragma unroll
    for (int s = 0; s < 8; ++s) { const bf16x8 a = scale8(*(const LAS bf16x8*)(A + (ra + r32) * TS + 16 * s + 8 * hi), rowscale), b = *(const LAS bf16x8*)(B + (rb + r32) * TS + 16 * s + 8 * hi);
        acc = __builtin_amdgcn_mfma_f32_32x32x16_bf16(a, b, acc, 0, 0, 0); }
    return acc;
}
__device__ __forceinline__ void ld4(const bf16_t* src, int ld, int tid, bf16x8 (&v)[4]) {
#pragma unroll
    for (int p = 0; p < 4; ++p) { const int idx = tid + 512 * p; v[p] = *reinterpret_cast<const bf16x8*>(src + (size_t)(idx >> 4) * ld + (idx & 15) * 8); }
}
__device__ __forceinline__ void st4_nat(LAS bf16_t* dst, int tid, const bf16x8 (&v)[4]) {
#pragma unroll
    for (int p = 0; p < 4; ++p) { const int idx = tid + 512 * p; *(LAS bf16x8*)(dst + (idx >> 4) * TS + (idx & 15) * 8) = v[p]; }
}
__device__ __forceinline__ void st4_tr(LAS bf16_t* dst, int tid, const bf16x8 (&v)[4], float e0, float e1) {
#pragma unroll
    for (int p = 0; p < 4; ++p) { const int idx = tid + 512 * p; const int m = idx >> 4, c0 = (idx & 15) * 8; const float sc = __builtin_amdgcn_exp2f(e0 + e1 * (float)m);
#pragma unroll
        for (int i = 0; i < 8; ++i) dst[(c0 + i) * TS + m] = f2bf(bf2f((bf16_t)v[p][i]) * sc); }
}

__device__ __forceinline__ void st4_vst(LAS bf16_t* dst, int tid, const bf16x8 (&v)[4]) {
#pragma unroll
    for (int p = 0; p < 4; ++p) { const int idx = tid + 512 * p; const int m = idx >> 4, c0 = (idx & 15) * 8; *(LAS bf16x8*)((LAS char*)dst + (m >> 6) * 16384 + att::v_st(m & 63, c0)) = v[p]; }
}
__device__ __forceinline__ void st4_vst_scaled(LAS bf16_t* dst, int tid, const bf16x8 (&v)[4], float e0, float e1) {
#pragma unroll
    for (int p = 0; p < 4; ++p) { const int idx = tid + 512 * p; const int m = idx >> 4, c0 = (idx & 15) * 8; *(LAS bf16x8*)((LAS char*)dst + (m >> 6) * 16384 + att::v_st(m & 63, c0)) = scale8(v[p], __builtin_amdgcn_exp2f(e0 + e1 * (float)m)); }
}
template <int KS> __device__ __forceinline__ bf16x8 trfrag(int base) {
    const s16x4 lo = att::vtr(base + (KS >> 2) * 16384 + att::v_rd_off(0, KS & 3, 0)), hi = att::vtr(base + (KS >> 2) * 16384 + att::v_rd_off(0, KS & 3, 1));
    return (bf16x8){lo[0], lo[1], lo[2], lo[3], hi[0], hi[1], hi[2], hi[3]};
}
__device__ __forceinline__ f32x16 mm_block_trB(const LAS bf16_t* A, int ra, int tb, int r32, int hi, f32x16 acc) {
#define RET_STEP(KS) acc = __builtin_amdgcn_mfma_f32_32x32x16_bf16(*(const LAS bf16x8*)(A + (ra + r32) * TS + 16 * KS + 8 * hi), trfrag<KS>(tb), acc, 0, 0, 0)
    RET_STEP(0); RET_STEP(1); RET_STEP(2); RET_STEP(3); RET_STEP(4); RET_STEP(5); RET_STEP(6); RET_STEP(7);
#undef RET_STEP
    return acc;
}

__device__ __forceinline__ void c1_unit(const Ctx& F, int li, int bh, int c) {
    const int b = bh >> 2, h = bh & 3, tid = F.tid, wid = F.wave, r32 = F.lane & 31, hi = F.lane >> 5;
    LAS bf16_t* TVt = (LAS bf16_t*)F.lds; LAS bf16_t* KF = TVt + 16384; LAS bf16_t* KB = KF + 16384;
    const float lf = log2_gamma(F.in(I_RDF)[li * 4 + h]), lb = log2_gamma(F.in(I_RDB)[li * 4 + h]);
    const bf16_t* base = F.P() + (size_t)chunk_row0(b, c) * INW + h * HD;
    bf16x8 kv[4], vv[4]; ld4(base + C_CK, INW, tid, kv); ld4(base + C_CV, INW, tid, vv);
    __syncthreads();
    st4_vst(TVt, tid, vv); st4_vst_scaled(KF, tid, kv, 127.f * lf, -lf); st4_vst_scaled(KB, tid, kv, 0.f, lb);
    __syncthreads();
    const int dvb = wid >> 1, dk0 = 2 * (wid & 1); const int l0 = (int)(uintptr_t)F.lds + att::v_rd_base(F.lane);
    const int av = l0 + dvb * 512, bf0 = l0 + 32768 + dk0 * 512, bb0 = l0 + 65536 + dk0 * 512;
    f32x16 f0 = {}, f1 = {}, g0 = {}, g1 = {};
#define C1_STEP(KS) do { const bf16x8 a_ = trfrag<KS>(av); f0 = __builtin_amdgcn_mfma_f32_32x32x16_bf16(a_, trfrag<KS>(bf0), f0, 0, 0, 0); f1 = __builtin_amdgcn_mfma_f32_32x32x16_bf16(a_, trfrag<KS>(bf0 + 512), f1, 0, 0, 0); \
        g0 = __builtin_amdgcn_mfma_f32_32x32x16_bf16(a_, trfrag<KS>(bb0), g0, 0, 0, 0); g1 = __builtin_amdgcn_mfma_f32_32x32x16_bf16(a_, trfrag<KS>(bb0 + 512), g1, 0, 0, 0); } while (0)
    C1_STEP(0); C1_STEP(1); C1_STEP(2); C1_STEP(3); C1_STEP(4); C1_STEP(5); C1_STEP(6); C1_STEP(7);
#undef C1_STEP
    bf16_t* Uf = F.U() + ((size_t)(0 * 8 + bh) * NCH + c) * 16384; bf16_t* Ub = F.U() + ((size_t)(1 * 8 + bh) * NCH + c) * 16384;
#pragma unroll
    for (int r = 0; r < 16; ++r) { const int o_ = (dvb * 32 + crow(r, hi)) * 128 + dk0 * 32 + r32; Uf[o_] = f2bf(f0[r]); Uf[o_ + 32] = f2bf(f1[r]); Ub[o_] = f2bf(g0[r]); Ub[o_ + 32] = f2bf(g1[r]); }
}
__device__ __forceinline__ void c2_scan(const Ctx& F, int li) {
    for (int gid = F.wg * 512 + F.tid; gid < 2 * 8 * 16384; gid += F.G * 512) {
        const int dir = gid >> 17, bh = (gid >> 14) & 7, el = gid & 16383, h = bh & 3;
        const float lg = log2_gamma((dir ? F.in(I_RDB) : F.in(I_RDF))[li * 4 + h]); const float cd = __builtin_amdgcn_exp2f(128.f * lg);
        const bf16_t* U = F.U() + (size_t)(dir * 8 + bh) * NCH * 16384 + el; bf16_t* S = F.S() + (size_t)(dir * 8 + bh) * NCH * 16384 + el;
        float s = 0.f;
        if (dir == 0) {
#pragma unroll 8
            for (int c = 0; c < NCH; ++c) { const float u = bf2f(U[(size_t)c * 16384]); S[(size_t)c * 16384] = f2bf(s); s = cd * s + u; }
        } else {
            { const float u1 = bf2f(U[(size_t)1 * 16384]), u0 = bf2f(U[0]); S[(size_t)1 * 16384] = f2bf(0.f); s = u1; S[0] = f2bf(s); s = cd * s + u0; }
#pragma unroll 8
            for (int c = NCH - 1; c >= 2; --c) { const float u = bf2f(U[(size_t)c * 16384]); S[(size_t)c * 16384] = f2bf(s); s = cd * s + u; }
        }
    }
}
__device__ __forceinline__ void c3_unit(const Ctx& F, int li, int bh, int c) {
    int tid_ = F.tid, lane_ = F.lane; asm volatile("" : "+v"(tid_), "+v"(lane_));
    const int b = bh >> 2, h = bh & 3, tid = tid_, wid = F.wave, lane = lane_, r32 = lane & 31, hi = lane >> 5;
    LAS bf16_t* TQ = (LAS bf16_t*)F.lds; LAS bf16_t* TK = TQ + 128 * TS; LAS bf16_t* TV = TK + 128 * TS; LAS bf16_t* TP = TV + 128 * TS; LAS float* ST = (LAS float*)(TP + 128 * TS);
    const float lf = log2_gamma(F.in(I_RDF)[li * 4 + h]), lb = log2_gamma(F.in(I_RDB)[li * 4 + h]);
    const int row0 = chunk_row0(b, c);
    const bf16_t* base = F.P() + (size_t)row0 * INW + h * HD;
    bf16x8 qv[4], kv[4], vv[4], sf[4], sb[4], gv[4];
    ld4(base + C_CQ, INW, tid, qv); ld4(base + C_CK, INW, tid, kv); ld4(base + C_CV, INW, tid, vv);
    ld4(F.S() + ((size_t)(0 * 8 + bh) * NCH + c) * 16384, 128, tid, sf);
    __syncthreads();
    st4_nat(TQ, tid, qv); st4_nat(TK, tid, kv); st4_vst(TV, tid, vv);
    __syncthreads();
    const int rb = wid >> 1, cb0 = 2 * (wid & 1);
    {
        f32x16 s0 = {}, s1 = {}; s0 = mm_block(TQ, rb * 32, TK, cb0 * 32, r32, hi, s0); s1 = mm_block(TQ, rb * 32, TK, (cb0 + 1) * 32, r32, hi, s1);
#pragma unroll
        for (int r = 0; r < 16; ++r) { const int n = rb * 32 + crow(r, hi);
#pragma unroll
            for (int i = 0; i < 2; ++i) { const int m = (cb0 + i) * 32 + r32; const int d = n - m; float w = __builtin_amdgcn_exp2f((float)d * (d > 0 ? lf : -lb)); w = (d == 0) ? 2.0f : w;
                TP[n * TS + m] = f2bf((i ? s1[r] : s0[r]) * w); } }
    }
    __syncthreads();
    st4_nat(TK, tid, sf);
    asm volatile("" ::: "memory");
    ld4(F.S() + ((size_t)(1 * 8 + bh) * NCH + c) * 16384, 128, tid, sb);
    ld4(base + C_CG, INW, tid, gv);
    __syncthreads();
    const int nrow = rb * 32 + r32;
    f32x16 o0 = {}, o1 = {};
    { const int tvb = (int)(uintptr_t)F.lds + 2 * TILE_B + att::v_rd_base(lane) + cb0 * 512;
      o0 = mm_block_trB(TP, rb * 32, tvb, r32, hi, o0); o1 = mm_block_trB(TP, rb * 32, tvb + 512, r32, hi, o1); }
    { const float qs = __builtin_amdgcn_exp2f((float)(nrow + 1) * lf);
      o0 = mm_block_rowscaled(TQ, rb * 32, qs, TK, cb0 * 32, r32, hi, o0); o1 = mm_block_rowscaled(TQ, rb * 32, qs, TK, (cb0 + 1) * 32, r32, hi, o1); }
    __syncthreads();
    st4_nat(TK, tid, sb);
    __syncthreads();
    { const float qs = __builtin_amdgcn_exp2f((float)(128 - nrow) * lb);
      o0 = mm_block_rowscaled(TQ, rb * 32, qs, TK, cb0 * 32, r32, hi, o0); o1 = mm_block_rowscaled(TQ, rb * 32, qs, TK, (cb0 + 1) * 32, r32, hi, o1); }
#pragma unroll
    for (int r = 0; r < 16; ++r) { float s1 = o0[r] + o1[r], s2 = o0[r] * o0[r] + o1[r] * o1[r];
        s1 = sum32(s1); s2 = sum32(s2);
        if (r32 == 0) { ST[(rb * 32 + crow(r, hi)) * 4 + (wid & 1) * 2] = s1; ST[(rb * 32 + crow(r, hi)) * 4 + (wid & 1) * 2 + 1] = s2; } }
    __syncthreads();
    st4_nat(TQ, tid, gv);
    __syncthreads();
    const float* gg = F.in(I_GNG) + li * 512 + h * HD; const float* gb = F.in(I_GNB) + li * 512 + h * HD;
    float g0 = gg[cb0 * 32 + r32], g1 = gg[(cb0 + 1) * 32 + r32], b0 = gb[cb0 * 32 + r32], b1 = gb[(cb0 + 1) * 32 + r32];
#pragma unroll
    for (int r = 0; r < 16; ++r) { const int n = rb * 32 + crow(r, hi); const f32x4 st = *(const LAS f32x4*)(ST + n * 4);
        const float mean = (st[0] + st[2]) * (1.0f / 128.0f), var = (st[1] + st[3]) * (1.0f / 128.0f) - mean * mean, rstd = rsqrtf(var + 1e-5f);
        bf16_t* op = F.O() + (size_t)(row0 + n) * DM + 1024 + h * HD;
        const float gt0 = bf2f(TQ[n * TS + cb0 * 32 + r32]), gt1 = bf2f(TQ[n * TS + (cb0 + 1) * 32 + r32]);
        op[cb0 * 32 + r32] = f2bf(siluf(gt0) * ((o0[r] - mean) * rstd * g0 + b0)); op[(cb0 + 1) * 32 + r32] = f2bf(siluf(gt1) * ((o1[r] - mean) * rstd * g1 + b1)); }
}
}
__device__ __forceinline__ int clampi(int x, int lo, int hi) { return x < lo ? lo : (x > hi ? hi : x); }
__device__ __forceinline__ void unitA(const Ctx& F, int li, int idx) {
    const bool ctxq = idx >= 512; const int bh = ctxq ? idx - 512 : (idx & 7), qb = ctxq ? 0 : (idx >> 3), b = bh >> 2, h = bh & 3;
    LAS float* biasL = (LAS float*)(F.lds + att::BIAS_OFF);
    __syncthreads();
    { const float* rp = F.in(I_RPB) + (size_t)(li * 4 + h) * 15 * 31; for (int i = F.tid; i < 15 * 31; i += 512) biasL[i] = rp[i] * LOG2E; }
    att::Tiles T; att::MP mp{};
    const bf16_t* ctxrow = F.P() + (size_t)(NLAT + b * LCTX) * INW; const bf16_t* latrow = F.P() + (size_t)(b * SEQ) * INW;
    T.kctx = ctxrow + C_AK + h * HD; T.klat = latrow + C_AK + h * HD; T.vdelta = C_AV - C_AK; T.nctx = 4;
    const int r32 = F.lane & 31;
    const int qr0 = qb * 4; const int lo = clampi(qr0 - 4, 0, 248), hi_ = clampi(qr0 - 1, 0, 248) + 7;
    T.lat0 = lo; T.nt = ctxq ? 4 : 4 + (hi_ - lo + 1);
    const size_t qrow = ctxq ? (size_t)(NLAT + b * LCTX) : (size_t)(b * SEQ + qb * 256);
    const unsigned* kmA = (const unsigned*)(F.ws() + WS_CTL + CTL_KMAX) + 64 + li * 64 + b * 16 + h * 4;
    const float kb2 = __uint_as_float(kmA[0]) + __uint_as_float(kmA[1]) + __uint_as_float(kmA[2]) + __uint_as_float(kmA[3]);
    att::attn_unit_a2(F.P() + qrow * INW + C_AQ + h * HD, T, F.O() + qrow * DM + h * HD, !ctxq, (const LAS float*)(F.lds + att::BIAS_OFF), qr0, F.ldsg, F.tid, kb2, F.misc()[8 + li * 4 + h]);
}
__device__ __forceinline__ void unitD(const Ctx& F, int li, int idx) {
    const bool ctxq = idx >= 512; const int bh = ctxq ? idx - 512 : (idx & 7), qb = ctxq ? 0 : (idx >> 3), b = bh >> 2, h = bh & 3, kv = h >> 1;
    att::Tiles T; att::MP mp{};
    const bf16_t* ctxrow = F.P() + (size_t)(NLAT + b * LCTX) * INW; const bf16_t* latrow = F.P() + (size_t)(b * SEQ) * INW;
    T.kctx = ctxrow + C_DK + kv * HD; T.klat = latrow + C_DK + kv * HD; T.vdelta = C_DV - C_DK; T.nctx = 4;
    mp.sink_l2 = F.in(I_SINK)[li * 4 + h] * LOG2E;
    const int lo = qb * 4 - 2 < 0 ? 0 : qb * 4 - 2, hi_ = qb * 4 + 5 > 255 ? 255 : qb * 4 + 5;
    T.lat0 = lo; T.nt = ctxq ? 4 : 4 + (hi_ - lo + 1); mp.masked = !ctxq; mp.tq = qb * 256 + F.wave * 32 + (F.lane & 31);
    const size_t qrow = ctxq ? (size_t)(NLAT + b * LCTX) : (size_t)(b * SEQ + qb * 256);
    att::attn_unit_simple<2>(F.P() + qrow * INW + C_DQ + h * HD, T, F.O() + qrow * DM + 1536 + h * HD, mp, F.ldsg, F.tid);
}
__device__ __forceinline__ void unitB(const Ctx& F, int li, int idx) {
    const bool ctxq = idx >= 1024; const int j = ctxq ? idx - 1024 : idx; const int bh = j & 7, qb = j >> 3, b = bh >> 2, h = bh & 3;
    att::TilesB3 T; att::MP mp{};
    const bf16_t* ctxrow = F.P() + (size_t)(NLAT + b * LCTX) * INW; const bf16_t* latrow = F.P() + (size_t)(b * SEQ) * INW;
    T.kctx = ctxrow + C_BK + h * HD; T.klat = latrow + C_BK + h * HD; T.vdelta = C_BV - C_BK; T.nt = ctxq ? 4 : 4 + SEQ / 64;
    mp.lam = F.misc()[li * 2]; mp.post = 1.0f - F.misc()[li * 2 + 1]; mp.normg = F.in(I_DNG) + li * HD;
    const size_t qrow = (ctxq ? (size_t)(NLAT + b * LCTX) : (size_t)(b * SEQ)) + (size_t)qb * 128;
    att::attn_unit_b3(F.P() + qrow * INW + C_BQ + h * HD, T, F.O() + qrow * DM + 512 + h * HD, mp, (const unsigned*)(F.ws() + WS_CTL + CTL_KMAX) + li * 16 + b * 8 + h * 2, F.ldsg, F.tid);
}

#define DYN_UNITS(ctr_, n_, slot_, BODY) do { unsigned nx_ = 0u; if (F.tid == 0) nx_ = __hip_atomic_fetch_add((ctr_), 1u, __ATOMIC_RELAXED, __HIP_MEMORY_SCOPE_AGENT); \
    for (;;) { __syncthreads(); if (F.tid == 0) (slot_)[0] = nx_; __syncthreads(); const int idx = (int)__builtin_amdgcn_readfirstlane((slot_)[0]); if (idx >= (n_)) break; \
        if (F.tid == 0) nx_ = __hip_atomic_fetch_add((ctr_), 1u, __ATOMIC_RELAXED, __HIP_MEMORY_SCOPE_AGENT); BODY } } while (0)
constexpr size_t CTL_DYN = 32768;
constexpr int LDS_SCRATCH = 147456, LDS_BYTES = LDS_SCRATCH + 256, IDXL_OFF = 131072;
constexpr int N_PHASES = 23;
__global__ void __launch_bounds__(512, 2) fwd_kernel(Args a) {
    extern __shared__ __attribute__((aligned(16))) unsigned char lds_raw[];
    volatile LAS unsigned* misc = (volatile LAS unsigned*)((LAS unsigned char*)lds_raw + LDS_SCRATCH);
    const int wave_s = __builtin_amdgcn_readfirstlane(threadIdx.x >> 6);
    if (wave_s == 0) { const int l0 = hw_lane(); if (l0 < 4) misc[l0] = 0u; }
    __syncthreads();
    const int lo = a.ph_lo, hi = a.ph_hi;
#ifdef DIAG_BARWAIT
    unsigned barwait_ = 0u;
#endif
    const bool use_bar = (hi - lo) > 1;
    XcdBarrier bar; bar.bar = (unsigned*)(a.ws + WS_CTL); bar.x = 0; bar.st = misc;
    if (use_bar) bar = xcd_barrier_post((unsigned*)(a.ws + WS_CTL), misc, wave_s == 0 && hw_lane() == 0);
#define FCTX const Ctx F = make_ctx(lds_raw, wave_s)
#ifndef PHMASK
#define PHMASK 0xFFFFFFFFu
#endif
#define EN(j) (((PHMASK) >> (j)) & 1u)
#ifndef REPMASK
#define REPMASK 0u
#endif
#define NREP(j) ((((REPMASK) >> (j)) & 1u) ? 2 : 1)
#define IN(k) (lo <= (k) && (k) < hi)
#ifdef EXP_BAR2
#define SEAM(k) do { if (IN(k) && IN((k) + 1)) { xcd_barrier(bar, wave_s == 0 && hw_lane() == 0); xcd_barrier(bar, wave_s == 0 && hw_lane() == 0); } } while (0)
#else
#ifdef DIAG_BARWAIT
#define SEAM(k) do { if (IN(k) && IN((k) + 1)) { const unsigned long long w0_ = wall_clock64(); xcd_barrier(bar, wave_s == 0 && hw_lane() == 0); if ((DIAG_SEAMS >> (k)) & 1u) barwait_ += (unsigned)(wall_clock64() - w0_); } } while (0)
#else
#define SEAM(k) do { if (IN(k) && IN((k) + 1)) xcd_barrier(bar, wave_s == 0 && hw_lane() == 0); } while (0)
#endif
#endif
    for (int rep_ = 0; rep_ < NREP(0); ++rep_) if (EN(0) && IN(0)) { FCTX; ph_mod_partial(F); } SEAM(0);
    for (int rep_ = 0; rep_ < NREP(1); ++rep_) if (EN(1) && IN(1)) { FCTX; ph_mod_reduce(F); ph_convert(F); } SEAM(1);
    const int F_G = gridDim.x;
    for (int li = 0; li < DEPTH; ++li) {
        const int pb = 2 + li * 10;
        for (int rep_ = 0; rep_ < (li == 0 ? NREP(2) : 1); ++rep_) if (EN(2) && IN(pb + 0)) { FCTX; ph_norm1(F, li); } SEAM(pb + 0);
        const bool split_in = use_bar && EN(3) && EN(4) && IN(pb + 1) && IN(pb + 2) && F_G >= 96;
        for (int rep_ = 0; rep_ < NREP(3); ++rep_) if (EN(3) && IN(pb + 1)) {
            if (split_in) {
                { FCTX; pg8::Gemm g{F.H(), F.w_in_t(li), DM, nullptr}; pg8::EpiInProj E{F.P(), F.rope(), (unsigned*)(F.ws() + WS_CTL + CTL_KMAX) + li * 16, (unsigned*)(F.ws() + WS_CTL + CTL_KMAX) + 64 + li * 64};
                  pg8::StaticOrder S; S.init(NLAT / 256, INW / 256, F.G, F.wg); pg8::gemm_phase<pg8::EpiInProj, pg8::StaticOrder, false>(F.lds, g, S, E, nullptr, F.tid); }
                xcd_barrier(bar, wave_s == 0 && hw_lane() == 0);
                if (blockIdx.x < 48) { FCTX; pg8::Gemm g{F.H(), F.w_in_t(li), DM, nullptr}; pg8::EpiInProj E{F.P(), F.rope(), (unsigned*)(F.ws() + WS_CTL + CTL_KMAX) + li * 16, (unsigned*)(F.ws() + WS_CTL + CTL_KMAX) + 64 + li * 64};
                  pg8::OffsetOrder S; S.init(NCTX / 256, INW / 256, 48, F.wg); S.pm0 = NLAT / 256; pg8::gemm_phase<pg8::EpiInProj, pg8::OffsetOrder, false>(F.lds, g, S, E, nullptr, F.tid); }
                else { FCTX; for (int idx = F.wg - 48; idx < 8 * (NCH - 2); idx += F.G - 48) ret::c1_unit(F, li, idx & 7, 2 + (idx >> 3)); }
            } else {
                FCTX; pg8::Gemm g{F.H(), F.w_in_t(li), DM, nullptr}; pg8::EpiInProj E{F.P(), F.rope(), (unsigned*)(F.ws() + WS_CTL + CTL_KMAX) + li * 16, (unsigned*)(F.ws() + WS_CTL + CTL_KMAX) + 64 + li * 64};
                pg8::StaticOrder S; S.init(MTOT / 256, INW / 256, F.G, F.wg);
#ifdef EXP_NOEPI_REP
                if (rep_ == 1) pg8::gemm_phase<pg8::EpiInProj, pg8::StaticOrder, false, true>(F.lds, g, S, E, nullptr, F.tid); else
#endif
                pg8::gemm_phase<pg8::EpiInProj, pg8::StaticOrder, false>(F.lds, g, S, E, nullptr, F.tid);
            }
        } SEAM(pb + 1);
        for (int rep_ = 0; rep_ < NREP(4); ++rep_) if (EN(4) && IN(pb + 2)) {
            FCTX;
            for (int r2_ = 0; r2_ < NREP(15); ++r2_) if (EN(15)) { if (split_in) { for (int idx = (F.wg + F.G - 120) % F.G; idx < 16; idx += F.G) ret::c1_unit(F, li, idx & 7, idx >> 3); }   else { for (int idx = F.wg; idx < 8 * NCH; idx += F.G) ret::c1_unit(F, li, idx & 7, idx >> 3); } }
            const int nAD = (li == 0) ? 520 : 512;
            for (int r2_ = 0; r2_ < NREP(13); ++r2_) if (EN(13)) for (int idx = (F.wg + 8) % F.G; idx < nAD; idx += F.G) unitA(F, li, idx);
            for (int r2_ = 0; r2_ < NREP(14); ++r2_) if (EN(14)) for (int idx = F.wg; idx < nAD; idx += F.G) unitD(F, li, idx);
        } SEAM(pb + 2);
        for (int rep_ = 0; rep_ < NREP(5); ++rep_) if (EN(5) && IN(pb + 3)) { FCTX; ret::c2_scan(F, li); } SEAM(pb + 3);
        for (int rep_ = 0; rep_ < NREP(6); ++rep_) if (EN(6) && IN(pb + 4)) {
            FCTX; const int nB = (li == 0) ? 1040 : 1024;
            if (EN(16)) for (int idx = F.wg; idx < nB; idx += F.G) unitB(F, li, idx);
            if (EN(17)) { if (use_bar) { unsigned* ctr = (unsigned*)(F.ws() + WS_CTL + CTL_DYN) + (li * 4 + 1) * 64; volatile LAS unsigned* slot = misc + 8;
                    DYN_UNITS(ctr, nB, slot, { if (idx < 1024) ret::c3_unit(F, li, idx & 7, 2 + (idx >> 3)); else ret::c3_unit(F, li, (idx - 1024) & 7, (idx - 1024) >> 3); }); }
                else for (int idx = F.wg; idx < nB; idx += F.G) { if (idx < 1024) ret::c3_unit(F, li, idx & 7, 2 + (idx >> 3)); else ret::c3_unit(F, li, (idx - 1024) & 7, (idx - 1024) >> 3); } }
        } SEAM(pb + 4);
        const bool split_out = use_bar && li == 0 && EN(7) && EN(8) && IN(pb + 5) && IN(pb + 6) && F_G >= 64;
        for (int rep_ = 0; rep_ < (li == 0 ? NREP(7) : 1); ++rep_) if (EN(7) && IN(pb + 5)) {
            FCTX; pg8::Gemm g{F.O(), F.w_out_t(li), DM, nullptr};
            pg8::EpiOutProj E{li == 0 ? F.in(I_X) : nullptr, F.xb(), F.xb(), F.in(I_CTX), F.xc(), F.mod() + (size_t)li * 3 * 12288};
            pg8::StaticOrder S; S.init((li == 0 && !split_out) ? MTOT / 256 : NLAT / 256, DM / 256, F.G, F.wg);
            pg8::gemm_phase<pg8::EpiOutProj, pg8::StaticOrder, false>(F.lds, g, S, E, nullptr, F.tid);
        } SEAM(pb + 5);
        for (int rep_ = 0; rep_ < NREP(8); ++rep_) if (EN(8) && IN(pb + 6)) {
            if (split_out) {
                if (blockIdx.x < 16) { FCTX; pg8::Gemm g{F.O(), F.w_out_t(li), DM, nullptr}; pg8::EpiOutProj E{F.in(I_X), F.xb(), F.xb(), F.in(I_CTX), F.xc(), F.mod() + (size_t)li * 3 * 12288};
                    pg8::OffsetOrder S; S.init(NCTX / 256, DM / 256, 16, F.wg); S.pm0 = NLAT / 256; pg8::gemm_phase<pg8::EpiOutProj, pg8::OffsetOrder, false>(F.lds, g, S, E, nullptr, F.tid); }
                else { FCTX; ph_norm2(F, li, 0, NLAT, 16, F.G - 16); }
                xcd_barrier(bar, wave_s == 0 && hw_lane() == 0);
                if (blockIdx.x < 16) { FCTX; ph_norm2(F, li, NLAT, MTOT, 0, 16); }
            } else { FCTX; ph_norm2(F, li, 0, NLAT, 0, F.G); if (li == 0) ph_norm2(F, li, NLAT, MTOT, 0, F.G); }
        } SEAM(pb + 6);
        for (int rep_ = 0; rep_ < NREP(9); ++rep_) if (EN(9) && IN(pb + 7)) { FCTX; ph_topk(F, li); } SEAM(pb + 7);
        for (int rep_ = 0; rep_ < NREP(10); ++rep_) if (EN(10) && IN(pb + 8)) {
            FCTX; pg8::Gemm g{F.H(), F.w_gu_t(li), DM, F.rowidx()}; pg8::MoeOrder S; S.init(li == 0 ? 272 : 256, 8, F.G, F.wg); pg8::EpiSwiGLU E{F.ACT()};
            pg8::gemm_phase<pg8::EpiSwiGLU, pg8::MoeOrder, true>(F.lds, g, S, E, (LAS int*)(F.lds + IDXL_OFF), F.tid);
        } SEAM(pb + 8);
        for (int rep_ = 0; rep_ < NREP(11); ++rep_) if (EN(11) && IN(pb + 9)) {
            FCTX; pg8::Gemm g{F.ACT(), F.w_dn_t(li), FF, nullptr}; pg8::MoeOrder S; S.init(li == 0 ? 272 : 256, 8, F.G, F.wg); pg8::EpiDown E{F.Y(), F.gatev()};
            pg8::gemm_phase<pg8::EpiDown, pg8::MoeOrder, false>(F.lds, g, S, E, nullptr, F.tid);
        } SEAM(pb + 9);
    }
    for (int rep_ = 0; rep_ < NREP(12); ++rep_) if (EN(12) && IN(22)) { FCTX; ph_final(F); }
#ifdef DIAG_BARWAIT
    if (blockIdx.x == DIAG_WG && wave_s == 0 && hw_lane() == 0 && barwait_ > (unsigned)DIAG_BARWAIT) a.out[(size_t)DIAG_WG * 3] += 1000.0f;
#endif
#undef IN
#undef SEAM
#undef FCTX
}

#ifndef N_LAUNCHES
#define N_LAUNCHES 1
#endif
extern "C" void kernel_launch(void* const* d_in, const int* in_sizes, int n_in, void* d_out, int out_size, void* d_ws, size_t ws_size, hipStream_t stream) {
    static int grid = 0;
    if (grid == 0) {
        if (n_in != 23 || out_size != NLAT * DM || ws_size < WS_END) { fprintf(stderr, "kernel_launch: unexpected shapes: n_in %d out %d ws %zu (need %zu)\n", n_in, out_size, ws_size, (size_t)WS_END); grid = -1; return; }
        int dev = 0, cus = 0, per_cu = 0;
        if (hipGetDevice(&dev) != hipSuccess || hipDeviceGetAttribute(&cus, hipDeviceAttributeMultiprocessorCount, dev) != hipSuccess) { grid = -1; return; }
        if (hipFuncSetAttribute((const void*)fwd_kernel, hipFuncAttributeMaxDynamicSharedMemorySize, LDS_BYTES) != hipSuccess) { fprintf(stderr, "kernel_launch: hipFuncSetAttribute failed\n"); grid = -1; return; }
        if (hipOccupancyMaxActiveBlocksPerMultiprocessor(&per_cu, (const void*)fwd_kernel, 512, LDS_BYTES) != hipSuccess || per_cu < 1) fprintf(stderr, "kernel_launch: occupancy query says %d\n", per_cu);
        (void)hipGetLastError();
        grid = cus;
    }
    if (grid < 0) return;
    hipMemsetAsync((char*)d_ws + WS_CTL, 0, CTL_BYTES, stream);
    Args a{};
    for (int i = 0; i < 23; ++i) a.in[i] = (const float*)d_in[i];
    a.out = (float*)d_out; a.ws = (unsigned char*)d_ws;
    for (int k = 0; k < N_LAUNCHES; ++k) {
        a.ph_lo = (N_LAUNCHES == 1) ? 0 : k; a.ph_hi = (N_LAUNCHES == 1) ? N_PHASES : k + 1;
        hipLaunchKernelGGL(fwd_kernel, dim3(grid), dim3(512), LDS_BYTES, stream, a);
    }
    const hipError_t le = hipPeekAtLastError();
    if (le != hipSuccess) fprintf(stderr, "kernel_launch: launch failed: %s\n", hipGetErrorName(le));
}
```

```cpp
#include <hip/hip_runtime.h>
#include <cstdio>
#include <cstdint>

#define LAS __attribute__((address_space(3)))
typedef unsigned short bf16_t;
typedef short bf16x8 __attribute__((ext_vector_type(8)));
typedef short s16x4 __attribute__((ext_vector_type(4)));
typedef float f32x4 __attribute__((ext_vector_type(4)));
typedef float f32x2 __attribute__((ext_vector_type(2)));
typedef float f32x16 __attribute__((ext_vector_type(16)));
typedef unsigned u32x4 __attribute__((ext_vector_type(4)));
typedef unsigned u32x2 __attribute__((ext_vector_type(2)));

constexpr int DM = 2048, NBATCH = 2, SEQ = 16384, LCTX = 256, DEPTH = 2;
constexpr int NLAT = NBATCH * SEQ;
constexpr int NCTX = NBATCH * LCTX;
constexpr int MTOT = NLAT + NCTX;
constexpr int INW = 6144;
constexpr int HD = 128;
constexpr int NE = 16, FF = 1024, CAP = 2048, CAPC = 32;
constexpr int MOE_ROWS = NBATCH * NE * CAP + NE * 256;
constexpr int NCH = 130;
constexpr int C_AQ = 0, C_AK = 512, C_AV = 1024, C_BQ = 1536, C_BK = 2048, C_BV = 2560, C_CQ = 3072, C_CK = 3584, C_CV = 4096, C_CG = 4608, C_DQ = 5120, C_DK = 5632, C_DV = 5888;
constexpr float LOG2E = 1.4426950408889634f;
constexpr float NEGBIG = -1e30f;

constexpr size_t al256(size_t x) { return (x + 255) / 256 * 256; }
constexpr size_t WS_CTL = 0;
constexpr size_t CTL_BYTES = 65536;
constexpr size_t WS_MODP = WS_CTL + CTL_BYTES;
constexpr size_t WS_MOD = WS_MODP + al256((size_t)16 * 2 * 3 * 12288 * 4);
constexpr size_t WS_MISC = WS_MOD + al256((size_t)2 * 3 * 12288 * 4);
constexpr size_t WS_ROPE = WS_MISC + 256;
constexpr size_t WS_XC = WS_ROPE + al256((size_t)(256 * 32 * 2 + 256 * 16 * 2) * 4);
constexpr size_t WS_AFF = WS_XC + al256((size_t)NCTX * DM * 4);
constexpr size_t WS_ROWIDX = WS_AFF + al256((size_t)MTOT * NE * 4);
constexpr size_t WS_GATEV = WS_ROWIDX + al256((size_t)MOE_ROWS * 4);
constexpr size_t WS_SLOT = WS_GATEV + al256((size_t)MOE_ROWS * 4);
constexpr size_t WS_H = WS_SLOT + al256((size_t)MTOT * NE * 4);
constexpr size_t H_BYTES = (size_t)MTOT * DM * 2;
constexpr size_t WS_P = WS_H + al256(H_BYTES);
constexpr size_t P_BYTES = (size_t)MTOT * INW * 2;
constexpr size_t WS_O = WS_P + al256(P_BYTES);
constexpr size_t WS_S = WS_O + al256(H_BYTES);
constexpr size_t S_BYTES = (size_t)2 * 8 * NCH * 16384 * 2;
constexpr size_t WS_W = WS_S + al256(S_BYTES);
constexpr size_t W_IN_B = (size_t)INW * DM * 2, W_OUT_B = (size_t)DM * DM * 2, W_GU_B = (size_t)NE * 2048 * DM * 2, W_DN_B = (size_t)NE * DM * FF * 2;
constexpr size_t WL_IN = 0, WL_OUT = WL_IN + W_IN_B, WL_GU = WL_OUT + W_OUT_B, WL_DN = WL_GU + W_GU_B, WL_BYTES = WL_DN + W_DN_B;
constexpr size_t WS_XB = WS_W + 2 * WL_BYTES;
constexpr size_t WS_END = WS_XB + al256((size_t)NLAT * DM * 2);
constexpr size_t ACT_OFF = 0;
constexpr size_t Y_OFF = al256((size_t)MOE_ROWS * FF * 2);
static_assert(Y_OFF + (size_t)MOE_ROWS * DM * 2 <= al256(P_BYTES) + H_BYTES, "Y must fit in P + O");
static_assert((size_t)2 * 8 * NCH * 16384 * 2 <= (size_t)NLAT * DM * 2, "retention U (bf16) must fit in the latent part of H");

__device__ __forceinline__ unsigned cvt_pk_bf16(float lo, float hi) { unsigned r; asm volatile("v_cvt_pk_bf16_f32 %0, %1, %2" : "=v"(r) : "v"(lo), "v"(hi)); return r; }
__device__ __forceinline__ bf16_t f2bf(float f) { return (bf16_t)(cvt_pk_bf16(f, 0.f) & 0xffffu); }
__device__ __forceinline__ float bf2f(bf16_t b) { return __uint_as_float(((unsigned)b) << 16); }
__device__ __forceinline__ float bflo(unsigned w) { return __uint_as_float(w << 16); }
__device__ __forceinline__ float bfhi(unsigned w) { return __uint_as_float(w & 0xffff0000u); }
__device__ __forceinline__ float siluf(float x) { return x / (1.0f + __expf(-x)); }
template <int M> __device__ __forceinline__ float xshf(float v) { return __int_as_float(__builtin_amdgcn_ds_swizzle(__float_as_int(v), (M << 10) | 0x1f)); }
__device__ __forceinline__ float sum32(float s) { s += xshf<1>(s); s += xshf<2>(s); s += xshf<4>(s); s += xshf<8>(s); s += xshf<16>(s); return s; }
__device__ __forceinline__ float sum64(float s) { s = sum32(s); auto rr = __builtin_amdgcn_permlane32_swap(__float_as_uint(s), __float_as_uint(s), false, false); return __uint_as_float(rr[0]) + __uint_as_float(rr[1]); }
__device__ __forceinline__ unsigned lane_up(unsigned v, int lane, int o) { return (unsigned)__builtin_amdgcn_ds_bpermute((lane - o) << 2, (int)v); }
__device__ __forceinline__ int crow(int r, int hi) { return (r & 3) + 8 * (r >> 2) + 4 * hi; }

#define XB_TMO      128
#define XB_XCNT(j)  (256  + 64 * (j))
#define XB_XSUB(j)  (1280 + 64 * (j))
#define XB_XGEN(j)  (2304 + 64 * (j))
#define XB_TOP      3328
#define XB_TOPGEN   3392
#define XCD_BAR_WORDS 3456
#define XB_SPIN_CAP (1u << 24)
__device__ __forceinline__ unsigned xb_ld(unsigned* p)              { return __hip_atomic_load(p, __ATOMIC_RELAXED, __HIP_MEMORY_SCOPE_AGENT); }
__device__ __forceinline__ unsigned xb_add(unsigned* p, unsigned v) { return __hip_atomic_fetch_add(p, v, __ATOMIC_RELAXED, __HIP_MEMORY_SCOPE_AGENT); }
__device__ __forceinline__ unsigned xb_xcc_id() { return (unsigned)__builtin_amdgcn_s_getreg((3 << 11) | 20) & 0xFu; }
#define XB_SPIN(cond, bar) do { unsigned _sp = 0; while (cond) { __builtin_amdgcn_s_sleep(1); \
    if ((++_sp & 255u) == 0u) { if (xb_ld(&(bar)[XB_TMO])) break; if (_sp > XB_SPIN_CAP) { atomicAdd(&(bar)[XB_TMO], 1u); break; } } } } while (0)
struct XcdBarrier { unsigned* bar; unsigned x; volatile LAS unsigned* st; };
__device__ __forceinline__ XcdBarrier xcd_barrier_post(unsigned* bar, volatile LAS unsigned* st, bool leader) {
    XcdBarrier b; b.bar = bar; b.x = xb_xcc_id(); b.st = st;
    if (leader) (void)xb_add(&bar[XB_XCNT(b.x)], 1u);
    return b;
}
__device__ __forceinline__ void xcd_barrier_complete(unsigned* bar, unsigned x, unsigned& nloc, unsigned& nx) {
    const unsigned G = gridDim.x * gridDim.y * gridDim.z;
    unsigned sum, cnt, mine, sp = 0u;
    for (;;) {
        sum = 0u; cnt = 0u; mine = 0u;
#pragma unroll
        for (unsigned j = 0; j < 16; ++j) { const unsigned c = xb_ld(&bar[XB_XCNT(j)]); sum += c; cnt += (c > 0u) ? 1u : 0u; mine = (j == x) ? c : mine; }
        if (sum == G) break;
        __builtin_amdgcn_s_sleep(1);
        if ((++sp & 255u) == 0u) { if (xb_ld(&bar[XB_TMO])) break; if (sp > XB_SPIN_CAP) { atomicAdd(&bar[XB_TMO], 1u); break; } }
    }
    nloc = mine > 0u ? mine : 1u; nx = cnt > 0u ? cnt : 1u;
}
__device__ __forceinline__ void xcd_barrier(const XcdBarrier& b, bool leader) {
    asm volatile("s_waitcnt vmcnt(0)" ::: "memory");
    __syncthreads();
    if (leader) {
        unsigned* bar = b.bar;
        __builtin_amdgcn_s_waitcnt(0);
        unsigned nloc = b.st[0], nx = b.st[1];
        if (nloc == 0u) { xcd_barrier_complete(bar, b.x, nloc, nx); b.st[0] = nloc; b.st[1] = nx; }
        const unsigned old = xb_add(&bar[XB_XSUB(b.x)], 1u);
        const unsigned gen = old / nloc;
        if (old + 1u == (gen + 1u) * nloc) {
            __builtin_amdgcn_fence(__ATOMIC_RELEASE, "agent");
            asm volatile("s_waitcnt vmcnt(0)" ::: "memory");
            const unsigned og = xb_add(&bar[XB_TOP], 1u);
            const unsigned tg = og / nx;
            if (og + 1u == (tg + 1u) * nx) xb_add(&bar[XB_TOPGEN], 1u);
            else XB_SPIN(xb_ld(&bar[XB_TOPGEN]) == tg, bar);
            __builtin_amdgcn_fence(__ATOMIC_ACQUIRE, "agent");
            xb_add(&bar[XB_XGEN(b.x)], 1u);
            asm volatile("s_waitcnt vmcnt(0)" ::: "memory");
        } else {
            XB_SPIN(xb_ld(&bar[XB_XGEN(b.x)]) == gen, bar);
            __builtin_amdgcn_fence(__ATOMIC_ACQUIRE, "agent");
            asm volatile("s_waitcnt vmcnt(0)" ::: "memory");
        }
    }
    __syncthreads();
}
namespace pg8 {
constexpr int BM = 256, BK = 64, HALF = 128, HTB = HALF * BK * 2, STAGE_BYTES = 8 * HTB, NXCD = 8, WGM = 8;
__host__ __device__ __forceinline__ int lds_byte(int r, int c) { const int st = (r >> 4) * 2 + (c >> 5), rr = r & 15, cc = c & 31, ob = rr * 64 + cc * 2; return st * 1024 + (ob ^ (((ob >> 9) & 1) << 5)); }
__host__ __device__ __forceinline__ void stage_rc(int b, int& R, int& C) { const int st = b / 1024, sb = b % 1024, swz = sb ^ (((sb >> 9) & 1) << 5); R = (st >> 1) * 16 + swz / 64; C = (st & 1) * 32 + (swz % 64) / 2; }
__host__ __device__ __forceinline__ int perm32(int rho) { const int n = rho >> 4, i = rho & 15; return 8 * (i >> 2) + 4 * n + (i & 3); }

struct Unit { int pm, pn; };
struct Gemm { const bf16_t* A; const bf16_t* Bt; int K; const int* rowidx; };

struct StaticOrder {
    int nM, nN, nwg, G, c;
    __device__ void init(int nM_, int nN_, int G_, int c_) { nM = nM_; nN = nN_; nwg = nM * nN; G = G_; c = c_; }
    __device__ bool next(int i, Unit& u) const {
        const long L = (long)i * G + c; if (L >= nwg) return false;
        int wgid = (int)L; { const int q = nwg / NXCD, r = nwg % NXCD, xcd = wgid % NXCD, off = wgid / NXCD; wgid = (xcd < r ? xcd * (q + 1) : r * (q + 1) + (xcd - r) * q) + off; }
        const int nig = WGM * nN, gid = wgid / nig, fm = gid * WGM, gsz = (nM - fm) < WGM ? (nM - fm) : WGM;
        u.pm = fm + ((wgid % nig) % gsz); u.pn = (wgid % nig) / gsz; return true;
    }
};
struct OffsetOrder : StaticOrder {
    int pm0;
    __device__ bool next(int i, Unit& u) const { if (!StaticOrder::next(i, u)) return false; u.pm += pm0; return true; }
};
__device__ __forceinline__ int moe_expert_of_tile(int pm) { return pm < 256 ? ((pm >> 3) & 15) : (pm - 256); }
struct MoeOrder : StaticOrder {
    __device__ bool next(int i, Unit& u) const { if (!StaticOrder::next(i, u)) return false; u.pn += moe_expert_of_tile(u.pm) * 8; return true; }
};

template <class Epi, class Sched, bool GATHER, bool NOEPI = false>
__device__ __forceinline__ void gemm_phase(LAS unsigned char* lds, const Gemm g, const Sched& S, const Epi& E, LAS int* idxl, const int tid) {
    const int wid = __builtin_amdgcn_readfirstlane(tid >> 6), lane = tid & 63, wr = wid >> 2, wc = wid & 3, fr = lane & 15, fq = lane >> 4;
    const int K = g.K, nt = K / BK;
    unsigned voffA[2], voffB[2]; int RA[2];
#pragma unroll
    for (int i = 0; i < 2; ++i) { int R, C; stage_rc(tid * 16 + i * 8192, R, C); const int Rb = Epi::PERM ? ((R & ~31) + perm32(R & 31)) : R;
        voffA[i] = (unsigned)(R * K + C) * 2u; voffB[i] = (unsigned)(Rb * K + C) * 2u; RA[i] = R; if (GATHER) voffA[i] = (unsigned)C * 2u; }
    const size_t kstep = (size_t)(BK * 2);
    const size_t hstep = (size_t)HALF * K * 2;
    const size_t tstep = 2 * hstep;
    const unsigned ldsw = (unsigned)wid * 1024u;
    const int aoff = lds_byte(wr * 64 + fr, fq * 8), boff = lds_byte(wc * 32 + fr, fq * 8);
#define PG8_SA(b, h) (((b) * 2 + (h)) * HTB)
#define PG8_SB(b, h) ((4 + (b) * 2 + (h)) * HTB)
#define PG8_STAGE(bufoff, gbase, voff) do { _Pragma("unroll") for (int _i = 0; _i < 2; ++_i) \
        __builtin_amdgcn_global_load_lds((const unsigned*)((const char*)(gbase) + (voff)[_i]), (LAS unsigned*)(lds + (bufoff) + ldsw + _i * 8192), 16, 0, 0); } while (0)
#define PG8_STAGE_A(bufoff, h, pA, offs) do { _Pragma("unroll") for (int _i = 0; _i < 2; ++_i) { const char* _p; \
        if constexpr (GATHER) _p = (const char*)(pA) + (offs)[h][_i]; else _p = (const char*)(pA) + (size_t)(h) * hstep + voffA[_i]; \
        __builtin_amdgcn_global_load_lds((const unsigned*)_p, (LAS unsigned*)(lds + (bufoff) + ldsw + _i * 8192), 16, 0, 0); } } while (0)
#define PG8_LDA(dst, b, h) do { _Pragma("unroll") for (int m = 0; m < 4; ++m) _Pragma("unroll") for (int k = 0; k < 2; ++k) dst[m][k] = *(const LAS bf16x8*)(lds + PG8_SA(b, h) + aoff + m * 2048 + k * 1024); } while (0)
#define PG8_LDB(dst, b, h) do { _Pragma("unroll") for (int n = 0; n < 2; ++n) _Pragma("unroll") for (int k = 0; k < 2; ++k) dst[n][k] = *(const LAS bf16x8*)(lds + PG8_SB(b, h) + boff + n * 2048 + k * 1024); } while (0)
#define PG8_MMA(ai, bj, At, Bt) do { __builtin_amdgcn_s_setprio(1); _Pragma("unroll") for (int m = 0; m < 4; ++m) _Pragma("unroll") for (int n = 0; n < 2; ++n) _Pragma("unroll") for (int k = 0; k < 2; ++k) \
        acc[ai][bj][m][n] = __builtin_amdgcn_mfma_f32_16x16x32_bf16(Bt[n][k], At[m][k], acc[ai][bj][m][n], 0, 0, 0); __builtin_amdgcn_s_setprio(0); } while (0)
#define PG8_WAIT_V(n) asm volatile("s_waitcnt vmcnt(" #n ")" ::: "memory")
#define PG8_WAIT_L(n) asm volatile("s_waitcnt lgkmcnt(" #n ")" ::: "memory")
#define PG8_BAR __builtin_amdgcn_s_barrier()
#define PG8_SCHED __builtin_amdgcn_sched_barrier(0)
    Unit cur, nxt; int ui = 0;
    if (!S.next(0, cur)) return;
    f32x4 acc[2][2][4][2];
#pragma unroll
    for (int a = 0; a < 2; ++a)
#pragma unroll
        for (int b = 0; b < 2; ++b)
#pragma unroll
            for (int m = 0; m < 4; ++m)
#pragma unroll
                for (int n = 0; n < 2; ++n) acc[a][b][m][n] = (f32x4){0.f, 0.f, 0.f, 0.f};
    bf16x8 At[4][2], B0[2][2], B1[2][2];
    unsigned oc[2][2] = {{0u, 0u}, {0u, 0u}}, on[2][2] = {{0u, 0u}, {0u, 0u}};
#define PG8_GOFF(dst, ui_) do { if constexpr (GATHER) { _Pragma("unroll") for (int _h = 0; _h < 2; ++_h) _Pragma("unroll") for (int _i = 0; _i < 2; ++_i) \
        dst[_h][_i] = (unsigned)idxl[(ui_) * BM + _h * HALF + RA[_i]] * (unsigned)(K * 2) + voffA[_i]; } } while (0)
    if constexpr (GATHER) {
        for (int i = 0; i < 16; ++i) { Unit uu; if (!S.next(i, uu)) break; if (tid < BM) idxl[i * BM + tid] = g.rowidx[uu.pm * BM + tid]; }
        __syncthreads();
    }
    PG8_GOFF(oc, 0);
    const char* cA = GATHER ? (const char*)g.A : (const char*)g.A + (size_t)cur.pm * tstep; const char* cB = (const char*)g.Bt + (size_t)cur.pn * tstep;
    PG8_STAGE(PG8_SB(0, 0), cB, voffB); PG8_STAGE(PG8_SB(0, 1), cB + hstep, voffB); PG8_STAGE_A(PG8_SA(0, 0), 0, cA, oc); PG8_STAGE_A(PG8_SA(0, 1), 1, cA, oc);
    if (wr == 1) PG8_BAR;
    PG8_WAIT_V(2); PG8_BAR;
    PG8_STAGE(PG8_SB(1, 0), cB + kstep, voffB); PG8_STAGE_A(PG8_SA(1, 0), 0, cA + kstep, oc); PG8_STAGE(PG8_SB(1, 1), cB + hstep + kstep, voffB);
    PG8_WAIT_V(6); PG8_BAR;
    for (;;) {
        const bool has_next = S.next(ui + 1, nxt);
        if (has_next) PG8_GOFF(on, ui + 1); else { if constexpr (GATHER) { on[0][0] = oc[0][0]; on[0][1] = oc[0][1]; on[1][0] = oc[1][0]; on[1][1] = oc[1][1]; } }
        const char* nA = GATHER ? (const char*)g.A : (has_next ? (const char*)g.A + (size_t)nxt.pm * tstep : cA);
        const char* nB = has_next ? (const char*)g.Bt + (size_t)nxt.pn * tstep : cB;
        for (int t = 0; t < nt; t += 2) {
            const bool last = (t == nt - 2);
            const char* a1 = cA + (size_t)(t + 1) * kstep;
            const char* a2 = last ? nA : cA + (size_t)(t + 2) * kstep; const char* b2 = last ? nB : cB + (size_t)(t + 2) * kstep;
            const char* a3 = a2 + kstep; const char* b3 = b2 + kstep;
            unsigned o2[2][2];
#pragma unroll
            for (int _h = 0; _h < 2; ++_h)
#pragma unroll
                for (int _i = 0; _i < 2; ++_i) o2[_h][_i] = last ? on[_h][_i] : oc[_h][_i];
            PG8_LDB(B0, 0, 0); PG8_LDB(B1, 0, 1); PG8_SCHED; PG8_LDA(At, 0, 0); PG8_STAGE_A(PG8_SA(1, 1), 1, a1, oc);
            PG8_WAIT_V(8); PG8_WAIT_L(0); PG8_BAR; PG8_MMA(0, 0, At, B0); PG8_MMA(0, 1, At, B1); PG8_BAR; PG8_SCHED;
            PG8_LDA(At, 0, 1); PG8_STAGE(PG8_SB(0, 0), b2, voffB); PG8_STAGE(PG8_SB(0, 1), b2 + hstep, voffB); PG8_STAGE_A(PG8_SA(0, 0), 0, a2, o2);
            PG8_WAIT_V(8); PG8_WAIT_L(0); PG8_BAR; PG8_MMA(1, 0, At, B0); PG8_MMA(1, 1, At, B1); PG8_BAR; PG8_SCHED;
            PG8_LDB(B0, 1, 0); PG8_LDB(B1, 1, 1); PG8_SCHED; PG8_LDA(At, 1, 0); PG8_STAGE_A(PG8_SA(0, 1), 1, a2, o2);
            PG8_WAIT_V(8); PG8_WAIT_L(0); PG8_BAR; PG8_MMA(0, 0, At, B0); PG8_MMA(0, 1, At, B1); PG8_BAR; PG8_SCHED;
            PG8_LDA(At, 1, 1); PG8_STAGE(PG8_SB(1, 0), b3, voffB); PG8_STAGE(PG8_SB(1, 1), b3 + hstep, voffB); PG8_STAGE_A(PG8_SA(1, 0), 0, a3, o2);
            PG8_WAIT_V(8); PG8_WAIT_L(0); PG8_BAR; PG8_MMA(1, 0, At, B0); PG8_MMA(1, 1, At, B1); PG8_BAR; PG8_SCHED;
        }
        if (wr == 0) PG8_BAR;
        if constexpr (!NOEPI) E(acc, cur, wr, wc, fr, fq); else { float d_ = 0.f; _Pragma("unroll") for (int a_ = 0; a_ < 2; ++a_) _Pragma("unroll") for (int b_ = 0; b_ < 2; ++b_) _Pragma("unroll") for (int m_ = 0; m_ < 4; ++m_) _Pragma("unroll") for (int n_ = 0; n_ < 2; ++n_) d_ += acc[a_][b_][m_][n_][0] + acc[a_][b_][m_][n_][3]; if (d_ == 1.2345e30f) ((float*)g.A)[0] = d_; }
#ifdef EXP_EPI2
        if constexpr (Epi::PERM && !GATHER && sizeof(Epi) == 16) { asm volatile("" ::: "memory"); E(acc, cur, wr, wc, fr, fq); }
#endif
        if (!has_next) break;
#pragma unroll
        for (int a = 0; a < 2; ++a)
#pragma unroll
            for (int b = 0; b < 2; ++b)
#pragma unroll
                for (int m = 0; m < 4; ++m)
#pragma unroll
                    for (int n = 0; n < 2; ++n) acc[a][b][m][n] = (f32x4){0.f, 0.f, 0.f, 0.f};
        cur = nxt; cA = nA; cB = nB; ++ui;
        if constexpr (GATHER) { oc[0][0] = on[0][0]; oc[0][1] = on[0][1]; oc[1][0] = on[1][0]; oc[1][1] = on[1][1]; }
        if (wr == 1) PG8_BAR;
    }
    PG8_WAIT_V(0);
    PG8_BAR;
#undef PG8_SA
#undef PG8_SB
#undef PG8_STAGE
#undef PG8_STAGE_A
#undef PG8_GOFF
#undef PG8_LDA
#undef PG8_LDB
#undef PG8_MMA
#undef PG8_WAIT_V
#undef PG8_WAIT_L
#undef PG8_BAR
#undef PG8_SCHED
}

__device__ __forceinline__ u32x4 pack8(const f32x4 a, const f32x4 b) { u32x4 w; w.x = cvt_pk_bf16(a[0], a[1]); w.y = cvt_pk_bf16(a[2], a[3]); w.z = cvt_pk_bf16(b[0], b[1]); w.w = cvt_pk_bf16(b[2], b[3]); return w; }

struct EpiInProj {
    static constexpr bool PERM = true;
    bf16_t* P; const float* rope;
    unsigned* kmax;
    __device__ __forceinline__ void operator()(const f32x4 (&acc)[2][2][4][2], const Unit& u, int wr, int wc, int fr, int fq) const {
        const int pn = u.pn; const bool lat = u.pm < (NLAT / 256);
        const int kind = (pn >= 6 && pn <= 9) ? 2 : (((pn >= 12 && pn <= 15) || (pn >= 20 && pn <= 22)) ? 1 : 0);
        const int row0 = u.pm * BM + wr * 64 + fr;
        if (kind == 0) {
            const int col0 = pn * 256 + wc * 32 + 8 * fq;
#pragma unroll
            for (int ai = 0; ai < 2; ++ai)
#pragma unroll
                for (int m = 0; m < 4; ++m) { bf16_t* rowp = P + (size_t)(row0 + ai * HALF + m * 16) * INW + col0;
#pragma unroll
                    for (int bj = 0; bj < 2; ++bj) *(u32x4*)(rowp + bj * HALF) = pack8(acc[ai][bj][m][0], acc[ai][bj][m][1]); }
        } else {
            const bool k1 = kind == 1; const int nf = k1 ? 32 : 16, pstep = k1 ? 32 : 16;
            const int cu1 = k1 ? pn * 256 + (wc >> 1) * 128 + (wc & 1) * 64 + 8 * fq : pn * 256 + wc * 64 + (fq >> 1) * 32 + 8 * (fq & 1);
            const int i0 = k1 ? 8 * fq : 8 * (fq & 1); const bool colp = k1 ? ((wc & 1) != 0) : ((fq >> 1) != 0);
            const float* TC = k1 ? rope : rope + 2 * 256 * 32; const float* TS = TC + 256 * nf;
            const int trow0 = ((u.pm * BM) & (SEQ - 1)) / 64 + wr;
            f32x4 nc0, nc1, ns0, ns1; float kq = 0.f;
#define RP_LOAD(g_) do { const int pos_ = colp ? (fr + 16 * ((g_) & 3)) : (trow0 + 2 * ((g_) >> 2)); const float* pc_ = TC + pos_ * nf + i0; const float* ps_ = TS + pos_ * nf + i0; \
                nc0 = *(const f32x4*)(pc_); nc1 = *(const f32x4*)(pc_ + 4); ns0 = *(const f32x4*)(ps_); ns1 = *(const f32x4*)(ps_ + 4); } while (0)
            if (lat) RP_LOAD(0);
#pragma unroll
            for (int gidx = 0; gidx < 8; ++gidx) { const int ai = gidx >> 2, m = gidx & 3; const int row = row0 + ai * HALF + m * 16;
                f32x4 a0 = acc[ai][0][m][0], a1 = acc[ai][0][m][1], b0 = acc[ai][1][m][0], b1 = acc[ai][1][m][1];
                if (lat) { const f32x4 c0 = nc0, c1 = nc1, s0 = ns0, s1 = ns1;
                    if (gidx < 7) RP_LOAD(gidx + 1);
                    const f32x4 x0 = a0 * c0 - b0 * s0, x1 = a1 * c1 - b1 * s1, y0 = b0 * c0 + a0 * s0, y1 = b1 * c1 + a1 * s1; a0 = x0; a1 = x1; b0 = y0; b1 = y1; }
                bf16_t* rowp = P + (size_t)row * INW + cu1;
                const u32x4 w0 = pack8(a0, a1), w1 = pack8(b0, b1); *(u32x4*)(rowp) = w0; *(u32x4*)(rowp + pstep) = w1;
                if (pn == 8 || pn == 9) {
                    float q2 = bflo(w0.x) * bflo(w0.x) + bfhi(w0.x) * bfhi(w0.x) + bflo(w0.y) * bflo(w0.y) + bfhi(w0.y) * bfhi(w0.y) + bflo(w0.z) * bflo(w0.z) + bfhi(w0.z) * bfhi(w0.z) + bflo(w0.w) * bflo(w0.w) + bfhi(w0.w) * bfhi(w0.w)
                             + bflo(w1.x) * bflo(w1.x) + bfhi(w1.x) * bfhi(w1.x) + bflo(w1.y) * bflo(w1.y) + bfhi(w1.y) * bfhi(w1.y) + bflo(w1.z) * bflo(w1.z) + bfhi(w1.z) * bfhi(w1.z) + bflo(w1.w) * bflo(w1.w) + bfhi(w1.w) * bfhi(w1.w);
                    q2 += xshf<16>(q2); { auto rr = __builtin_amdgcn_permlane32_swap(__float_as_uint(q2), __float_as_uint(q2), false, false); q2 = __uint_as_float(rr[0]) + __uint_as_float(rr[1]); }
                    kq = fmaxf(kq, q2); } }
            if (pn == 8 || pn == 9) {
                kq = fmaxf(kq, xshf<1>(kq)); kq = fmaxf(kq, xshf<2>(kq)); kq = fmaxf(kq, xshf<4>(kq)); kq = fmaxf(kq, xshf<8>(kq));
                if (fr == 0 && fq == 0) __hip_atomic_fetch_max(kmax + (lat ? (u.pm >> 6) : (u.pm - NLAT / 256)) * 8 + (pn - 8) * 4 + wc, __float_as_uint(kq), __ATOMIC_RELAXED, __HIP_MEMORY_SCOPE_AGENT); }
#undef RP_LOAD
        }
    }
};
struct EpiOutProj {
    static constexpr bool PERM = true;
    const float* xin_f32; const bf16_t* xin_bf; bf16_t* xout_bf; const float* xin_ctx; float* xout_ctx; const float* modl;
    __device__ __forceinline__ void operator()(const f32x4 (&acc)[2][2][4][2], const Unit& u, int wr, int wc, int fr, int fq) const {
        const bool lat = u.pm < (NLAT / 256); const int v = lat ? (u.pm >> 6) : 2;
        const float* g1 = modl + v * 12288 + 2 * DM;
        const int rloc = (lat ? u.pm : (u.pm - NLAT / 256)) * BM + wr * 64 + fr; const int col0 = u.pn * BM + wc * 32 + 8 * fq;
        f32x4 gv[2][2];
#pragma unroll
        for (int bj = 0; bj < 2; ++bj)
#pragma unroll
            for (int n = 0; n < 2; ++n) gv[bj][n] = *(const f32x4*)(g1 + col0 + bj * HALF + 4 * n);
        if (lat && xin_f32 == nullptr) {
#pragma unroll
            for (int ai = 0; ai < 2; ++ai) { u32x4 x[4][2];
#pragma unroll
                for (int m = 0; m < 4; ++m)
#pragma unroll
                    for (int bj = 0; bj < 2; ++bj) x[m][bj] = *(const u32x4*)(xin_bf + (size_t)(rloc + ai * HALF + m * 16) * DM + col0 + bj * HALF);
#pragma unroll
                for (int m = 0; m < 4; ++m)
#pragma unroll
                    for (int bj = 0; bj < 2; ++bj) { asm volatile("" : "+v"(x[m][bj])); const u32x4 w = x[m][bj];
                        const f32x4 x0 = (f32x4){bflo(w.x), bfhi(w.x), bflo(w.y), bfhi(w.y)}, x1 = (f32x4){bflo(w.z), bfhi(w.z), bflo(w.w), bfhi(w.w)};
                        *(u32x4*)(xout_bf + (size_t)(rloc + ai * HALF + m * 16) * DM + col0 + bj * HALF) = pack8(x0 + gv[bj][0] * acc[ai][bj][m][0], x1 + gv[bj][1] * acc[ai][bj][m][1]); }
            }
        } else {
            const float* xi = lat ? xin_f32 : xin_ctx;
#pragma unroll
            for (int ai = 0; ai < 2; ++ai) { f32x4 x[4][2][2];
#pragma unroll
                for (int m = 0; m < 4; ++m)
#pragma unroll
                    for (int bj = 0; bj < 2; ++bj)
#pragma unroll
                        for (int n = 0; n < 2; ++n) x[m][bj][n] = *(const f32x4*)(xi + (size_t)(rloc + ai * HALF + m * 16) * DM + col0 + bj * HALF + 4 * n);
#pragma unroll
                for (int m = 0; m < 4; ++m)
#pragma unroll
                    for (int bj = 0; bj < 2; ++bj) { asm volatile("" : "+v"(x[m][bj][0]), "+v"(x[m][bj][1]));
                        const f32x4 y0 = x[m][bj][0] + gv[bj][0] * acc[ai][bj][m][0], y1 = x[m][bj][1] + gv[bj][1] * acc[ai][bj][m][1]; const size_t off = (size_t)(rloc + ai * HALF + m * 16) * DM + col0 + bj * HALF;
                        if (lat) *(u32x4*)(xout_bf + off) = pack8(y0, y1); else { *(f32x4*)(xout_ctx + off) = y0; *(f32x4*)(xout_ctx + off + 4) = y1; } }
            }
        }
    }
};
struct EpiSwiGLU {
    static constexpr bool PERM = true;
    bf16_t* ACT;
    __device__ __forceinline__ void operator()(const f32x4 (&acc)[2][2][4][2], const Unit& u, int wr, int wc, int fr, int fq) const {
        const int pnl = u.pn & 7; const int row0 = u.pm * BM + wr * 64 + fr; const int col0 = pnl * 128 + wc * 32 + 8 * fq;
#pragma unroll
        for (int ai = 0; ai < 2; ++ai)
#pragma unroll
            for (int m = 0; m < 4; ++m) { f32x4 o[2];
#pragma unroll
                for (int n = 0; n < 2; ++n) { const f32x4 gt = acc[ai][0][m][n], up = acc[ai][1][m][n];
#pragma unroll
                    for (int j = 0; j < 4; ++j) o[n][j] = gt[j] * __builtin_amdgcn_rcpf(1.0f + __builtin_amdgcn_exp2f(-gt[j] * LOG2E)) * up[j]; }
                *(u32x4*)(ACT + (size_t)(row0 + ai * HALF + m * 16) * FF + col0) = pack8(o[0], o[1]); }
    }
};
struct EpiDown {
    static constexpr bool PERM = true;
    bf16_t* Y; const float* gatev;
    __device__ __forceinline__ void operator()(const f32x4 (&acc)[2][2][4][2], const Unit& u, int wr, int wc, int fr, int fq) const {
        const int pnl = u.pn & 7; const int row0 = u.pm * BM + wr * 64 + fr; const int col0 = pnl * 256 + wc * 32 + 8 * fq;
        float gs[2][4];
#pragma unroll
        for (int ai = 0; ai < 2; ++ai)
#pragma unroll
            for (int m = 0; m < 4; ++m) gs[ai][m] = gatev[row0 + ai * HALF + m * 16];
#pragma unroll
        for (int ai = 0; ai < 2; ++ai)
#pragma unroll
            for (int m = 0; m < 4; ++m) { asm volatile("" : "+v"(gs[ai][m]));
#pragma unroll
                for (int bj = 0; bj < 2; ++bj) *(u32x4*)(Y + (size_t)(row0 + ai * HALF + m * 16) * DM + col0 + bj * HALF) = pack8(acc[ai][bj][m][0] * gs[ai][m], acc[ai][bj][m][1] * gs[ai][m]); }
    }
};
}
namespace att {
constexpr int LDP = INW, LDOUT = DM, KVBLK = 64;
constexpr size_t SHM_V = KVBLK * 128 * 2, SHM_K = KVBLK * 128 * 2, SHM_ATTN = 2 * SHM_V + 2 * SHM_K + 8 * 64 * 4;
constexpr size_t QL_OFF = 73728, QL_STRIDE = 272;
constexpr size_t BIAS_OFF = SHM_ATTN;
constexpr float THR_L2 = 8.f * LOG2E;
#define KSWZ(row, colB) ((row) * 256 + ((colB) ^ (((row) & 7) << 4)))
#define SBAR() __builtin_amdgcn_sched_barrier(0)

struct Tiles { const bf16_t* kctx; const bf16_t* klat; long vdelta; int lat0, nt, nctx; };
struct MP {
    bool masked;
    int tq;
    int qr, rs, qc, cs;
    const LAS float* bias;
    float sink_l2;
    float lam, post;
    const float* normg;
};

__device__ __forceinline__ const bf16_t* tile_ptr(const Tiles& T, int j) { return (j < T.nctx) ? T.kctx + (long)j * KVBLK * LDP : T.klat + (long)(T.lat0 + j - T.nctx) * KVBLK * LDP; }

template <int MODE> __device__ __forceinline__ void apply_mask(f32x16& p0, f32x16& p1, int j, const Tiles& T, const MP& mp, int hi) {
  if constexpr (MODE == 1) return;
  if (!mp.masked || j < T.nctx) return;
  const int kt = T.lat0 + j - T.nctx;
  if constexpr (MODE == 2) {
    const int base = kt * KVBLK - mp.tq + 128;
#pragma unroll
    for (int r = 0; r < 16; ++r) { const int kk = crow(r, hi); if ((unsigned)(base + kk) > 256u) p0[r] = NEGBIG; if ((unsigned)(base + kk + 32) > 256u) p1[r] = NEGBIG; }
  }
  if constexpr (MODE == 0) {
    const bool rowok = (unsigned)(kt - mp.rs) < 8u; const LAS float* bp = mp.bias + ((kt - mp.qr + 7) * 31 + 15 - mp.qc + 4 * hi);
    const int t = rowok ? (4 * hi - mp.cs) : 0x40000000;
#pragma unroll
    for (int g = 0; g < 4; ++g) {
#pragma unroll
      for (int rr = 0; rr < 4; ++rr) { const int r = g * 4 + rr; const int c0 = (r & 3) + 8 * (r >> 2);
        const float b0 = bp[c0], b1 = bp[c0 + 32];
        p0[r] = ((unsigned)(t + c0) < 16u) ? p0[r] + b0 : NEGBIG; p1[r] = ((unsigned)(t + c0 + 32) < 16u) ? p1[r] + b1 : NEGBIG; }
      asm volatile("" ::: "memory");
    }
  }
}
template <int MODE> __device__ __forceinline__ void partialSM(f32x16& p0, f32x16& p1, float& m_reg, float& mn, float& alpha, int j, const Tiles& T, const MP& mp, int hi) {
  apply_mask<MODE>(p0, p1, j, T, mp, hi);
  float pmax = p0[0];
#pragma unroll
  for (int r = 1; r < 16; ++r) pmax = fmaxf(pmax, p0[r]);
#pragma unroll
  for (int r = 0; r < 16; ++r) pmax = fmaxf(pmax, p1[r]);
  { auto rr = __builtin_amdgcn_permlane32_swap(__float_as_uint(pmax), __float_as_uint(pmax), false, false);
    pmax = fmaxf(__uint_as_float(rr[0]), __uint_as_float(rr[1])); }
  if (__builtin_expect(__all(pmax - m_reg <= THR_L2), 1)) { mn = m_reg; alpha = 1.f; }
  else { mn = fmaxf(m_reg, pmax); alpha = __builtin_amdgcn_exp2f(m_reg - mn); m_reg = mn; }
#pragma unroll
  for (int r = 0; r < 16; ++r) p0[r] = p0[r] - mn;
#pragma unroll
  for (int r = 0; r < 16; ++r) p1[r] = p1[r] - mn;
#pragma unroll
  for (int r = 0; r < 16; ++r) p0[r] = __builtin_amdgcn_exp2f(p0[r]);
}
__device__ __forceinline__ void finishSM(f32x16& p0, f32x16& p1, float alpha, float& l_reg, bf16x8& pa0, bf16x8& pa1, bf16x8& pa2, bf16x8& pa3) {
#pragma unroll
  for (int r = 0; r < 16; ++r) p1[r] = __builtin_amdgcn_exp2f(p1[r]);
  float ps = 0;
#pragma unroll
  for (int r = 0; r < 16; ++r) ps += p0[r];
#pragma unroll
  for (int r = 0; r < 16; ++r) ps += p1[r];
  { auto rr = __builtin_amdgcn_permlane32_swap(__float_as_uint(ps), __float_as_uint(ps), false, false);
    ps = __uint_as_float(rr[0]) + __uint_as_float(rr[1]); }
  l_reg = l_reg * alpha + ps;
#define PK4(P, BASE, OUT) do { unsigned a0 = cvt_pk_bf16(P[BASE + 0], P[BASE + 1]), a1 = cvt_pk_bf16(P[BASE + 2], P[BASE + 3]);   \
    unsigned b0 = cvt_pk_bf16(P[BASE + 4], P[BASE + 5]), b1 = cvt_pk_bf16(P[BASE + 6], P[BASE + 7]);                              \
    auto r0 = __builtin_amdgcn_permlane32_swap(a0, b0, false, false); auto r1 = __builtin_amdgcn_permlane32_swap(a1, b1, false, false); \
    u32x4 w = {r0[0], r1[0], r0[1], r1[1]}; OUT = *reinterpret_cast<bf16x8*>(&w); } while (0)
  PK4(p0, 0, pa0); PK4(p0, 8, pa1); PK4(p1, 0, pa2); PK4(p1, 8, pa3);
#undef PK4
}
template <int NQ> __device__ __forceinline__ void qkt(f32x16& p0, f32x16& p1, const char* Ks, const bf16x8* qr, int r32, int hi, int cboff) {
  p0 = f32x16{}; p1 = f32x16{};
#pragma unroll
  for (int d0 = 0; d0 < NQ; ++d0) { const int cb = (d0 * 16 + hi * 8) * 2 + cboff;
    bf16x8 b0 = *reinterpret_cast<const bf16x8*>(Ks + KSWZ(r32, cb));
    bf16x8 b1 = *reinterpret_cast<const bf16x8*>(Ks + KSWZ(32 + r32, cb));
    p0 = __builtin_amdgcn_mfma_f32_32x32x16_bf16(b0, qr[d0], p0, 0, 0, 0);
    p1 = __builtin_amdgcn_mfma_f32_32x32x16_bf16(b1, qr[d0], p1, 0, 0, 0); }
}
__device__ __forceinline__ int v_st(int k, int c) { const int kk = (k & ~0xC) | ((k & 4) << 1) | ((k & 8) >> 1); return ((kk >> 3) * 4 + (c >> 5)) * 512 + ((kk & 7) * 32 + (c & 31)) * 2; }
__device__ __forceinline__ int v_rd_base(int lane) { return ((lane & 3) << 3) | (((lane >> 2) & 3) << 6) | (((lane >> 4) & 1) << 5) | (((lane >> 5) & 1) << 8); }
constexpr int v_rd_off(int d0, int ks, int half) { return d0 * 512 + ks * 4096 + half * 2048; }
template <int OFF> __device__ __forceinline__ s16x4 tr_read(int vb) {
  s16x4 r; asm volatile("ds_read_b64_tr_b16 %0, %1 offset:%2" : "=&v"(r) : "v"(vb), "i"(OFF) : "memory"); return r;
}
template <int D0> __device__ __forceinline__ void pv_one(f32x16& od, int vb, bf16x8 pa0, bf16x8 pa1, bf16x8 pa2, bf16x8 pa3) {
  const s16x4 l0 = tr_read<v_rd_off(D0, 0, 0)>(vb), h0 = tr_read<v_rd_off(D0, 0, 1)>(vb), l1 = tr_read<v_rd_off(D0, 1, 0)>(vb), h1 = tr_read<v_rd_off(D0, 1, 1)>(vb);
  const s16x4 l2 = tr_read<v_rd_off(D0, 2, 0)>(vb), h2 = tr_read<v_rd_off(D0, 2, 1)>(vb), l3 = tr_read<v_rd_off(D0, 3, 0)>(vb), h3 = tr_read<v_rd_off(D0, 3, 1)>(vb);
  asm volatile("s_waitcnt lgkmcnt(0)" ::: "memory"); SBAR();
#define PK(L, H) (bf16x8){L[0], L[1], L[2], L[3], H[0], H[1], H[2], H[3]}
  od = __builtin_amdgcn_mfma_f32_32x32x16_bf16(pa0, PK(l0, h0), od, 0, 0, 0);
  od = __builtin_amdgcn_mfma_f32_32x32x16_bf16(pa1, PK(l1, h1), od, 0, 0, 0);
  od = __builtin_amdgcn_mfma_f32_32x32x16_bf16(pa2, PK(l2, h2), od, 0, 0, 0);
  od = __builtin_amdgcn_mfma_f32_32x32x16_bf16(pa3, PK(l3, h3), od, 0, 0, 0);
#undef PK
}
__device__ __forceinline__ void pv_d0(f32x16* o, int vb, bf16x8 pa0, bf16x8 pa1, bf16x8 pa2, bf16x8 pa3) {
  pv_one<0>(o[0], vb, pa0, pa1, pa2, pa3); pv_one<1>(o[1], vb, pa0, pa1, pa2, pa3); pv_one<2>(o[2], vb, pa0, pa1, pa2, pa3); pv_one<3>(o[3], vb, pa0, pa1, pa2, pa3);
}

template <int MODE>
__device__ __forceinline__ void attn_unit_simple(const bf16_t* __restrict__ Qrow0, const Tiles T, bf16_t* __restrict__ Orow0, const MP mp, char* lds, const int tid) {
  const int wid = tid >> 6, lane = tid & 63, r32 = lane & 31, hi = lane >> 5;
  char* V_lds = lds; char* K_lds = lds + 2 * SHM_V;
  float* wsf = (float*)(lds + 2 * SHM_V + 2 * SHM_K) + wid * 64; float* li_l = wsf; float* al_l = wsf + 32;
  float m_reg = NEGBIG, l_reg = 0; f32x16 o[4] = {};
  const int sr = tid >> 4, sc = (tid & 15) * 8, vst0 = v_st(sr, sc), kst0 = KSWZ(sr, sc * 2);
  const int vb0 = (int)(uintptr_t)V_lds + v_rd_base(lane);
  const char* Qr = lds + QL_OFF + (wid * 32 + r32) * QL_STRIDE + hi * 16;
  bf16x8 vs0, vs1, ks0, ks1;
#define SLOAD1(j_) do { const bf16_t* kp_ = tile_ptr(T, (j_)) + (long)sr * LDP + sc; \
    vs0 = *reinterpret_cast<const bf16x8*>(kp_ + T.vdelta); vs1 = *reinterpret_cast<const bf16x8*>(kp_ + T.vdelta + 32L * LDP); \
    ks0 = *reinterpret_cast<const bf16x8*>(kp_); ks1 = *reinterpret_cast<const bf16x8*>(kp_ + 32L * LDP); } while (0)
#define SWRITE1(b) do { *(bf16x8*)(V_lds + (b) * SHM_V + vst0) = vs0; *(bf16x8*)(V_lds + (b) * SHM_V + vst0 + 8192) = vs1; \
    *(bf16x8*)(K_lds + (b) * SHM_K + kst0) = ks0; *(bf16x8*)(K_lds + (b) * SHM_K + kst0 + 8192) = ks1; } while (0)
  const int NT = T.nt;
  __syncthreads();
#pragma unroll
  for (int p = 0; p < 8; ++p) { const int idx = tid + 512 * p; *(bf16x8*)(lds + QL_OFF + (idx >> 4) * QL_STRIDE + (idx & 15) * 16) = *reinterpret_cast<const bf16x8*>(Qrow0 + (long)(idx >> 4) * LDP + (idx & 15) * 8); }
  SLOAD1(0); SWRITE1(0); __syncthreads();
  for (int j = 0; j < NT; ++j) {
    const int buf = j & 1;
    if (j + 1 < NT) SLOAD1(j + 1);
    bool live = true;
    if (mp.masked && j >= T.nctx) { const int kt = T.lat0 + j - T.nctx;
      if constexpr (MODE == 0) live = (unsigned)(kt - mp.rs) < 8u;
      if constexpr (MODE == 2) { const int q0w = __builtin_amdgcn_readfirstlane(mp.tq - r32); live = (kt * KVBLK + 63 >= q0w - 128) && (kt * KVBLK <= q0w + 31 + 128); } }
    if (live) {
    f32x16 p0, p1; float mn, al; bf16x8 pa0, pa1, pa2, pa3;
    { p0 = f32x16{}; p1 = f32x16{}; const char* Ks = K_lds + buf * SHM_K;
#pragma unroll
      for (int d0 = 0; d0 < 8; ++d0) { const int cb = (d0 * 16 + hi * 8) * 2; const bf16x8 q = *reinterpret_cast<const bf16x8*>(Qr + d0 * 32);
        const bf16x8 b0 = *reinterpret_cast<const bf16x8*>(Ks + KSWZ(r32, cb)), b1 = *reinterpret_cast<const bf16x8*>(Ks + KSWZ(32 + r32, cb));
        p0 = __builtin_amdgcn_mfma_f32_32x32x16_bf16(b0, q, p0, 0, 0, 0); p1 = __builtin_amdgcn_mfma_f32_32x32x16_bf16(b1, q, p1, 0, 0, 0); } }
    partialSM<MODE>(p0, p1, m_reg, mn, al, j, T, mp, hi);
    if (__any(al < 1.f)) { if (hi == 0) al_l[r32] = al; asm volatile("s_waitcnt lgkmcnt(0)" ::: "memory");
#pragma unroll
      for (int d = 0; d < 4; ++d)
#pragma unroll
        for (int r = 0; r < 16; ++r) o[d][r] *= al_l[crow(r, hi)]; }
    finishSM(p0, p1, al, l_reg, pa0, pa1, pa2, pa3);
    pv_d0(o, vb0 + buf * (int)SHM_V, pa0, pa1, pa2, pa3);
    }
    if (j + 1 < NT) SWRITE1(buf ^ 1);
    __syncthreads();
  }
  if constexpr (MODE == 2) l_reg += __builtin_amdgcn_exp2f(mp.sink_l2 - m_reg);
  if (hi == 0) li_l[r32] = l_reg; asm volatile("s_waitcnt lgkmcnt(0)" ::: "memory");
  bf16_t* Ow = Orow0 + (long)(wid * 32) * LDOUT;
#pragma unroll
  for (int r = 0; r < 16; ++r) { const int orow = crow(r, hi); const float rl = __builtin_amdgcn_rcpf(li_l[orow]);
#pragma unroll
    for (int d0 = 0; d0 < 4; ++d0) Ow[(long)orow * LDOUT + d0 * 32 + r32] = f2bf(o[d0][r] * rl); }
#undef SLOAD1
#undef SWRITE1
}
__device__ __forceinline__ void qktB(f32x16& p0, f32x16& p1, const char* Ks, const bf16x8* qr, int r32, int hi, int cboff, const f32x16& nb) {
  { const int cb = (hi * 8) * 2 + cboff;
    bf16x8 b0 = *reinterpret_cast<const bf16x8*>(Ks + KSWZ(r32, cb)), b1 = *reinterpret_cast<const bf16x8*>(Ks + KSWZ(32 + r32, cb));
    p0 = __builtin_amdgcn_mfma_f32_32x32x16_bf16(b0, qr[0], nb, 0, 0, 0); p1 = __builtin_amdgcn_mfma_f32_32x32x16_bf16(b1, qr[0], nb, 0, 0, 0); }
#pragma unroll
  for (int d0 = 1; d0 < 4; ++d0) { const int cb = (d0 * 16 + hi * 8) * 2 + cboff;
    bf16x8 b0 = *reinterpret_cast<const bf16x8*>(Ks + KSWZ(r32, cb)), b1 = *reinterpret_cast<const bf16x8*>(Ks + KSWZ(32 + r32, cb));
    p0 = __builtin_amdgcn_mfma_f32_32x32x16_bf16(b0, qr[d0], p0, 0, 0, 0); p1 = __builtin_amdgcn_mfma_f32_32x32x16_bf16(b1, qr[d0], p1, 0, 0, 0); }
}
__device__ __forceinline__ void expA(f32x16& p0) {
#pragma unroll
  for (int r = 0; r < 16; ++r) p0[r] = __builtin_amdgcn_exp2f(p0[r]);
}
__device__ __forceinline__ void finishB(f32x16& p0, f32x16& p1, float& l_reg, bf16x8& pa0, bf16x8& pa1, bf16x8& pa2, bf16x8& pa3) {
#pragma unroll
  for (int r = 0; r < 16; ++r) p1[r] = __builtin_amdgcn_exp2f(p1[r]);
  float ps = 0;
#pragma unroll
  for (int r = 0; r < 16; ++r) ps += p0[r];
#pragma unroll
  for (int r = 0; r < 16; ++r) ps += p1[r];
  l_reg += ps;
#define PK4(P, BASE, OUT) do { unsigned a0 = cvt_pk_bf16(P[BASE + 0], P[BASE + 1]), a1 = cvt_pk_bf16(P[BASE + 2], P[BASE + 3]);   \
    unsigned b0 = cvt_pk_bf16(P[BASE + 4], P[BASE + 5]), b1 = cvt_pk_bf16(P[BASE + 6], P[BASE + 7]);                              \
    auto r0 = __builtin_amdgcn_permlane32_swap(a0, b0, false, false); auto r1 = __builtin_amdgcn_permlane32_swap(a1, b1, false, false); \
    u32x4 w = {r0[0], r1[0], r0[1], r1[1]}; OUT = *reinterpret_cast<bf16x8*>(&w); } while (0)
  PK4(p0, 0, pa0); PK4(p0, 8, pa1); PK4(p1, 0, pa2); PK4(p1, 8, pa3);
#undef PK4
}

typedef short v4i16_t __attribute__((ext_vector_type(4)));
__device__ __forceinline__ s16x4 vtr(int addr) { return __builtin_bit_cast(s16x4, __builtin_amdgcn_ds_read_tr16_b64_v4i16((LAS v4i16_t*)(uintptr_t)(unsigned)addr)); }
template <int D0> __device__ __forceinline__ void pv_one_v(f32x16& od, int vb, bf16x8 pa0, bf16x8 pa1, bf16x8 pa2, bf16x8 pa3) {
  const s16x4 l0 = vtr(vb + v_rd_off(D0, 0, 0)), h0 = vtr(vb + v_rd_off(D0, 0, 1)), l1 = vtr(vb + v_rd_off(D0, 1, 0)), h1 = vtr(vb + v_rd_off(D0, 1, 1));
  const s16x4 l2 = vtr(vb + v_rd_off(D0, 2, 0)), h2 = vtr(vb + v_rd_off(D0, 2, 1)), l3 = vtr(vb + v_rd_off(D0, 3, 0)), h3 = vtr(vb + v_rd_off(D0, 3, 1));
#define PK(L, H) (bf16x8){L[0], L[1], L[2], L[3], H[0], H[1], H[2], H[3]}
  od = __builtin_amdgcn_mfma_f32_32x32x16_bf16(pa0, PK(l0, h0), od, 0, 0, 0);
  od = __builtin_amdgcn_mfma_f32_32x32x16_bf16(pa1, PK(l1, h1), od, 0, 0, 0);
  od = __builtin_amdgcn_mfma_f32_32x32x16_bf16(pa2, PK(l2, h2), od, 0, 0, 0);
  od = __builtin_amdgcn_mfma_f32_32x32x16_bf16(pa3, PK(l3, h3), od, 0, 0, 0);
#undef PK
}
__device__ __forceinline__ void pv_d0_v(f32x16* o, int vb, bf16x8 pa0, bf16x8 pa1, bf16x8 pa2, bf16x8 pa3) {
  pv_one_v<0>(o[0], vb, pa0, pa1, pa2, pa3); pv_one_v<1>(o[1], vb, pa0, pa1, pa2, pa3); pv_one_v<2>(o[2], vb, pa0, pa1, pa2, pa3); pv_one_v<3>(o[3], vb, pa0, pa1, pa2, pa3);
}
__device__ __forceinline__ void glds16(const void* g, unsigned lds_base) {
    unsigned sv; asm volatile("s_mov_b32 %0, m0\n\ts_mov_b32 m0, %2\n\ts_nop 0\n\tglobal_load_lds_dwordx4 %1, off\n\ts_mov_b32 m0, %0" : "=&s"(sv) : "v"(g), "s"(lds_base) : "memory"); }
__device__ __forceinline__ void glds16s(const void* gbase, unsigned voff, unsigned lds_base) {
    unsigned sv; asm volatile("s_mov_b32 %0, m0\n\ts_mov_b32 m0, %3\n\ts_nop 0\n\tglobal_load_lds_dwordx4 %1, %2\n\ts_mov_b32 m0, %0" : "=&s"(sv) : "v"(voff), "s"(gbase), "s"(lds_base) : "memory"); }
__device__ __forceinline__ int v_st_u(int k, int c) { return ((k >> 3) * 4 + (c >> 5)) * 512 + ((k & 7) * 32 + (c & 31)) * 2; }
__device__ __forceinline__ void attn_unit_a2(const bf16_t* __restrict__ Qrow0, const Tiles T, bf16_t* __restrict__ Orow0, const bool masked, const LAS float* bias, const int qr0, char* lds, const int tid) {
  const int wid = __builtin_amdgcn_readfirstlane(tid >> 6), lane = tid & 63, r32 = lane & 31, hi = lane >> 5;
  char* V_lds = lds; char* K_lds = lds + 2 * SHM_V;
  float* wsf = (float*)(lds + 2 * SHM_V + 2 * SHM_K) + wid * 64; float* li_l = wsf; float* al_l = wsf + 32;
  const int rp = wid >> 2, cbk = wid & 3;
  const int qloc = (2 * rp + (r32 >> 4)) * 64 + 16 * cbk + (r32 & 15);
  const int qr = qr0 + 2 * rp + (r32 >> 4), qc = 16 * cbk + (r32 & 15);
  const int rs = qr - 4 < 0 ? 0 : (qr - 4 > 248 ? 248 : qr - 4), cs = qc - 8 < 0 ? 0 : (qc - 8 > 48 ? 48 : qc - 8);
  const int kb = 16 * cbk - 8 < 0 ? 0 : (16 * cbk - 8 > 32 ? 32 : 16 * cbk - 8);
  const int rsa = (qr0 + 2 * rp - 4) < 0 ? 0 : ((qr0 + 2 * rp - 4) > 248 ? 248 : (qr0 + 2 * rp - 4)), rsb = (qr0 + 2 * rp - 3) < 0 ? 0 : ((qr0 + 2 * rp - 3) > 248 ? 248 : (qr0 + 2 * rp - 3));
  float m_reg = NEGBIG, l_reg = 0; f32x16 o[4] = {};
  const int sr = tid >> 4, sc = (tid & 15) * 8, vst0 = v_st_u(sr, sc), kst0 = KSWZ(sr, sc * 2);
  const int vb0 = (int)(uintptr_t)V_lds + v_rd_base(lane);
  const char* Qr = lds + QL_OFF + qloc * QL_STRIDE + hi * 16;
  bf16x8 vs0, vs1, ks0, ks1;
#define SLOAD1(j_) do { const bf16_t* kp_ = tile_ptr(T, (j_)) + (long)sr * LDP + sc; \
    vs0 = *reinterpret_cast<const bf16x8*>(kp_ + T.vdelta); vs1 = *reinterpret_cast<const bf16x8*>(kp_ + T.vdelta + 32L * LDP); \
    ks0 = *reinterpret_cast<const bf16x8*>(kp_); ks1 = *reinterpret_cast<const bf16x8*>(kp_ + 32L * LDP); } while (0)
#define SWRITE1(b) do { *(bf16x8*)(V_lds + (b) * SHM_V + vst0) = vs0; *(bf16x8*)(V_lds + (b) * SHM_V + vst0 + 8192) = vs1; \
    *(bf16x8*)(K_lds + (b) * SHM_K + kst0) = ks0; *(bf16x8*)(K_lds + (b) * SHM_K + kst0 + 8192) = ks1; } while (0)
  const int NT = T.nt;
  __syncthreads();
#pragma unroll
  for (int p = 0; p < 8; ++p) { const int idx = tid + 512 * p; *(bf16x8*)(lds + QL_OFF + (idx >> 4) * QL_STRIDE + (idx & 15) * 16) = *reinterpret_cast<const bf16x8*>(Qrow0 + (long)(idx >> 4) * LDP + (idx & 15) * 8); }
  SLOAD1(0); SWRITE1(0); __syncthreads();
  for (int j = 0; j < NT; ++j) {
    const int buf = j & 1;
    if (j + 1 < NT) SLOAD1(j + 1);
    const bool ctxt = j < T.nctx; const int kr = T.lat0 + j - T.nctx;
    const bool live = ctxt || !masked || ((unsigned)(kr - rsa) < 8u) || ((unsigned)(kr - rsb) < 8u);
    if (live) {
      const int nblk = (ctxt || !masked) ? 2 : 1;
      for (int blk = 0; blk < nblk; ++blk) {
        const int kbb = (ctxt || !masked) ? 32 * blk : kb;
        f32x16 p = {}; const char* Ks = K_lds + buf * SHM_K;
#pragma unroll
        for (int d0 = 0; d0 < 8; ++d0) { const int cb = (d0 * 16 + hi * 8) * 2; const bf16x8 q = *reinterpret_cast<const bf16x8*>(Qr + d0 * 32);
          const bf16x8 b0 = *reinterpret_cast<const bf16x8*>(Ks + KSWZ(kbb + r32, cb)); p = __builtin_amdgcn_mfma_f32_32x32x16_bf16(b0, q, p, 0, 0, 0); }
        if (masked && !ctxt) {
          const bool rowok = (unsigned)(kr - rs) < 8u; const LAS float* bp = bias + ((kr - qr + 7) * 31 + 15 - qc + kbb + 4 * hi);
          const int t = rowok ? (kbb + 4 * hi - cs) : 0x40000000;
          float bv[16];
#pragma unroll
          for (int r = 0; r < 16; ++r) bv[r] = bp[(r & 3) + 8 * (r >> 2)];
#pragma unroll
          for (int r = 0; r < 16; ++r) { const int c0 = (r & 3) + 8 * (r >> 2); p[r] = ((unsigned)(t + c0) < 16u) ? p[r] + bv[r] : NEGBIG; }
        }
        float pmax = p[0];
#pragma unroll
        for (int r = 1; r < 16; ++r) pmax = fmaxf(pmax, p[r]);
        { auto rr = __builtin_amdgcn_permlane32_swap(__float_as_uint(pmax), __float_as_uint(pmax), false, false); pmax = fmaxf(__uint_as_float(rr[0]), __uint_as_float(rr[1])); }
        float mn, al;
        if (__builtin_expect(__all(pmax - m_reg <= THR_L2), 1)) { mn = m_reg; al = 1.f; } else { mn = fmaxf(m_reg, pmax); al = __builtin_amdgcn_exp2f(m_reg - mn); m_reg = mn; }
        float ps = 0.f;
#pragma unroll
        for (int r = 0; r < 16; ++r) { p[r] = __builtin_amdgcn_exp2f(p[r] - mn); ps += p[r]; }
        { auto rr = __builtin_amdgcn_permlane32_swap(__float_as_uint(ps), __float_as_uint(ps), false, false); ps = __uint_as_float(rr[0]) + __uint_as_float(rr[1]); }
        l_reg = l_reg * al + ps;
        if (__any(al < 1.f)) { if (hi == 0) al_l[r32] = al; asm volatile("s_waitcnt lgkmcnt(0)" ::: "memory");
#pragma unroll
          for (int d = 0; d < 4; ++d)
#pragma unroll
            for (int r = 0; r < 16; ++r) o[d][r] *= al_l[crow(r, hi)]; }
        u32x4 w0 = {cvt_pk_bf16(p[0], p[1]), cvt_pk_bf16(p[2], p[3]), cvt_pk_bf16(p[4], p[5]), cvt_pk_bf16(p[6], p[7])}, w1 = {cvt_pk_bf16(p[8], p[9]), cvt_pk_bf16(p[10], p[11]), cvt_pk_bf16(p[12], p[13]), cvt_pk_bf16(p[14], p[15])};
        const bf16x8 pa0 = *reinterpret_cast<bf16x8*>(&w0), pa1 = *reinterpret_cast<bf16x8*>(&w1);
        const int vb = vb0 + buf * (int)SHM_V + (kbb >> 3) * 2048;
#pragma unroll
        for (int d0 = 0; d0 < 4; ++d0) { const s16x4 l0 = vtr(vb + d0 * 512), h0 = vtr(vb + d0 * 512 + 2048), l1 = vtr(vb + d0 * 512 + 4096), h1 = vtr(vb + d0 * 512 + 6144);
          o[d0] = __builtin_amdgcn_mfma_f32_32x32x16_bf16(pa0, (bf16x8){l0[0], l0[1], l0[2], l0[3], h0[0], h0[1], h0[2], h0[3]}, o[d0], 0, 0, 0);
          o[d0] = __builtin_amdgcn_mfma_f32_32x32x16_bf16(pa1, (bf16x8){l1[0], l1[1], l1[2], l1[3], h1[0], h1[1], h1[2], h1[3]}, o[d0], 0, 0, 0); }
      }
    }
    if (j + 1 < NT) SWRITE1(buf ^ 1);
    __syncthreads();
  }
  if (hi == 0) li_l[r32] = l_reg; asm volatile("s_waitcnt lgkmcnt(0)" ::: "memory");
#pragma unroll
  for (int r = 0; r < 16; ++r) { const int i = crow(r, hi); const float rl = __builtin_amdgcn_rcpf(li_l[i]);
    bf16_t* Ow = Orow0 + (long)((2 * rp + (i >> 4)) * 64 + 16 * cbk + (i & 15)) * LDOUT;
#pragma unroll
    for (int d0 = 0; d0 < 4; ++d0) Ow[d0 * 32 + r32] = f2bf(o[d0][r] * rl); }
#undef SLOAD1
#undef SWRITE1
}

#define B3_MF(a, b, c) __builtin_amdgcn_mfma_f32_32x32x16_bf16(a, b, c, 0, 0, 0)
#define B3_PIN(x) asm volatile("" : "+v"(x))
#define B3_WAITBAR(N) asm volatile("s_waitcnt vmcnt(" #N ") lgkmcnt(0)\n\ts_barrier" ::: "memory")
struct TilesB3 { const bf16_t* kctx; const bf16_t* klat; long vdelta; int nt; };
__device__ __forceinline__ void attn_unit_b3(const bf16_t* __restrict__ Qrow0, const TilesB3 T, bf16_t* __restrict__ Orow0, const MP mp, const unsigned* __restrict__ kmax2, char* lds, const int tid) {
  const int wid = __builtin_amdgcn_readfirstlane(tid >> 6), lane = tid & 63, r32 = lane & 31, hi = lane >> 5;
  constexpr int KRING = 0, VRING = 65536, WSF = 131072, SLOT = 16384;
  float* li_l = (float*)(lds + WSF) + wid * 64;
  float l_reg = 0; f32x16 o[4] = {}; bf16x8 qr[4];
  const int qrow = (wid & 3) * 32 + r32, map = wid >> 2, mapoff = map * 64;
  const bf16_t* Qw = Qrow0 + (long)qrow * LDP + mapoff + hi * 8;
#pragma unroll
  for (int d0 = 0; d0 < 4; ++d0) qr[d0] = *reinterpret_cast<const bf16x8*>(Qw + d0 * 16);
  f32x16 nb;
  { float q2 = 0.f;
#pragma unroll
    for (int d0 = 0; d0 < 4; ++d0) { const u32x4 w = *reinterpret_cast<const u32x4*>(&qr[d0]);
      q2 += bflo(w.x) * bflo(w.x) + bfhi(w.x) * bfhi(w.x) + bflo(w.y) * bflo(w.y) + bfhi(w.y) * bfhi(w.y) + bflo(w.z) * bflo(w.z) + bfhi(w.z) * bfhi(w.z) + bflo(w.w) * bflo(w.w) + bfhi(w.w) * bfhi(w.w); }
    { auto rr = __builtin_amdgcn_permlane32_swap(__float_as_uint(q2), __float_as_uint(q2), false, false); q2 = __uint_as_float(rr[0]) + __uint_as_float(rr[1]); }
    const float negb = -sqrtf(q2 * __uint_as_float(kmax2[map])) * 1.0001f;
#pragma unroll
    for (int r = 0; r < 16; ++r) nb[r] = negb; }
  B3_PIN(nb);
  const int rowk = 4 * wid + (lane >> 4); const unsigned koff = (unsigned)(rowk * LDP + (((lane & 15) ^ (rowk & 7)) * 8)) * 2u;
  const int sub0 = 2 * wid + (lane >> 5), key0 = (sub0 >> 2) * 8 + ((lane & 31) >> 2);
  const unsigned voff = (unsigned)(key0 * LDP + (sub0 & 3) * 32 + (lane & 3) * 8) * 2u + (unsigned)(T.vdelta * 2);
  const unsigned lds0 = (unsigned)(uintptr_t)lds; const unsigned kdst = lds0 + KRING + (unsigned)wid * 1024u, vdst = lds0 + VRING + (unsigned)wid * 1024u;
#define B3_TPTR(j_) ((const char*)(((j_) < 4) ? T.kctx + (long)(j_) * 64 * LDP : T.klat + (long)((j_) - 4) * 64 * LDP))
#define B3_DMAK(j_, sl_) do { const char* sp_ = B3_TPTR(j_); glds16s(sp_, koff, (unsigned)__builtin_amdgcn_readfirstlane(kdst + (sl_))); glds16s(sp_ + (size_t)32 * LDP * 2, koff, (unsigned)__builtin_amdgcn_readfirstlane(kdst + (sl_) + 8192)); } while (0)
#define B3_DMAV(j_, sl_) do { const char* sp_ = B3_TPTR(j_); glds16s(sp_, voff, (unsigned)__builtin_amdgcn_readfirstlane(vdst + (sl_))); glds16s(sp_ + (size_t)32 * LDP * 2, voff, (unsigned)__builtin_amdgcn_readfirstlane(vdst + (sl_) + 8192)); } while (0)
  int kro[4];
#pragma unroll
  for (int d0 = 0; d0 < 4; ++d0) kro[d0] = r32 * 256 + (((d0 * 16 + hi * 8) * 2 + mapoff * 2) ^ ((r32 & 7) << 4));
  const LAS char* kring = (const LAS char*)(uintptr_t)(lds0 + KRING);
  const int vbase = (int)lds0 + VRING + v_rd_base(lane);
#define B3_KF(kp_, n_, d0_) (*(const LAS bf16x8*)((kp_) + kro[d0_] + (n_) * 8192))
#define B3_VF(dst_, vp_, g_) do { const s16x4 lo_ = vtr((vp_) + v_rd_off((g_) & 3, (g_) >> 2, 0)), hi_ = vtr((vp_) + v_rd_off((g_) & 3, (g_) >> 2, 1)); dst_ = (bf16x8){lo_[0], lo_[1], lo_[2], lo_[3], hi_[0], hi_[1], hi_[2], hi_[3]}; } while (0)
  const int NT = T.nt;
#define B3_SL(j_) (((j_) & 3) * SLOT)
  f32x16 pA0, pA1, pB0, pB1; bf16x8 pa0, pa1, pa2, pa3;
  __syncthreads();
  B3_DMAK(0, B3_SL(0)); B3_DMAV(0, B3_SL(0)); B3_DMAK(1, B3_SL(1)); B3_DMAK(2, B3_SL(2)); B3_DMAV(1, B3_SL(1));
  B3_WAITBAR(8);
  { const LAS char* kp = kring + B3_SL(0); bf16x8 kf[8];
#pragma unroll
    for (int d0 = 0; d0 < 4; ++d0) { kf[2 * d0] = B3_KF(kp, 0, d0); kf[2 * d0 + 1] = B3_KF(kp, 1, d0); }
    pA0 = B3_MF(kf[0], qr[0], nb); pA1 = B3_MF(kf[1], qr[0], nb); pA0 = B3_MF(kf[2], qr[1], pA0); pA1 = B3_MF(kf[3], qr[1], pA1);
    pA0 = B3_MF(kf[4], qr[2], pA0); pA1 = B3_MF(kf[5], qr[2], pA1); pA0 = B3_MF(kf[6], qr[3], pA0); pA1 = B3_MF(kf[7], qr[3], pA1);
#pragma unroll
    for (int r = 0; r < 16; ++r) { pA0[r] = __builtin_amdgcn_exp2f(pA0[r]); pA1[r] = __builtin_amdgcn_exp2f(pA1[r]); l_reg += pA0[r] + pA1[r]; } }
  B3_WAITBAR(0);
#define B3_GA(MFS, P, i_, CA, CB) do { MFS; CA = cvt_pk_bf16(P[i_], P[(i_) + 1]); CB = cvt_pk_bf16(P[(i_) + 2], P[(i_) + 3]); } while (0)
#define B3_SW(OUT, c0_, c1_, c2_, c3_) do { u32x4 w_ = {c0_, c1_, c2_, c3_}; OUT = *reinterpret_cast<bf16x8*>(&w_); B3_PIN(OUT); } while (0)
#define B3_GB(MFS, X, i_) do { MFS; X[i_] = __builtin_amdgcn_exp2f(X[i_]); X[(i_) + 1] = __builtin_amdgcn_exp2f(X[(i_) + 1]); sacc += X[i_]; sacc += X[(i_) + 1]; B3_PIN(X); B3_PIN(sacc); SBAR(); } while (0)
#define B3_STEP(C0, C1, P0, P1, t_) do { SBAR(); \
    const LAS char* kp_ = kring + B3_SL(t_); const int vp_ = vbase + B3_SL((t_) - 1); bf16x8 kf[8], vf[8]; unsigned c0_, c1_, c2_, c3_; float sacc = 0.f; \
    _Pragma("unroll") for (int d0 = 0; d0 < 4; ++d0) { kf[2 * d0] = B3_KF(kp_, 0, d0); kf[2 * d0 + 1] = B3_KF(kp_, 1, d0); } SBAR(); \
    B3_GA(C0 = B3_MF(kf[0], qr[0], nb), P0, 0, c0_, c1_); SBAR(); \
    B3_GA(C1 = B3_MF(kf[1], qr[0], nb), P0, 4, c2_, c3_); B3_SW(pa0, c0_, c1_, c2_, c3_); SBAR(); \
    B3_GA(C0 = B3_MF(kf[2], qr[1], C0), P0, 8, c0_, c1_); SBAR(); \
    B3_GA(C1 = B3_MF(kf[3], qr[1], C1), P0, 12, c2_, c3_); B3_SW(pa1, c0_, c1_, c2_, c3_); SBAR(); \
    B3_VF(vf[0], vp_, 0); B3_GA(C0 = B3_MF(kf[4], qr[2], C0), P1, 0, c0_, c1_); SBAR(); \
    B3_VF(vf[1], vp_, 1); B3_GA(C1 = B3_MF(kf[5], qr[2], C1), P1, 4, c2_, c3_); B3_SW(pa2, c0_, c1_, c2_, c3_); SBAR(); \
    B3_VF(vf[2], vp_, 2); B3_GA(C0 = B3_MF(kf[6], qr[3], C0), P1, 8, c0_, c1_); SBAR(); \
    B3_VF(vf[3], vp_, 3); B3_GA(C1 = B3_MF(kf[7], qr[3], C1), P1, 12, c2_, c3_); B3_SW(pa3, c0_, c1_, c2_, c3_); SBAR(); \
    B3_VF(vf[4], vp_, 4);  B3_GB(o[0] = B3_MF(pa0, vf[0], o[0]), C0, 0); \
    B3_VF(vf[5], vp_, 5);  B3_GB(o[1] = B3_MF(pa0, vf[1], o[1]), C0, 2); \
    B3_VF(vf[6], vp_, 6);  B3_GB(o[2] = B3_MF(pa0, vf[2], o[2]), C0, 4); \
    B3_VF(vf[7], vp_, 7);  B3_GB(o[3] = B3_MF(pa0, vf[3], o[3]), C0, 6); \
    B3_VF(vf[0], vp_, 8);  B3_GB(o[0] = B3_MF(pa1, vf[4], o[0]), C0, 8); \
    B3_VF(vf[1], vp_, 9);  B3_GB(o[1] = B3_MF(pa1, vf[5], o[1]), C0, 10); \
    B3_VF(vf[2], vp_, 10); B3_GB(o[2] = B3_MF(pa1, vf[6], o[2]), C0, 12); \
    B3_VF(vf[3], vp_, 11); B3_GB(o[3] = B3_MF(pa1, vf[7], o[3]), C0, 14); \
    B3_VF(vf[4], vp_, 12); B3_GB(o[0] = B3_MF(pa2, vf[0], o[0]), C1, 0); \
    B3_VF(vf[5], vp_, 13); B3_GB(o[1] = B3_MF(pa2, vf[1], o[1]), C1, 2); \
    B3_VF(vf[6], vp_, 14); B3_GB(o[2] = B3_MF(pa2, vf[2], o[2]), C1, 4); \
    B3_VF(vf[7], vp_, 15); B3_GB(o[3] = B3_MF(pa2, vf[3], o[3]), C1, 6); \
    B3_GB(o[0] = B3_MF(pa3, vf[4], o[0]), C1, 8); \
    B3_GB(o[1] = B3_MF(pa3, vf[5], o[1]), C1, 10); \
    B3_GB(o[2] = B3_MF(pa3, vf[6], o[2]), C1, 12); \
    B3_GB(o[3] = B3_MF(pa3, vf[7], o[3]), C1, 14); \
    l_reg += sacc; } while (0)
  int t = 1;
  for (; t + 3 < NT; t += 2) {
    B3_DMAK(t + 2, B3_SL(t + 2)); B3_DMAK(t + 3, B3_SL(t + 3)); B3_DMAV(t + 1, B3_SL(t + 1)); B3_DMAV(t + 2, B3_SL(t + 2));
    B3_STEP(pB0, pB1, pA0, pA1, t); B3_STEP(pA0, pA1, pB0, pB1, t + 1);
    B3_WAITBAR(0);
  }
  B3_DMAK(t + 2, B3_SL(t + 2)); B3_DMAV(t + 1, B3_SL(t + 1)); B3_DMAV(t + 2, B3_SL(t + 2));
  B3_STEP(pB0, pB1, pA0, pA1, t); B3_STEP(pA0, pA1, pB0, pB1, t + 1);
  B3_WAITBAR(0);
  B3_STEP(pB0, pB1, pA0, pA1, t + 2);
  { unsigned c[16];
#pragma unroll
    for (int i = 0; i < 8; ++i) { c[i] = cvt_pk_bf16(pB0[2 * i], pB0[2 * i + 1]); c[8 + i] = cvt_pk_bf16(pB1[2 * i], pB1[2 * i + 1]); }
    B3_SW(pa0, c[0], c[1], c[2], c[3]); B3_SW(pa1, c[4], c[5], c[6], c[7]); B3_SW(pa2, c[8], c[9], c[10], c[11]); B3_SW(pa3, c[12], c[13], c[14], c[15]);
    pv_d0_v(o, vbase + B3_SL(NT - 1), pa0, pa1, pa2, pa3); }
#undef B3_STEP
#undef B3_GA
#undef B3_GB
#undef B3_SW
  { auto rr = __builtin_amdgcn_permlane32_swap(__float_as_uint(l_reg), __float_as_uint(l_reg), false, false); l_reg = __uint_as_float(rr[0]) + __uint_as_float(rr[1]); }
  if (hi == 0) li_l[r32] = l_reg; asm volatile("s_waitcnt lgkmcnt(0)" ::: "memory");
#pragma unroll
  for (int r = 0; r < 16; ++r) { const float rl = __builtin_amdgcn_rcpf(li_l[crow(r, hi)]);
#pragma unroll
    for (int d0 = 0; d0 < 4; ++d0) o[d0][r] *= rl; }
  __syncthreads();
  float* X = (float*)lds + (size_t)(wid & 3) * 32 * 128;
  if (wid >= 4) {
#pragma unroll
    for (int d0 = 0; d0 < 4; ++d0)
#pragma unroll
      for (int r = 0; r < 16; ++r) X[crow(r, hi) * 128 + d0 * 32 + r32] = o[d0][r];
  }
  __syncthreads();
  if (wid < 4) {
    float ss[16];
#pragma unroll
    for (int r = 0; r < 16; ++r) { float s = 0.f;
#pragma unroll
      for (int d0 = 0; d0 < 4; ++d0) { const float v = o[d0][r] - mp.lam * X[crow(r, hi) * 128 + d0 * 32 + r32]; o[d0][r] = v; s += v * v; }
      ss[r] = s; }
#pragma unroll
    for (int r = 0; r < 16; ++r) ss[r] = rsqrtf(sum32(ss[r]) * (1.0f / 128.0f) + 1e-6f) * mp.post;
    float gcol[4];
#pragma unroll
    for (int d0 = 0; d0 < 4; ++d0) gcol[d0] = mp.normg[d0 * 32 + r32];
    bf16_t* Ow = Orow0 + (long)(wid * 32) * LDOUT;
#pragma unroll
    for (int r = 0; r < 16; ++r) { const int orow = crow(r, hi);
#pragma unroll
      for (int d0 = 0; d0 < 4; ++d0) Ow[(long)orow * LDOUT + d0 * 32 + r32] = f2bf(o[d0][r] * ss[r] * gcol[d0]); }
  }
}
}
struct Args { const float* in[23]; float* out; unsigned char* ws; int ph_lo, ph_hi; };
typedef const Args __attribute__((address_space(4)))* KArgs;
struct Ctx {
    KArgs ka; LAS unsigned char* lds; char* ldsg; int tid, lane, wave, G, wg;
    __device__ __forceinline__ const float* in(int k) const { return ka->in[k]; }
    __device__ __forceinline__ float* out() const { return ka->out; }
    __device__ __forceinline__ unsigned char* ws() const { return ka->ws; }
    __device__ __forceinline__ float* modp() const { return (float*)(ws() + WS_MODP); }
    __device__ __forceinline__ float* mod() const { return (float*)(ws() + WS_MOD); }
    __device__ __forceinline__ float* misc() const { return (float*)(ws() + WS_MISC); }
    __device__ __forceinline__ float* rope() const { return (float*)(ws() + WS_ROPE); }
    __device__ __forceinline__ float* xc() const { return (float*)(ws() + WS_XC); }
    __device__ __forceinline__ bf16_t* xb() const { return (bf16_t*)(ws() + WS_XB); }
    __device__ __forceinline__ float* aff() const { return (float*)(ws() + WS_AFF); }
    __device__ __forceinline__ int* rowidx() const { return (int*)(ws() + WS_ROWIDX); }
    __device__ __forceinline__ float* gatev() const { return (float*)(ws() + WS_GATEV); }
    __device__ __forceinline__ int* slot() const { return (int*)(ws() + WS_SLOT); }
    __device__ __forceinline__ bf16_t* H() const { return (bf16_t*)(ws() + WS_H); }
    __device__ __forceinline__ bf16_t* P() const { return (bf16_t*)(ws() + WS_P); }
    __device__ __forceinline__ bf16_t* O() const { return (bf16_t*)(ws() + WS_O); }
    __device__ __forceinline__ bf16_t* S() const { return (bf16_t*)(ws() + WS_S); }
    __device__ __forceinline__ bf16_t* U() const { return (bf16_t*)(ws() + WS_H); }
    __device__ __forceinline__ bf16_t* ACT() const { return (bf16_t*)(ws() + WS_P + ACT_OFF); }
    __device__ __forceinline__ bf16_t* Y() const { return (bf16_t*)(ws() + WS_P + Y_OFF); }
    __device__ __forceinline__ bf16_t* w_in_t(int l) const { return (bf16_t*)(ws() + WS_W + (size_t)l * WL_BYTES + WL_IN); }
    __device__ __forceinline__ bf16_t* w_out_t(int l) const { return (bf16_t*)(ws() + WS_W + (size_t)l * WL_BYTES + WL_OUT); }
    __device__ __forceinline__ bf16_t* w_gu_t(int l) const { return (bf16_t*)(ws() + WS_W + (size_t)l * WL_BYTES + WL_GU); }
    __device__ __forceinline__ bf16_t* w_dn_t(int l) const { return (bf16_t*)(ws() + WS_W + (size_t)l * WL_BYTES + WL_DN); }
};
__device__ __forceinline__ int hw_lane() { int l; asm volatile("v_mbcnt_lo_u32_b32 %0, -1, 0\n\tv_mbcnt_hi_u32_b32 %0, -1, %0" : "=v"(l)); return l; }
__device__ __forceinline__ Ctx make_ctx(unsigned char* lds_raw, int wave_s) {
    Ctx F; KArgs p = (KArgs)__builtin_amdgcn_kernarg_segment_ptr(); asm volatile("" : "+s"(p));
    F.ka = p; F.lds = (LAS unsigned char*)lds_raw; F.ldsg = (char*)lds_raw;
    F.lane = hw_lane(); F.wave = wave_s; F.tid = wave_s * 64 + F.lane; F.G = gridDim.x; F.wg = blockIdx.x; return F;
}
enum { I_X = 0, I_C, I_CTX, I_CCTX, I_WMOD, I_BMOD, I_N1G, I_WIN, I_RPB, I_DLAM, I_DNG, I_RDF, I_RDB, I_GNG, I_GNB, I_SINK, I_WOUT, I_N2G, I_WR, I_WG, I_WU, I_WD, I_FNG };

__device__ __forceinline__ void ph_mod_partial(const Ctx& F) {
    const float* c = F.in(I_C); const float* cc = F.in(I_CCTX); const float* wm = F.in(I_WMOD);
    for (int gid = F.wg * 512 + F.tid; gid < 2 * 16 * 3072; gid += F.G * 512) {
        const int cg = gid % 3072, ks = (gid / 3072) % 16, l = gid / (3072 * 16);
        const float* w = wm + (size_t)l * DM * 12288 + (size_t)(ks * 128) * 12288 + cg * 4;
        f32x4 a0 = {0.f, 0.f, 0.f, 0.f}, a1 = a0, a2 = a0;
#pragma unroll 8
        for (int k = 0; k < 128; ++k) { const f32x4 wv = *(const f32x4*)(w + (size_t)k * 12288); const int kk = ks * 128 + k;
            const float s0 = siluf(c[kk]), s1 = siluf(c[DM + kk]), s2 = siluf(cc[kk]); a0 += s0 * wv; a1 += s1 * wv; a2 += s2 * wv; }
        float* o = F.modp() + (size_t)((ks * 2 + l) * 3) * 12288 + cg * 4;
        *(f32x4*)(o) = a0; *(f32x4*)(o + 12288) = a1; *(f32x4*)(o + 2 * 12288) = a2;
    }
}
__device__ __forceinline__ void ph_mod_reduce(const Ctx& F) {
    const int NMOD = 2 * 3 * 12288, NR128 = 256 * 32, NR64 = 256 * 16;
    for (int idx = F.wg * 512 + F.tid; idx < NMOD + NR128 + NR64 + 2; idx += F.G * 512) {
        if (idx < NMOD) { const int l = idx / (3 * 12288), v = (idx / 12288) % 3, col = idx % 12288; float s = F.in(I_BMOD)[l * 12288 + col];
            for (int ks = 0; ks < 16; ++ks) s += F.modp()[(size_t)((ks * 2 + l) * 3 + v) * 12288 + col];
            F.mod()[idx] = s;
        } else if (idx < NMOD + NR128) { const int e = idx - NMOD, pos = e >> 5, i = e & 31; const float inv = powf(10000.0f, -(float)i / 32.0f); const float a = (float)pos * inv;
            F.rope()[e] = cosf(a); F.rope()[NR128 + e] = sinf(a);
        } else if (idx < NMOD + NR128 + NR64) { const int e = idx - NMOD - NR128, pos = e >> 4, i = e & 15; const float inv = powf(10000.0f, -(float)i / 16.0f); const float a = (float)pos * inv;
            F.rope()[2 * NR128 + e] = cosf(a); F.rope()[2 * NR128 + NR64 + e] = sinf(a);
        } else { const int l = idx - (NMOD + NR128 + NR64); const float* dl = F.in(I_DLAM) + l * 4 * 64; float s1 = 0.f, s2 = 0.f;
            for (int i = 0; i < 64; ++i) { s1 += dl[i] * dl[64 + i]; s2 += dl[128 + i] * dl[192 + i]; }
            const float lam_init = 0.8f - 0.6f * expf(-0.3f * (float)l);
            F.misc()[l * 2] = expf(s1) - expf(s2) + lam_init; F.misc()[l * 2 + 1] = lam_init; }
    }
}
__device__ __forceinline__ int inproj_perm(int np) {
    const int pn = np >> 8, p = np & 255;
    if (pn >= 6 && pn <= 9) { const int half = p >> 7, pp = p & 127, sh = pp >> 5, rc = (pp >> 4) & 1, i = pp & 15; return pn * 256 + sh * 64 + rc * 32 + half * 16 + i; }
    if ((pn >= 12 && pn <= 15) || (pn >= 20 && pn <= 22)) { const int half = p >> 7, pp = p & 127, hs = pp >> 6, rc = (pp >> 5) & 1, i = pp & 31; return pn * 256 + hs * 128 + rc * 64 + half * 32 + i; }
    return np;
}
__device__ __forceinline__ float inproj_scale(int col) {
    if (col < C_AK) return 0.08838834764831845f * LOG2E;
    if (col >= C_BQ && col < C_BK) return 0.125f * LOG2E;
    if (col >= C_CK && col < C_CV) return 0.08838834764831845f;
    if (col >= C_DQ && col < C_DK) return 0.08838834764831845f * LOG2E;
    return 1.0f;
}
struct CvTile { const float* src; bf16_t* dst; int nsrc, K, n0, k0, kind; };
__device__ __forceinline__ CvTile cv_tile(const Ctx& F, int t) {
    const int T_IN = 96 * 32, T_OUT = 32 * 32, T_GU = 16 * 32 * 32, T_DN = 16 * 32 * 16, TL = T_IN + T_OUT + T_GU + T_DN;
    const int l = t / TL; int r = t % TL; CvTile c;
    if (r < T_IN) { c.kind = 0; c.n0 = (r % 96) * 64; c.k0 = (r / 96) * 64; c.src = F.in(I_WIN) + (size_t)l * DM * INW; c.nsrc = INW; c.K = DM; c.dst = F.w_in_t(l); }
    else if (r < T_IN + T_OUT) { r -= T_IN; c.kind = 1; c.n0 = (r % 32) * 64; c.k0 = (r / 32) * 64; c.src = F.in(I_WOUT) + (size_t)l * DM * DM; c.nsrc = DM; c.K = DM; c.dst = F.w_out_t(l); }
    else if (r < T_IN + T_OUT + T_GU) { r -= T_IN + T_OUT; c.kind = 2; const int e = r / 1024, rr = r % 1024; c.n0 = (rr % 32) * 64; c.k0 = (rr / 32) * 64;
        const int half = (c.n0 & 255) >> 7; c.src = (half ? F.in(I_WU) : F.in(I_WG)) + (size_t)(l * NE + e) * DM * FF; c.nsrc = FF; c.K = DM; c.dst = F.w_gu_t(l) + (size_t)e * 2048 * DM; }
    else { r -= T_IN + T_OUT + T_GU; c.kind = 3; const int e = r / 512, rr = r % 512; c.n0 = (rr % 32) * 64; c.k0 = (rr / 32) * 64; c.src = F.in(I_WD) + (size_t)(l * NE + e) * FF * DM; c.nsrc = DM; c.K = FF; c.dst = F.w_dn_t(l) + (size_t)e * DM * FF; }
    return c;
}
__device__ __forceinline__ void ph_convert(const Ctx& F) {
    LAS float* tile = (LAS float*)F.lds;
    const int TL = 96 * 32 + 32 * 32 + 16 * 32 * 32 + 16 * 32 * 16, NT = 2 * TL;
    const int tx = F.tid & 63, ty = F.tid >> 6, kx2 = F.tid & 31, ny = F.tid >> 5;
    float v[4][8]; float sc[4];
#define CV_LOAD(t0_) do { _Pragma("unroll") for (int u = 0; u < 4; ++u) { const int t = (t0_) + u; if (t < NT) { const CvTile c = cv_tile(F, t); \
            const int np = c.n0 + tx; int scol = np; sc[u] = 1.0f; \
            if (c.kind == 0) { scol = inproj_perm(np); sc[u] = inproj_scale(scol); } else if (c.kind == 2) { scol = (np >> 8) * 128 + (np & 127); } \
            _Pragma("unroll") for (int i = 0; i < 8; ++i) v[u][i] = c.src[(size_t)(c.k0 + ty + 8 * i) * c.nsrc + scol]; } } } while (0)
    int t0 = F.wg * 4;
    __syncthreads();
    if (t0 < NT) CV_LOAD(t0);
    for (; t0 < NT; t0 += 4 * F.G) {
#pragma unroll
        for (int u = 0; u < 4; ++u) { const int t = t0 + u; if (t < NT) {
#pragma unroll
            for (int i = 0; i < 8; ++i) tile[u * (64 * 65) + (ty + 8 * i) * 65 + tx] = v[u][i] * sc[u]; } }
        if (t0 + 4 * F.G < NT) CV_LOAD(t0 + 4 * F.G);
        asm volatile("s_waitcnt lgkmcnt(0)" ::: "memory"); __builtin_amdgcn_s_barrier();
#pragma unroll
        for (int u = 0; u < 4; ++u) { const int t = t0 + u; if (t < NT) { const CvTile c = cv_tile(F, t);
#pragma unroll
            for (int i = 0; i < 4; ++i) { const int nn = ny + 16 * i; const float lo = tile[u * (64 * 65) + (2 * kx2) * 65 + nn], hi = tile[u * (64 * 65) + (2 * kx2 + 1) * 65 + nn];
                *(unsigned*)(c.dst + (size_t)(c.n0 + nn) * c.K + c.k0 + 2 * kx2) = cvt_pk_bf16(lo, hi); } } }
        asm volatile("s_waitcnt lgkmcnt(0)" ::: "memory"); __builtin_amdgcn_s_barrier();
    }
#undef CV_LOAD
    __syncthreads();
}

__device__ __forceinline__ float wave_sum(float s) { return sum64(s); }
__device__ __forceinline__ void load_x(const Ctx& F, const void* xrow, bool bf, f32x4 (&x)[8]) {
    const int lane = F.lane;
    if (bf) {
#pragma unroll
        for (int j = 0; j < 8; ++j) { const u32x2 w = *(const u32x2*)((const bf16_t*)xrow + j * 256 + lane * 4); x[j] = (f32x4){bflo(w.x), bfhi(w.x), bflo(w.y), bfhi(w.y)}; }
    } else {
#pragma unroll
        for (int j = 0; j < 8; ++j) x[j] = *(const f32x4*)((const float*)xrow + j * 256 + lane * 4);
    }
}
__device__ __forceinline__ void ld_y(const Ctx& F, int s, u32x2 (&w)[8]) {
    const bf16_t* y = F.Y() + (size_t)s * DM + F.lane * 4;
#pragma unroll
    for (int j = 0; j < 8; ++j) w[j] = *(const u32x2*)(y + j * 256);
}
__device__ __forceinline__ void acc_y(f32x4 (&ys)[8], const u32x2 (&w)[8]) {
#pragma unroll
    for (int j = 0; j < 8; ++j) ys[j] += (f32x4){bflo(w[j].x), bfhi(w[j].x), bflo(w[j].y), bfhi(w[j].y)};
}
__device__ __forceinline__ int load_slots(const Ctx& F, int row) { return F.slot()[(size_t)row * NE + (F.lane & 15)]; }
__device__ __forceinline__ void moe_fold2(const Ctx& F, const LAS float* g2, int sva, int svb, f32x4 (&xa)[8], f32x4 (&xb)[8]) {
    f32x4 ya[8], yb[8];
#pragma unroll
    for (int j = 0; j < 8; ++j) { ya[j] = (f32x4){0.f, 0.f, 0.f, 0.f}; yb[j] = (f32x4){0.f, 0.f, 0.f, 0.f}; }
    unsigned ma = (unsigned)__builtin_amdgcn_ballot_w64(sva >= 0) & 0xFFFFu, mb = (unsigned)__builtin_amdgcn_ballot_w64(svb >= 0) & 0xFFFFu;
    while ((ma | mb) != 0u) {
        const bool ha = ma != 0u, hb = mb != 0u; u32x2 wa[8], wb[8];
        if (ha) { const int e = __builtin_ctz(ma); ma &= ma - 1u; ld_y(F, __builtin_amdgcn_readlane(sva, e), wa); }
        if (hb) { const int e = __builtin_ctz(mb); mb &= mb - 1u; ld_y(F, __builtin_amdgcn_readlane(svb, e), wb); }
        if (ha) acc_y(ya, wa);
        if (hb) acc_y(yb, wb);
    }
#pragma unroll
    for (int j = 0; j < 8; ++j) { const f32x4 g = *(const LAS f32x4*)(g2 + j * 256 + F.lane * 4); xa[j] += g * ya[j]; xb[j] += g * yb[j]; }
}
__device__ __forceinline__ float row_rstd(const f32x4 (&x)[8]) {
    float s = 0.f;
#pragma unroll
    for (int j = 0; j < 8; ++j) s += x[j][0] * x[j][0] + x[j][1] * x[j][1] + x[j][2] * x[j][2] + x[j][3] * x[j][3];
    s = wave_sum(s); return rsqrtf(s * (1.0f / DM) + 1e-6f);
}
__device__ __forceinline__ void norm1_row(const Ctx& F, int li, int row, const float* ng, f32x4 (&x)[8]) {
    const bool lat = row < NLAT; const int v = lat ? row / SEQ : 2;
    if (li != 0) {
        if (lat) { bf16_t* xo = F.xb() + (size_t)row * DM;
#pragma unroll
            for (int j = 0; j < 8; ++j) { u32x2 w; w.x = cvt_pk_bf16(x[j][0], x[j][1]); w.y = cvt_pk_bf16(x[j][2], x[j][3]); *(u32x2*)(xo + j * 256 + F.lane * 4) = w;
                x[j] = (f32x4){bflo(w.x), bfhi(w.x), bflo(w.y), bfhi(w.y)}; }
        } else { float* xo = F.xc() + (size_t)(row - NLAT) * DM;
#pragma unroll
            for (int j = 0; j < 8; ++j) *(f32x4*)(xo + j * 256 + F.lane * 4) = x[j]; } }
    const float rs = row_rstd(x);
    const LAS float* gs = (const LAS float*)F.lds + v * (2 * DM); const LAS float* s0p = gs + DM;
    bf16_t* h = F.H() + (size_t)row * DM;
#pragma unroll
    for (int j = 0; j < 8; ++j) { const int c = j * 256 + F.lane * 4; const f32x4 g = *(const LAS f32x4*)(gs + c), s0 = *(const LAS f32x4*)(s0p + c);
        const f32x4 y = x[j] * rs * g + s0; u32x2 w; w.x = cvt_pk_bf16(y[0], y[1]); w.y = cvt_pk_bf16(y[2], y[3]); *(u32x2*)(h + c) = w; }
}
__device__ __forceinline__ const void* norm1_src(const Ctx& F, int li, int row, bool& bf) {
    const bool lat = row < NLAT; bf = (li != 0) && lat;
    if (li == 0) return lat ? (const void*)(F.in(I_X) + (size_t)row * DM) : (const void*)(F.in(I_CTX) + (size_t)(row - NLAT) * DM);
    return lat ? (const void*)(F.xb() + (size_t)row * DM) : (const void*)(F.xc() + (size_t)(row - NLAT) * DM);
}
__device__ __forceinline__ void ph_norm1(const Ctx& F, int li) {
    const float* ng = F.in(I_N1G) + li * DM;
    __syncthreads();
    for (int i = F.tid; i < 3 * DM; i += 512) { const int v = i / DM, c = i - v * DM; const float* sh = F.mod() + (size_t)(li * 3 + v) * 12288;
        ((LAS float*)F.lds)[v * (2 * DM) + c] = ng[c] * (1.0f + sh[DM + c]); ((LAS float*)F.lds)[v * (2 * DM) + DM + c] = sh[c];
        if (li != 0) ((LAS float*)F.lds)[6 * DM + i] = F.mod()[(size_t)((li - 1) * 3 + v) * 12288 + 5 * DM + c]; }
    __syncthreads();
    for (int row = (F.wg * 8 + F.wave) * 2; row < MTOT; row += F.G * 16) {
        f32x4 xa[8], xb[8]; bool bfa, bfb; const void* pa = norm1_src(F, li, row, bfa); const void* pb = norm1_src(F, li, row + 1, bfb);
        int sva = -1, svb = -1; if (li != 0) { sva = load_slots(F, row); svb = load_slots(F, row + 1); }
        load_x(F, pa, bfa, xa); load_x(F, pb, bfb, xb);
        if (li != 0) moe_fold2(F, (const LAS float*)F.lds + 6 * DM + (row < NLAT ? row / SEQ : 2) * DM, sva, svb, xa, xb);
        norm1_row(F, li, row, ng, xa); norm1_row(F, li, row + 1, ng, xb);
    }
}
__device__ __forceinline__ void ph_final(const Ctx& F) {
    __syncthreads();
    for (int i = F.tid; i < 3 * DM; i += 512) ((LAS float*)F.lds)[i] = i < DM ? F.in(I_FNG)[i] : F.mod()[(size_t)(3 + (i / DM - 1)) * 12288 + 5 * DM + (i & (DM - 1))];
    __syncthreads();
    const LAS float* ng = (const LAS float*)F.lds;
    for (int row = (F.wg * 8 + F.wave) * 2; row < NLAT; row += F.G * 16) {
        f32x4 xa[8], xb[8]; const int sva = load_slots(F, row), svb = load_slots(F, row + 1);
        load_x(F, F.xb() + (size_t)row * DM, true, xa); load_x(F, F.xb() + (size_t)(row + 1) * DM, true, xb);
        moe_fold2(F, ng + DM + (row / SEQ) * DM, sva, svb, xa, xb);
        const float ra = row_rstd(xa), rb = row_rstd(xb); float* xr = F.out() + (size_t)row * DM;
#pragma unroll
        for (int j = 0; j < 8; ++j) { const int c = j * 256 + F.lane * 4; const f32x4 g = *(const LAS f32x4*)(ng + c); *(f32x4*)(xr + c) = xa[j] * ra * g; *(f32x4*)(xr + DM + c) = xb[j] * rb * g; }
    }
}
__device__ __forceinline__ void router_reduce_store(float (&v)[16], int lane, float* affrow) {
    float a[8];
#pragma unroll
    for (int i = 0; i < 8; ++i) { auto rr = __builtin_amdgcn_permlane32_swap(__float_as_uint(v[i]), __float_as_uint(v[i + 8]), false, false); a[i] = __uint_as_float(rr[0]) + __uint_as_float(rr[1]); }
    float b[4]; const bool b16 = (lane & 16) != 0;
#pragma unroll
    for (int i = 0; i < 4; ++i) { const float keep = b16 ? a[i + 4] : a[i], send = b16 ? a[i] : a[i + 4]; b[i] = keep + xshf<16>(send); }
    float c[2]; const bool b8 = (lane & 8) != 0;
#pragma unroll
    for (int i = 0; i < 2; ++i) { const float keep = b8 ? b[i + 2] : b[i], send = b8 ? b[i] : b[i + 2]; c[i] = keep + xshf<8>(send); }
    const bool b4 = (lane & 4) != 0; float lg = (b4 ? c[1] : c[0]) + xshf<4>(b4 ? c[0] : c[1]);
    lg += xshf<2>(lg); lg += xshf<1>(lg);
    float mx = lg; mx = fmaxf(mx, xshf<4>(mx)); mx = fmaxf(mx, xshf<8>(mx)); mx = fmaxf(mx, xshf<16>(mx));
    { auto rr = __builtin_amdgcn_permlane32_swap(__float_as_uint(mx), __float_as_uint(mx), false, false); mx = fmaxf(__uint_as_float(rr[0]), __uint_as_float(rr[1])); }
    const float ex = expf(lg - mx); float den = ex; den += xshf<4>(den); den += xshf<8>(den); den += xshf<16>(den);
    { auto rr = __builtin_amdgcn_permlane32_swap(__float_as_uint(den), __float_as_uint(den), false, false); den = __uint_as_float(rr[0]) + __uint_as_float(rr[1]); }
    const int e = ((lane >> 5) & 1) * 8 + ((lane >> 4) & 1) * 4 + ((lane >> 3) & 1) * 2 + ((lane >> 2) & 1);
    if ((lane & 3) == 0) affrow[e] = ex / den;
}
__device__ __forceinline__ void ph_norm2(const Ctx& F, int li, int rbeg, int rend, int wg0, int nwg) {
    const float* ng = F.in(I_N2G) + li * DM; const float* wr = F.in(I_WR) + (size_t)li * DM * NE; LAS float* wl = (LAS float*)F.lds;
    __syncthreads();
    int ts_ = F.tid; asm volatile("" : "+v"(ts_));
    for (int h = 0; h < 2; ++h) { f32x4 wv[8];
#pragma unroll
      for (int q = 0; q < 8; ++q) wv[q] = *(const f32x4*)(wr + (size_t)(ts_ + 512 * (h * 8 + q)) * 4);
#pragma unroll
      for (int q = 0; q < 8; ++q) { const int i4 = ts_ + 512 * (h * 8 + q), k = i4 >> 2, e0 = (i4 & 3) * 4; wl[(e0 + 0) * DM + k] = wv[q][0]; wl[(e0 + 1) * DM + k] = wv[q][1]; wl[(e0 + 2) * DM + k] = wv[q][2]; wl[(e0 + 3) * DM + k] = wv[q][3]; } }
    LAS float* gsl = wl + NE * DM;
    for (int i = F.tid; i < 2 * DM; i += 512) { const int v = (rbeg < NLAT) ? i / DM : 2, c = i & (DM - 1); gsl[i] = ng[c] * (1.0f + F.mod()[(size_t)(li * 3 + v) * 12288 + 4 * DM + c]); }
    __syncthreads();
    for (int row0 = rbeg + ((F.wg - wg0) * 8 + F.wave) * 4; row0 < rend; row0 += nwg * 32) {
        const bool lat = row0 < NLAT; const int v = lat ? row0 / SEQ : 2;
        const float* sh = F.mod() + (size_t)(li * 3 + v) * 12288 + 3 * DM; const LAS float* gsv = gsl + (lat ? v * DM : 0);
        f32x4 x[4][8];
        if (lat) { const bf16_t* xin = F.xb() + (size_t)row0 * DM;
#pragma unroll
            for (int r = 0; r < 4; ++r)
#pragma unroll
                for (int j = 0; j < 8; ++j) { const u32x2 w = *(const u32x2*)(xin + (size_t)r * DM + j * 256 + F.lane * 4); x[r][j] = (f32x4){bflo(w.x), bfhi(w.x), bflo(w.y), bfhi(w.y)}; }
        } else { const float* xin = F.xc() + (size_t)(row0 - NLAT) * DM;
#pragma unroll
            for (int r = 0; r < 4; ++r)
#pragma unroll
                for (int j = 0; j < 8; ++j) x[r][j] = *(const f32x4*)(xin + (size_t)r * DM + j * 256 + F.lane * 4); }
        float rs[4];
#pragma unroll
        for (int r = 0; r < 4; ++r) rs[r] = row_rstd(x[r]);
#pragma unroll
        for (int j = 0; j < 8; ++j) { const int c = j * 256 + F.lane * 4; const f32x4 s0 = *(const f32x4*)(sh + c); const f32x4 gs = *(const LAS f32x4*)(gsv + c);
#pragma unroll
            for (int r = 0; r < 4; ++r) { const f32x4 y = x[r][j] * rs[r] * gs + s0; x[r][j] = y; u32x2 w; w.x = cvt_pk_bf16(y[0], y[1]); w.y = cvt_pk_bf16(y[2], y[3]); *(u32x2*)(F.H() + (size_t)(row0 + r) * DM + c) = w; } }
        float lg[4][16];
#pragma unroll
        for (int e = 0; e < NE; ++e) { f32x2 a0 = {0.f, 0.f}, a1 = {0.f, 0.f}, a2 = {0.f, 0.f}, a3 = {0.f, 0.f};
#pragma unroll
            for (int j = 0; j < 8; ++j) { const f32x4 w = *(const LAS f32x4*)(wl + e * DM + j * 256 + F.lane * 4); const f32x2 wlo = __builtin_shufflevector(w, w, 0, 1), whi = __builtin_shufflevector(w, w, 2, 3);
                a0 += __builtin_shufflevector(x[0][j], x[0][j], 0, 1) * wlo; a0 += __builtin_shufflevector(x[0][j], x[0][j], 2, 3) * whi;
                a1 += __builtin_shufflevector(x[1][j], x[1][j], 0, 1) * wlo; a1 += __builtin_shufflevector(x[1][j], x[1][j], 2, 3) * whi;
                a2 += __builtin_shufflevector(x[2][j], x[2][j], 0, 1) * wlo; a2 += __builtin_shufflevector(x[2][j], x[2][j], 2, 3) * whi;
                a3 += __builtin_shufflevector(x[3][j], x[3][j], 0, 1) * wlo; a3 += __builtin_shufflevector(x[3][j], x[3][j], 2, 3) * whi; }
            float s0 = a0[0] + a0[1], s1 = a1[0] + a1[1], s2 = a2[0] + a2[1], s3 = a3[0] + a3[1];
            asm volatile("" : "+v"(s0), "+v"(s1), "+v"(s2), "+v"(s3) :: "memory"); __builtin_amdgcn_sched_barrier(0);
            lg[0][e] = s0; lg[1][e] = s1; lg[2][e] = s2; lg[3][e] = s3; }
#pragma unroll
        for (int r = 0; r < 4; ++r) router_reduce_store(lg[r], F.lane, F.aff() + (size_t)(row0 + r) * NE);
    }
}

__device__ __forceinline__ void topk_group(const Ctx& F, int N, int k, int row_base  , int e, int out_base  ) {
    LAS unsigned* keys = (LAS unsigned*)F.lds; LAS unsigned* hist = keys + 16384; LAS unsigned* sh = hist + 256;
    const int tid = F.tid;
    __syncthreads();
    for (int i = tid; i < N; i += 512) keys[i] = __float_as_uint(F.aff()[(size_t)(row_base + i) * NE + e]);
    unsigned prefix = 0u, need = (unsigned)k;
    for (int shift = 24; shift >= 0; shift -= 8) {
        if (tid < 256) hist[tid] = 0u;
        __syncthreads();
        for (int i = tid; i < N; i += 512) { const unsigned key = keys[i]; if (shift == 24 || (key >> (shift + 8)) == (prefix >> (shift + 8))) atomicAdd((unsigned*)&hist[(key >> shift) & 255u], 1u); }
        __syncthreads();
        if (tid < 64) {
            const int b0 = 255 - 4 * tid; const unsigned c0 = hist[b0], c1 = hist[b0 - 1], c2 = hist[b0 - 2], c3 = hist[b0 - 3]; const unsigned loc = c0 + c1 + c2 + c3;
            unsigned inc = loc;
#pragma unroll
            for (int o = 1; o < 64; o <<= 1) { const unsigned t = lane_up(inc, tid, o); if (tid >= o) inc += t; }
            const unsigned before = inc - loc;
            if (before < need && need <= inc) { unsigned cum = before; int d;
                if (cum + c0 >= need) d = b0; else { cum += c0; if (cum + c1 >= need) d = b0 - 1; else { cum += c1; if (cum + c2 >= need) d = b0 - 2; else { cum += c2; d = b0 - 3; } } }
                sh[0] = prefix | ((unsigned)d << shift); sh[1] = need - cum; }
        }
        __syncthreads();
        prefix = sh[0]; need = sh[1];
        __syncthreads();
    }
    const int per = N >= 512 ? N / 512 : 1; const int nact = N / per; unsigned cg = 0u, ce = 0u;
    if (tid < nact) for (int i = 0; i < per; ++i) { const unsigned key = keys[tid * per + i]; cg += key > prefix; ce += key == prefix; }
    unsigned pk = cg | (ce << 16), inc = pk;
#pragma unroll
    for (int o = 1; o < 64; o <<= 1) { const unsigned t = lane_up(inc, F.lane, o); if (F.lane >= o) inc += t; }
    if (F.lane == 63) sh[8 + F.wave] = inc;
    __syncthreads();
    unsigned woff = 0u;
    for (int w = 0; w < F.wave; ++w) woff += sh[8 + w];
    const unsigned exc = inc - pk + woff; unsigned gb = exc & 0xffffu, eb = exc >> 16; const unsigned ngt = (unsigned)k - need;
    if (tid < nact) for (int i = 0; i < per; ++i) { const int ti = tid * per + i; const unsigned key = keys[ti]; int s = -1;
        if (key > prefix) { s = (int)gb; ++gb; } else if (key == prefix) { if (eb < need) s = (int)(ngt + eb); ++eb; }
        const int row = row_base + ti;
        if (s >= 0) { F.rowidx()[out_base + s] = row; F.gatev()[out_base + s] = __uint_as_float(key); }
        F.slot()[(size_t)row * NE + e] = s >= 0 ? out_base + s : -1; }
    __syncthreads();
}
__device__ __forceinline__ void ph_topk(const Ctx& F, int li) {
    const int ngroups = (li == 0) ? 64 : 32;
    for (int g = F.wg; g < ngroups; g += F.G) {
        if (g < 32) { const int b = g >> 4, e = g & 15; topk_group(F, SEQ, CAP, b * SEQ, e, g * CAP); }
        else { const int b = (g - 32) >> 4, e = (g - 32) & 15; const int base = NBATCH * NE * CAP + e * 256;
            topk_group(F, LCTX, CAPC, NLAT + b * LCTX, e, base + b * CAPC);
            if (b == 0 && F.tid < 192) { F.rowidx()[base + 64 + F.tid] = 0; F.gatev()[base + 64 + F.tid] = 0.f; } }
    }
}

constexpr size_t CTL_KMAX = 16384;
namespace ret {
constexpr int TS = 136;
constexpr int TILE_B = 128 * TS * 2;
__device__ __forceinline__ float log2_gamma(float decay) { return -log1pf(expf(-decay)) * LOG2E; }
__device__ __forceinline__ int chunk_row0(int b, int c) { return c < 2 ? NLAT + b * LCTX + c * 128 : b * SEQ + (c - 2) * 128; }
__device__ __forceinline__ f32x16 mm_block(const LAS bf16_t* A, int ra, const LAS bf16_t* B, int rb, int r32, int hi, f32x16 acc) {
#pragma unroll
    for (int s = 0; s < 8; ++s) { const bf16x8 a = *(const LAS bf16x8*)(A + (ra + r32) * TS + 16 * s + 8 * hi), b = *(const LAS bf16x8*)(B + (rb + r32) * TS + 16 * s + 8 * hi);
        acc = __builtin_amdgcn_mfma_f32_32x32x16_bf16(a, b, acc, 0, 0, 0); }
    return acc;
}
__device__ __forceinline__ bf16x8 scale8(bf16x8 v, float s) {
    const u32x4 w = *reinterpret_cast<const u32x4*>(&v); u32x4 o;
    o.x = cvt_pk_bf16(bflo(w.x) * s, bfhi(w.x) * s); o.y = cvt_pk_bf16(bflo(w.y) * s, bfhi(w.y) * s); o.z = cvt_pk_bf16(bflo(w.z) * s, bfhi(w.z) * s); o.w = cvt_pk_bf16(bflo(w.w) * s, bfhi(w.w) * s);
    return *reinterpret_cast<const bf16x8*>(&o);
}
__device__ __forceinline__ f32x16 mm_block_rowscaled(const LAS bf16_t* A, int ra, float rowscale, const LAS bf16_t* B, int rb, int r32, int hi, f32x16 acc) {
#pragma unroll
    for (int s = 0; s < 8; ++s) { const bf16x8 a = scale8(*(const LAS bf16x8*)(A + (ra + r32) * TS + 16 * s + 8 * hi), rowscale), b = *(const LAS bf16x8*)(B + (rb + r32) * TS + 16 * s + 8 * hi);
        acc = __builtin_amdgcn_mfma_f32_32x32x16_bf16(a, b, acc, 0, 0, 0); }
    return acc;
}
__device__ __forceinline__ void ld4(const bf16_t* src, int ld, int tid, bf16x8 (&v)[4]) {
#pragma unroll
    for (int p = 0; p < 4; ++p) { const int idx = tid + 512 * p; v[p] = *reinterpret_cast<const bf16x8*>(src + (size_t)(idx >> 4) * ld + (idx & 15) * 8); }
}
__device__ __forceinline__ void st4_nat(LAS bf16_t* dst, int tid, const bf16x8 (&v)[4]) {
#pragma unroll
    for (int p = 0; p < 4; ++p) { const int idx = tid + 512 * p; *(LAS bf16x8*)(dst + (idx >> 4) * TS + (idx & 15) * 8) = v[p]; }
}
__device__ __forceinline__ void st4_tr(LAS bf16_t* dst, int tid, const bf16x8 (&v)[4], float e0, float e1) {
#pragma unroll
    for (int p = 0; p < 4; ++p) { const int idx = tid + 512 * p; const int m = idx >> 4, c0 = (idx & 15) * 8; const float sc = __builtin_amdgcn_exp2f(e0 + e1 * (float)m);
#pragma unroll
        for (int i = 0; i < 8; ++i) dst[(c0 + i) * TS + m] = f2bf(bf2f((bf16_t)v[p][i]) * sc); }
}

__device__ __forceinline__ void st4_vst(LAS bf16_t* dst, int tid, const bf16x8 (&v)[4]) {
#pragma unroll
    for (int p = 0; p < 4; ++p) { const int idx = tid + 512 * p; const int m = idx >> 4, c0 = (idx & 15) * 8; *(LAS bf16x8*)((LAS char*)dst + (m >> 6) * 16384 + att::v_st(m & 63, c0)) = v[p]; }
}
__device__ __forceinline__ void st4_vst_scaled(LAS bf16_t* dst, int tid, const bf16x8 (&v)[4], float e0, float e1) {
#pragma unroll
    for (int p = 0; p < 4; ++p) { const int idx = tid + 512 * p; const int m = idx >> 4, c0 = (idx & 15) * 8; *(LAS bf16x8*)((LAS char*)dst + (m >> 6) * 16384 + att::v_st(m & 63, c0)) = scale8(v[p], __builtin_amdgcn_exp2f(e0 + e1 * (float)m)); }
}
template <int KS> __device__ __forceinline__ bf16x8 trfrag(int base) {
    const s16x4 lo = att::vtr(base + (KS >> 2) * 16384 + att::v_rd_off(0, KS & 3, 0)), hi = att::vtr(base + (KS >> 2) * 16384 + att::v_rd_off(0, KS & 3, 1));
    return (bf16x8){lo[0], lo[1], lo[2], lo[3], hi[0], hi[1], hi[2], hi[3]};
}
__device__ __forceinline__ f32x16 mm_block_trB(const LAS bf16_t* A, int ra, int tb, int r32, int hi, f32x16 acc) {
#define RET_STEP(KS) acc = __builtin_amdgcn_mfma_f32_32x32x16_bf16(*(const LAS bf16x8*)(A + (ra + r32) * TS + 16 * KS + 8 * hi), trfrag<KS>(tb), acc, 0, 0, 0)
    RET_STEP(0); RET_STEP(1); RET_STEP(2); RET_STEP(3); RET_STEP(4); RET_STEP(5); RET_STEP(6); RET_STEP(7);
#undef RET_STEP
    return acc;
}

__device__ __forceinline__ void c1_unit(const Ctx& F, int li, int bh, int c) {
    const int b = bh >> 2, h = bh & 3, tid = F.tid, wid = F.wave, r32 = F.lane & 31, hi = F.lane >> 5;
    LAS bf16_t* TVt = (LAS bf16_t*)F.lds; LAS bf16_t* KF = TVt + 16384; LAS bf16_t* KB = KF + 16384;
    const float lf = log2_gamma(F.in(I_RDF)[li * 4 + h]), lb = log2_gamma(F.in(I_RDB)[li * 4 + h]);
    const bf16_t* base = F.P() + (size_t)chunk_row0(b, c) * INW + h * HD;
    bf16x8 kv[4], vv[4]; ld4(base + C_CK, INW, tid, kv); ld4(base + C_CV, INW, tid, vv);
    __syncthreads();
    st4_vst(TVt, tid, vv); st4_vst_scaled(KF, tid, kv, 127.f * lf, -lf); st4_vst_scaled(KB, tid, kv, 0.f, lb);
    __syncthreads();
    const int dvb = wid >> 1, dk0 = 2 * (wid & 1); const int l0 = (int)(uintptr_t)F.lds + att::v_rd_base(F.lane);
    const int av = l0 + dvb * 512, bf0 = l0 + 32768 + dk0 * 512, bb0 = l0 + 65536 + dk0 * 512;
    f32x16 f0 = {}, f1 = {}, g0 = {}, g1 = {};
#define C1_STEP(KS) do { const bf16x8 a_ = trfrag<KS>(av); f0 = __builtin_amdgcn_mfma_f32_32x32x16_bf16(a_, trfrag<KS>(bf0), f0, 0, 0, 0); f1 = __builtin_amdgcn_mfma_f32_32x32x16_bf16(a_, trfrag<KS>(bf0 + 512), f1, 0, 0, 0); \
        g0 = __builtin_amdgcn_mfma_f32_32x32x16_bf16(a_, trfrag<KS>(bb0), g0, 0, 0, 0); g1 = __builtin_amdgcn_mfma_f32_32x32x16_bf16(a_, trfrag<KS>(bb0 + 512), g1, 0, 0, 0); } while (0)
    C1_STEP(0); C1_STEP(1); C1_STEP(2); C1_STEP(3); C1_STEP(4); C1_STEP(5); C1_STEP(6); C1_STEP(7);
#undef C1_STEP
    bf16_t* Uf = F.U() + ((size_t)(0 * 8 + bh) * NCH + c) * 16384; bf16_t* Ub = F.U() + ((size_t)(1 * 8 + bh) * NCH + c) * 16384;
#pragma unroll
    for (int r = 0; r < 16; ++r) { const int o_ = (dvb * 32 + crow(r, hi)) * 128 + dk0 * 32 + r32; Uf[o_] = f2bf(f0[r]); Uf[o_ + 32] = f2bf(f1[r]); Ub[o_] = f2bf(g0[r]); Ub[o_ + 32] = f2bf(g1[r]); }
}
__device__ __forceinline__ void c2_scan(const Ctx& F, int li) {
    for (int gid = F.wg * 512 + F.tid; gid < 2 * 8 * 16384; gid += F.G * 512) {
        const int dir = gid >> 17, bh = (gid >> 14) & 7, el = gid & 16383, h = bh & 3;
        const float lg = log2_gamma((dir ? F.in(I_RDB) : F.in(I_RDF))[li * 4 + h]); const float cd = __builtin_amdgcn_exp2f(128.f * lg);
        const bf16_t* U = F.U() + (size_t)(dir * 8 + bh) * NCH * 16384 + el; bf16_t* S = F.S() + (size_t)(dir * 8 + bh) * NCH * 16384 + el;
        float s = 0.f;
        if (dir == 0) {
#pragma unroll 8
            for (int c = 0; c < NCH; ++c) { const float u = bf2f(U[(size_t)c * 16384]); S[(size_t)c * 16384] = f2bf(s); s = cd * s + u; }
        } else {
            { const float u1 = bf2f(U[(size_t)1 * 16384]), u0 = bf2f(U[0]); S[(size_t)1 * 16384] = f2bf(0.f); s = u1; S[0] = f2bf(s); s = cd * s + u0; }
#pragma unroll 8
            for (int c = NCH - 1; c >= 2; --c) { const float u = bf2f(U[(size_t)c * 16384]); S[(size_t)c * 16384] = f2bf(s); s = cd * s + u; }
        }
    }
}
__device__ __forceinline__ void c3_unit(const Ctx& F, int li, int bh, int c) {
    int tid_ = F.tid, lane_ = F.lane; asm volatile("" : "+v"(tid_), "+v"(lane_));
    const int b = bh >> 2, h = bh & 3, tid = tid_, wid = F.wave, lane = lane_, r32 = lane & 31, hi = lane >> 5;
    LAS bf16_t* TQ = (LAS bf16_t*)F.lds; LAS bf16_t* TK = TQ + 128 * TS; LAS bf16_t* TV = TK + 128 * TS; LAS bf16_t* TP = TV + 128 * TS; LAS float* ST = (LAS float*)(TP + 128 * TS);
    const float lf = log2_gamma(F.in(I_RDF)[li * 4 + h]), lb = log2_gamma(F.in(I_RDB)[li * 4 + h]);
    const int row0 = chunk_row0(b, c);
    const bf16_t* base = F.P() + (size_t)row0 * INW + h * HD;
    bf16x8 qv[4], kv[4], vv[4], sf[4], sb[4], gv[4];
    ld4(base + C_CQ, INW, tid, qv); ld4(base + C_CK, INW, tid, kv); ld4(base + C_CV, INW, tid, vv);
    ld4(F.S() + ((size_t)(0 * 8 + bh) * NCH + c) * 16384, 128, tid, sf);
    __syncthreads();
    st4_nat(TQ, tid, qv); st4_nat(TK, tid, kv); st4_vst(TV, tid, vv);
    __syncthreads();
    const int rb = wid >> 1, cb0 = 2 * (wid & 1);
    {
        f32x16 s0 = {}, s1 = {}; s0 = mm_block(TQ, rb * 32, TK, cb0 * 32, r32, hi, s0); s1 = mm_block(TQ, rb * 32, TK, (cb0 + 1) * 32, r32, hi, s1);
#pragma unroll
        for (int r = 0; r < 16; ++r) { const int n = rb * 32 + crow(r, hi);
#pragma unroll
            for (int i = 0; i < 2; ++i) { const int m = (cb0 + i) * 32 + r32; const int d = n - m; float w = __builtin_amdgcn_exp2f((float)d * (d > 0 ? lf : -lb)); w = (d == 0) ? 2.0f : w;
                TP[n * TS + m] = f2bf((i ? s1[r] : s0[r]) * w); } }
    }
    __syncthreads();
    st4_nat(TK, tid, sf);
    asm volatile("" ::: "memory");
    ld4(F.S() + ((size_t)(1 * 8 + bh) * NCH + c) * 16384, 128, tid, sb);
    ld4(base + C_CG, INW, tid, gv);
    __syncthreads();
    const int nrow = rb * 32 + r32;
    f32x16 o0 = {}, o1 = {};
    { const int tvb = (int)(uintptr_t)F.lds + 2 * TILE_B + att::v_rd_base(lane) + cb0 * 512;
      o0 = mm_block_trB(TP, rb * 32, tvb, r32, hi, o0); o1 = mm_block_trB(TP, rb * 32, tvb + 512, r32, hi, o1); }
    { const float qs = __builtin_amdgcn_exp2f((float)(nrow + 1) * lf);
      o0 = mm_block_rowscaled(TQ, rb * 32, qs, TK, cb0 * 32, r32, hi, o0); o1 = mm_block_rowscaled(TQ, rb * 32, qs, TK, (cb0 + 1) * 32, r32, hi, o1); }
    __syncthreads();
    st4_nat(TK, tid, sb);
    __syncthreads();
    { const float qs = __builtin_amdgcn_exp2f((float)(128 - nrow) * lb);
      o0 = mm_block_rowscaled(TQ, rb * 32, qs, TK, cb0 * 32, r32, hi, o0); o1 = mm_block_rowscaled(TQ, rb * 32, qs, TK, (cb0 + 1) * 32, r32, hi, o1); }
#pragma unroll
    for (int r = 0; r < 16; ++r) { float s1 = o0[r] + o1[r], s2 = o0[r] * o0[r] + o1[r] * o1[r];
        s1 = sum32(s1); s2 = sum32(s2);
        if (r32 == 0) { ST[(rb * 32 + crow(r, hi)) * 4 + (wid & 1) * 2] = s1; ST[(rb * 32 + crow(r, hi)) * 4 + (wid & 1) * 2 + 1] = s2; } }
    __syncthreads();
    st4_nat(TQ, tid, gv);
    __syncthreads();
    const float* gg = F.in(I_GNG) + li * 512 + h * HD; const float* gb = F.in(I_GNB) + li * 512 + h * HD;
    float g0 = gg[cb0 * 32 + r32], g1 = gg[(cb0 + 1) * 32 + r32], b0 = gb[cb0 * 32 + r32], b1 = gb[(cb0 + 1) * 32 + r32];
#pragma unroll
    for (int r = 0; r < 16; ++r) { const int n = rb * 32 + crow(r, hi); const f32x4 st = *(const LAS f32x4*)(ST + n * 4);
        const float mean = (st[0] + st[2]) * (1.0f / 128.0f), var = (st[1] + st[3]) * (1.0f / 128.0f) - mean * mean, rstd = rsqrtf(var + 1e-5f);
        bf16_t* op = F.O() + (size_t)(row0 + n) * DM + 1024 + h * HD;
        const float gt0 = bf2f(TQ[n * TS + cb0 * 32 + r32]), gt1 = bf2f(TQ[n * TS + (cb0 + 1) * 32 + r32]);
        op[cb0 * 32 + r32] = f2bf(siluf(gt0) * ((o0[r] - mean) * rstd * g0 + b0)); op[(cb0 + 1) * 32 + r32] = f2bf(siluf(gt1) * ((o1[r] - mean) * rstd * g1 + b1)); }
}
}
__device__ __forceinline__ int clampi(int x, int lo, int hi) { return x < lo ? lo : (x > hi ? hi : x); }
__device__ __forceinline__ void unitA(const Ctx& F, int li, int idx) {
    const bool ctxq = idx >= 512; const int bh = ctxq ? idx - 512 : (idx & 7), qb = ctxq ? 0 : (idx >> 3), b = bh >> 2, h = bh & 3;
    LAS float* biasL = (LAS float*)(F.lds + att::BIAS_OFF);
    __syncthreads();
    { const float* rp = F.in(I_RPB) + (size_t)(li * 4 + h) * 15 * 31; for (int i = F.tid; i < 15 * 31; i += 512) biasL[i] = rp[i] * LOG2E; }
    att::Tiles T; att::MP mp{};
    const bf16_t* ctxrow = F.P() + (size_t)(NLAT + b * LCTX) * INW; const bf16_t* latrow = F.P() + (size_t)(b * SEQ) * INW;
    T.kctx = ctxrow + C_AK + h * HD; T.klat = latrow + C_AK + h * HD; T.vdelta = C_AV - C_AK; T.nctx = 4;
    const int r32 = F.lane & 31;
    const int qr0 = qb * 4; const int lo = clampi(qr0 - 4, 0, 248), hi_ = clampi(qr0 - 1, 0, 248) + 7;
    T.lat0 = lo; T.nt = ctxq ? 4 : 4 + (hi_ - lo + 1);
    const size_t qrow = ctxq ? (size_t)(NLAT + b * LCTX) : (size_t)(b * SEQ + qb * 256);
    att::attn_unit_a2(F.P() + qrow * INW + C_AQ + h * HD, T, F.O() + qrow * DM + h * HD, !ctxq, (const LAS float*)(F.lds + att::BIAS_OFF), qr0, F.ldsg, F.tid);
}
__device__ __forceinline__ void unitD(const Ctx& F, int li, int idx) {
    const bool ctxq = idx >= 512; const int bh = ctxq ? idx - 512 : (idx & 7), qb = ctxq ? 0 : (idx >> 3), b = bh >> 2, h = bh & 3, kv = h >> 1;
    att::Tiles T; att::MP mp{};
    const bf16_t* ctxrow = F.P() + (size_t)(NLAT + b * LCTX) * INW; const bf16_t* latrow = F.P() + (size_t)(b * SEQ) * INW;
    T.kctx = ctxrow + C_DK + kv * HD; T.klat = latrow + C_DK + kv * HD; T.vdelta = C_DV - C_DK; T.nctx = 4;
    mp.sink_l2 = F.in(I_SINK)[li * 4 + h] * LOG2E;
    const int lo = qb * 4 - 2 < 0 ? 0 : qb * 4 - 2, hi_ = qb * 4 + 5 > 255 ? 255 : qb * 4 + 5;
    T.lat0 = lo; T.nt = ctxq ? 4 : 4 + (hi_ - lo + 1); mp.masked = !ctxq; mp.tq = qb * 256 + F.wave * 32 + (F.lane & 31);
    const size_t qrow = ctxq ? (size_t)(NLAT + b * LCTX) : (size_t)(b * SEQ + qb * 256);
    att::attn_unit_simple<2>(F.P() + qrow * INW + C_DQ + h * HD, T, F.O() + qrow * DM + 1536 + h * HD, mp, F.ldsg, F.tid);
}
__device__ __forceinline__ void unitB(const Ctx& F, int li, int idx) {
    const bool ctxq = idx >= 1024; const int j = ctxq ? idx - 1024 : idx; const int bh = j & 7, qb = j >> 3, b = bh >> 2, h = bh & 3;
    att::TilesB3 T; att::MP mp{};
    const bf16_t* ctxrow = F.P() + (size_t)(NLAT + b * LCTX) * INW; const bf16_t* latrow = F.P() + (size_t)(b * SEQ) * INW;
    T.kctx = ctxrow + C_BK + h * HD; T.klat = latrow + C_BK + h * HD; T.vdelta = C_BV - C_BK; T.nt = ctxq ? 4 : 4 + SEQ / 64;
    mp.lam = F.misc()[li * 2]; mp.post = 1.0f - F.misc()[li * 2 + 1]; mp.normg = F.in(I_DNG) + li * HD;
    const size_t qrow = (ctxq ? (size_t)(NLAT + b * LCTX) : (size_t)(b * SEQ)) + (size_t)qb * 128;
    att::attn_unit_b3(F.P() + qrow * INW + C_BQ + h * HD, T, F.O() + qrow * DM + 512 + h * HD, mp, (const unsigned*)(F.ws() + WS_CTL + CTL_KMAX) + li * 16 + b * 8 + h * 2, F.ldsg, F.tid);
}

#define DYN_UNITS(ctr_, n_, slot_, BODY) do { unsigned nx_ = 0u; if (F.tid == 0) nx_ = __hip_atomic_fetch_add((ctr_), 1u, __ATOMIC_RELAXED, __HIP_MEMORY_SCOPE_AGENT); \
    for (;;) { __syncthreads(); if (F.tid == 0) (slot_)[0] = nx_; __syncthreads(); const int idx = (int)__builtin_amdgcn_readfirstlane((slot_)[0]); if (idx >= (n_)) break; \
        if (F.tid == 0) nx_ = __hip_atomic_fetch_add((ctr_), 1u, __ATOMIC_RELAXED, __HIP_MEMORY_SCOPE_AGENT); BODY } } while (0)
constexpr size_t CTL_DYN = 32768;
constexpr int LDS_SCRATCH = 147456, LDS_BYTES = LDS_SCRATCH + 256, IDXL_OFF = 131072;
constexpr int N_PHASES = 23;
__global__ void __launch_bounds__(512, 2) fwd_kernel(Args a) {
    extern __shared__ __attribute__((aligned(16))) unsigned char lds_raw[];
    volatile LAS unsigned* misc = (volatile LAS unsigned*)((LAS unsigned char*)lds_raw + LDS_SCRATCH);
    const int wave_s = __builtin_amdgcn_readfirstlane(threadIdx.x >> 6);
    if (wave_s == 0) { const int l0 = hw_lane(); if (l0 < 4) misc[l0] = 0u; }
    __syncthreads();
    const int lo = a.ph_lo, hi = a.ph_hi;
#ifdef DIAG_BARWAIT
    unsigned barwait_ = 0u;
#endif
    const bool use_bar = (hi - lo) > 1;
    XcdBarrier bar; bar.bar = (unsigned*)(a.ws + WS_CTL); bar.x = 0; bar.st = misc;
    if (use_bar) bar = xcd_barrier_post((unsigned*)(a.ws + WS_CTL), misc, wave_s == 0 && hw_lane() == 0);
#define FCTX const Ctx F = make_ctx(lds_raw, wave_s)
#ifndef PHMASK
#define PHMASK 0xFFFFFFFFu
#endif
#define EN(j) (((PHMASK) >> (j)) & 1u)
#ifndef REPMASK
#define REPMASK 0u
#endif
#define NREP(j) ((((REPMASK) >> (j)) & 1u) ? 2 : 1)
#define IN(k) (lo <= (k) && (k) < hi)
#ifdef EXP_BAR2
#define SEAM(k) do { if (IN(k) && IN((k) + 1)) { xcd_barrier(bar, wave_s == 0 && hw_lane() == 0); xcd_barrier(bar, wave_s == 0 && hw_lane() == 0); } } while (0)
#else
#ifdef DIAG_BARWAIT
#define SEAM(k) do { if (IN(k) && IN((k) + 1)) { const unsigned long long w0_ = wall_clock64(); xcd_barrier(bar, wave_s == 0 && hw_lane() == 0); if ((DIAG_SEAMS >> (k)) & 1u) barwait_ += (unsigned)(wall_clock64() - w0_); } } while (0)
#else
#define SEAM(k) do { if (IN(k) && IN((k) + 1)) xcd_barrier(bar, wave_s == 0 && hw_lane() == 0); } while (0)
#endif
#endif
    for (int rep_ = 0; rep_ < NREP(0); ++rep_) if (EN(0) && IN(0)) { FCTX; ph_mod_partial(F); } SEAM(0);
    for (int rep_ = 0; rep_ < NREP(1); ++rep_) if (EN(1) && IN(1)) { FCTX; ph_mod_reduce(F); ph_convert(F); } SEAM(1);
    const int F_G = gridDim.x;
    for (int li = 0; li < DEPTH; ++li) {
        const int pb = 2 + li * 10;
        for (int rep_ = 0; rep_ < (li == 0 ? NREP(2) : 1); ++rep_) if (EN(2) && IN(pb + 0)) { FCTX; ph_norm1(F, li); } SEAM(pb + 0);
        const bool split_in = use_bar && EN(3) && EN(4) && IN(pb + 1) && IN(pb + 2) && F_G >= 96;
        for (int rep_ = 0; rep_ < NREP(3); ++rep_) if (EN(3) && IN(pb + 1)) {
            if (split_in) {
                { FCTX; pg8::Gemm g{F.H(), F.w_in_t(li), DM, nullptr}; pg8::EpiInProj E{F.P(), F.rope(), (unsigned*)(F.ws() + WS_CTL + CTL_KMAX) + li * 16};
                  pg8::StaticOrder S; S.init(NLAT / 256, INW / 256, F.G, F.wg); pg8::gemm_phase<pg8::EpiInProj, pg8::StaticOrder, false>(F.lds, g, S, E, nullptr, F.tid); }
                xcd_barrier(bar, wave_s == 0 && hw_lane() == 0);
                if (blockIdx.x < 48) { FCTX; pg8::Gemm g{F.H(), F.w_in_t(li), DM, nullptr}; pg8::EpiInProj E{F.P(), F.rope(), (unsigned*)(F.ws() + WS_CTL + CTL_KMAX) + li * 16};
                  pg8::OffsetOrder S; S.init(NCTX / 256, INW / 256, 48, F.wg); S.pm0 = NLAT / 256; pg8::gemm_phase<pg8::EpiInProj, pg8::OffsetOrder, false>(F.lds, g, S, E, nullptr, F.tid); }
                else { FCTX; for (int idx = F.wg - 48; idx < 8 * (NCH - 2); idx += F.G - 48) ret::c1_unit(F, li, idx & 7, 2 + (idx >> 3)); }
            } else {
                FCTX; pg8::Gemm g{F.H(), F.w_in_t(li), DM, nullptr}; pg8::EpiInProj E{F.P(), F.rope(), (unsigned*)(F.ws() + WS_CTL + CTL_KMAX) + li * 16};
                pg8::StaticOrder S; S.init(MTOT / 256, INW / 256, F.G, F.wg);
#ifdef EXP_NOEPI_REP
                if (rep_ == 1) pg8::gemm_phase<pg8::EpiInProj, pg8::StaticOrder, false, true>(F.lds, g, S, E, nullptr, F.tid); else
#endif
                pg8::gemm_phase<pg8::EpiInProj, pg8::StaticOrder, false>(F.lds, g, S, E, nullptr, F.tid);
            }
        } SEAM(pb + 1);
        for (int rep_ = 0; rep_ < NREP(4); ++rep_) if (EN(4) && IN(pb + 2)) {
            FCTX;
            for (int r2_ = 0; r2_ < NREP(15); ++r2_) if (EN(15)) { if (split_in) { for (int idx = (F.wg + F.G - 120) % F.G; idx < 16; idx += F.G) ret::c1_unit(F, li, idx & 7, idx >> 3); }   else { for (int idx = F.wg; idx < 8 * NCH; idx += F.G) ret::c1_unit(F, li, idx & 7, idx >> 3); } }
            const int nAD = (li == 0) ? 520 : 512;
            for (int r2_ = 0; r2_ < NREP(13); ++r2_) if (EN(13)) for (int idx = (F.wg + 8) % F.G; idx < nAD; idx += F.G) unitA(F, li, idx);
            for (int r2_ = 0; r2_ < NREP(14); ++r2_) if (EN(14)) for (int idx = F.wg; idx < nAD; idx += F.G) unitD(F, li, idx);
        } SEAM(pb + 2);
        for (int rep_ = 0; rep_ < NREP(5); ++rep_) if (EN(5) && IN(pb + 3)) { FCTX; ret::c2_scan(F, li); } SEAM(pb + 3);
        for (int rep_ = 0; rep_ < NREP(6); ++rep_) if (EN(6) && IN(pb + 4)) {
            FCTX; const int nB = (li == 0) ? 1040 : 1024;
            if (EN(16)) for (int idx = F.wg; idx < nB; idx += F.G) unitB(F, li, idx);
            if (EN(17)) { if (use_bar) { unsigned* ctr = (unsigned*)(F.ws() + WS_CTL + CTL_DYN) + (li * 4 + 1) * 64; volatile LAS unsigned* slot = misc + 8;
                    DYN_UNITS(ctr, nB, slot, { if (idx < 1024) ret::c3_unit(F, li, idx & 7, 2 + (idx >> 3)); else ret::c3_unit(F, li, (idx - 1024) & 7, (idx - 1024) >> 3); }); }
                else for (int idx = F.wg; idx < nB; idx += F.G) { if (idx < 1024) ret::c3_unit(F, li, idx & 7, 2 + (idx >> 3)); else ret::c3_unit(F, li, (idx - 1024) & 7, (idx - 1024) >> 3); } }
        } SEAM(pb + 4);
        const bool split_out = use_bar && li == 0 && EN(7) && EN(8) && IN(pb + 5) && IN(pb + 6) && F_G >= 64;
        for (int rep_ = 0; rep_ < (li == 0 ? NREP(7) : 1); ++rep_) if (EN(7) && IN(pb + 5)) {
            FCTX; pg8::Gemm g{F.O(), F.w_out_t(li), DM, nullptr};
            pg8::EpiOutProj E{li == 0 ? F.in(I_X) : nullptr, F.xb(), F.xb(), F.in(I_CTX), F.xc(), F.mod() + (size_t)li * 3 * 12288};
            pg8::StaticOrder S; S.init((li == 0 && !split_out) ? MTOT / 256 : NLAT / 256, DM / 256, F.G, F.wg);
            pg8::gemm_phase<pg8::EpiOutProj, pg8::StaticOrder, false>(F.lds, g, S, E, nullptr, F.tid);
        } SEAM(pb + 5);
        for (int rep_ = 0; rep_ < NREP(8); ++rep_) if (EN(8) && IN(pb + 6)) {
            if (split_out) {
                if (blockIdx.x < 16) { FCTX; pg8::Gemm g{F.O(), F.w_out_t(li), DM, nullptr}; pg8::EpiOutProj E{F.in(I_X), F.xb(), F.xb(), F.in(I_CTX), F.xc(), F.mod() + (size_t)li * 3 * 12288};
                    pg8::OffsetOrder S; S.init(NCTX / 256, DM / 256, 16, F.wg); S.pm0 = NLAT / 256; pg8::gemm_phase<pg8::EpiOutProj, pg8::OffsetOrder, false>(F.lds, g, S, E, nullptr, F.tid); }
                else { FCTX; ph_norm2(F, li, 0, NLAT, 16, F.G - 16); }
                xcd_barrier(bar, wave_s == 0 && hw_lane() == 0);
                if (blockIdx.x < 16) { FCTX; ph_norm2(F, li, NLAT, MTOT, 0, 16); }
            } else { FCTX; ph_norm2(F, li, 0, NLAT, 0, F.G); if (li == 0) ph_norm2(F, li, NLAT, MTOT, 0, F.G); }
        } SEAM(pb + 6);
        for (int rep_ = 0; rep_ < NREP(9); ++rep_) if (EN(9) && IN(pb + 7)) { FCTX; ph_topk(F, li); } SEAM(pb + 7);
        for (int rep_ = 0; rep_ < NREP(10); ++rep_) if (EN(10) && IN(pb + 8)) {
            FCTX; pg8::Gemm g{F.H(), F.w_gu_t(li), DM, F.rowidx()}; pg8::MoeOrder S; S.init(li == 0 ? 272 : 256, 8, F.G, F.wg); pg8::EpiSwiGLU E{F.ACT()};
            pg8::gemm_phase<pg8::EpiSwiGLU, pg8::MoeOrder, true>(F.lds, g, S, E, (LAS int*)(F.lds + IDXL_OFF), F.tid);
        } SEAM(pb + 8);
        for (int rep_ = 0; rep_ < NREP(11); ++rep_) if (EN(11) && IN(pb + 9)) {
            FCTX; pg8::Gemm g{F.ACT(), F.w_dn_t(li), FF, nullptr}; pg8::MoeOrder S; S.init(li == 0 ? 272 : 256, 8, F.G, F.wg); pg8::EpiDown E{F.Y(), F.gatev()};
            pg8::gemm_phase<pg8::EpiDown, pg8::MoeOrder, false>(F.lds, g, S, E, nullptr, F.tid);
        } SEAM(pb + 9);
    }
    for (int rep_ = 0; rep_ < NREP(12); ++rep_) if (EN(12) && IN(22)) { FCTX; ph_final(F); }
#ifdef DIAG_BARWAIT
    if (blockIdx.x == DIAG_WG && wave_s == 0 && hw_lane() == 0 && barwait_ > (unsigned)DIAG_BARWAIT) a.out[(size_t)DIAG_WG * 3] += 1000.0f;
#endif
#undef IN
#undef SEAM
#undef FCTX
}

#ifndef N_LAUNCHES
#define N_LAUNCHES 1
#endif
extern "C" void kernel_launch(void* const* d_in, const int* in_sizes, int n_in, void* d_out, int out_size, void* d_ws, size_t ws_size, hipStream_t stream) {
    static int grid = 0;
    if (grid == 0) {
        if (n_in != 23 || out_size != NLAT * DM || ws_size < WS_END) { fprintf(stderr, "kernel_launch: unexpected shapes: n_in %d out %d ws %zu (need %zu)\n", n_in, out_size, ws_size, (size_t)WS_END); grid = -1; return; }
        int dev = 0, cus = 0, per_cu = 0;
        if (hipGetDevice(&dev) != hipSuccess || hipDeviceGetAttribute(&cus, hipDeviceAttributeMultiprocessorCount, dev) != hipSuccess) { grid = -1; return; }
        if (hipFuncSetAttribute((const void*)fwd_kernel, hipFuncAttributeMaxDynamicSharedMemorySize, LDS_BYTES) != hipSuccess) { fprintf(stderr, "kernel_launch: hipFuncSetAttribute failed\n"); grid = -1; return; }
        if (hipOccupancyMaxActiveBlocksPerMultiprocessor(&per_cu, (const void*)fwd_kernel, 512, LDS_BYTES) != hipSuccess || per_cu < 1) fprintf(stderr, "kernel_launch: occupancy query says %d\n", per_cu);
        (void)hipGetLastError();
        grid = cus;
    }
    if (grid < 0) return;
    hipMemsetAsync((char*)d_ws + WS_CTL, 0, CTL_BYTES, stream);
    Args a{};
    for (int i = 0; i < 23; ++i) a.in[i] = (const float*)d_in[i];
    a.out = (float*)d_out; a.ws = (unsigned char*)d_ws;
    for (int k = 0; k < N_LAUNCHES; ++k) {
        a.ph_lo = (N_LAUNCHES == 1) ? 0 : k; a.ph_hi = (N_LAUNCHES == 1) ? N_PHASES : k + 1;
        hipLaunchKernelGGL(fwd_kernel, dim3(grid), dim3(512), LDS_BYTES, stream, a);
    }
    const hipError_t le = hipPeekAtLastError();
    if (le != hipSuccess) fprintf(stderr, "kernel_launch: launch failed: %s\n", hipGetErrorName(le));
}
```

```cpp
#include <hip/hip_runtime.h>
#include <cstdio>
#include <cstdint>

#define LAS __attribute__((address_space(3)))
typedef unsigned short bf16_t;
typedef short bf16x8 __attribute__((ext_vector_type(8)));
typedef short s16x4 __attribute__((ext_vector_type(4)));
typedef float f32x4 __attribute__((ext_vector_type(4)));
typedef float f32x2 __attribute__((ext_vector_type(2)));
typedef float f32x16 __attribute__((ext_vector_type(16)));
typedef unsigned u32x4 __attribute__((ext_vector_type(4)));
typedef unsigned u32x2 __attribute__((ext_vector_type(2)));

constexpr int DM = 2048, NBATCH = 2, SEQ = 16384, LCTX = 256, DEPTH = 2;
constexpr int NLAT = NBATCH * SEQ;
constexpr int NCTX = NBATCH * LCTX;
constexpr int MTOT = NLAT + NCTX;
constexpr int INW = 6144;
constexpr int HD = 128;
constexpr int NE = 16, FF = 1024, CAP = 2048, CAPC = 32;
constexpr int MOE_ROWS = NBATCH * NE * CAP + NE * 256;
constexpr int NCH = 130;
constexpr int C_AQ = 0, C_AK = 512, C_AV = 1024, C_BQ = 1536, C_BK = 2048, C_BV = 2560, C_CQ = 3072, C_CK = 3584, C_CV = 4096, C_CG = 4608, C_DQ = 5120, C_DK = 5632, C_DV = 5888;
constexpr float LOG2E = 1.4426950408889634f;
constexpr float NEGBIG = -1e30f;

constexpr size_t al256(size_t x) { return (x + 255) / 256 * 256; }
constexpr size_t WS_CTL = 0;
constexpr size_t CTL_BYTES = 65536;
constexpr size_t WS_MODP = WS_CTL + CTL_BYTES;
constexpr size_t WS_MOD = WS_MODP + al256((size_t)16 * 2 * 3 * 12288 * 4);
constexpr size_t WS_MISC = WS_MOD + al256((size_t)2 * 3 * 12288 * 4);
constexpr size_t WS_ROPE = WS_MISC + 256;
constexpr size_t WS_XC = WS_ROPE + al256((size_t)(256 * 32 * 2 + 256 * 16 * 2) * 4);
constexpr size_t WS_AFF = WS_XC + al256((size_t)NCTX * DM * 4);
constexpr size_t WS_ROWIDX = WS_AFF + al256((size_t)MTOT * NE * 4);
constexpr size_t WS_GATEV = WS_ROWIDX + al256((size_t)MOE_ROWS * 4);
constexpr size_t WS_SLOT = WS_GATEV + al256((size_t)MOE_ROWS * 4);
constexpr size_t WS_H = WS_SLOT + al256((size_t)MTOT * NE * 4);
constexpr size_t H_BYTES = (size_t)MTOT * DM * 2;
constexpr size_t WS_P = WS_H + al256(H_BYTES);
constexpr size_t P_BYTES = (size_t)MTOT * INW * 2;
constexpr size_t WS_O = WS_P + al256(P_BYTES);
constexpr size_t WS_S = WS_O + al256(H_BYTES);
constexpr size_t S_BYTES = (size_t)2 * 8 * NCH * 16384 * 2;
constexpr size_t WS_W = WS_S + al256(S_BYTES);
constexpr size_t W_IN_B = (size_t)INW * DM * 2, W_OUT_B = (size_t)DM * DM * 2, W_GU_B = (size_t)NE * 2048 * DM * 2, W_DN_B = (size_t)NE * DM * FF * 2;
constexpr size_t WL_IN = 0, WL_OUT = WL_IN + W_IN_B, WL_GU = WL_OUT + W_OUT_B, WL_DN = WL_GU + W_GU_B, WL_BYTES = WL_DN + W_DN_B;
constexpr size_t WS_XB = WS_W + 2 * WL_BYTES;
constexpr size_t WS_END = WS_XB + al256((size_t)NLAT * DM * 2);
constexpr size_t ACT_OFF = 0;
constexpr size_t Y_OFF = al256((size_t)MOE_ROWS * FF * 2);
static_assert(Y_OFF + (size_t)MOE_ROWS * DM * 2 <= al256(P_BYTES) + H_BYTES, "Y must fit in P + O");
static_assert((size_t)2 * 8 * NCH * 16384 * 2 <= (size_t)NLAT * DM * 2, "retention U (bf16) must fit in the latent part of H");

__device__ __forceinline__ unsigned cvt_pk_bf16(float lo, float hi) { unsigned r; asm volatile("v_cvt_pk_bf16_f32 %0, %1, %2" : "=v"(r) : "v"(lo), "v"(hi)); return r; }
__device__ __forceinline__ bf16_t f2bf(float f) { return (bf16_t)(cvt_pk_bf16(f, 0.f) & 0xffffu); }
__device__ __forceinline__ float bf2f(bf16_t b) { return __uint_as_float(((unsigned)b) << 16); }
__device__ __forceinline__ float bflo(unsigned w) { return __uint_as_float(w << 16); }
__device__ __forceinline__ float bfhi(unsigned w) { return __uint_as_float(w & 0xffff0000u); }
__device__ __forceinline__ float siluf(float x) { return x / (1.0f + __expf(-x)); }
template <int M> __device__ __forceinline__ float xshf(float v) { return __int_as_float(__builtin_amdgcn_ds_swizzle(__float_as_int(v), (M << 10) | 0x1f)); }
__device__ __forceinline__ float sum32(float s) { s += xshf<1>(s); s += xshf<2>(s); s += xshf<4>(s); s += xshf<8>(s); s += xshf<16>(s); return s; }
__device__ __forceinline__ float sum64(float s) { s = sum32(s); auto rr = __builtin_amdgcn_permlane32_swap(__float_as_uint(s), __float_as_uint(s), false, false); return __uint_as_float(rr[0]) + __uint_as_float(rr[1]); }
__device__ __forceinline__ unsigned lane_up(unsigned v, int lane, int o) { return (unsigned)__builtin_amdgcn_ds_bpermute((lane - o) << 2, (int)v); }
__device__ __forceinline__ int crow(int r, int hi) { return (r & 3) + 8 * (r >> 2) + 4 * hi; }

#define XB_TMO      128
#define XB_XCNT(j)  (256  + 64 * (j))
#define XB_XSUB(j)  (1280 + 64 * (j))
#define XB_XGEN(j)  (2304 + 64 * (j))
#define XB_TOP      3328
#define XB_TOPGEN   3392
#define XCD_BAR_WORDS 3456
#define XB_SPIN_CAP (1u << 24)
__device__ __forceinline__ unsigned xb_ld(unsigned* p)              { return __hip_atomic_load(p, __ATOMIC_RELAXED, __HIP_MEMORY_SCOPE_AGENT); }
__device__ __forceinline__ unsigned xb_add(unsigned* p, unsigned v) { return __hip_atomic_fetch_add(p, v, __ATOMIC_RELAXED, __HIP_MEMORY_SCOPE_AGENT); }
__device__ __forceinline__ unsigned xb_xcc_id() { return (unsigned)__builtin_amdgcn_s_getreg((3 << 11) | 20) & 0xFu; }
#define XB_SPIN(cond, bar) do { unsigned _sp = 0; while (cond) { __builtin_amdgcn_s_sleep(1); \
    if ((++_sp & 255u) == 0u) { if (xb_ld(&(bar)[XB_TMO])) break; if (_sp > XB_SPIN_CAP) { atomicAdd(&(bar)[XB_TMO], 1u); break; } } } } while (0)
struct XcdBarrier { unsigned* bar; unsigned x; volatile LAS unsigned* st; };
__device__ __forceinline__ XcdBarrier xcd_barrier_post(unsigned* bar, volatile LAS unsigned* st, bool leader) {
    XcdBarrier b; b.bar = bar; b.x = xb_xcc_id(); b.st = st;
    if (leader) (void)xb_add(&bar[XB_XCNT(b.x)], 1u);
    return b;
}
__device__ __forceinline__ void xcd_barrier_complete(unsigned* bar, unsigned x, unsigned& nloc, unsigned& nx) {
    const unsigned G = gridDim.x * gridDim.y * gridDim.z;
    unsigned sum, cnt, mine, sp = 0u;
    for (;;) {
        sum = 0u; cnt = 0u; mine = 0u;
#pragma unroll
        for (unsigned j = 0; j < 16; ++j) { const unsigned c = xb_ld(&bar[XB_XCNT(j)]); sum += c; cnt += (c > 0u) ? 1u : 0u; mine = (j == x) ? c : mine; }
        if (sum == G) break;
        __builtin_amdgcn_s_sleep(1);
        if ((++sp & 255u) == 0u) { if (xb_ld(&bar[XB_TMO])) break; if (sp > XB_SPIN_CAP) { atomicAdd(&bar[XB_TMO], 1u); break; } }
    }
    nloc = mine > 0u ? mine : 1u; nx = cnt > 0u ? cnt : 1u;
}
__device__ __forceinline__ void xcd_barrier(const XcdBarrier& b, bool leader) {
    asm volatile("s_waitcnt vmcnt(0)" ::: "memory");
    __syncthreads();
    if (leader) {
        unsigned* bar = b.bar;
        __builtin_amdgcn_s_waitcnt(0);
        unsigned nloc = b.st[0], nx = b.st[1];
        if (nloc == 0u) { xcd_barrier_complete(bar, b.x, nloc, nx); b.st[0] = nloc; b.st[1] = nx; }
        const unsigned old = xb_add(&bar[XB_XSUB(b.x)], 1u);
        const unsigned gen = old / nloc;
        if (old + 1u == (gen + 1u) * nloc) {
            __builtin_amdgcn_fence(__ATOMIC_RELEASE, "agent");
            asm volatile("s_waitcnt vmcnt(0)" ::: "memory");
            const unsigned og = xb_add(&bar[XB_TOP], 1u);
            const unsigned tg = og / nx;
            if (og + 1u == (tg + 1u) * nx) xb_add(&bar[XB_TOPGEN], 1u);
            else XB_SPIN(xb_ld(&bar[XB_TOPGEN]) == tg, bar);
            __builtin_amdgcn_fence(__ATOMIC_ACQUIRE, "agent");
            xb_add(&bar[XB_XGEN(b.x)], 1u);
            asm volatile("s_waitcnt vmcnt(0)" ::: "memory");
        } else {
            XB_SPIN(xb_ld(&bar[XB_XGEN(b.x)]) == gen, bar);
            __builtin_amdgcn_fence(__ATOMIC_ACQUIRE, "agent");
            asm volatile("s_waitcnt vmcnt(0)" ::: "memory");
        }
    }
    __syncthreads();
}
namespace pg8 {
constexpr int BM = 256, BK = 64, HALF = 128, HTB = HALF * BK * 2, STAGE_BYTES = 8 * HTB, NXCD = 8, WGM = 8;
__host__ __device__ __forceinline__ int lds_byte(int r, int c) { const int st = (r >> 4) * 2 + (c >> 5), rr = r & 15, cc = c & 31, ob = rr * 64 + cc * 2; return st * 1024 + (ob ^ (((ob >> 9) & 1) << 5)); }
__host__ __device__ __forceinline__ void stage_rc(int b, int& R, int& C) { const int st = b / 1024, sb = b % 1024, swz = sb ^ (((sb >> 9) & 1) << 5); R = (st >> 1) * 16 + swz / 64; C = (st & 1) * 32 + (swz % 64) / 2; }
__host__ __device__ __forceinline__ int perm32(int rho) { const int n = rho >> 4, i = rho & 15; return 8 * (i >> 2) + 4 * n + (i & 3); }

struct Unit { int pm, pn; };
struct Gemm { const bf16_t* A; const bf16_t* Bt; int K; const int* rowidx; };

struct StaticOrder {
    int nM, nN, nwg, G, c;
    __device__ void init(int nM_, int nN_, int G_, int c_) { nM = nM_; nN = nN_; nwg = nM * nN; G = G_; c = c_; }
    __device__ bool next(int i, Unit& u) const {
        const long L = (long)i * G + c; if (L >= nwg) return false;
        int wgid = (int)L; { const int q = nwg / NXCD, r = nwg % NXCD, xcd = wgid % NXCD, off = wgid / NXCD; wgid = (xcd < r ? xcd * (q + 1) : r * (q + 1) + (xcd - r) * q) + off; }
        const int nig = WGM * nN, gid = wgid / nig, fm = gid * WGM, gsz = (nM - fm) < WGM ? (nM - fm) : WGM;
        u.pm = fm + ((wgid % nig) % gsz); u.pn = (wgid % nig) / gsz; return true;
    }
};
struct OffsetOrder : StaticOrder {
    int pm0;
    __device__ bool next(int i, Unit& u) const { if (!StaticOrder::next(i, u)) return false; u.pm += pm0; return true; }
};
__device__ __forceinline__ int moe_expert_of_tile(int pm) { return pm < 256 ? ((pm >> 3) & 15) : (pm - 256); }
struct MoeOrder : StaticOrder {
    __device__ bool next(int i, Unit& u) const { if (!StaticOrder::next(i, u)) return false; u.pn += moe_expert_of_tile(u.pm) * 8; return true; }
};

template <class Epi, class Sched, bool GATHER, bool NOEPI = false>
__device__ __forceinline__ void gemm_phase(LAS unsigned char* lds, const Gemm g, const Sched& S, const Epi& E, LAS int* idxl, const int tid) {
    const int wid = __builtin_amdgcn_readfirstlane(tid >> 6), lane = tid & 63, wr = wid >> 2, wc = wid & 3, fr = lane & 15, fq = lane >> 4;
    const int K = g.K, nt = K / BK;
    unsigned voffA[2], voffB[2]; int RA[2];
#pragma unroll
    for (int i = 0; i < 2; ++i) { int R, C; stage_rc(tid * 16 + i * 8192, R, C); const int Rb = Epi::PERM ? ((R & ~31) + perm32(R & 31)) : R;
        voffA[i] = (unsigned)(R * K + C) * 2u; voffB[i] = (unsigned)(Rb * K + C) * 2u; RA[i] = R; if (GATHER) voffA[i] = (unsigned)C * 2u; }
    const size_t kstep = (size_t)(BK * 2);
    const size_t hstep = (size_t)HALF * K * 2;
    const size_t tstep = 2 * hstep;
    const unsigned ldsw = (unsigned)wid * 1024u;
    const int aoff = lds_byte(wr * 64 + fr, fq * 8), boff = lds_byte(wc * 32 + fr, fq * 8);
#define PG8_SA(b, h) (((b) * 2 + (h)) * HTB)
#define PG8_SB(b, h) ((4 + (b) * 2 + (h)) * HTB)
#define PG8_STAGE(bufoff, gbase, voff) do { _Pragma("unroll") for (int _i = 0; _i < 2; ++_i) \
        __builtin_amdgcn_global_load_lds((const unsigned*)((const char*)(gbase) + (voff)[_i]), (LAS unsigned*)(lds + (bufoff) + ldsw + _i * 8192), 16, 0, 0); } while (0)
#define PG8_STAGE_A(bufoff, h, pA, offs) do { _Pragma("unroll") for (int _i = 0; _i < 2; ++_i) { const char* _p; \
        if constexpr (GATHER) _p = (const char*)(pA) + (offs)[h][_i]; else _p = (const char*)(pA) + (size_t)(h) * hstep + voffA[_i]; \
        __builtin_amdgcn_global_load_lds((const unsigned*)_p, (LAS unsigned*)(lds + (bufoff) + ldsw + _i * 8192), 16, 0, 0); } } while (0)
#define PG8_LDA(dst, b, h) do { _Pragma("unroll") for (int m = 0; m < 4; ++m) _Pragma("unroll") for (int k = 0; k < 2; ++k) dst[m][k] = *(const LAS bf16x8*)(lds + PG8_SA(b, h) + aoff + m * 2048 + k * 1024); } while (0)
#define PG8_LDB(dst, b, h) do { _Pragma("unroll") for (int n = 0; n < 2; ++n) _Pragma("unroll") for (int k = 0; k < 2; ++k) dst[n][k] = *(const LAS bf16x8*)(lds + PG8_SB(b, h) + boff + n * 2048 + k * 1024); } while (0)
#define PG8_MMA(ai, bj, At, Bt) do { __builtin_amdgcn_s_setprio(1); _Pragma("unroll") for (int m = 0; m < 4; ++m) _Pragma("unroll") for (int n = 0; n < 2; ++n) _Pragma("unroll") for (int k = 0; k < 2; ++k) \
        acc[ai][bj][m][n] = __builtin_amdgcn_mfma_f32_16x16x32_bf16(Bt[n][k], At[m][k], acc[ai][bj][m][n], 0, 0, 0); __builtin_amdgcn_s_setprio(0); } while (0)
#define PG8_WAIT_V(n) asm volatile("s_waitcnt vmcnt(" #n ")" ::: "memory")
#define PG8_WAIT_L(n) asm volatile("s_waitcnt lgkmcnt(" #n ")" ::: "memory")
#define PG8_BAR __builtin_amdgcn_s_barrier()
#define PG8_SCHED __builtin_amdgcn_sched_barrier(0)
    Unit cur, nxt; int ui = 0;
    if (!S.next(0, cur)) return;
    f32x4 acc[2][2][4][2];
#pragma unroll
    for (int a = 0; a < 2; ++a)
#pragma unroll
        for (int b = 0; b < 2; ++b)
#pragma unroll
            for (int m = 0; m < 4; ++m)
#pragma unroll
                for (int n = 0; n < 2; ++n) acc[a][b][m][n] = (f32x4){0.f, 0.f, 0.f, 0.f};
    bf16x8 At[4][2], B0[2][2], B1[2][2];
    unsigned oc[2][2] = {{0u, 0u}, {0u, 0u}}, on[2][2] = {{0u, 0u}, {0u, 0u}};
#define PG8_GOFF(dst, ui_) do { if constexpr (GATHER) { _Pragma("unroll") for (int _h = 0; _h < 2; ++_h) _Pragma("unroll") for (int _i = 0; _i < 2; ++_i) \
        dst[_h][_i] = (unsigned)idxl[(ui_) * BM + _h * HALF + RA[_i]] * (unsigned)(K * 2) + voffA[_i]; } } while (0)
    if constexpr (GATHER) {
        for (int i = 0; i < 16; ++i) { Unit uu; if (!S.next(i, uu)) break; if (tid < BM) idxl[i * BM + tid] = g.rowidx[uu.pm * BM + tid]; }
        __syncthreads();
    }
    PG8_GOFF(oc, 0);
    const char* cA = GATHER ? (const char*)g.A : (const char*)g.A + (size_t)cur.pm * tstep; const char* cB = (const char*)g.Bt + (size_t)cur.pn * tstep;
    PG8_STAGE(PG8_SB(0, 0), cB, voffB); PG8_STAGE(PG8_SB(0, 1), cB + hstep, voffB); PG8_STAGE_A(PG8_SA(0, 0), 0, cA, oc); PG8_STAGE_A(PG8_SA(0, 1), 1, cA, oc);
    if (wr == 1) PG8_BAR;
    PG8_WAIT_V(2); PG8_BAR;
    PG8_STAGE(PG8_SB(1, 0), cB + kstep, voffB); PG8_STAGE_A(PG8_SA(1, 0), 0, cA + kstep, oc); PG8_STAGE(PG8_SB(1, 1), cB + hstep + kstep, voffB);
    PG8_WAIT_V(6); PG8_BAR;
    for (;;) {
        const bool has_next = S.next(ui + 1, nxt);
        if (has_next) PG8_GOFF(on, ui + 1); else { if constexpr (GATHER) { on[0][0] = oc[0][0]; on[0][1] = oc[0][1]; on[1][0] = oc[1][0]; on[1][1] = oc[1][1]; } }
        const char* nA = GATHER ? (const char*)g.A : (has_next ? (const char*)g.A + (size_t)nxt.pm * tstep : cA);
        const char* nB = has_next ? (const char*)g.Bt + (size_t)nxt.pn * tstep : cB;
        asm volatile(".p2align 8");
        for (int t = 0; t < nt; t += 2) {
            const bool last = (t == nt - 2);
            const char* a1 = cA + (size_t)(t + 1) * kstep;
            const char* a2 = last ? nA : cA + (size_t)(t + 2) * kstep; const char* b2 = last ? nB : cB + (size_t)(t + 2) * kstep;
            const char* a3 = a2 + kstep; const char* b3 = b2 + kstep;
            unsigned o2[2][2];
#pragma unroll
            for (int _h = 0; _h < 2; ++_h)
#pragma unroll
                for (int _i = 0; _i < 2; ++_i) o2[_h][_i] = last ? on[_h][_i] : oc[_h][_i];
            PG8_LDB(B0, 0, 0); PG8_LDB(B1, 0, 1); PG8_SCHED; PG8_LDA(At, 0, 0); PG8_STAGE_A(PG8_SA(1, 1), 1, a1, oc);
            PG8_WAIT_V(8); PG8_WAIT_L(0); PG8_BAR; PG8_MMA(0, 0, At, B0); PG8_MMA(0, 1, At, B1); PG8_BAR; PG8_SCHED;
            PG8_LDA(At, 0, 1); PG8_STAGE(PG8_SB(0, 0), b2, voffB); PG8_STAGE(PG8_SB(0, 1), b2 + hstep, voffB); PG8_STAGE_A(PG8_SA(0, 0), 0, a2, o2);
            PG8_WAIT_V(8); PG8_WAIT_L(0); PG8_BAR; PG8_MMA(1, 0, At, B0); PG8_MMA(1, 1, At, B1); PG8_BAR; PG8_SCHED;
            PG8_LDB(B0, 1, 0); PG8_LDB(B1, 1, 1); PG8_SCHED; PG8_LDA(At, 1, 0); PG8_STAGE_A(PG8_SA(0, 1), 1, a2, o2);
            PG8_WAIT_V(8); PG8_WAIT_L(0); PG8_BAR; PG8_MMA(0, 0, At, B0); PG8_MMA(0, 1, At, B1); PG8_BAR; PG8_SCHED;
            PG8_LDA(At, 1, 1); PG8_STAGE(PG8_SB(1, 0), b3, voffB); PG8_STAGE(PG8_SB(1, 1), b3 + hstep, voffB); PG8_STAGE_A(PG8_SA(1, 0), 0, a3, o2);
            PG8_WAIT_V(8); PG8_WAIT_L(0); PG8_BAR; PG8_MMA(1, 0, At, B0); PG8_MMA(1, 1, At, B1); PG8_BAR; PG8_SCHED;
        }
        if (wr == 0) PG8_BAR;
        if constexpr (!NOEPI) E(acc, cur, wr, wc, fr, fq); else { float d_ = 0.f; _Pragma("unroll") for (int a_ = 0; a_ < 2; ++a_) _Pragma("unroll") for (int b_ = 0; b_ < 2; ++b_) _Pragma("unroll") for (int m_ = 0; m_ < 4; ++m_) _Pragma("unroll") for (int n_ = 0; n_ < 2; ++n_) d_ += acc[a_][b_][m_][n_][0] + acc[a_][b_][m_][n_][3]; if (d_ == 1.2345e30f) ((float*)g.A)[0] = d_; }
#ifdef EXP_EPI2
        if constexpr (Epi::PERM && !GATHER && sizeof(Epi) == 16) { asm volatile("" ::: "memory"); E(acc, cur, wr, wc, fr, fq); }
#endif
        if (!has_next) break;
#pragma unroll
        for (int a = 0; a < 2; ++a)
#pragma unroll
            for (int b = 0; b < 2; ++b)
#pragma unroll
                for (int m = 0; m < 4; ++m)
#pragma unroll
                    for (int n = 0; n < 2; ++n) acc[a][b][m][n] = (f32x4){0.f, 0.f, 0.f, 0.f};
        cur = nxt; cA = nA; cB = nB; ++ui;
        if constexpr (GATHER) { oc[0][0] = on[0][0]; oc[0][1] = on[0][1]; oc[1][0] = on[1][0]; oc[1][1] = on[1][1]; }
        if (wr == 1) PG8_BAR;
    }
    PG8_WAIT_V(0);
    PG8_BAR;
#undef PG8_SA
#undef PG8_SB
#undef PG8_STAGE
#undef PG8_STAGE_A
#undef PG8_GOFF
#undef PG8_LDA
#undef PG8_LDB
#undef PG8_MMA
#undef PG8_WAIT_V
#undef PG8_WAIT_L
#undef PG8_BAR
#undef PG8_SCHED
}

__device__ __forceinline__ u32x4 pack8(const f32x4 a, const f32x4 b) { u32x4 w; w.x = cvt_pk_bf16(a[0], a[1]); w.y = cvt_pk_bf16(a[2], a[3]); w.z = cvt_pk_bf16(b[0], b[1]); w.w = cvt_pk_bf16(b[2], b[3]); return w; }

struct EpiInProj {
    static constexpr bool PERM = true;
    bf16_t* P; const float* rope;
    unsigned* kmax;
    __device__ __forceinline__ void operator()(const f32x4 (&acc)[2][2][4][2], const Unit& u, int wr, int wc, int fr, int fq) const {
        const int pn = u.pn; const bool lat = u.pm < (NLAT / 256);
        const int kind = (pn >= 6 && pn <= 9) ? 2 : (((pn >= 12 && pn <= 15) || (pn >= 20 && pn <= 22)) ? 1 : 0);
        const int row0 = u.pm * BM + wr * 64 + fr;
        if (kind == 0) {
            const int col0 = pn * 256 + wc * 32 + 8 * fq;
#pragma unroll
            for (int ai = 0; ai < 2; ++ai)
#pragma unroll
                for (int m = 0; m < 4; ++m) { bf16_t* rowp = P + (size_t)(row0 + ai * HALF + m * 16) * INW + col0;
#pragma unroll
                    for (int bj = 0; bj < 2; ++bj) *(u32x4*)(rowp + bj * HALF) = pack8(acc[ai][bj][m][0], acc[ai][bj][m][1]); }
        } else {
            const bool k1 = kind == 1; const int nf = k1 ? 32 : 16, pstep = k1 ? 32 : 16;
            const int cu1 = k1 ? pn * 256 + (wc >> 1) * 128 + (wc & 1) * 64 + 8 * fq : pn * 256 + wc * 64 + (fq >> 1) * 32 + 8 * (fq & 1);
            const int i0 = k1 ? 8 * fq : 8 * (fq & 1); const bool colp = k1 ? ((wc & 1) != 0) : ((fq >> 1) != 0);
            const float* TC = k1 ? rope : rope + 2 * 256 * 32; const float* TS = TC + 256 * nf;
            const int trow0 = ((u.pm * BM) & (SEQ - 1)) / 64 + wr;
            f32x4 nc0, nc1, ns0, ns1; float kq = 0.f;
#define RP_LOAD(g_) do { const int pos_ = colp ? (fr + 16 * ((g_) & 3)) : (trow0 + 2 * ((g_) >> 2)); const float* pc_ = TC + pos_ * nf + i0; const float* ps_ = TS + pos_ * nf + i0; \
                nc0 = *(const f32x4*)(pc_); nc1 = *(const f32x4*)(pc_ + 4); ns0 = *(const f32x4*)(ps_); ns1 = *(const f32x4*)(ps_ + 4); } while (0)
            if (lat) RP_LOAD(0);
#pragma unroll
            for (int gidx = 0; gidx < 8; ++gidx) { const int ai = gidx >> 2, m = gidx & 3; const int row = row0 + ai * HALF + m * 16;
                f32x4 a0 = acc[ai][0][m][0], a1 = acc[ai][0][m][1], b0 = acc[ai][1][m][0], b1 = acc[ai][1][m][1];
                if (lat) { const f32x4 c0 = nc0, c1 = nc1, s0 = ns0, s1 = ns1;
                    if (gidx < 7) RP_LOAD(gidx + 1);
                    const f32x4 x0 = a0 * c0 - b0 * s0, x1 = a1 * c1 - b1 * s1, y0 = b0 * c0 + a0 * s0, y1 = b1 * c1 + a1 * s1; a0 = x0; a1 = x1; b0 = y0; b1 = y1; }
                bf16_t* rowp = P + (size_t)row * INW + cu1;
                const u32x4 w0 = pack8(a0, a1), w1 = pack8(b0, b1); *(u32x4*)(rowp) = w0; *(u32x4*)(rowp + pstep) = w1;
                if (pn == 8 || pn == 9) {
                    float q2 = bflo(w0.x) * bflo(w0.x) + bfhi(w0.x) * bfhi(w0.x) + bflo(w0.y) * bflo(w0.y) + bfhi(w0.y) * bfhi(w0.y) + bflo(w0.z) * bflo(w0.z) + bfhi(w0.z) * bfhi(w0.z) + bflo(w0.w) * bflo(w0.w) + bfhi(w0.w) * bfhi(w0.w)
                             + bflo(w1.x) * bflo(w1.x) + bfhi(w1.x) * bfhi(w1.x) + bflo(w1.y) * bflo(w1.y) + bfhi(w1.y) * bfhi(w1.y) + bflo(w1.z) * bflo(w1.z) + bfhi(w1.z) * bfhi(w1.z) + bflo(w1.w) * bflo(w1.w) + bfhi(w1.w) * bfhi(w1.w);
                    q2 += xshf<16>(q2); { auto rr = __builtin_amdgcn_permlane32_swap(__float_as_uint(q2), __float_as_uint(q2), false, false); q2 = __uint_as_float(rr[0]) + __uint_as_float(rr[1]); }
                    kq = fmaxf(kq, q2); } }
            if (pn == 8 || pn == 9) {
                kq = fmaxf(kq, xshf<1>(kq)); kq = fmaxf(kq, xshf<2>(kq)); kq = fmaxf(kq, xshf<4>(kq)); kq = fmaxf(kq, xshf<8>(kq));
                if (fr == 0 && fq == 0) __hip_atomic_fetch_max(kmax + (lat ? (u.pm >> 6) : (u.pm - NLAT / 256)) * 8 + (pn - 8) * 4 + wc, __float_as_uint(kq), __ATOMIC_RELAXED, __HIP_MEMORY_SCOPE_AGENT); }
#undef RP_LOAD
        }
    }
};
struct EpiOutProj {
    static constexpr bool PERM = true;
    const float* xin_f32; const bf16_t* xin_bf; bf16_t* xout_bf; const float* xin_ctx; float* xout_ctx; const float* modl;
    __device__ __forceinline__ void operator()(const f32x4 (&acc)[2][2][4][2], const Unit& u, int wr, int wc, int fr, int fq) const {
        const bool lat = u.pm < (NLAT / 256); const int v = lat ? (u.pm >> 6) : 2;
        const float* g1 = modl + v * 12288 + 2 * DM;
        const int rloc = (lat ? u.pm : (u.pm - NLAT / 256)) * BM + wr * 64 + fr; const int col0 = u.pn * BM + wc * 32 + 8 * fq;
        f32x4 gv[2][2];
#pragma unroll
        for (int bj = 0; bj < 2; ++bj)
#pragma unroll
            for (int n = 0; n < 2; ++n) gv[bj][n] = *(const f32x4*)(g1 + col0 + bj * HALF + 4 * n);
        if (lat && xin_f32 == nullptr) {
#pragma unroll
            for (int ai = 0; ai < 2; ++ai) { u32x4 x[4][2];
#pragma unroll
                for (int m = 0; m < 4; ++m)
#pragma unroll
                    for (int bj = 0; bj < 2; ++bj) x[m][bj] = *(const u32x4*)(xin_bf + (size_t)(rloc + ai * HALF + m * 16) * DM + col0 + bj * HALF);
#pragma unroll
                for (int m = 0; m < 4; ++m)
#pragma unroll
                    for (int bj = 0; bj < 2; ++bj) { asm volatile("" : "+v"(x[m][bj])); const u32x4 w = x[m][bj];
                        const f32x4 x0 = (f32x4){bflo(w.x), bfhi(w.x), bflo(w.y), bfhi(w.y)}, x1 = (f32x4){bflo(w.z), bfhi(w.z), bflo(w.w), bfhi(w.w)};
                        *(u32x4*)(xout_bf + (size_t)(rloc + ai * HALF + m * 16) * DM + col0 + bj * HALF) = pack8(x0 + gv[bj][0] * acc[ai][bj][m][0], x1 + gv[bj][1] * acc[ai][bj][m][1]); }
            }
        } else {
            const float* xi = lat ? xin_f32 : xin_ctx;
#pragma unroll
            for (int ai = 0; ai < 2; ++ai) { f32x4 x[4][2][2];
#pragma unroll
                for (int m = 0; m < 4; ++m)
#pragma unroll
                    for (int bj = 0; bj < 2; ++bj)
#pragma unroll
                        for (int n = 0; n < 2; ++n) x[m][bj][n] = *(const f32x4*)(xi + (size_t)(rloc + ai * HALF + m * 16) * DM + col0 + bj * HALF + 4 * n);
#pragma unroll
                for (int m = 0; m < 4; ++m)
#pragma unroll
                    for (int bj = 0; bj < 2; ++bj) { asm volatile("" : "+v"(x[m][bj][0]), "+v"(x[m][bj][1]));
                        const f32x4 y0 = x[m][bj][0] + gv[bj][0] * acc[ai][bj][m][0], y1 = x[m][bj][1] + gv[bj][1] * acc[ai][bj][m][1]; const size_t off = (size_t)(rloc + ai * HALF + m * 16) * DM + col0 + bj * HALF;
                        if (lat) *(u32x4*)(xout_bf + off) = pack8(y0, y1); else { *(f32x4*)(xout_ctx + off) = y0; *(f32x4*)(xout_ctx + off + 4) = y1; } }
            }
        }
    }
};
struct EpiSwiGLU {
    static constexpr bool PERM = true;
    bf16_t* ACT;
    __device__ __forceinline__ void operator()(const f32x4 (&acc)[2][2][4][2], const Unit& u, int wr, int wc, int fr, int fq) const {
        const int pnl = u.pn & 7; const int row0 = u.pm * BM + wr * 64 + fr; const int col0 = pnl * 128 + wc * 32 + 8 * fq;
#pragma unroll
        for (int ai = 0; ai < 2; ++ai)
#pragma unroll
            for (int m = 0; m < 4; ++m) { f32x4 o[2];
#pragma unroll
                for (int n = 0; n < 2; ++n) { const f32x4 gt = acc[ai][0][m][n], up = acc[ai][1][m][n];
#pragma unroll
                    for (int j = 0; j < 4; ++j) o[n][j] = gt[j] * __builtin_amdgcn_rcpf(1.0f + __builtin_amdgcn_exp2f(-gt[j] * LOG2E)) * up[j]; }
                *(u32x4*)(ACT + (size_t)(row0 + ai * HALF + m * 16) * FF + col0) = pack8(o[0], o[1]); }
    }
};
struct EpiDown {
    static constexpr bool PERM = true;
    bf16_t* Y; const float* gatev;
    __device__ __forceinline__ void operator()(const f32x4 (&acc)[2][2][4][2], const Unit& u, int wr, int wc, int fr, int fq) const {
        const int pnl = u.pn & 7; const int row0 = u.pm * BM + wr * 64 + fr; const int col0 = pnl * 256 + wc * 32 + 8 * fq;
        float gs[2][4];
#pragma unroll
        for (int ai = 0; ai < 2; ++ai)
#pragma unroll
            for (int m = 0; m < 4; ++m) gs[ai][m] = gatev[row0 + ai * HALF + m * 16];
#pragma unroll
        for (int ai = 0; ai < 2; ++ai)
#pragma unroll
            for (int m = 0; m < 4; ++m) { asm volatile("" : "+v"(gs[ai][m]));
#pragma unroll
                for (int bj = 0; bj < 2; ++bj) *(u32x4*)(Y + (size_t)(row0 + ai * HALF + m * 16) * DM + col0 + bj * HALF) = pack8(acc[ai][bj][m][0] * gs[ai][m], acc[ai][bj][m][1] * gs[ai][m]); }
    }
};
}
namespace att {
constexpr int LDP = INW, LDOUT = DM, KVBLK = 64;
constexpr size_t SHM_V = KVBLK * 128 * 2, SHM_K = KVBLK * 128 * 2, SHM_ATTN = 2 * SHM_V + 2 * SHM_K + 8 * 64 * 4;
constexpr size_t QL_OFF = 73728, QL_STRIDE = 272;
constexpr size_t BIAS_OFF = SHM_ATTN;
constexpr float THR_L2 = 8.f * LOG2E;
#define KSWZ(row, colB) ((row) * 256 + ((colB) ^ (((row) & 7) << 4)))
#define SBAR() __builtin_amdgcn_sched_barrier(0)

struct Tiles { const bf16_t* kctx; const bf16_t* klat; long vdelta; int lat0, nt, nctx; };
struct MP {
    bool masked;
    int tq;
    int qr, rs, qc, cs;
    const LAS float* bias;
    float sink_l2;
    float lam, post;
    const float* normg;
};

__device__ __forceinline__ const bf16_t* tile_ptr(const Tiles& T, int j) { return (j < T.nctx) ? T.kctx + (long)j * KVBLK * LDP : T.klat + (long)(T.lat0 + j - T.nctx) * KVBLK * LDP; }

template <int MODE> __device__ __forceinline__ void apply_mask(f32x16& p0, f32x16& p1, int j, const Tiles& T, const MP& mp, int hi) {
  if constexpr (MODE == 1) return;
  if (!mp.masked || j < T.nctx) return;
  const int kt = T.lat0 + j - T.nctx;
  if constexpr (MODE == 2) {
    const int base = kt * KVBLK - mp.tq + 128;
#pragma unroll
    for (int r = 0; r < 16; ++r) { const int kk = crow(r, hi); if ((unsigned)(base + kk) > 256u) p0[r] = NEGBIG; if ((unsigned)(base + kk + 32) > 256u) p1[r] = NEGBIG; }
  }
  if constexpr (MODE == 0) {
    const bool rowok = (unsigned)(kt - mp.rs) < 8u; const LAS float* bp = mp.bias + ((kt - mp.qr + 7) * 31 + 15 - mp.qc + 4 * hi);
    const int t = rowok ? (4 * hi - mp.cs) : 0x40000000;
#pragma unroll
    for (int g = 0; g < 4; ++g) {
#pragma unroll
      for (int rr = 0; rr < 4; ++rr) { const int r = g * 4 + rr; const int c0 = (r & 3) + 8 * (r >> 2);
        const float b0 = bp[c0], b1 = bp[c0 + 32];
        p0[r] = ((unsigned)(t + c0) < 16u) ? p0[r] + b0 : NEGBIG; p1[r] = ((unsigned)(t + c0 + 32) < 16u) ? p1[r] + b1 : NEGBIG; }
      asm volatile("" ::: "memory");
    }
  }
}
template <int MODE> __device__ __forceinline__ void partialSM(f32x16& p0, f32x16& p1, float& m_reg, float& mn, float& alpha, int j, const Tiles& T, const MP& mp, int hi) {
  apply_mask<MODE>(p0, p1, j, T, mp, hi);
  float pmax = p0[0];
#pragma unroll
  for (int r = 1; r < 16; ++r) pmax = fmaxf(pmax, p0[r]);
#pragma unroll
  for (int r = 0; r < 16; ++r) pmax = fmaxf(pmax, p1[r]);
  { auto rr = __builtin_amdgcn_permlane32_swap(__float_as_uint(pmax), __float_as_uint(pmax), false, false);
    pmax = fmaxf(__uint_as_float(rr[0]), __uint_as_float(rr[1])); }
  if (__builtin_expect(__all(pmax - m_reg <= THR_L2), 1)) { mn = m_reg; alpha = 1.f; }
  else { mn = fmaxf(m_reg, pmax); alpha = __builtin_amdgcn_exp2f(m_reg - mn); m_reg = mn; }
#pragma unroll
  for (int r = 0; r < 16; ++r) p0[r] = p0[r] - mn;
#pragma unroll
  for (int r = 0; r < 16; ++r) p1[r] = p1[r] - mn;
#pragma unroll
  for (int r = 0; r < 16; ++r) p0[r] = __builtin_amdgcn_exp2f(p0[r]);
}
__device__ __forceinline__ void finishSM(f32x16& p0, f32x16& p1, float alpha, float& l_reg, bf16x8& pa0, bf16x8& pa1, bf16x8& pa2, bf16x8& pa3) {
#pragma unroll
  for (int r = 0; r < 16; ++r) p1[r] = __builtin_amdgcn_exp2f(p1[r]);
  float ps = 0;
#pragma unroll
  for (int r = 0; r < 16; ++r) ps += p0[r];
#pragma unroll
  for (int r = 0; r < 16; ++r) ps += p1[r];
  { auto rr = __builtin_amdgcn_permlane32_swap(__float_as_uint(ps), __float_as_uint(ps), false, false);
    ps = __uint_as_float(rr[0]) + __uint_as_float(rr[1]); }
  l_reg = l_reg * alpha + ps;
#define PK4(P, BASE, OUT) do { unsigned a0 = cvt_pk_bf16(P[BASE + 0], P[BASE + 1]), a1 = cvt_pk_bf16(P[BASE + 2], P[BASE + 3]);   \
    unsigned b0 = cvt_pk_bf16(P[BASE + 4], P[BASE + 5]), b1 = cvt_pk_bf16(P[BASE + 6], P[BASE + 7]);                              \
    auto r0 = __builtin_amdgcn_permlane32_swap(a0, b0, false, false); auto r1 = __builtin_amdgcn_permlane32_swap(a1, b1, false, false); \
    u32x4 w = {r0[0], r1[0], r0[1], r1[1]}; OUT = *reinterpret_cast<bf16x8*>(&w); } while (0)
  PK4(p0, 0, pa0); PK4(p0, 8, pa1); PK4(p1, 0, pa2); PK4(p1, 8, pa3);
#undef PK4
}
template <int NQ> __device__ __forceinline__ void qkt(f32x16& p0, f32x16& p1, const char* Ks, const bf16x8* qr, int r32, int hi, int cboff) {
  p0 = f32x16{}; p1 = f32x16{};
#pragma unroll
  for (int d0 = 0; d0 < NQ; ++d0) { const int cb = (d0 * 16 + hi * 8) * 2 + cboff;
    bf16x8 b0 = *reinterpret_cast<const bf16x8*>(Ks + KSWZ(r32, cb));
    bf16x8 b1 = *reinterpret_cast<const bf16x8*>(Ks + KSWZ(32 + r32, cb));
    p0 = __builtin_amdgcn_mfma_f32_32x32x16_bf16(b0, qr[d0], p0, 0, 0, 0);
    p1 = __builtin_amdgcn_mfma_f32_32x32x16_bf16(b1, qr[d0], p1, 0, 0, 0); }
}
__device__ __forceinline__ int v_st(int k, int c) { const int kk = (k & ~0xC) | ((k & 4) << 1) | ((k & 8) >> 1); return ((kk >> 3) * 4 + (c >> 5)) * 512 + ((kk & 7) * 32 + (c & 31)) * 2; }
__device__ __forceinline__ int v_rd_base(int lane) { return ((lane & 3) << 3) | (((lane >> 2) & 3) << 6) | (((lane >> 4) & 1) << 5) | (((lane >> 5) & 1) << 8); }
constexpr int v_rd_off(int d0, int ks, int half) { return d0 * 512 + ks * 4096 + half * 2048; }
template <int OFF> __device__ __forceinline__ s16x4 tr_read(int vb) {
  s16x4 r; asm volatile("ds_read_b64_tr_b16 %0, %1 offset:%2" : "=&v"(r) : "v"(vb), "i"(OFF) : "memory"); return r;
}
template <int D0> __device__ __forceinline__ void pv_one(f32x16& od, int vb, bf16x8 pa0, bf16x8 pa1, bf16x8 pa2, bf16x8 pa3) {
  const s16x4 l0 = tr_read<v_rd_off(D0, 0, 0)>(vb), h0 = tr_read<v_rd_off(D0, 0, 1)>(vb), l1 = tr_read<v_rd_off(D0, 1, 0)>(vb), h1 = tr_read<v_rd_off(D0, 1, 1)>(vb);
  const s16x4 l2 = tr_read<v_rd_off(D0, 2, 0)>(vb), h2 = tr_read<v_rd_off(D0, 2, 1)>(vb), l3 = tr_read<v_rd_off(D0, 3, 0)>(vb), h3 = tr_read<v_rd_off(D0, 3, 1)>(vb);
  asm volatile("s_waitcnt lgkmcnt(0)" ::: "memory"); SBAR();
#define PK(L, H) (bf16x8){L[0], L[1], L[2], L[3], H[0], H[1], H[2], H[3]}
  od = __builtin_amdgcn_mfma_f32_32x32x16_bf16(pa0, PK(l0, h0), od, 0, 0, 0);
  od = __builtin_amdgcn_mfma_f32_32x32x16_bf16(pa1, PK(l1, h1), od, 0, 0, 0);
  od = __builtin_amdgcn_mfma_f32_32x32x16_bf16(pa2, PK(l2, h2), od, 0, 0, 0);
  od = __builtin_amdgcn_mfma_f32_32x32x16_bf16(pa3, PK(l3, h3), od, 0, 0, 0);
#undef PK
}
__device__ __forceinline__ void pv_d0(f32x16* o, int vb, bf16x8 pa0, bf16x8 pa1, bf16x8 pa2, bf16x8 pa3) {
  pv_one<0>(o[0], vb, pa0, pa1, pa2, pa3); pv_one<1>(o[1], vb, pa0, pa1, pa2, pa3); pv_one<2>(o[2], vb, pa0, pa1, pa2, pa3); pv_one<3>(o[3], vb, pa0, pa1, pa2, pa3);
}

template <int MODE>
__device__ __forceinline__ void attn_unit_simple(const bf16_t* __restrict__ Qrow0, const Tiles T, bf16_t* __restrict__ Orow0, const MP mp, char* lds, const int tid) {
  const int wid = tid >> 6, lane = tid & 63, r32 = lane & 31, hi = lane >> 5;
  char* V_lds = lds; char* K_lds = lds + 2 * SHM_V;
  float* wsf = (float*)(lds + 2 * SHM_V + 2 * SHM_K) + wid * 64; float* li_l = wsf; float* al_l = wsf + 32;
  float m_reg = NEGBIG, l_reg = 0; f32x16 o[4] = {};
  const int sr = tid >> 4, sc = (tid & 15) * 8, vst0 = v_st(sr, sc), kst0 = KSWZ(sr, sc * 2);
  const int vb0 = (int)(uintptr_t)V_lds + v_rd_base(lane);
  const char* Qr = lds + QL_OFF + (wid * 32 + r32) * QL_STRIDE + hi * 16;
  bf16x8 vs0, vs1, ks0, ks1;
#define SLOAD1(j_) do { const bf16_t* kp_ = tile_ptr(T, (j_)) + (long)sr * LDP + sc; \
    vs0 = *reinterpret_cast<const bf16x8*>(kp_ + T.vdelta); vs1 = *reinterpret_cast<const bf16x8*>(kp_ + T.vdelta + 32L * LDP); \
    ks0 = *reinterpret_cast<const bf16x8*>(kp_); ks1 = *reinterpret_cast<const bf16x8*>(kp_ + 32L * LDP); } while (0)
#define SWRITE1(b) do { *(bf16x8*)(V_lds + (b) * SHM_V + vst0) = vs0; *(bf16x8*)(V_lds + (b) * SHM_V + vst0 + 8192) = vs1; \
    *(bf16x8*)(K_lds + (b) * SHM_K + kst0) = ks0; *(bf16x8*)(K_lds + (b) * SHM_K + kst0 + 8192) = ks1; } while (0)
  const int NT = T.nt;
  __syncthreads();
#pragma unroll
  for (int p = 0; p < 8; ++p) { const int idx = tid + 512 * p; *(bf16x8*)(lds + QL_OFF + (idx >> 4) * QL_STRIDE + (idx & 15) * 16) = *reinterpret_cast<const bf16x8*>(Qrow0 + (long)(idx >> 4) * LDP + (idx & 15) * 8); }
  SLOAD1(0); SWRITE1(0); __syncthreads();
  for (int j = 0; j < NT; ++j) {
    const int buf = j & 1;
    if (j + 1 < NT) SLOAD1(j + 1);
    bool live = true;
    if (mp.masked && j >= T.nctx) { const int kt = T.lat0 + j - T.nctx;
      if constexpr (MODE == 0) live = (unsigned)(kt - mp.rs) < 8u;
      if constexpr (MODE == 2) { const int q0w = __builtin_amdgcn_readfirstlane(mp.tq - r32); live = (kt * KVBLK + 63 >= q0w - 128) && (kt * KVBLK <= q0w + 31 + 128); } }
    if (live) {
    f32x16 p0, p1; float mn, al; bf16x8 pa0, pa1, pa2, pa3;
    { p0 = f32x16{}; p1 = f32x16{}; const char* Ks = K_lds + buf * SHM_K;
#pragma unroll
      for (int d0 = 0; d0 < 8; ++d0) { const int cb = (d0 * 16 + hi * 8) * 2; const bf16x8 q = *reinterpret_cast<const bf16x8*>(Qr + d0 * 32);
        const bf16x8 b0 = *reinterpret_cast<const bf16x8*>(Ks + KSWZ(r32, cb)), b1 = *reinterpret_cast<const bf16x8*>(Ks + KSWZ(32 + r32, cb));
        p0 = __builtin_amdgcn_mfma_f32_32x32x16_bf16(b0, q, p0, 0, 0, 0); p1 = __builtin_amdgcn_mfma_f32_32x32x16_bf16(b1, q, p1, 0, 0, 0); } }
    partialSM<MODE>(p0, p1, m_reg, mn, al, j, T, mp, hi);
    if (__any(al < 1.f)) { if (hi == 0) al_l[r32] = al; asm volatile("s_waitcnt lgkmcnt(0)" ::: "memory");
#pragma unroll
      for (int d = 0; d < 4; ++d)
#pragma unroll
        for (int r = 0; r < 16; ++r) o[d][r] *= al_l[crow(r, hi)]; }
    finishSM(p0, p1, al, l_reg, pa0, pa1, pa2, pa3);
    pv_d0(o, vb0 + buf * (int)SHM_V, pa0, pa1, pa2, pa3);
    }
    if (j + 1 < NT) SWRITE1(buf ^ 1);
    __syncthreads();
  }
  if constexpr (MODE == 2) l_reg += __builtin_amdgcn_exp2f(mp.sink_l2 - m_reg);
  if (hi == 0) li_l[r32] = l_reg; asm volatile("s_waitcnt lgkmcnt(0)" ::: "memory");
  bf16_t* Ow = Orow0 + (long)(wid * 32) * LDOUT;
#pragma unroll
  for (int r = 0; r < 16; ++r) { const int orow = crow(r, hi); const float rl = __builtin_amdgcn_rcpf(li_l[orow]);
#pragma unroll
    for (int d0 = 0; d0 < 4; ++d0) Ow[(long)orow * LDOUT + d0 * 32 + r32] = f2bf(o[d0][r] * rl); }
#undef SLOAD1
#undef SWRITE1
}
__device__ __forceinline__ void qktB(f32x16& p0, f32x16& p1, const char* Ks, const bf16x8* qr, int r32, int hi, int cboff, const f32x16& nb) {
  { const int cb = (hi * 8) * 2 + cboff;
    bf16x8 b0 = *reinterpret_cast<const bf16x8*>(Ks + KSWZ(r32, cb)), b1 = *reinterpret_cast<const bf16x8*>(Ks + KSWZ(32 + r32, cb));
    p0 = __builtin_amdgcn_mfma_f32_32x32x16_bf16(b0, qr[0], nb, 0, 0, 0); p1 = __builtin_amdgcn_mfma_f32_32x32x16_bf16(b1, qr[0], nb, 0, 0, 0); }
#pragma unroll
  for (int d0 = 1; d0 < 4; ++d0) { const int cb = (d0 * 16 + hi * 8) * 2 + cboff;
    bf16x8 b0 = *reinterpret_cast<const bf16x8*>(Ks + KSWZ(r32, cb)), b1 = *reinterpret_cast<const bf16x8*>(Ks + KSWZ(32 + r32, cb));
    p0 = __builtin_amdgcn_mfma_f32_32x32x16_bf16(b0, qr[d0], p0, 0, 0, 0); p1 = __builtin_amdgcn_mfma_f32_32x32x16_bf16(b1, qr[d0], p1, 0, 0, 0); }
}
__device__ __forceinline__ void expA(f32x16& p0) {
#pragma unroll
  for (int r = 0; r < 16; ++r) p0[r] = __builtin_amdgcn_exp2f(p0[r]);
}
__device__ __forceinline__ void finishB(f32x16& p0, f32x16& p1, float& l_reg, bf16x8& pa0, bf16x8& pa1, bf16x8& pa2, bf16x8& pa3) {
#pragma unroll
  for (int r = 0; r < 16; ++r) p1[r] = __builtin_amdgcn_exp2f(p1[r]);
  float ps = 0;
#pragma unroll
  for (int r = 0; r < 16; ++r) ps += p0[r];
#pragma unroll
  for (int r = 0; r < 16; ++r) ps += p1[r];
  l_reg += ps;
#define PK4(P, BASE, OUT) do { unsigned a0 = cvt_pk_bf16(P[BASE + 0], P[BASE + 1]), a1 = cvt_pk_bf16(P[BASE + 2], P[BASE + 3]);   \
    unsigned b0 = cvt_pk_bf16(P[BASE + 4], P[BASE + 5]), b1 = cvt_pk_bf16(P[BASE + 6], P[BASE + 7]);                              \
    auto r0 = __builtin_amdgcn_permlane32_swap(a0, b0, false, false); auto r1 = __builtin_amdgcn_permlane32_swap(a1, b1, false, false); \
    u32x4 w = {r0[0], r1[0], r0[1], r1[1]}; OUT = *reinterpret_cast<bf16x8*>(&w); } while (0)
  PK4(p0, 0, pa0); PK4(p0, 8, pa1); PK4(p1, 0, pa2); PK4(p1, 8, pa3);
#undef PK4
}

typedef short v4i16_t __attribute__((ext_vector_type(4)));
__device__ __forceinline__ s16x4 vtr(int addr) { return __builtin_bit_cast(s16x4, __builtin_amdgcn_ds_read_tr16_b64_v4i16((LAS v4i16_t*)(uintptr_t)(unsigned)addr)); }
template <int D0> __device__ __forceinline__ void pv_one_v(f32x16& od, int vb, bf16x8 pa0, bf16x8 pa1, bf16x8 pa2, bf16x8 pa3) {
  const s16x4 l0 = vtr(vb + v_rd_off(D0, 0, 0)), h0 = vtr(vb + v_rd_off(D0, 0, 1)), l1 = vtr(vb + v_rd_off(D0, 1, 0)), h1 = vtr(vb + v_rd_off(D0, 1, 1));
  const s16x4 l2 = vtr(vb + v_rd_off(D0, 2, 0)), h2 = vtr(vb + v_rd_off(D0, 2, 1)), l3 = vtr(vb + v_rd_off(D0, 3, 0)), h3 = vtr(vb + v_rd_off(D0, 3, 1));
#define PK(L, H) (bf16x8){L[0], L[1], L[2], L[3], H[0], H[1], H[2], H[3]}
  od = __builtin_amdgcn_mfma_f32_32x32x16_bf16(pa0, PK(l0, h0), od, 0, 0, 0);
  od = __builtin_amdgcn_mfma_f32_32x32x16_bf16(pa1, PK(l1, h1), od, 0, 0, 0);
  od = __builtin_amdgcn_mfma_f32_32x32x16_bf16(pa2, PK(l2, h2), od, 0, 0, 0);
  od = __builtin_amdgcn_mfma_f32_32x32x16_bf16(pa3, PK(l3, h3), od, 0, 0, 0);
#undef PK
}
__device__ __forceinline__ void pv_d0_v(f32x16* o, int vb, bf16x8 pa0, bf16x8 pa1, bf16x8 pa2, bf16x8 pa3) {
  pv_one_v<0>(o[0], vb, pa0, pa1, pa2, pa3); pv_one_v<1>(o[1], vb, pa0, pa1, pa2, pa3); pv_one_v<2>(o[2], vb, pa0, pa1, pa2, pa3); pv_one_v<3>(o[3], vb, pa0, pa1, pa2, pa3);
}
__device__ __forceinline__ void glds16(const void* g, unsigned lds_base) {
    unsigned sv; asm volatile("s_mov_b32 %0, m0\n\ts_mov_b32 m0, %2\n\ts_nop 0\n\tglobal_load_lds_dwordx4 %1, off\n\ts_mov_b32 m0, %0" : "=&s"(sv) : "v"(g), "s"(lds_base) : "memory"); }
__device__ __forceinline__ void glds16s(const void* gbase, unsigned voff, unsigned lds_base) {
    unsigned sv; asm volatile("s_mov_b32 %0, m0\n\ts_mov_b32 m0, %3\n\ts_nop 0\n\tglobal_load_lds_dwordx4 %1, %2\n\ts_mov_b32 m0, %0" : "=&s"(sv) : "v"(voff), "s"(gbase), "s"(lds_base) : "memory"); }
__device__ __forceinline__ int v_st_u(int k, int c) { return ((k >> 3) * 4 + (c >> 5)) * 512 + ((k & 7) * 32 + (c & 31)) * 2; }
__device__ __forceinline__ void attn_unit_a2(const bf16_t* __restrict__ Qrow0, const Tiles T, bf16_t* __restrict__ Orow0, const bool masked, const LAS float* bias, const int qr0, char* lds, const int tid) {
  const int wid = __builtin_amdgcn_readfirstlane(tid >> 6), lane = tid & 63, r32 = lane & 31, hi = lane >> 5;
  char* V_lds = lds; char* K_lds = lds + 2 * SHM_V;
  float* wsf = (float*)(lds + 2 * SHM_V + 2 * SHM_K) + wid * 64; float* li_l = wsf; float* al_l = wsf + 32;
  const int rp = wid >> 2, cbk = wid & 3;
  const int qloc = (2 * rp + (r32 >> 4)) * 64 + 16 * cbk + (r32 & 15);
  const int qr = qr0 + 2 * rp + (r32 >> 4), qc = 16 * cbk + (r32 & 15);
  const int rs = qr - 4 < 0 ? 0 : (qr - 4 > 248 ? 248 : qr - 4), cs = qc - 8 < 0 ? 0 : (qc - 8 > 48 ? 48 : qc - 8);
  const int kb = 16 * cbk - 8 < 0 ? 0 : (16 * cbk - 8 > 32 ? 32 : 16 * cbk - 8);
  const int rsa = (qr0 + 2 * rp - 4) < 0 ? 0 : ((qr0 + 2 * rp - 4) > 248 ? 248 : (qr0 + 2 * rp - 4)), rsb = (qr0 + 2 * rp - 3) < 0 ? 0 : ((qr0 + 2 * rp - 3) > 248 ? 248 : (qr0 + 2 * rp - 3));
  float m_reg = NEGBIG, l_reg = 0; f32x16 o[4] = {};
  const int sr = tid >> 4, sc = (tid & 15) * 8, vst0 = v_st_u(sr, sc), kst0 = KSWZ(sr, sc * 2);
  const int vb0 = (int)(uintptr_t)V_lds + v_rd_base(lane);
  const char* Qr = lds + QL_OFF + qloc * QL_STRIDE + hi * 16;
  bf16x8 vs0, vs1, ks0, ks1;
#define SLOAD1(j_) do { const bf16_t* kp_ = tile_ptr(T, (j_)) + (long)sr * LDP + sc; \
    vs0 = *reinterpret_cast<const bf16x8*>(kp_ + T.vdelta); vs1 = *reinterpret_cast<const bf16x8*>(kp_ + T.vdelta + 32L * LDP); \
    ks0 = *reinterpret_cast<const bf16x8*>(kp_); ks1 = *reinterpret_cast<const bf16x8*>(kp_ + 32L * LDP); } while (0)
#define SWRITE1(b) do { *(bf16x8*)(V_lds + (b) * SHM_V + vst0) = vs0; *(bf16x8*)(V_lds + (b) * SHM_V + vst0 + 8192) = vs1; \
    *(bf16x8*)(K_lds + (b) * SHM_K + kst0) = ks0; *(bf16x8*)(K_lds + (b) * SHM_K + kst0 + 8192) = ks1; } while (0)
  const int NT = T.nt;
  __syncthreads();
#pragma unroll
  for (int p = 0; p < 8; ++p) { const int idx = tid + 512 * p; *(bf16x8*)(lds + QL_OFF + (idx >> 4) * QL_STRIDE + (idx & 15) * 16) = *reinterpret_cast<const bf16x8*>(Qrow0 + (long)(idx >> 4) * LDP + (idx & 15) * 8); }
  SLOAD1(0); SWRITE1(0); __syncthreads();
  for (int j = 0; j < NT; ++j) {
    const int buf = j & 1;
    if (j + 1 < NT) SLOAD1(j + 1);
    const bool ctxt = j < T.nctx; const int kr = T.lat0 + j - T.nctx;
    const bool live = ctxt || !masked || ((unsigned)(kr - rsa) < 8u) || ((unsigned)(kr - rsb) < 8u);
    if (live) {
      const int nblk = (ctxt || !masked) ? 2 : 1;
      for (int blk = 0; blk < nblk; ++blk) {
        const int kbb = (ctxt || !masked) ? 32 * blk : kb;
        f32x16 p = {}; const char* Ks = K_lds + buf * SHM_K;
#pragma unroll
        for (int d0 = 0; d0 < 8; ++d0) { const int cb = (d0 * 16 + hi * 8) * 2; const bf16x8 q = *reinterpret_cast<const bf16x8*>(Qr + d0 * 32);
          const bf16x8 b0 = *reinterpret_cast<const bf16x8*>(Ks + KSWZ(kbb + r32, cb)); p = __builtin_amdgcn_mfma_f32_32x32x16_bf16(b0, q, p, 0, 0, 0); }
        if (masked && !ctxt) {
          const bool rowok = (unsigned)(kr - rs) < 8u; const LAS float* bp = bias + ((kr - qr + 7) * 31 + 15 - qc + kbb + 4 * hi);
          const int t = rowok ? (kbb + 4 * hi - cs) : 0x40000000;
#pragma unroll
          for (int r = 0; r < 16; ++r) { const int c0 = (r & 3) + 8 * (r >> 2); const float bv = bp[c0]; p[r] = ((unsigned)(t + c0) < 16u) ? p[r] + bv : NEGBIG; }
        }
        float pmax = p[0];
#pragma unroll
        for (int r = 1; r < 16; ++r) pmax = fmaxf(pmax, p[r]);
        { auto rr = __builtin_amdgcn_permlane32_swap(__float_as_uint(pmax), __float_as_uint(pmax), false, false); pmax = fmaxf(__uint_as_float(rr[0]), __uint_as_float(rr[1])); }
        float mn, al;
        if (__builtin_expect(__all(pmax - m_reg <= THR_L2), 1)) { mn = m_reg; al = 1.f; } else { mn = fmaxf(m_reg, pmax); al = __builtin_amdgcn_exp2f(m_reg - mn); m_reg = mn; }
        float ps = 0.f;
#pragma unroll
        for (int r = 0; r < 16; ++r) { p[r] = __builtin_amdgcn_exp2f(p[r] - mn); ps += p[r]; }
        { auto rr = __builtin_amdgcn_permlane32_swap(__float_as_uint(ps), __float_as_uint(ps), false, false); ps = __uint_as_float(rr[0]) + __uint_as_float(rr[1]); }
        l_reg = l_reg * al + ps;
        if (__any(al < 1.f)) { if (hi == 0) al_l[r32] = al; asm volatile("s_waitcnt lgkmcnt(0)" ::: "memory");
#pragma unroll
          for (int d = 0; d < 4; ++d)
#pragma unroll
            for (int r = 0; r < 16; ++r) o[d][r] *= al_l[crow(r, hi)]; }
        u32x4 w0 = {cvt_pk_bf16(p[0], p[1]), cvt_pk_bf16(p[2], p[3]), cvt_pk_bf16(p[4], p[5]), cvt_pk_bf16(p[6], p[7])}, w1 = {cvt_pk_bf16(p[8], p[9]), cvt_pk_bf16(p[10], p[11]), cvt_pk_bf16(p[12], p[13]), cvt_pk_bf16(p[14], p[15])};
        const bf16x8 pa0 = *reinterpret_cast<bf16x8*>(&w0), pa1 = *reinterpret_cast<bf16x8*>(&w1);
        const int vb = vb0 + buf * (int)SHM_V + (kbb >> 3) * 2048;
#pragma unroll
        for (int d0 = 0; d0 < 4; ++d0) { const s16x4 l0 = vtr(vb + d0 * 512), h0 = vtr(vb + d0 * 512 + 2048), l1 = vtr(vb + d0 * 512 + 4096), h1 = vtr(vb + d0 * 512 + 6144);
          o[d0] = __builtin_amdgcn_mfma_f32_32x32x16_bf16(pa0, (bf16x8){l0[0], l0[1], l0[2], l0[3], h0[0], h0[1], h0[2], h0[3]}, o[d0], 0, 0, 0);
          o[d0] = __builtin_amdgcn_mfma_f32_32x32x16_bf16(pa1, (bf16x8){l1[0], l1[1], l1[2], l1[3], h1[0], h1[1], h1[2], h1[3]}, o[d0], 0, 0, 0); }
      }
    }
    if (j + 1 < NT) SWRITE1(buf ^ 1);
    __syncthreads();
  }
  if (hi == 0) li_l[r32] = l_reg; asm volatile("s_waitcnt lgkmcnt(0)" ::: "memory");
#pragma unroll
  for (int r = 0; r < 16; ++r) { const int i = crow(r, hi); const float rl = __builtin_amdgcn_rcpf(li_l[i]);
    bf16_t* Ow = Orow0 + (long)((2 * rp + (i >> 4)) * 64 + 16 * cbk + (i & 15)) * LDOUT;
#pragma unroll
    for (int d0 = 0; d0 < 4; ++d0) Ow[d0 * 32 + r32] = f2bf(o[d0][r] * rl); }
#undef SLOAD1
#undef SWRITE1
}

#define B3_MF(a, b, c) __builtin_amdgcn_mfma_f32_32x32x16_bf16(a, b, c, 0, 0, 0)
#define B3_PIN(x) asm volatile("" : "+v"(x))
#define B3_WAITBAR(N) asm volatile("s_waitcnt vmcnt(" #N ") lgkmcnt(0)\n\ts_barrier" ::: "memory")
struct TilesB3 { const bf16_t* kctx; const bf16_t* klat; long vdelta; int nt; };
__device__ __forceinline__ void attn_unit_b3(const bf16_t* __restrict__ Qrow0, const TilesB3 T, bf16_t* __restrict__ Orow0, const MP mp, const unsigned* __restrict__ kmax2, char* lds, const int tid) {
  const int wid = __builtin_amdgcn_readfirstlane(tid >> 6), lane = tid & 63, r32 = lane & 31, hi = lane >> 5;
  constexpr int KRING = 0, VRING = 65536, WSF = 131072, SLOT = 16384;
  float* li_l = (float*)(lds + WSF) + wid * 64;
  float l_reg = 0; f32x16 o[4] = {}; bf16x8 qr[4];
  const int qrow = (wid & 3) * 32 + r32, map = wid >> 2, mapoff = map * 64;
  const bf16_t* Qw = Qrow0 + (long)qrow * LDP + mapoff + hi * 8;
#pragma unroll
  for (int d0 = 0; d0 < 4; ++d0) qr[d0] = *reinterpret_cast<const bf16x8*>(Qw + d0 * 16);
  f32x16 nb;
  { float q2 = 0.f;
#pragma unroll
    for (int d0 = 0; d0 < 4; ++d0) { const u32x4 w = *reinterpret_cast<const u32x4*>(&qr[d0]);
      q2 += bflo(w.x) * bflo(w.x) + bfhi(w.x) * bfhi(w.x) + bflo(w.y) * bflo(w.y) + bfhi(w.y) * bfhi(w.y) + bflo(w.z) * bflo(w.z) + bfhi(w.z) * bfhi(w.z) + bflo(w.w) * bflo(w.w) + bfhi(w.w) * bfhi(w.w); }
    { auto rr = __builtin_amdgcn_permlane32_swap(__float_as_uint(q2), __float_as_uint(q2), false, false); q2 = __uint_as_float(rr[0]) + __uint_as_float(rr[1]); }
    const float negb = -sqrtf(q2 * __uint_as_float(kmax2[map])) * 1.0001f;
#pragma unroll
    for (int r = 0; r < 16; ++r) nb[r] = negb; }
  B3_PIN(nb);
  const int rowk = 4 * wid + (lane >> 4); const unsigned koff = (unsigned)(rowk * LDP + (((lane & 15) ^ (rowk & 7)) * 8)) * 2u;
  const int sub0 = 2 * wid + (lane >> 5), key0 = (sub0 >> 2) * 8 + ((lane & 31) >> 2);
  const unsigned voff = (unsigned)(key0 * LDP + (sub0 & 3) * 32 + (lane & 3) * 8) * 2u + (unsigned)(T.vdelta * 2);
  const unsigned lds0 = (unsigned)(uintptr_t)lds; const unsigned kdst = lds0 + KRING + (unsigned)wid * 1024u, vdst = lds0 + VRING + (unsigned)wid * 1024u;
#define B3_TPTR(j_) ((const char*)(((j_) < 4) ? T.kctx + (long)(j_) * 64 * LDP : T.klat + (long)((j_) - 4) * 64 * LDP))
#define B3_DMAK(j_, sl_) do { const char* sp_ = B3_TPTR(j_); glds16s(sp_, koff, (unsigned)__builtin_amdgcn_readfirstlane(kdst + (sl_))); glds16s(sp_ + (size_t)32 * LDP * 2, koff, (unsigned)__builtin_amdgcn_readfirstlane(kdst + (sl_) + 8192)); } while (0)
#define B3_DMAV(j_, sl_) do { const char* sp_ = B3_TPTR(j_); glds16s(sp_, voff, (unsigned)__builtin_amdgcn_readfirstlane(vdst + (sl_))); glds16s(sp_ + (size_t)32 * LDP * 2, voff, (unsigned)__builtin_amdgcn_readfirstlane(vdst + (sl_) + 8192)); } while (0)
  int kro[4];
#pragma unroll
  for (int d0 = 0; d0 < 4; ++d0) kro[d0] = r32 * 256 + (((d0 * 16 + hi * 8) * 2 + mapoff * 2) ^ ((r32 & 7) << 4));
  const LAS char* kring = (const LAS char*)(uintptr_t)(lds0 + KRING);
  const int vbase = (int)lds0 + VRING + v_rd_base(lane);
#define B3_KF(kp_, n_, d0_) (*(const LAS bf16x8*)((kp_) + kro[d0_] + (n_) * 8192))
#define B3_VF(dst_, vp_, g_) do { const s16x4 lo_ = vtr((vp_) + v_rd_off((g_) & 3, (g_) >> 2, 0)), hi_ = vtr((vp_) + v_rd_off((g_) & 3, (g_) >> 2, 1)); dst_ = (bf16x8){lo_[0], lo_[1], lo_[2], lo_[3], hi_[0], hi_[1], hi_[2], hi_[3]}; } while (0)
  const int NT = T.nt;
#define B3_SL(j_) (((j_) & 3) * SLOT)
  f32x16 pA0, pA1, pB0, pB1; bf16x8 pa0, pa1, pa2, pa3;
  __syncthreads();
  B3_DMAK(0, B3_SL(0)); B3_DMAV(0, B3_SL(0)); B3_DMAK(1, B3_SL(1)); B3_DMAK(2, B3_SL(2)); B3_DMAV(1, B3_SL(1));
  B3_WAITBAR(8);
  { const LAS char* kp = kring + B3_SL(0); bf16x8 kf[8];
#pragma unroll
    for (int d0 = 0; d0 < 4; ++d0) { kf[2 * d0] = B3_KF(kp, 0, d0); kf[2 * d0 + 1] = B3_KF(kp, 1, d0); }
    pA0 = B3_MF(kf[0], qr[0], nb); pA1 = B3_MF(kf[1], qr[0], nb); pA0 = B3_MF(kf[2], qr[1], pA0); pA1 = B3_MF(kf[3], qr[1], pA1);
    pA0 = B3_MF(kf[4], qr[2], pA0); pA1 = B3_MF(kf[5], qr[2], pA1); pA0 = B3_MF(kf[6], qr[3], pA0); pA1 = B3_MF(kf[7], qr[3], pA1);
#pragma unroll
    for (int r = 0; r < 16; ++r) { pA0[r] = __builtin_amdgcn_exp2f(pA0[r]); pA1[r] = __builtin_amdgcn_exp2f(pA1[r]); l_reg += pA0[r] + pA1[r]; } }
  B3_WAITBAR(0);
#define B3_GA(MFS, P, i_, CA, CB) do { MFS; CA = cvt_pk_bf16(P[i_], P[(i_) + 1]); CB = cvt_pk_bf16(P[(i_) + 2], P[(i_) + 3]); } while (0)
#define B3_SW(OUT, c0_, c1_, c2_, c3_) do { u32x4 w_ = {c0_, c1_, c2_, c3_}; OUT = *reinterpret_cast<bf16x8*>(&w_); B3_PIN(OUT); } while (0)
#define B3_GB(MFS, X, i_) do { MFS; X[i_] = __builtin_amdgcn_exp2f(X[i_]); X[(i_) + 1] = __builtin_amdgcn_exp2f(X[(i_) + 1]); sacc += X[i_]; sacc += X[(i_) + 1]; B3_PIN(X); B3_PIN(sacc); SBAR(); } while (0)
#define B3_STEP(C0, C1, P0, P1, t_) do { SBAR(); \
    const LAS char* kp_ = kring + B3_SL(t_); const int vp_ = vbase + B3_SL((t_) - 1); bf16x8 kf[8], vf[8]; unsigned c0_, c1_, c2_, c3_; float sacc = 0.f; \
    _Pragma("unroll") for (int d0 = 0; d0 < 4; ++d0) { kf[2 * d0] = B3_KF(kp_, 0, d0); kf[2 * d0 + 1] = B3_KF(kp_, 1, d0); } SBAR(); \
    B3_GA(C0 = B3_MF(kf[0], qr[0], nb), P0, 0, c0_, c1_); SBAR(); \
    B3_GA(C1 = B3_MF(kf[1], qr[0], nb), P0, 4, c2_, c3_); B3_SW(pa0, c0_, c1_, c2_, c3_); SBAR(); \
    B3_GA(C0 = B3_MF(kf[2], qr[1], C0), P0, 8, c0_, c1_); SBAR(); \
    B3_GA(C1 = B3_MF(kf[3], qr[1], C1), P0, 12, c2_, c3_); B3_SW(pa1, c0_, c1_, c2_, c3_); SBAR(); \
    B3_VF(vf[0], vp_, 0); B3_GA(C0 = B3_MF(kf[4], qr[2], C0), P1, 0, c0_, c1_); SBAR(); \
    B3_VF(vf[1], vp_, 1); B3_GA(C1 = B3_MF(kf[5], qr[2], C1), P1, 4, c2_, c3_); B3_SW(pa2, c0_, c1_, c2_, c3_); SBAR(); \
    B3_VF(vf[2], vp_, 2); B3_GA(C0 = B3_MF(kf[6], qr[3], C0), P1, 8, c0_, c1_); SBAR(); \
    B3_VF(vf[3], vp_, 3); B3_GA(C1 = B3_MF(kf[7], qr[3], C1), P1, 12, c2_, c3_); B3_SW(pa3, c0_, c1_, c2_, c3_); SBAR(); \
    B3_VF(vf[4], vp_, 4);  B3_GB(o[0] = B3_MF(pa0, vf[0], o[0]), C0, 0); \
    B3_VF(vf[5], vp_, 5);  B3_GB(o[1] = B3_MF(pa0, vf[1], o[1]), C0, 2); \
    B3_VF(vf[6], vp_, 6);  B3_GB(o[2] = B3_MF(pa0, vf[2], o[2]), C0, 4); \
    B3_VF(vf[7], vp_, 7);  B3_GB(o[3] = B3_MF(pa0, vf[3], o[3]), C0, 6); \
    B3_VF(vf[0], vp_, 8);  B3_GB(o[0] = B3_MF(pa1, vf[4], o[0]), C0, 8); \
    B3_VF(vf[1], vp_, 9);  B3_GB(o[1] = B3_MF(pa1, vf[5], o[1]), C0, 10); \
    B3_VF(vf[2], vp_, 10); B3_GB(o[2] = B3_MF(pa1, vf[6], o[2]), C0, 12); \
    B3_VF(vf[3], vp_, 11); B3_GB(o[3] = B3_MF(pa1, vf[7], o[3]), C0, 14); \
    B3_VF(vf[4], vp_, 12); B3_GB(o[0] = B3_MF(pa2, vf[0], o[0]), C1, 0); \
    B3_VF(vf[5], vp_, 13); B3_GB(o[1] = B3_MF(pa2, vf[1], o[1]), C1, 2); \
    B3_VF(vf[6], vp_, 14); B3_GB(o[2] = B3_MF(pa2, vf[2], o[2]), C1, 4); \
    B3_VF(vf[7], vp_, 15); B3_GB(o[3] = B3_MF(pa2, vf[3], o[3]), C1, 6); \
    B3_GB(o[0] = B3_MF(pa3, vf[4], o[0]), C1, 8); \
    B3_GB(o[1] = B3_MF(pa3, vf[5], o[1]), C1, 10); \
    B3_GB(o[2] = B3_MF(pa3, vf[6], o[2]), C1, 12); \
    B3_GB(o[3] = B3_MF(pa3, vf[7], o[3]), C1, 14); \
    l_reg += sacc; } while (0)
  int t = 1;
  asm volatile(".p2align 8");
  for (; t + 3 < NT; t += 2) {
    B3_DMAK(t + 2, B3_SL(t + 2)); B3_DMAK(t + 3, B3_SL(t + 3)); B3_DMAV(t + 1, B3_SL(t + 1)); B3_DMAV(t + 2, B3_SL(t + 2));
    B3_STEP(pB0, pB1, pA0, pA1, t); B3_STEP(pA0, pA1, pB0, pB1, t + 1);
    B3_WAITBAR(0);
  }
  B3_DMAK(t + 2, B3_SL(t + 2)); B3_DMAV(t + 1, B3_SL(t + 1)); B3_DMAV(t + 2, B3_SL(t + 2));
  B3_STEP(pB0, pB1, pA0, pA1, t); B3_STEP(pA0, pA1, pB0, pB1, t + 1);
  B3_WAITBAR(0);
  B3_STEP(pB0, pB1, pA0, pA1, t + 2);
  { unsigned c[16];
#pragma unroll
    for (int i = 0; i < 8; ++i) { c[i] = cvt_pk_bf16(pB0[2 * i], pB0[2 * i + 1]); c[8 + i] = cvt_pk_bf16(pB1[2 * i], pB1[2 * i + 1]); }
    B3_SW(pa0, c[0], c[1], c[2], c[3]); B3_SW(pa1, c[4], c[5], c[6], c[7]); B3_SW(pa2, c[8], c[9], c[10], c[11]); B3_SW(pa3, c[12], c[13], c[14], c[15]);
    pv_d0_v(o, vbase + B3_SL(NT - 1), pa0, pa1, pa2, pa3); }
#undef B3_STEP
#undef B3_GA
#undef B3_GB
#undef B3_SW
  { auto rr = __builtin_amdgcn_permlane32_swap(__float_as_uint(l_reg), __float_as_uint(l_reg), false, false); l_reg = __uint_as_float(rr[0]) + __uint_as_float(rr[1]); }
  if (hi == 0) li_l[r32] = l_reg; asm volatile("s_waitcnt lgkmcnt(0)" ::: "memory");
#pragma unroll
  for (int r = 0; r < 16; ++r) { const float rl = __builtin_amdgcn_rcpf(li_l[crow(r, hi)]);
#pragma unroll
    for (int d0 = 0; d0 < 4; ++d0) o[d0][r] *= rl; }
  __syncthreads();
  float* X = (float*)lds + (size_t)(wid & 3) * 32 * 128;
  if (wid >= 4) {
#pragma unroll
    for (int d0 = 0; d0 < 4; ++d0)
#pragma unroll
      for (int r = 0; r < 16; ++r) X[crow(r, hi) * 128 + d0 * 32 + r32] = o[d0][r];
  }
  __syncthreads();
  if (wid < 4) {
    float ss[16];
#pragma unroll
    for (int r = 0; r < 16; ++r) { float s = 0.f;
#pragma unroll
      for (int d0 = 0; d0 < 4; ++d0) { const float v = o[d0][r] - mp.lam * X[crow(r, hi) * 128 + d0 * 32 + r32]; o[d0][r] = v; s += v * v; }
      ss[r] = s; }
#pragma unroll
    for (int r = 0; r < 16; ++r) ss[r] = rsqrtf(sum32(ss[r]) * (1.0f / 128.0f) + 1e-6f) * mp.post;
    float gcol[4];
#pragma unroll
    for (int d0 = 0; d0 < 4; ++d0) gcol[d0] = mp.normg[d0 * 32 + r32];
    bf16_t* Ow = Orow0 + (long)(wid * 32) * LDOUT;
#pragma unroll
    for (int r = 0; r < 16; ++r) { const int orow = crow(r, hi);
#pragma unroll
      for (int d0 = 0; d0 < 4; ++d0) Ow[(long)orow * LDOUT + d0 * 32 + r32] = f2bf(o[d0][r] * ss[r] * gcol[d0]); }
  }
}
}
struct Args { const float* in[23]; float* out; unsigned char* ws; int ph_lo, ph_hi; };
typedef const Args __attribute__((address_space(4)))* KArgs;
struct Ctx {
    KArgs ka; LAS unsigned char* lds; char* ldsg; int tid, lane, wave, G, wg;
    __device__ __forceinline__ const float* in(int k) const { return ka->in[k]; }
    __device__ __forceinline__ float* out() const { return ka->out; }
    __device__ __forceinline__ unsigned char* ws() const { return ka->ws; }
    __device__ __forceinline__ float* modp() const { return (float*)(ws() + WS_MODP); }
    __device__ __forceinline__ float* mod() const { return (float*)(ws() + WS_MOD); }
    __device__ __forceinline__ float* misc() const { return (float*)(ws() + WS_MISC); }
    __device__ __forceinline__ float* rope() const { return (float*)(ws() + WS_ROPE); }
    __device__ __forceinline__ float* xc() const { return (float*)(ws() + WS_XC); }
    __device__ __forceinline__ bf16_t* xb() const { return (bf16_t*)(ws() + WS_XB); }
    __device__ __forceinline__ float* aff() const { return (float*)(ws() + WS_AFF); }
    __device__ __forceinline__ int* rowidx() const { return (int*)(ws() + WS_ROWIDX); }
    __device__ __forceinline__ float* gatev() const { return (float*)(ws() + WS_GATEV); }
    __device__ __forceinline__ int* slot() const { return (int*)(ws() + WS_SLOT); }
    __device__ __forceinline__ bf16_t* H() const { return (bf16_t*)(ws() + WS_H); }
    __device__ __forceinline__ bf16_t* P() const { return (bf16_t*)(ws() + WS_P); }
    __device__ __forceinline__ bf16_t* O() const { return (bf16_t*)(ws() + WS_O); }
    __device__ __forceinline__ bf16_t* S() const { return (bf16_t*)(ws() + WS_S); }
    __device__ __forceinline__ bf16_t* U() const { return (bf16_t*)(ws() + WS_H); }
    __device__ __forceinline__ bf16_t* ACT() const { return (bf16_t*)(ws() + WS_P + ACT_OFF); }
    __device__ __forceinline__ bf16_t* Y() const { return (bf16_t*)(ws() + WS_P + Y_OFF); }
    __device__ __forceinline__ bf16_t* w_in_t(int l) const { return (bf16_t*)(ws() + WS_W + (size_t)l * WL_BYTES + WL_IN); }
    __device__ __forceinline__ bf16_t* w_out_t(int l) const { return (bf16_t*)(ws() + WS_W + (size_t)l * WL_BYTES + WL_OUT); }
    __device__ __forceinline__ bf16_t* w_gu_t(int l) const { return (bf16_t*)(ws() + WS_W + (size_t)l * WL_BYTES + WL_GU); }
    __device__ __forceinline__ bf16_t* w_dn_t(int l) const { return (bf16_t*)(ws() + WS_W + (size_t)l * WL_BYTES + WL_DN); }
};
__device__ __forceinline__ int hw_lane() { int l; asm volatile("v_mbcnt_lo_u32_b32 %0, -1, 0\n\tv_mbcnt_hi_u32_b32 %0, -1, %0" : "=v"(l)); return l; }
__device__ __forceinline__ Ctx make_ctx(unsigned char* lds_raw, int wave_s) {
    Ctx F; KArgs p = (KArgs)__builtin_amdgcn_kernarg_segment_ptr(); asm volatile("" : "+s"(p));
    F.ka = p; F.lds = (LAS unsigned char*)lds_raw; F.ldsg = (char*)lds_raw;
    F.lane = hw_lane(); F.wave = wave_s; F.tid = wave_s * 64 + F.lane; F.G = gridDim.x; F.wg = blockIdx.x; return F;
}
enum { I_X = 0, I_C, I_CTX, I_CCTX, I_WMOD, I_BMOD, I_N1G, I_WIN, I_RPB, I_DLAM, I_DNG, I_RDF, I_RDB, I_GNG, I_GNB, I_SINK, I_WOUT, I_N2G, I_WR, I_WG, I_WU, I_WD, I_FNG };

__device__ __forceinline__ void ph_mod_partial(const Ctx& F) {
    const float* c = F.in(I_C); const float* cc = F.in(I_CCTX); const float* wm = F.in(I_WMOD);
    for (int gid = F.wg * 512 + F.tid; gid < 2 * 16 * 3072; gid += F.G * 512) {
        const int cg = gid % 3072, ks = (gid / 3072) % 16, l = gid / (3072 * 16);
        const float* w = wm + (size_t)l * DM * 12288 + (size_t)(ks * 128) * 12288 + cg * 4;
        f32x4 a0 = {0.f, 0.f, 0.f, 0.f}, a1 = a0, a2 = a0;
#pragma unroll 8
        for (int k = 0; k < 128; ++k) { const f32x4 wv = *(const f32x4*)(w + (size_t)k * 12288); const int kk = ks * 128 + k;
            const float s0 = siluf(c[kk]), s1 = siluf(c[DM + kk]), s2 = siluf(cc[kk]); a0 += s0 * wv; a1 += s1 * wv; a2 += s2 * wv; }
        float* o = F.modp() + (size_t)((ks * 2 + l) * 3) * 12288 + cg * 4;
        *(f32x4*)(o) = a0; *(f32x4*)(o + 12288) = a1; *(f32x4*)(o + 2 * 12288) = a2;
    }
}
__device__ __forceinline__ void ph_mod_reduce(const Ctx& F) {
    const int NMOD = 2 * 3 * 12288, NR128 = 256 * 32, NR64 = 256 * 16;
    for (int idx = F.wg * 512 + F.tid; idx < NMOD + NR128 + NR64 + 2; idx += F.G * 512) {
        if (idx < NMOD) { const int l = idx / (3 * 12288), v = (idx / 12288) % 3, col = idx % 12288; float s = F.in(I_BMOD)[l * 12288 + col];
            for (int ks = 0; ks < 16; ++ks) s += F.modp()[(size_t)((ks * 2 + l) * 3 + v) * 12288 + col];
            F.mod()[idx] = s;
        } else if (idx < NMOD + NR128) { const int e = idx - NMOD, pos = e >> 5, i = e & 31; const float inv = powf(10000.0f, -(float)i / 32.0f); const float a = (float)pos * inv;
            F.rope()[e] = cosf(a); F.rope()[NR128 + e] = sinf(a);
        } else if (idx < NMOD + NR128 + NR64) { const int e = idx - NMOD - NR128, pos = e >> 4, i = e & 15; const float inv = powf(10000.0f, -(float)i / 16.0f); const float a = (float)pos * inv;
            F.rope()[2 * NR128 + e] = cosf(a); F.rope()[2 * NR128 + NR64 + e] = sinf(a);
        } else { const int l = idx - (NMOD + NR128 + NR64); const float* dl = F.in(I_DLAM) + l * 4 * 64; float s1 = 0.f, s2 = 0.f;
            for (int i = 0; i < 64; ++i) { s1 += dl[i] * dl[64 + i]; s2 += dl[128 + i] * dl[192 + i]; }
            const float lam_init = 0.8f - 0.6f * expf(-0.3f * (float)l);
            F.misc()[l * 2] = expf(s1) - expf(s2) + lam_init; F.misc()[l * 2 + 1] = lam_init; }
    }
}
__device__ __forceinline__ int inproj_perm(int np) {
    const int pn = np >> 8, p = np & 255;
    if (pn >= 6 && pn <= 9) { const int half = p >> 7, pp = p & 127, sh = pp >> 5, rc = (pp >> 4) & 1, i = pp & 15; return pn * 256 + sh * 64 + rc * 32 + half * 16 + i; }
    if ((pn >= 12 && pn <= 15) || (pn >= 20 && pn <= 22)) { const int half = p >> 7, pp = p & 127, hs = pp >> 6, rc = (pp >> 5) & 1, i = pp & 31; return pn * 256 + hs * 128 + rc * 64 + half * 32 + i; }
    return np;
}
__device__ __forceinline__ float inproj_scale(int col) {
    if (col < C_AK) return 0.08838834764831845f * LOG2E;
    if (col >= C_BQ && col < C_BK) return 0.125f * LOG2E;
    if (col >= C_CK && col < C_CV) return 0.08838834764831845f;
    if (col >= C_DQ && col < C_DK) return 0.08838834764831845f * LOG2E;
    return 1.0f;
}
struct CvTile { const float* src; bf16_t* dst; int nsrc, K, n0, k0, kind; };
__device__ __forceinline__ CvTile cv_tile(const Ctx& F, int t) {
    const int T_IN = 96 * 32, T_OUT = 32 * 32, T_GU = 16 * 32 * 32, T_DN = 16 * 32 * 16, TL = T_IN + T_OUT + T_GU + T_DN;
    const int l = t / TL; int r = t % TL; CvTile c;
    if (r < T_IN) { c.kind = 0; c.n0 = (r % 96) * 64; c.k0 = (r / 96) * 64; c.src = F.in(I_WIN) + (size_t)l * DM * INW; c.nsrc = INW; c.K = DM; c.dst = F.w_in_t(l); }
    else if (r < T_IN + T_OUT) { r -= T_IN; c.kind = 1; c.n0 = (r % 32) * 64; c.k0 = (r / 32) * 64; c.src = F.in(I_WOUT) + (size_t)l * DM * DM; c.nsrc = DM; c.K = DM; c.dst = F.w_out_t(l); }
    else if (r < T_IN + T_OUT + T_GU) { r -= T_IN + T_OUT; c.kind = 2; const int e = r / 1024, rr = r % 1024; c.n0 = (rr % 32) * 64; c.k0 = (rr / 32) * 64;
        const int half = (c.n0 & 255) >> 7; c.src = (half ? F.in(I_WU) : F.in(I_WG)) + (size_t)(l * NE + e) * DM * FF; c.nsrc = FF; c.K = DM; c.dst = F.w_gu_t(l) + (size_t)e * 2048 * DM; }
    else { r -= T_IN + T_OUT + T_GU; c.kind = 3; const int e = r / 512, rr = r % 512; c.n0 = (rr % 32) * 64; c.k0 = (rr / 32) * 64; c.src = F.in(I_WD) + (size_t)(l * NE + e) * FF * DM; c.nsrc = DM; c.K = FF; c.dst = F.w_dn_t(l) + (size_t)e * DM * FF; }
    return c;
}
__device__ __forceinline__ void ph_convert(const Ctx& F) {
    LAS float* tile = (LAS float*)F.lds;
    const int TL = 96 * 32 + 32 * 32 + 16 * 32 * 32 + 16 * 32 * 16, NT = 2 * TL;
    const int tx = F.tid & 63, ty = F.tid >> 6, kx2 = F.tid & 31, ny = F.tid >> 5;
    float v[4][8]; float sc[4];
#define CV_LOAD(t0_) do { _Pragma("unroll") for (int u = 0; u < 4; ++u) { const int t = (t0_) + u; if (t < NT) { const CvTile c = cv_tile(F, t); \
            const int np = c.n0 + tx; int scol = np; sc[u] = 1.0f; \
            if (c.kind == 0) { scol = inproj_perm(np); sc[u] = inproj_scale(scol); } else if (c.kind == 2) { scol = (np >> 8) * 128 + (np & 127); } \
            _Pragma("unroll") for (int i = 0; i < 8; ++i) v[u][i] = c.src[(size_t)(c.k0 + ty + 8 * i) * c.nsrc + scol]; } } } while (0)
    int t0 = F.wg * 4;
    __syncthreads();
    if (t0 < NT) CV_LOAD(t0);
    for (; t0 < NT; t0 += 4 * F.G) {
#pragma unroll
        for (int u = 0; u < 4; ++u) { const int t = t0 + u; if (t < NT) {
#pragma unroll
            for (int i = 0; i < 8; ++i) tile[u * (64 * 65) + (ty + 8 * i) * 65 + tx] = v[u][i] * sc[u]; } }
        if (t0 + 4 * F.G < NT) CV_LOAD(t0 + 4 * F.G);
        asm volatile("s_waitcnt lgkmcnt(0)" ::: "memory"); __builtin_amdgcn_s_barrier();
#pragma unroll
        for (int u = 0; u < 4; ++u) { const int t = t0 + u; if (t < NT) { const CvTile c = cv_tile(F, t);
#pragma unroll
            for (int i = 0; i < 4; ++i) { const int nn = ny + 16 * i; const float lo = tile[u * (64 * 65) + (2 * kx2) * 65 + nn], hi = tile[u * (64 * 65) + (2 * kx2 + 1) * 65 + nn];
                *(unsigned*)(c.dst + (size_t)(c.n0 + nn) * c.K + c.k0 + 2 * kx2) = cvt_pk_bf16(lo, hi); } } }
        asm volatile("s_waitcnt lgkmcnt(0)" ::: "memory"); __builtin_amdgcn_s_barrier();
    }
#undef CV_LOAD
    __syncthreads();
}

__device__ __forceinline__ float wave_sum(float s) { return sum64(s); }
__device__ __forceinline__ void load_x(const Ctx& F, const void* xrow, bool bf, f32x4 (&x)[8]) {
    const int lane = F.lane;
    if (bf) {
#pragma unroll
        for (int j = 0; j < 8; ++j) { const u32x2 w = *(const u32x2*)((const bf16_t*)xrow + j * 256 + lane * 4); x[j] = (f32x4){bflo(w.x), bfhi(w.x), bflo(w.y), bfhi(w.y)}; }
    } else {
#pragma unroll
        for (int j = 0; j < 8; ++j) x[j] = *(const f32x4*)((const float*)xrow + j * 256 + lane * 4);
    }
}
__device__ __forceinline__ void ld_y(const Ctx& F, int s, u32x2 (&w)[8]) {
    const bf16_t* y = F.Y() + (size_t)s * DM + F.lane * 4;
#pragma unroll
    for (int j = 0; j < 8; ++j) w[j] = *(const u32x2*)(y + j * 256);
}
__device__ __forceinline__ void acc_y(f32x4 (&ys)[8], const u32x2 (&w)[8]) {
#pragma unroll
    for (int j = 0; j < 8; ++j) ys[j] += (f32x4){bflo(w[j].x), bfhi(w[j].x), bflo(w[j].y), bfhi(w[j].y)};
}
__device__ __forceinline__ int load_slots(const Ctx& F, int row) { return F.slot()[(size_t)row * NE + (F.lane & 15)]; }
__device__ __forceinline__ void moe_fold2(const Ctx& F, const LAS float* g2, int sva, int svb, f32x4 (&xa)[8], f32x4 (&xb)[8]) {
    f32x4 ya[8], yb[8];
#pragma unroll
    for (int j = 0; j < 8; ++j) { ya[j] = (f32x4){0.f, 0.f, 0.f, 0.f}; yb[j] = (f32x4){0.f, 0.f, 0.f, 0.f}; }
    unsigned ma = (unsigned)__builtin_amdgcn_ballot_w64(sva >= 0) & 0xFFFFu, mb = (unsigned)__builtin_amdgcn_ballot_w64(svb >= 0) & 0xFFFFu;
    while ((ma | mb) != 0u) {
        const bool ha = ma != 0u, hb = mb != 0u; u32x2 wa[8], wb[8];
        if (ha) { const int e = __builtin_ctz(ma); ma &= ma - 1u; ld_y(F, __builtin_amdgcn_readlane(sva, e), wa); }
        if (hb) { const int e = __builtin_ctz(mb); mb &= mb - 1u; ld_y(F, __builtin_amdgcn_readlane(svb, e), wb); }
        if (ha) acc_y(ya, wa);
        if (hb) acc_y(yb, wb);
    }
#pragma unroll
    for (int j = 0; j < 8; ++j) { const f32x4 g = *(const LAS f32x4*)(g2 + j * 256 + F.lane * 4); xa[j] += g * ya[j]; xb[j] += g * yb[j]; }
}
__device__ __forceinline__ float row_rstd(const f32x4 (&x)[8]) {
    float s = 0.f;
#pragma unroll
    for (int j = 0; j < 8; ++j) s += x[j][0] * x[j][0] + x[j][1] * x[j][1] + x[j][2] * x[j][2] + x[j][3] * x[j][3];
    s = wave_sum(s); return rsqrtf(s * (1.0f / DM) + 1e-6f);
}
__device__ __forceinline__ void norm1_row(const Ctx& F, int li, int row, const float* ng, f32x4 (&x)[8]) {
    const bool lat = row < NLAT; const int v = lat ? row / SEQ : 2;
    if (li != 0) {
        if (lat) { bf16_t* xo = F.xb() + (size_t)row * DM;
#pragma unroll
            for (int j = 0; j < 8; ++j) { u32x2 w; w.x = cvt_pk_bf16(x[j][0], x[j][1]); w.y = cvt_pk_bf16(x[j][2], x[j][3]); *(u32x2*)(xo + j * 256 + F.lane * 4) = w;
                x[j] = (f32x4){bflo(w.x), bfhi(w.x), bflo(w.y), bfhi(w.y)}; }
        } else { float* xo = F.xc() + (size_t)(row - NLAT) * DM;
#pragma unroll
            for (int j = 0; j < 8; ++j) *(f32x4*)(xo + j * 256 + F.lane * 4) = x[j]; } }
    const float rs = row_rstd(x);
    const LAS float* gs = (const LAS float*)F.lds + v * (2 * DM); const LAS float* s0p = gs + DM;
    bf16_t* h = F.H() + (size_t)row * DM;
#pragma unroll
    for (int j = 0; j < 8; ++j) { const int c = j * 256 + F.lane * 4; const f32x4 g = *(const LAS f32x4*)(gs + c), s0 = *(const LAS f32x4*)(s0p + c);
        const f32x4 y = x[j] * rs * g + s0; u32x2 w; w.x = cvt_pk_bf16(y[0], y[1]); w.y = cvt_pk_bf16(y[2], y[3]); *(u32x2*)(h + c) = w; }
}
__device__ __forceinline__ const void* norm1_src(const Ctx& F, int li, int row, bool& bf) {
    const bool lat = row < NLAT; bf = (li != 0) && lat;
    if (li == 0) return lat ? (const void*)(F.in(I_X) + (size_t)row * DM) : (const void*)(F.in(I_CTX) + (size_t)(row - NLAT) * DM);
    return lat ? (const void*)(F.xb() + (size_t)row * DM) : (const void*)(F.xc() + (size_t)(row - NLAT) * DM);
}
__device__ __forceinline__ void ph_norm1(const Ctx& F, int li) {
    const float* ng = F.in(I_N1G) + li * DM;
    __syncthreads();
    for (int i = F.tid; i < 3 * DM; i += 512) { const int v = i / DM, c = i - v * DM; const float* sh = F.mod() + (size_t)(li * 3 + v) * 12288;
        ((LAS float*)F.lds)[v * (2 * DM) + c] = ng[c] * (1.0f + sh[DM + c]); ((LAS float*)F.lds)[v * (2 * DM) + DM + c] = sh[c];
        if (li != 0) ((LAS float*)F.lds)[6 * DM + i] = F.mod()[(size_t)((li - 1) * 3 + v) * 12288 + 5 * DM + c]; }
    __syncthreads();
    for (int row = (F.wg * 8 + F.wave) * 2; row < MTOT; row += F.G * 16) {
        f32x4 xa[8], xb[8]; bool bfa, bfb; const void* pa = norm1_src(F, li, row, bfa); const void* pb = norm1_src(F, li, row + 1, bfb);
        int sva = -1, svb = -1; if (li != 0) { sva = load_slots(F, row); svb = load_slots(F, row + 1); }
        load_x(F, pa, bfa, xa); load_x(F, pb, bfb, xb);
        if (li != 0) moe_fold2(F, (const LAS float*)F.lds + 6 * DM + (row < NLAT ? row / SEQ : 2) * DM, sva, svb, xa, xb);
        norm1_row(F, li, row, ng, xa); norm1_row(F, li, row + 1, ng, xb);
    }
}
__device__ __forceinline__ void ph_final(const Ctx& F) {
    __syncthreads();
    for (int i = F.tid; i < 3 * DM; i += 512) ((LAS float*)F.lds)[i] = i < DM ? F.in(I_FNG)[i] : F.mod()[(size_t)(3 + (i / DM - 1)) * 12288 + 5 * DM + (i & (DM - 1))];
    __syncthreads();
    const LAS float* ng = (const LAS float*)F.lds;
    for (int row = (F.wg * 8 + F.wave) * 2; row < NLAT; row += F.G * 16) {
        f32x4 xa[8], xb[8]; const int sva = load_slots(F, row), svb = load_slots(F, row + 1);
        load_x(F, F.xb() + (size_t)row * DM, true, xa); load_x(F, F.xb() + (size_t)(row + 1) * DM, true, xb);
        moe_fold2(F, ng + DM + (row / SEQ) * DM, sva, svb, xa, xb);
        const float ra = row_rstd(xa), rb = row_rstd(xb); float* xr = F.out() + (size_t)row * DM;
#pragma unroll
        for (int j = 0; j < 8; ++j) { const int c = j * 256 + F.lane * 4; const f32x4 g = *(const LAS f32x4*)(ng + c); *(f32x4*)(xr + c) = xa[j] * ra * g; *(f32x4*)(xr + DM + c) = xb[j] * rb * g; }
    }
}
__device__ __forceinline__ void router_reduce_store(float (&v)[16], int lane, float* affrow) {
    float a[8];
#pragma unroll
    for (int i = 0; i < 8; ++i) { auto rr = __builtin_amdgcn_permlane32_swap(__float_as_uint(v[i]), __float_as_uint(v[i + 8]), false, false); a[i] = __uint_as_float(rr[0]) + __uint_as_float(rr[1]); }
    float b[4]; const bool b16 = (lane & 16) != 0;
#pragma unroll
    for (int i = 0; i < 4; ++i) { const float keep = b16 ? a[i + 4] : a[i], send = b16 ? a[i] : a[i + 4]; b[i] = keep + xshf<16>(send); }
    float c[2]; const bool b8 = (lane & 8) != 0;
#pragma unroll
    for (int i = 0; i < 2; ++i) { const float keep = b8 ? b[i + 2] : b[i], send = b8 ? b[i] : b[i + 2]; c[i] = keep + xshf<8>(send); }
    const bool b4 = (lane & 4) != 0; float lg = (b4 ? c[1] : c[0]) + xshf<4>(b4 ? c[0] : c[1]);
    lg += xshf<2>(lg); lg += xshf<1>(lg);
    float mx = lg; mx = fmaxf(mx, xshf<4>(mx)); mx = fmaxf(mx, xshf<8>(mx)); mx = fmaxf(mx, xshf<16>(mx));
    { auto rr = __builtin_amdgcn_permlane32_swap(__float_as_uint(mx), __float_as_uint(mx), false, false); mx = fmaxf(__uint_as_float(rr[0]), __uint_as_float(rr[1])); }
    const float ex = expf(lg - mx); float den = ex; den += xshf<4>(den); den += xshf<8>(den); den += xshf<16>(den);
    { auto rr = __builtin_amdgcn_permlane32_swap(__float_as_uint(den), __float_as_uint(den), false, false); den = __uint_as_float(rr[0]) + __uint_as_float(rr[1]); }
    const int e = ((lane >> 5) & 1) * 8 + ((lane >> 4) & 1) * 4 + ((lane >> 3) & 1) * 2 + ((lane >> 2) & 1);
    if ((lane & 3) == 0) affrow[e] = ex / den;
}
__device__ __forceinline__ void ph_norm2(const Ctx& F, int li, int rbeg, int rend, int wg0, int nwg) {
    const float* ng = F.in(I_N2G) + li * DM; const float* wr = F.in(I_WR) + (size_t)li * DM * NE; LAS float* wl = (LAS float*)F.lds;
    __syncthreads();
    int ts_ = F.tid; asm volatile("" : "+v"(ts_));
    for (int h = 0; h < 2; ++h) { f32x4 wv[8];
#pragma unroll
      for (int q = 0; q < 8; ++q) wv[q] = *(const f32x4*)(wr + (size_t)(ts_ + 512 * (h * 8 + q)) * 4);
#pragma unroll
      for (int q = 0; q < 8; ++q) { const int i4 = ts_ + 512 * (h * 8 + q), k = i4 >> 2, e0 = (i4 & 3) * 4; wl[(e0 + 0) * DM + k] = wv[q][0]; wl[(e0 + 1) * DM + k] = wv[q][1]; wl[(e0 + 2) * DM + k] = wv[q][2]; wl[(e0 + 3) * DM + k] = wv[q][3]; } }
    LAS float* gsl = wl + NE * DM;
    for (int i = F.tid; i < 2 * DM; i += 512) { const int v = (rbeg < NLAT) ? i / DM : 2, c = i & (DM - 1); gsl[i] = ng[c] * (1.0f + F.mod()[(size_t)(li * 3 + v) * 12288 + 4 * DM + c]); }
    __syncthreads();
    for (int row0 = rbeg + ((F.wg - wg0) * 8 + F.wave) * 4; row0 < rend; row0 += nwg * 32) {
        const bool lat = row0 < NLAT; const int v = lat ? row0 / SEQ : 2;
        const float* sh = F.mod() + (size_t)(li * 3 + v) * 12288 + 3 * DM; const LAS float* gsv = gsl + (lat ? v * DM : 0);
        f32x4 x[4][8];
        if (lat) { const bf16_t* xin = F.xb() + (size_t)row0 * DM;
#pragma unroll
            for (int r = 0; r < 4; ++r)
#pragma unroll
                for (int j = 0; j < 8; ++j) { const u32x2 w = *(const u32x2*)(xin + (size_t)r * DM + j * 256 + F.lane * 4); x[r][j] = (f32x4){bflo(w.x), bfhi(w.x), bflo(w.y), bfhi(w.y)}; }
        } else { const float* xin = F.xc() + (size_t)(row0 - NLAT) * DM;
#pragma unroll
            for (int r = 0; r < 4; ++r)
#pragma unroll
                for (int j = 0; j < 8; ++j) x[r][j] = *(const f32x4*)(xin + (size_t)r * DM + j * 256 + F.lane * 4); }
        float rs[4];
#pragma unroll
        for (int r = 0; r < 4; ++r) rs[r] = row_rstd(x[r]);
#pragma unroll
        for (int j = 0; j < 8; ++j) { const int c = j * 256 + F.lane * 4; const f32x4 s0 = *(const f32x4*)(sh + c); const f32x4 gs = *(const LAS f32x4*)(gsv + c);
#pragma unroll
            for (int r = 0; r < 4; ++r) { const f32x4 y = x[r][j] * rs[r] * gs + s0; x[r][j] = y; u32x2 w; w.x = cvt_pk_bf16(y[0], y[1]); w.y = cvt_pk_bf16(y[2], y[3]); *(u32x2*)(F.H() + (size_t)(row0 + r) * DM + c) = w; } }
        float lg[4][16];
#pragma unroll
        for (int e = 0; e < NE; ++e) { f32x2 a0 = {0.f, 0.f}, a1 = {0.f, 0.f}, a2 = {0.f, 0.f}, a3 = {0.f, 0.f};
#pragma unroll
            for (int j = 0; j < 8; ++j) { const f32x4 w = *(const LAS f32x4*)(wl + e * DM + j * 256 + F.lane * 4); const f32x2 wlo = __builtin_shufflevector(w, w, 0, 1), whi = __builtin_shufflevector(w, w, 2, 3);
                a0 += __builtin_shufflevector(x[0][j], x[0][j], 0, 1) * wlo; a0 += __builtin_shufflevector(x[0][j], x[0][j], 2, 3) * whi;
                a1 += __builtin_shufflevector(x[1][j], x[1][j], 0, 1) * wlo; a1 += __builtin_shufflevector(x[1][j], x[1][j], 2, 3) * whi;
                a2 += __builtin_shufflevector(x[2][j], x[2][j], 0, 1) * wlo; a2 += __builtin_shufflevector(x[2][j], x[2][j], 2, 3) * whi;
                a3 += __builtin_shufflevector(x[3][j], x[3][j], 0, 1) * wlo; a3 += __builtin_shufflevector(x[3][j], x[3][j], 2, 3) * whi; }
            float s0 = a0[0] + a0[1], s1 = a1[0] + a1[1], s2 = a2[0] + a2[1], s3 = a3[0] + a3[1];
            asm volatile("" : "+v"(s0), "+v"(s1), "+v"(s2), "+v"(s3) :: "memory"); __builtin_amdgcn_sched_barrier(0);
            lg[0][e] = s0; lg[1][e] = s1; lg[2][e] = s2; lg[3][e] = s3; }
#pragma unroll
        for (int r = 0; r < 4; ++r) router_reduce_store(lg[r], F.lane, F.aff() + (size_t)(row0 + r) * NE);
    }
}

__device__ __forceinline__ void topk_group(const Ctx& F, int N, int k, int row_base  , int e, int out_base  ) {
    LAS unsigned* keys = (LAS unsigned*)F.lds; LAS unsigned* hist = keys + 16384; LAS unsigned* sh = hist + 256;
    const int tid = F.tid;
    __syncthreads();
    for (int i = tid; i < N; i += 512) keys[i] = __float_as_uint(F.aff()[(size_t)(row_base + i) * NE + e]);
    unsigned prefix = 0u, need = (unsigned)k;
    for (int shift = 24; shift >= 0; shift -= 8) {
        if (tid < 256) hist[tid] = 0u;
        __syncthreads();
        for (int i = tid; i < N; i += 512) { const unsigned key = keys[i]; if (shift == 24 || (key >> (shift + 8)) == (prefix >> (shift + 8))) atomicAdd((unsigned*)&hist[(key >> shift) & 255u], 1u); }
        __syncthreads();
        if (tid < 64) {
            const int b0 = 255 - 4 * tid; const unsigned c0 = hist[b0], c1 = hist[b0 - 1], c2 = hist[b0 - 2], c3 = hist[b0 - 3]; const unsigned loc = c0 + c1 + c2 + c3;
            unsigned inc = loc;
#pragma unroll
            for (int o = 1; o < 64; o <<= 1) { const unsigned t = lane_up(inc, tid, o); if (tid >= o) inc += t; }
            const unsigned before = inc - loc;
            if (before < need && need <= inc) { unsigned cum = before; int d;
                if (cum + c0 >= need) d = b0; else { cum += c0; if (cum + c1 >= need) d = b0 - 1; else { cum += c1; if (cum + c2 >= need) d = b0 - 2; else { cum += c2; d = b0 - 3; } } }
                sh[0] = prefix | ((unsigned)d << shift); sh[1] = need - cum; }
        }
        __syncthreads();
        prefix = sh[0]; need = sh[1];
        __syncthreads();
    }
    const int per = N >= 512 ? N / 512 : 1; const int nact = N / per; unsigned cg = 0u, ce = 0u;
    if (tid < nact) for (int i = 0; i < per; ++i) { const unsigned key = keys[tid * per + i]; cg += key > prefix; ce += key == prefix; }
    unsigned pk = cg | (ce << 16), inc = pk;
#pragma unroll
    for (int o = 1; o < 64; o <<= 1) { const unsigned t = lane_up(inc, F.lane, o); if (F.lane >= o) inc += t; }
    if (F.lane == 63) sh[8 + F.wave] = inc;
    __syncthreads();
    unsigned woff = 0u;
    for (int w = 0; w < F.wave; ++w) woff += sh[8 + w];
    const unsigned exc = inc - pk + woff; unsigned gb = exc & 0xffffu, eb = exc >> 16; const unsigned ngt = (unsigned)k - need;
    if (tid < nact) for (int i = 0; i < per; ++i) { const int ti = tid * per + i; const unsigned key = keys[ti]; int s = -1;
        if (key > prefix) { s = (int)gb; ++gb; } else if (key == prefix) { if (eb < need) s = (int)(ngt + eb); ++eb; }
        const int row = row_base + ti;
        if (s >= 0) { F.rowidx()[out_base + s] = row; F.gatev()[out_base + s] = __uint_as_float(key); }
        F.slot()[(size_t)row * NE + e] = s >= 0 ? out_base + s : -1; }
    __syncthreads();
}
__device__ __forceinline__ void ph_topk(const Ctx& F, int li) {
    const int ngroups = (li == 0) ? 64 : 32;
    for (int g = F.wg; g < ngroups; g += F.G) {
        if (g < 32) { const int b = g >> 4, e = g & 15; topk_group(F, SEQ, CAP, b * SEQ, e, g * CAP); }
        else { const int b = (g - 32) >> 4, e = (g - 32) & 15; const int base = NBATCH * NE * CAP + e * 256;
            topk_group(F, LCTX, CAPC, NLAT + b * LCTX, e, base + b * CAPC);
            if (b == 0 && F.tid < 192) { F.rowidx()[base + 64 + F.tid] = 0; F.gatev()[base + 64 + F.tid] = 0.f; } }
    }
}

constexpr size_t CTL_KMAX = 16384;
namespace ret {
constexpr int TS = 136;
constexpr int TILE_B = 128 * TS * 2;
__device__ __forceinline__ float log2_gamma(float decay) { return -log1pf(expf(-decay)) * LOG2E; }
__device__ __forceinline__ int chunk_row0(int b, int c) { return c < 2 ? NLAT + b * LCTX + c * 128 : b * SEQ + (c - 2) * 128; }
__device__ __forceinline__ f32x16 mm_block(const LAS bf16_t* A, int ra, const LAS bf16_t* B, int rb, int r32, int hi, f32x16 acc) {
#pragma unroll
    for (int s = 0; s < 8; ++s) { const bf16x8 a = *(const LAS bf16x8*)(A + (ra + r32) * TS + 16 * s + 8 * hi), b = *(const LAS bf16x8*)(B + (rb + r32) * TS + 16 * s + 8 * hi);
        acc = __builtin_amdgcn_mfma_f32_32x32x16_bf16(a, b, acc, 0, 0, 0); }
    return acc;
}
__device__ __forceinline__ bf16x8 scale8(bf16x8 v, float s) {
    const u32x4 w = *reinterpret_cast<const u32x4*>(&v); u32x4 o;
    o.x = cvt_pk_bf16(bflo(w.x) * s, bfhi(w.x) * s); o.y = cvt_pk_bf16(bflo(w.y) * s, bfhi(w.y) * s); o.z = cvt_pk_bf16(bflo(w.z) * s, bfhi(w.z) * s); o.w = cvt_pk_bf16(bflo(w.w) * s, bfhi(w.w) * s);
    return *reinterpret_cast<const bf16x8*>(&o);
}
__device__ __forceinline__ f32x16 mm_block_rowscaled(const LAS bf16_t* A, int ra, float rowscale, const LAS bf16_t* B, int rb, int r32, int hi, f32x16 acc) {
#pragma unroll
    for (int s = 0; s < 8; ++s) { const bf16x8 a = scale8(*(const LAS bf16x8*)(A + (ra + r32) * TS + 16 * s + 8 * hi), rowscale), b = *(const LAS bf16x8*)(B + (rb + r32) * TS + 16 * s + 8 * hi);
        acc = __builtin_amdgcn_mfma_f32_32x32x16_bf16(a, b, acc, 0, 0, 0); }
    return acc;
}
__device__ __forceinline__ void ld4(const bf16_t* src, int ld, int tid, bf16x8 (&v)[4]) {
#pragma unroll
    for (int p = 0; p < 4; ++p) { const int idx = tid + 512 * p; v[p] = *reinterpret_cast<const bf16x8*>(src + (size_t)(idx >> 4) * ld + (idx & 15) * 8); }
}
__device__ __forceinline__ void st4_nat(LAS bf16_t* dst, int tid, const bf16x8 (&v)[4]) {
#pragma unroll
    for (int p = 0; p < 4; ++p) { const int idx = tid + 512 * p; *(LAS bf16x8*)(dst + (idx >> 4) * TS + (idx & 15) * 8) = v[p]; }
}
__device__ __forceinline__ void st4_tr(LAS bf16_t* dst, int tid, const bf16x8 (&v)[4], float e0, float e1) {
#pragma unroll
    for (int p = 0; p < 4; ++p) { const int idx = tid + 512 * p; const int m = idx >> 4, c0 = (idx & 15) * 8; const float sc = __builtin_amdgcn_exp2f(e0 + e1 * (float)m);
#pragma unroll
        for (int i = 0; i < 8; ++i) dst[(c0 + i) * TS + m] = f2bf(bf2f((bf16_t)v[p][i]) * sc); }
}

__device__ __forceinline__ void st4_vst(LAS bf16_t* dst, int tid, const bf16x8 (&v)[4]) {
#pragma unroll
    for (int p = 0; p < 4; ++p) { const int idx = tid + 512 * p; const int m = idx >> 4, c0 = (idx & 15) * 8; *(LAS bf16x8*)((LAS char*)dst + (m >> 6) * 16384 + att::v_st(m & 63, c0)) = v[p]; }
}
__device__ __forceinline__ void st4_vst_scaled(LAS bf16_t* dst, int tid, const bf16x8 (&v)[4], float e0, float e1) {
#pragma unroll
    for (int p = 0; p < 4; ++p) { const int idx = tid + 512 * p; const int m = idx >> 4, c0 = (idx & 15) * 8; *(LAS bf16x8*)((LAS char*)dst + (m >> 6) * 16384 + att::v_st(m & 63, c0)) = scale8(v[p], __builtin_amdgcn_exp2f(e0 + e1 * (float)m)); }
}
template <int KS> __device__ __forceinline__ bf16x8 trfrag(int base) {
    const s16x4 lo = att::vtr(base + (KS >> 2) * 16384 + att::v_rd_off(0, KS & 3, 0)), hi = att::vtr(base + (KS >> 2) * 16384 + att::v_rd_off(0, KS & 3, 1));
    return (bf16x8){lo[0], lo[1], lo[2], lo[3], hi[0], hi[1], hi[2], hi[3]};
}
__device__ __forceinline__ f32x16 mm_block_trB(const LAS bf16_t* A, int ra, int tb, int r32, int hi, f32x16 acc) {
#define RET_STEP(KS) acc = __builtin_amdgcn_mfma_f32_32x32x16_bf16(*(const LAS bf16x8*)(A + (ra + r32) * TS + 16 * KS + 8 * hi), trfrag<KS>(tb), acc, 0, 0, 0)
    RET_STEP(0); RET_STEP(1); RET_STEP(2); RET_STEP(3); RET_STEP(4); RET_STEP(5); RET_STEP(6); RET_STEP(7);
#undef RET_STEP
    return acc;
}

__device__ __forceinline__ void c1_unit(const Ctx& F, int li, int bh, int c) {
    const int b = bh >> 2, h = bh & 3, tid = F.tid, wid = F.wave, r32 = F.lane & 31, hi = F.lane >> 5;
    LAS bf16_t* TVt = (LAS bf16_t*)F.lds; LAS bf16_t* KF = TVt + 16384; LAS bf16_t* KB = KF + 16384;
    const float lf = log2_gamma(F.in(I_RDF)[li * 4 + h]), lb = log2_gamma(F.in(I_RDB)[li * 4 + h]);
    const bf16_t* base = F.P() + (size_t)chunk_row0(b, c) * INW + h * HD;
    bf16x8 kv[4], vv[4]; ld4(base + C_CK, INW, tid, kv); ld4(base + C_CV, INW, tid, vv);
    __syncthreads();
    st4_vst(TVt, tid, vv); st4_vst_scaled(KF, tid, kv, 127.f * lf, -lf); st4_vst_scaled(KB, tid, kv, 0.f, lb);
    __syncthreads();
    const int dvb = wid >> 1, dk0 = 2 * (wid & 1); const int l0 = (int)(uintptr_t)F.lds + att::v_rd_base(F.lane);
    const int av = l0 + dvb * 512, bf0 = l0 + 32768 + dk0 * 512, bb0 = l0 + 65536 + dk0 * 512;
    f32x16 f0 = {}, f1 = {}, g0 = {}, g1 = {};
#define C1_STEP(KS) do { const bf16x8 a_ = trfrag<KS>(av); f0 = __builtin_amdgcn_mfma_f32_32x32x16_bf16(a_, trfrag<KS>(bf0), f0, 0, 0, 0); f1 = __builtin_amdgcn_mfma_f32_32x32x16_bf16(a_, trfrag<KS>(bf0 + 512), f1, 0, 0, 0); \
        g0 = __builtin_amdgcn_mfma_f32_32x32x16_bf16(a_, trfrag<KS>(bb0), g0, 0, 0, 0); g1 = __builtin_amdgcn_mfma_f32_32x32x16_bf16(a_, trfrag<KS>(bb0 + 512), g1, 0, 0, 0); } while (0)
    C1_STEP(0); C1_STEP(1); C1_STEP(2); C1_STEP(3); C1_STEP(4); C1_STEP(5); C1_STEP(6); C1_STEP(7);
#undef C1_STEP
    bf16_t* Uf = F.U() + ((size_t)(0 * 8 + bh) * NCH + c) * 16384; bf16_t* Ub = F.U() + ((size_t)(1 * 8 + bh) * NCH + c) * 16384;
#pragma unroll
    for (int r = 0; r < 16; ++r) { const int o_ = (dvb * 32 + crow(r, hi)) * 128 + dk0 * 32 + r32; Uf[o_] = f2bf(f0[r]); Uf[o_ + 32] = f2bf(f1[r]); Ub[o_] = f2bf(g0[r]); Ub[o_ + 32] = f2bf(g1[r]); }
}
__device__ __forceinline__ void c2_scan(const Ctx& F, int li) {
    for (int gid = F.wg * 512 + F.tid; gid < 2 * 8 * 16384; gid += F.G * 512) {
        const int dir = gid >> 17, bh = (gid >> 14) & 7, el = gid & 16383, h = bh & 3;
        const float lg = log2_gamma((dir ? F.in(I_RDB) : F.in(I_RDF))[li * 4 + h]); const float cd = __builtin_amdgcn_exp2f(128.f * lg);
        const bf16_t* U = F.U() + (size_t)(dir * 8 + bh) * NCH * 16384 + el; bf16_t* S = F.S() + (size_t)(dir * 8 + bh) * NCH * 16384 + el;
        float s = 0.f;
        if (dir == 0) {
#pragma unroll 8
            for (int c = 0; c < NCH; ++c) { const float u = bf2f(U[(size_t)c * 16384]); S[(size_t)c * 16384] = f2bf(s); s = cd * s + u; }
        } else {
            { const float u1 = bf2f(U[(size_t)1 * 16384]), u0 = bf2f(U[0]); S[(size_t)1 * 16384] = f2bf(0.f); s = u1; S[0] = f2bf(s); s = cd * s + u0; }
#pragma unroll 8
            for (int c = NCH - 1; c >= 2; --c) { const float u = bf2f(U[(size_t)c * 16384]); S[(size_t)c * 16384] = f2bf(s); s = cd * s + u; }
        }
    }
}
__device__ __forceinline__ void c3_unit(const Ctx& F, int li, int bh, int c) {
    int tid_ = F.tid, lane_ = F.lane; asm volatile("" : "+v"(tid_), "+v"(lane_));
    const int b = bh >> 2, h = bh & 3, tid = tid_, wid = F.wave, lane = lane_, r32 = lane & 31, hi = lane >> 5;
    LAS bf16_t* TQ = (LAS bf16_t*)F.lds; LAS bf16_t* TK = TQ + 128 * TS; LAS bf16_t* TV = TK + 128 * TS; LAS bf16_t* TP = TV + 128 * TS; LAS float* ST = (LAS float*)(TP + 128 * TS);
    const float lf = log2_gamma(F.in(I_RDF)[li * 4 + h]), lb = log2_gamma(F.in(I_RDB)[li * 4 + h]);
    const int row0 = chunk_row0(b, c);
    const bf16_t* base = F.P() + (size_t)row0 * INW + h * HD;
    bf16x8 qv[4], kv[4], vv[4], sf[4], sb[4], gv[4];
    ld4(base + C_CQ, INW, tid, qv); ld4(base + C_CK, INW, tid, kv); ld4(base + C_CV, INW, tid, vv);
    ld4(F.S() + ((size_t)(0 * 8 + bh) * NCH + c) * 16384, 128, tid, sf);
    __syncthreads();
    st4_nat(TQ, tid, qv); st4_nat(TK, tid, kv); st4_vst(TV, tid, vv);
    __syncthreads();
    const int rb = wid >> 1, cb0 = 2 * (wid & 1);
    {
        f32x16 s0 = {}, s1 = {}; s0 = mm_block(TQ, rb * 32, TK, cb0 * 32, r32, hi, s0); s1 = mm_block(TQ, rb * 32, TK, (cb0 + 1) * 32, r32, hi, s1);
#pragma unroll
        for (int r = 0; r < 16; ++r) { const int n = rb * 32 + crow(r, hi);
#pragma unroll
            for (int i = 0; i < 2; ++i) { const int m = (cb0 + i) * 32 + r32; const int d = n - m; float w = __builtin_amdgcn_exp2f((float)d * (d > 0 ? lf : -lb)); w = (d == 0) ? 2.0f : w;
                TP[n * TS + m] = f2bf((i ? s1[r] : s0[r]) * w); } }
    }
    __syncthreads();
    st4_nat(TK, tid, sf);
    asm volatile("" ::: "memory");
    ld4(F.S() + ((size_t)(1 * 8 + bh) * NCH + c) * 16384, 128, tid, sb);
    ld4(base + C_CG, INW, tid, gv);
    __syncthreads();
    const int nrow = rb * 32 + r32;
    f32x16 o0 = {}, o1 = {};
    { const int tvb = (int)(uintptr_t)F.lds + 2 * TILE_B + att::v_rd_base(lane) + cb0 * 512;
      o0 = mm_block_trB(TP, rb * 32, tvb, r32, hi, o0); o1 = mm_block_trB(TP, rb * 32, tvb + 512, r32, hi, o1); }
    { const float qs = __builtin_amdgcn_exp2f((float)(nrow + 1) * lf);
      o0 = mm_block_rowscaled(TQ, rb * 32, qs, TK, cb0 * 32, r32, hi, o0); o1 = mm_block_rowscaled(TQ, rb * 32, qs, TK, (cb0 + 1) * 32, r32, hi, o1); }
    __syncthreads();
    st4_nat(TK, tid, sb);
    __syncthreads();
    { const float qs = __builtin_amdgcn_exp2f((float)(128 - nrow) * lb);
      o0 = mm_block_rowscaled(TQ, rb * 32, qs, TK, cb0 * 32, r32, hi, o0); o1 = mm_block_rowscaled(TQ, rb * 32, qs, TK, (cb0 + 1) * 32, r32, hi, o1); }
#pragma unroll
    for (int r = 0; r < 16; ++r) { float s1 = o0[r] + o1[r], s2 = o0[r] * o0[r] + o1[r] * o1[r];
        s1 = sum32(s1); s2 = sum32(s2);
        if (r32 == 0) { ST[(rb * 32 + crow(r, hi)) * 4 + (wid & 1) * 2] = s1; ST[(rb * 32 + crow(r, hi)) * 4 + (wid & 1) * 2 + 1] = s2; } }
    __syncthreads();
    st4_nat(TQ, tid, gv);
    __syncthreads();
    const float* gg = F.in(I_GNG) + li * 512 + h * HD; const float* gb = F.in(I_GNB) + li * 512 + h * HD;
    float g0 = gg[cb0 * 32 + r32], g1 = gg[(cb0 + 1) * 32 + r32], b0 = gb[cb0 * 32 + r32], b1 = gb[(cb0 + 1) * 32 + r32];
#pragma unroll
    for (int r = 0; r < 16; ++r) { const int n = rb * 32 + crow(r, hi); const f32x4 st = *(const LAS f32x4*)(ST + n * 4);
        const float mean = (st[0] + st[2]) * (1.0f / 128.0f), var = (st[1] + st[3]) * (1.0f / 128.0f) - mean * mean, rstd = rsqrtf(var + 1e-5f);
        bf16_t* op = F.O() + (size_t)(row0 + n) * DM + 1024 + h * HD;
        const float gt0 = bf2f(TQ[n * TS + cb0 * 32 + r32]), gt1 = bf2f(TQ[n * TS + (cb0 + 1) * 32 + r32]);
        op[cb0 * 32 + r32] = f2bf(siluf(gt0) * ((o0[r] - mean) * rstd * g0 + b0)); op[(cb0 + 1) * 32 + r32] = f2bf(siluf(gt1) * ((o1[r] - mean) * rstd * g1 + b1)); }
}
}
__device__ __forceinline__ int clampi(int x, int lo, int hi) { return x < lo ? lo : (x > hi ? hi : x); }
__device__ __forceinline__ void unitA(const Ctx& F, int li, int idx) {
    const bool ctxq = idx >= 512; const int bh = ctxq ? idx - 512 : (idx & 7), qb = ctxq ? 0 : (idx >> 3), b = bh >> 2, h = bh & 3;
    LAS float* biasL = (LAS float*)(F.lds + att::BIAS_OFF);
    __syncthreads();
    { const float* rp = F.in(I_RPB) + (size_t)(li * 4 + h) * 15 * 31; for (int i = F.tid; i < 15 * 31; i += 512) biasL[i] = rp[i] * LOG2E; }
    att::Tiles T; att::MP mp{};
    const bf16_t* ctxrow = F.P() + (size_t)(NLAT + b * LCTX) * INW; const bf16_t* latrow = F.P() + (size_t)(b * SEQ) * INW;
    T.kctx = ctxrow + C_AK + h * HD; T.klat = latrow + C_AK + h * HD; T.vdelta = C_AV - C_AK; T.nctx = 4;
    const int r32 = F.lane & 31;
    const int qr0 = qb * 4; const int lo = clampi(qr0 - 4, 0, 248), hi_ = clampi(qr0 - 1, 0, 248) + 7;
    T.lat0 = lo; T.nt = ctxq ? 4 : 4 + (hi_ - lo + 1);
    const size_t qrow = ctxq ? (size_t)(NLAT + b * LCTX) : (size_t)(b * SEQ + qb * 256);
    att::attn_unit_a2(F.P() + qrow * INW + C_AQ + h * HD, T, F.O() + qrow * DM + h * HD, !ctxq, (const LAS float*)(F.lds + att::BIAS_OFF), qr0, F.ldsg, F.tid);
}
__device__ __forceinline__ void unitD(const Ctx& F, int li, int idx) {
    const bool ctxq = idx >= 512; const int bh = ctxq ? idx - 512 : (idx & 7), qb = ctxq ? 0 : (idx >> 3), b = bh >> 2, h = bh & 3, kv = h >> 1;
    att::Tiles T; att::MP mp{};
    const bf16_t* ctxrow = F.P() + (size_t)(NLAT + b * LCTX) * INW; const bf16_t* latrow = F.P() + (size_t)(b * SEQ) * INW;
    T.kctx = ctxrow + C_DK + kv * HD; T.klat = latrow + C_DK + kv * HD; T.vdelta = C_DV - C_DK; T.nctx = 4;
    mp.sink_l2 = F.in(I_SINK)[li * 4 + h] * LOG2E;
    const int lo = qb * 4 - 2 < 0 ? 0 : qb * 4 - 2, hi_ = qb * 4 + 5 > 255 ? 255 : qb * 4 + 5;
    T.lat0 = lo; T.nt = ctxq ? 4 : 4 + (hi_ - lo + 1); mp.masked = !ctxq; mp.tq = qb * 256 + F.wave * 32 + (F.lane & 31);
    const size_t qrow = ctxq ? (size_t)(NLAT + b * LCTX) : (size_t)(b * SEQ + qb * 256);
    att::attn_unit_simple<2>(F.P() + qrow * INW + C_DQ + h * HD, T, F.O() + qrow * DM + 1536 + h * HD, mp, F.ldsg, F.tid);
}
__device__ __forceinline__ void unitB(const Ctx& F, int li, int idx) {
    const bool ctxq = idx >= 1024; const int j = ctxq ? idx - 1024 : idx; const int bh = j & 7, qb = j >> 3, b = bh >> 2, h = bh & 3;
    att::TilesB3 T; att::MP mp{};
    const bf16_t* ctxrow = F.P() + (size_t)(NLAT + b * LCTX) * INW; const bf16_t* latrow = F.P() + (size_t)(b * SEQ) * INW;
    T.kctx = ctxrow + C_BK + h * HD; T.klat = latrow + C_BK + h * HD; T.vdelta = C_BV - C_BK; T.nt = ctxq ? 4 : 4 + SEQ / 64;
    mp.lam = F.misc()[li * 2]; mp.post = 1.0f - F.misc()[li * 2 + 1]; mp.normg = F.in(I_DNG) + li * HD;
    const size_t qrow = (ctxq ? (size_t)(NLAT + b * LCTX) : (size_t)(b * SEQ)) + (size_t)qb * 128;
    att::attn_unit_b3(F.P() + qrow * INW + C_BQ + h * HD, T, F.O() + qrow * DM + 512 + h * HD, mp, (const unsigned*)(F.ws() + WS_CTL + CTL_KMAX) + li * 16 + b * 8 + h * 2, F.ldsg, F.tid);
}

#define DYN_UNITS(ctr_, n_, slot_, BODY) do { unsigned nx_ = 0u; if (F.tid == 0) nx_ = __hip_atomic_fetch_add((ctr_), 1u, __ATOMIC_RELAXED, __HIP_MEMORY_SCOPE_AGENT); \
    for (;;) { __syncthreads(); if (F.tid == 0) (slot_)[0] = nx_; __syncthreads(); const int idx = (int)__builtin_amdgcn_readfirstlane((slot_)[0]); if (idx >= (n_)) break; \
        if (F.tid == 0) nx_ = __hip_atomic_fetch_add((ctr_), 1u, __ATOMIC_RELAXED, __HIP_MEMORY_SCOPE_AGENT); BODY } } while (0)
constexpr size_t CTL_DYN = 32768;
constexpr int LDS_SCRATCH = 147456, LDS_BYTES = LDS_SCRATCH + 256, IDXL_OFF = 131072;
constexpr int N_PHASES = 23;
__global__ void __launch_bounds__(512, 2) fwd_kernel(Args a) {
    extern __shared__ __attribute__((aligned(16))) unsigned char lds_raw[];
    volatile LAS unsigned* misc = (volatile LAS unsigned*)((LAS unsigned char*)lds_raw + LDS_SCRATCH);
    const int wave_s = __builtin_amdgcn_readfirstlane(threadIdx.x >> 6);
    if (wave_s == 0) { const int l0 = hw_lane(); if (l0 < 4) misc[l0] = 0u; }
    __syncthreads();
    const int lo = a.ph_lo, hi = a.ph_hi;
#ifdef DIAG_BARWAIT
    unsigned barwait_ = 0u;
#endif
    const bool use_bar = (hi - lo) > 1;
    XcdBarrier bar; bar.bar = (unsigned*)(a.ws + WS_CTL); bar.x = 0; bar.st = misc;
    if (use_bar) bar = xcd_barrier_post((unsigned*)(a.ws + WS_CTL), misc, wave_s == 0 && hw_lane() == 0);
#define FCTX const Ctx F = make_ctx(lds_raw, wave_s)
#ifndef PHMASK
#define PHMASK 0xFFFFFFFFu
#endif
#define EN(j) (((PHMASK) >> (j)) & 1u)
#ifndef REPMASK
#define REPMASK 0u
#endif
#define NREP(j) ((((REPMASK) >> (j)) & 1u) ? 2 : 1)
#define IN(k) (lo <= (k) && (k) < hi)
#ifdef EXP_BAR2
#define SEAM(k) do { if (IN(k) && IN((k) + 1)) { xcd_barrier(bar, wave_s == 0 && hw_lane() == 0); xcd_barrier(bar, wave_s == 0 && hw_lane() == 0); } } while (0)
#else
#ifdef DIAG_BARWAIT
#define SEAM(k) do { if (IN(k) && IN((k) + 1)) { const unsigned long long w0_ = wall_clock64(); xcd_barrier(bar, wave_s == 0 && hw_lane() == 0); if ((DIAG_SEAMS >> (k)) & 1u) barwait_ += (unsigned)(wall_clock64() - w0_); } } while (0)
#else
#define SEAM(k) do { if (IN(k) && IN((k) + 1)) xcd_barrier(bar, wave_s == 0 && hw_lane() == 0); } while (0)
#endif
#endif
    for (int rep_ = 0; rep_ < NREP(0); ++rep_) if (EN(0) && IN(0)) { FCTX; ph_mod_partial(F); } SEAM(0);
    for (int rep_ = 0; rep_ < NREP(1); ++rep_) if (EN(1) && IN(1)) { FCTX; ph_mod_reduce(F); ph_convert(F); } SEAM(1);
    const int F_G = gridDim.x;
    for (int li = 0; li < DEPTH; ++li) {
        const int pb = 2 + li * 10;
        for (int rep_ = 0; rep_ < (li == 0 ? NREP(2) : 1); ++rep_) if (EN(2) && IN(pb + 0)) { FCTX; ph_norm1(F, li); } SEAM(pb + 0);
        const bool split_in = use_bar && EN(3) && EN(4) && IN(pb + 1) && IN(pb + 2) && F_G >= 96;
        for (int rep_ = 0; rep_ < NREP(3); ++rep_) if (EN(3) && IN(pb + 1)) {
            if (split_in) {
                { FCTX; pg8::Gemm g{F.H(), F.w_in_t(li), DM, nullptr}; pg8::EpiInProj E{F.P(), F.rope(), (unsigned*)(F.ws() + WS_CTL + CTL_KMAX) + li * 16};
                  pg8::StaticOrder S; S.init(NLAT / 256, INW / 256, F.G, F.wg); pg8::gemm_phase<pg8::EpiInProj, pg8::StaticOrder, false>(F.lds, g, S, E, nullptr, F.tid); }
                xcd_barrier(bar, wave_s == 0 && hw_lane() == 0);
                if (blockIdx.x < 48) { FCTX; pg8::Gemm g{F.H(), F.w_in_t(li), DM, nullptr}; pg8::EpiInProj E{F.P(), F.rope(), (unsigned*)(F.ws() + WS_CTL + CTL_KMAX) + li * 16};
                  pg8::OffsetOrder S; S.init(NCTX / 256, INW / 256, 48, F.wg); S.pm0 = NLAT / 256; pg8::gemm_phase<pg8::EpiInProj, pg8::OffsetOrder, false>(F.lds, g, S, E, nullptr, F.tid); }
                else { FCTX; for (int idx = F.wg - 48; idx < 8 * (NCH - 2); idx += F.G - 48) ret::c1_unit(F, li, idx & 7, 2 + (idx >> 3)); }
            } else {
                FCTX; pg8::Gemm g{F.H(), F.w_in_t(li), DM, nullptr}; pg8::EpiInProj E{F.P(), F.rope(), (unsigned*)(F.ws() + WS_CTL + CTL_KMAX) + li * 16};
                pg8::StaticOrder S; S.init(MTOT / 256, INW / 256, F.G, F.wg);
#ifdef EXP_NOEPI_REP
                if (rep_ == 1) pg8::gemm_phase<pg8::EpiInProj, pg8::StaticOrder, false, true>(F.lds, g, S, E, nullptr, F.tid); else
#endif
                pg8::gemm_phase<pg8::EpiInProj, pg8::StaticOrder, false>(F.lds, g, S, E, nullptr, F.tid);
            }
        } SEAM(pb + 1);
        for (int rep_ = 0; rep_ < NREP(4); ++rep_) if (EN(4) && IN(pb + 2)) {
            FCTX;
            for (int r2_ = 0; r2_ < NREP(15); ++r2_) if (EN(15)) { if (split_in) { for (int idx = (F.wg + F.G - 120) % F.G; idx < 16; idx += F.G) ret::c1_unit(F, li, idx & 7, idx >> 3); }   else { for (int idx = F.wg; idx < 8 * NCH; idx += F.G) ret::c1_unit(F, li, idx & 7, idx >> 3); } }
            const int nAD = (li == 0) ? 520 : 512;
            for (int r2_ = 0; r2_ < NREP(13); ++r2_) if (EN(13)) for (int idx = (F.wg + 8) % F.G; idx < nAD; idx += F.G) unitA(F, li, idx);
            for (int r2_ = 0; r2_ < NREP(14); ++r2_) if (EN(14)) for (int idx = F.wg; idx < nAD; idx += F.G) unitD(F, li, idx);
        } SEAM(pb + 2);
        for (int rep_ = 0; rep_ < NREP(5); ++rep_) if (EN(5) && IN(pb + 3)) { FCTX; ret::c2_scan(F, li); } SEAM(pb + 3);
        for (int rep_ = 0; rep_ < NREP(6); ++rep_) if (EN(6) && IN(pb + 4)) {
            FCTX; const int nB = (li == 0) ? 1040 : 1024;
            if (EN(16)) for (int idx = F.wg; idx < nB; idx += F.G) unitB(F, li, idx);
            if (EN(17)) { if (use_bar) { unsigned* ctr = (unsigned*)(F.ws() + WS_CTL + CTL_DYN) + (li * 4 + 1) * 64; volatile LAS unsigned* slot = misc + 8;
                    DYN_UNITS(ctr, nB, slot, { if (idx < 1024) ret::c3_unit(F, li, idx & 7, 2 + (idx >> 3)); else ret::c3_unit(F, li, (idx - 1024) & 7, (idx - 1024) >> 3); }); }
                else for (int idx = F.wg; idx < nB; idx += F.G) { if (idx < 1024) ret::c3_unit(F, li, idx & 7, 2 + (idx >> 3)); else ret::c3_unit(F, li, (idx - 1024) & 7, (idx - 1024) >> 3); } }
        } SEAM(pb + 4);
        const bool split_out = use_bar && li == 0 && EN(7) && EN(8) && IN(pb + 5) && IN(pb + 6) && F_G >= 64;
        for (int rep_ = 0; rep_ < (li == 0 ? NREP(7) : 1); ++rep_) if (EN(7) && IN(pb + 5)) {
            FCTX; pg8::Gemm g{F.O(), F.w_out_t(li), DM, nullptr};
            pg8::EpiOutProj E{li == 0 ? F.in(I_X) : nullptr, F.xb(), F.xb(), F.in(I_CTX), F.xc(), F.mod() + (size_t)li * 3 * 12288};
            pg8::StaticOrder S; S.init((li == 0 && !split_out) ? MTOT / 256 : NLAT / 256, DM / 256, F.G, F.wg);
            pg8::gemm_phase<pg8::EpiOutProj, pg8::StaticOrder, false>(F.lds, g, S, E, nullptr, F.tid);
        } SEAM(pb + 5);
        for (int rep_ = 0; rep_ < NREP(8); ++rep_) if (EN(8) && IN(pb + 6)) {
            if (split_out) {
                if (blockIdx.x < 16) { FCTX; pg8::Gemm g{F.O(), F.w_out_t(li), DM, nullptr}; pg8::EpiOutProj E{F.in(I_X), F.xb(), F.xb(), F.in(I_CTX), F.xc(), F.mod() + (size_t)li * 3 * 12288};
                    pg8::OffsetOrder S; S.init(NCTX / 256, DM / 256, 16, F.wg); S.pm0 = NLAT / 256; pg8::gemm_phase<pg8::EpiOutProj, pg8::OffsetOrder, false>(F.lds, g, S, E, nullptr, F.tid); }
                else { FCTX; ph_norm2(F, li, 0, NLAT, 16, F.G - 16); }
                xcd_barrier(bar, wave_s == 0 && hw_lane() == 0);
                if (blockIdx.x < 16) { FCTX; ph_norm2(F, li, NLAT, MTOT, 0, 16); }
            } else { FCTX; ph_norm2(F, li, 0, NLAT, 0, F.G); if (li == 0) ph_norm2(F, li, NLAT, MTOT, 0, F.G); }
        } SEAM(pb + 6);
        for (int rep_ = 0; rep_ < NREP(9); ++rep_) if (EN(9) && IN(pb + 7)) { FCTX; ph_topk(F, li); } SEAM(pb + 7);
        for (int rep_ = 0; rep_ < NREP(10); ++rep_) if (EN(10) && IN(pb + 8)) {
            FCTX; pg8::Gemm g{F.H(), F.w_gu_t(li), DM, F.rowidx()}; pg8::MoeOrder S; S.init(li == 0 ? 272 : 256, 8, F.G, F.wg); pg8::EpiSwiGLU E{F.ACT()};
            pg8::gemm_phase<pg8::EpiSwiGLU, pg8::MoeOrder, true>(F.lds, g, S, E, (LAS int*)(F.lds + IDXL_OFF), F.tid);
        } SEAM(pb + 8);
        for (int rep_ = 0; rep_ < NREP(11); ++rep_) if (EN(11) && IN(pb + 9)) {
            FCTX; pg8::Gemm g{F.ACT(), F.w_dn_t(li), FF, nullptr}; pg8::MoeOrder S; S.init(li == 0 ? 272 : 256, 8, F.G, F.wg); pg8::EpiDown E{F.Y(), F.gatev()};
            pg8::gemm_phase<pg8::EpiDown, pg8::MoeOrder, false>(F.lds, g, S, E, nullptr, F.tid);
        } SEAM(pb + 9);
    }
    for (int rep_ = 0; rep_ < NREP(12); ++rep_) if (EN(12) && IN(22)) { FCTX; ph_final(F); }
#ifdef DIAG_BARWAIT
    if (blockIdx.x == DIAG_WG && wave_s == 0 && hw_lane() == 0 && barwait_ > (unsigned)DIAG_BARWAIT) a.out[(size_t)DIAG_WG * 3] += 1000.0f;
#endif
#undef IN
#undef SEAM
#undef FCTX
}

#ifndef N_LAUNCHES
#define N_LAUNCHES 1
#endif
extern "C" void kernel_launch(void* const* d_in, const int* in_sizes, int n_in, void* d_out, int out_size, void* d_ws, size_t ws_size, hipStream_t stream) {
    static int grid = 0;
    if (grid == 0) {
        if (n_in != 23 || out_size != NLAT * DM || ws_size < WS_END) { fprintf(stderr, "kernel_launch: unexpected shapes: n_in %d out %d ws %zu (need %zu)\n", n_in, out_size, ws_size, (size_t)WS_END); grid = -1; return; }
        int dev = 0, cus = 0, per_cu = 0;
        if (hipGetDevice(&dev) != hipSuccess || hipDeviceGetAttribute(&cus, hipDeviceAttributeMultiprocessorCount, dev) != hipSuccess) { grid = -1; return; }
        if (hipFuncSetAttribute((const void*)fwd_kernel, hipFuncAttributeMaxDynamicSharedMemorySize, LDS_BYTES) != hipSuccess) { fprintf(stderr, "kernel_launch: hipFuncSetAttribute failed\n"); grid = -1; return; }
        if (hipOccupancyMaxActiveBlocksPerMultiprocessor(&per_cu, (const void*)fwd_kernel, 512, LDS_BYTES) != hipSuccess || per_cu < 1) fprintf(stderr, "kernel_launch: occupancy query says %d\n", per_cu);
        (void)hipGetLastError();
        grid = cus;
    }
    if (grid < 0) return;
    hipMemsetAsync((char*)d_ws + WS_CTL, 0, CTL_BYTES, stream);
    Args a{};
    for (int i = 0; i < 23; ++i) a.in[i] = (const float*)d_in[i];
    a.out = (float*)d_out; a.ws = (unsigned char*)d_ws;
    for (int k = 0; k < N_LAUNCHES; ++k) {
        a.ph_lo = (N_LAUNCHES == 1) ? 0 : k; a.ph_hi = (N_LAUNCHES == 1) ? N_PHASES : k + 1;
        hipLaunchKernelGGL(fwd_kernel, dim3(grid), dim3(512), LDS_BYTES, stream, a);
    }
    const hipError_t le = hipPeekAtLastError();
    if (le != hipSuccess) fprintf(stderr, "kernel_launch: launch failed: %s\n", hipGetErrorName(le));
}
```

```cpp
#include <hip/hip_runtime.h>
#include <cstdio>
#include <cstdint>

#define LAS __attribute__((address_space(3)))
typedef unsigned short bf16_t;
typedef short bf16x8 __attribute__((ext_vector_type(8)));
typedef short s16x4 __attribute__((ext_vector_type(4)));
typedef float f32x4 __attribute__((ext_vector_type(4)));
typedef float f32x2 __attribute__((ext_vector_type(2)));
typedef float f32x16 __attribute__((ext_vector_type(16)));
typedef unsigned u32x4 __attribute__((ext_vector_type(4)));
typedef unsigned u32x2 __attribute__((ext_vector_type(2)));

constexpr int DM = 2048, NBATCH = 2, SEQ = 16384, LCTX = 256, DEPTH = 2;
constexpr int NLAT = NBATCH * SEQ;
constexpr int NCTX = NBATCH * LCTX;
constexpr int MTOT = NLAT + NCTX;
constexpr int INW = 6144;
constexpr int HD = 128;
constexpr int NE = 16, FF = 1024, CAP = 2048, CAPC = 32;
constexpr int MOE_ROWS = NBATCH * NE * CAP + NE * 256;
constexpr int NCH = 130;
constexpr int C_AQ = 0, C_AK = 512, C_AV = 1024, C_BQ = 1536, C_BK = 2048, C_BV = 2560, C_CQ = 3072, C_CK = 3584, C_CV = 4096, C_CG = 4608, C_DQ = 5120, C_DK = 5632, C_DV = 5888;
constexpr float LOG2E = 1.4426950408889634f;
constexpr float NEGBIG = -1e30f;

constexpr size_t al256(size_t x) { return (x + 255) / 256 * 256; }
constexpr size_t WS_CTL = 0;
constexpr size_t CTL_BYTES = 65536;
constexpr size_t WS_MODP = WS_CTL + CTL_BYTES;
constexpr size_t WS_MOD = WS_MODP + al256((size_t)16 * 2 * 3 * 12288 * 4);
constexpr size_t WS_MISC = WS_MOD + al256((size_t)2 * 3 * 12288 * 4);
constexpr size_t WS_ROPE = WS_MISC + 256;
constexpr size_t WS_XC = WS_ROPE + al256((size_t)(256 * 32 * 2 + 256 * 16 * 2) * 4);
constexpr size_t WS_AFF = WS_XC + al256((size_t)NCTX * DM * 4);
constexpr size_t WS_ROWIDX = WS_AFF + al256((size_t)MTOT * NE * 4);
constexpr size_t WS_GATEV = WS_ROWIDX + al256((size_t)MOE_ROWS * 4);
constexpr size_t WS_SLOT = WS_GATEV + al256((size_t)MOE_ROWS * 4);
constexpr size_t WS_H = WS_SLOT + al256((size_t)MTOT * NE * 4);
constexpr size_t H_BYTES = (size_t)MTOT * DM * 2;
constexpr size_t WS_P = WS_H + al256(H_BYTES);
constexpr size_t P_BYTES = (size_t)MTOT * INW * 2;
constexpr size_t WS_O = WS_P + al256(P_BYTES);
constexpr size_t WS_S = WS_O + al256(H_BYTES);
constexpr size_t S_BYTES = (size_t)2 * 8 * NCH * 16384 * 2;
constexpr size_t WS_W = WS_S + al256(S_BYTES);
constexpr size_t W_IN_B = (size_t)INW * DM * 2, W_OUT_B = (size_t)DM * DM * 2, W_GU_B = (size_t)NE * 2048 * DM * 2, W_DN_B = (size_t)NE * DM * FF * 2;
constexpr size_t WL_IN = 0, WL_OUT = WL_IN + W_IN_B, WL_GU = WL_OUT + W_OUT_B, WL_DN = WL_GU + W_GU_B, WL_BYTES = WL_DN + W_DN_B;
constexpr size_t WS_XB = WS_W + 2 * WL_BYTES;
constexpr size_t WS_END = WS_XB + al256((size_t)NLAT * DM * 2);
constexpr size_t ACT_OFF = 0;
constexpr size_t Y_OFF = al256((size_t)MOE_ROWS * FF * 2);
static_assert(Y_OFF + (size_t)MOE_ROWS * DM * 2 <= al256(P_BYTES) + H_BYTES, "Y must fit in P + O");
static_assert((size_t)2 * 8 * NCH * 16384 * 2 <= (size_t)NLAT * DM * 2, "retention U (bf16) must fit in the latent part of H");

__device__ __forceinline__ unsigned cvt_pk_bf16(float lo, float hi) { unsigned r; asm volatile("v_cvt_pk_bf16_f32 %0, %1, %2" : "=v"(r) : "v"(lo), "v"(hi)); return r; }
__device__ __forceinline__ bf16_t f2bf(float f) { return (bf16_t)(cvt_pk_bf16(f, 0.f) & 0xffffu); }
__device__ __forceinline__ float bf2f(bf16_t b) { return __uint_as_float(((unsigned)b) << 16); }
__device__ __forceinline__ float bflo(unsigned w) { return __uint_as_float(w << 16); }
__device__ __forceinline__ float bfhi(unsigned w) { return __uint_as_float(w & 0xffff0000u); }
__device__ __forceinline__ float siluf(float x) { return x / (1.0f + __expf(-x)); }
template <int M> __device__ __forceinline__ float xshf(float v) { return __int_as_float(__builtin_amdgcn_ds_swizzle(__float_as_int(v), (M << 10) | 0x1f)); }
__device__ __forceinline__ float sum32(float s) { s += xshf<1>(s); s += xshf<2>(s); s += xshf<4>(s); s += xshf<8>(s); s += xshf<16>(s); return s; }
__device__ __forceinline__ float sum64(float s) { s = sum32(s); auto rr = __builtin_amdgcn_permlane32_swap(__float_as_uint(s), __float_as_uint(s), false, false); return __uint_as_float(rr[0]) + __uint_as_float(rr[1]); }
__device__ __forceinline__ unsigned lane_up(unsigned v, int lane, int o) { return (unsigned)__builtin_amdgcn_ds_bpermute((lane - o) << 2, (int)v); }
__device__ __forceinline__ int crow(int r, int hi) { return (r & 3) + 8 * (r >> 2) + 4 * hi; }

#define XB_TMO      128
#define XB_XCNT(j)  (256  + 64 * (j))
#define XB_XSUB(j)  (1280 + 64 * (j))
#define XB_XGEN(j)  (2304 + 64 * (j))
#define XB_TOP      3328
#define XB_TOPGEN   3392
#define XCD_BAR_WORDS 3456
#define XB_SPIN_CAP (1u << 24)
__device__ __forceinline__ unsigned xb_ld(unsigned* p)              { return __hip_atomic_load(p, __ATOMIC_RELAXED, __HIP_MEMORY_SCOPE_AGENT); }
__device__ __forceinline__ unsigned xb_add(unsigned* p, unsigned v) { return __hip_atomic_fetch_add(p, v, __ATOMIC_RELAXED, __HIP_MEMORY_SCOPE_AGENT); }
__device__ __forceinline__ unsigned xb_xcc_id() { return (unsigned)__builtin_amdgcn_s_getreg((3 << 11) | 20) & 0xFu; }
#define XB_SPIN(cond, bar) do { unsigned _sp = 0; while (cond) { __builtin_amdgcn_s_sleep(1); \
    if ((++_sp & 255u) == 0u) { if (xb_ld(&(bar)[XB_TMO])) break; if (_sp > XB_SPIN_CAP) { atomicAdd(&(bar)[XB_TMO], 1u); break; } } } } while (0)
struct XcdBarrier { unsigned* bar; unsigned x; volatile LAS unsigned* st; };
__device__ __forceinline__ XcdBarrier xcd_barrier_post(unsigned* bar, volatile LAS unsigned* st, bool leader) {
    XcdBarrier b; b.bar = bar; b.x = xb_xcc_id(); b.st = st;
    if (leader) (void)xb_add(&bar[XB_XCNT(b.x)], 1u);
    return b;
}
__device__ __forceinline__ void xcd_barrier_complete(unsigned* bar, unsigned x, unsigned& nloc, unsigned& nx) {
    const unsigned G = gridDim.x * gridDim.y * gridDim.z;
    unsigned sum, cnt, mine, sp = 0u;
    for (;;) {
        sum = 0u; cnt = 0u; mine = 0u;
#pragma unroll
        for (unsigned j = 0; j < 16; ++j) { const unsigned c = xb_ld(&bar[XB_XCNT(j)]); sum += c; cnt += (c > 0u) ? 1u : 0u; mine = (j == x) ? c : mine; }
        if (sum == G) break;
        __builtin_amdgcn_s_sleep(1);
        if ((++sp & 255u) == 0u) { if (xb_ld(&bar[XB_TMO])) break; if (sp > XB_SPIN_CAP) { atomicAdd(&bar[XB_TMO], 1u); break; } }
    }
    nloc = mine > 0u ? mine : 1u; nx = cnt > 0u ? cnt : 1u;
}
__device__ __forceinline__ void xcd_barrier(const XcdBarrier& b, bool leader) {
    asm volatile("s_waitcnt vmcnt(0)" ::: "memory");
    __syncthreads();
    if (leader) {
        unsigned* bar = b.bar;
        __builtin_amdgcn_s_waitcnt(0);
        unsigned nloc = b.st[0], nx = b.st[1];
        if (nloc == 0u) { xcd_barrier_complete(bar, b.x, nloc, nx); b.st[0] = nloc; b.st[1] = nx; }
        const unsigned old = xb_add(&bar[XB_XSUB(b.x)], 1u);
        const unsigned gen = old / nloc;
        if (old + 1u == (gen + 1u) * nloc) {
            __builtin_amdgcn_fence(__ATOMIC_RELEASE, "agent");
            asm volatile("s_waitcnt vmcnt(0)" ::: "memory");
            const unsigned og = xb_add(&bar[XB_TOP], 1u);
            const unsigned tg = og / nx;
            if (og + 1u == (tg + 1u) * nx) xb_add(&bar[XB_TOPGEN], 1u);
            else XB_SPIN(xb_ld(&bar[XB_TOPGEN]) == tg, bar);
            __builtin_amdgcn_fence(__ATOMIC_ACQUIRE, "agent");
            xb_add(&bar[XB_XGEN(b.x)], 1u);
            asm volatile("s_waitcnt vmcnt(0)" ::: "memory");
        } else {
            XB_SPIN(xb_ld(&bar[XB_XGEN(b.x)]) == gen, bar);
            __builtin_amdgcn_fence(__ATOMIC_ACQUIRE, "agent");
            asm volatile("s_waitcnt vmcnt(0)" ::: "memory");
        }
    }
    __syncthreads();
}
namespace pg8 {
constexpr int BM = 256, BK = 64, HALF = 128, HTB = HALF * BK * 2, STAGE_BYTES = 8 * HTB, NXCD = 8, WGM = 8;
__host__ __device__ __forceinline__ int lds_byte(int r, int c) { const int st = (r >> 4) * 2 + (c >> 5), rr = r & 15, cc = c & 31, ob = rr * 64 + cc * 2; return st * 1024 + (ob ^ (((ob >> 9) & 1) << 5)); }
__host__ __device__ __forceinline__ void stage_rc(int b, int& R, int& C) { const int st = b / 1024, sb = b % 1024, swz = sb ^ (((sb >> 9) & 1) << 5); R = (st >> 1) * 16 + swz / 64; C = (st & 1) * 32 + (swz % 64) / 2; }
__host__ __device__ __forceinline__ int perm32(int rho) { const int n = rho >> 4, i = rho & 15; return 8 * (i >> 2) + 4 * n + (i & 3); }

struct Unit { int pm, pn; };
struct Gemm { const bf16_t* A; const bf16_t* Bt; int K; const int* rowidx; };

struct StaticOrder {
    int nM, nN, nwg, G, c;
    __device__ void init(int nM_, int nN_, int G_, int c_) { nM = nM_; nN = nN_; nwg = nM * nN; G = G_; c = c_; }
    __device__ bool next(int i, Unit& u) const {
        const long L = (long)i * G + c; if (L >= nwg) return false;
        int wgid = (int)L; { const int q = nwg / NXCD, r = nwg % NXCD, xcd = wgid % NXCD, off = wgid / NXCD; wgid = (xcd < r ? xcd * (q + 1) : r * (q + 1) + (xcd - r) * q) + off; }
        const int nig = WGM * nN, gid = wgid / nig, fm = gid * WGM, gsz = (nM - fm) < WGM ? (nM - fm) : WGM;
        u.pm = fm + ((wgid % nig) % gsz); u.pn = (wgid % nig) / gsz; return true;
    }
};
struct OffsetOrder : StaticOrder {
    int pm0;
    __device__ bool next(int i, Unit& u) const { if (!StaticOrder::next(i, u)) return false; u.pm += pm0; return true; }
};
__device__ __forceinline__ int moe_expert_of_tile(int pm) { return pm < 256 ? ((pm >> 3) & 15) : (pm - 256); }
struct MoeOrder : StaticOrder {
    __device__ bool next(int i, Unit& u) const { if (!StaticOrder::next(i, u)) return false; u.pn += moe_expert_of_tile(u.pm) * 8; return true; }
};

template <class Epi, class Sched, bool GATHER, bool NOEPI = false>
__device__ __forceinline__ void gemm_phase(LAS unsigned char* lds, const Gemm g, const Sched& S, const Epi& E, LAS int* idxl, const int tid) {
    const int wid = __builtin_amdgcn_readfirstlane(tid >> 6), lane = tid & 63, wr = wid >> 2, wc = wid & 3, fr = lane & 15, fq = lane >> 4;
    const int K = g.K, nt = K / BK;
    unsigned voffA[2], voffB[2]; int RA[2];
#pragma unroll
    for (int i = 0; i < 2; ++i) { int R, C; stage_rc(tid * 16 + i * 8192, R, C); const int Rb = Epi::PERM ? ((R & ~31) + perm32(R & 31)) : R;
        voffA[i] = (unsigned)(R * K + C) * 2u; voffB[i] = (unsigned)(Rb * K + C) * 2u; RA[i] = R; if (GATHER) voffA[i] = (unsigned)C * 2u; }
    const size_t kstep = (size_t)(BK * 2);
    const size_t hstep = (size_t)HALF * K * 2;
    const size_t tstep = 2 * hstep;
    const unsigned ldsw = (unsigned)wid * 1024u;
    const int aoff = lds_byte(wr * 64 + fr, fq * 8), boff = lds_byte(wc * 32 + fr, fq * 8);
#define PG8_SA(b, h) (((b) * 2 + (h)) * HTB)
#define PG8_SB(b, h) ((4 + (b) * 2 + (h)) * HTB)
#define PG8_STAGE(bufoff, gbase, voff) do { _Pragma("unroll") for (int _i = 0; _i < 2; ++_i) \
        __builtin_amdgcn_global_load_lds((const unsigned*)((const char*)(gbase) + (voff)[_i]), (LAS unsigned*)(lds + (bufoff) + ldsw + _i * 8192), 16, 0, 0); } while (0)
#define PG8_STAGE_A(bufoff, h, pA, offs) do { _Pragma("unroll") for (int _i = 0; _i < 2; ++_i) { const char* _p; \
        if constexpr (GATHER) _p = (const char*)(pA) + (offs)[h][_i]; else _p = (const char*)(pA) + (size_t)(h) * hstep + voffA[_i]; \
        __builtin_amdgcn_global_load_lds((const unsigned*)_p, (LAS unsigned*)(lds + (bufoff) + ldsw + _i * 8192), 16, 0, 0); } } while (0)
#define PG8_LDA(dst, b, h) do { _Pragma("unroll") for (int m = 0; m < 4; ++m) _Pragma("unroll") for (int k = 0; k < 2; ++k) dst[m][k] = *(const LAS bf16x8*)(lds + PG8_SA(b, h) + aoff + m * 2048 + k * 1024); } while (0)
#define PG8_LDB(dst, b, h) do { _Pragma("unroll") for (int n = 0; n < 2; ++n) _Pragma("unroll") for (int k = 0; k < 2; ++k) dst[n][k] = *(const LAS bf16x8*)(lds + PG8_SB(b, h) + boff + n * 2048 + k * 1024); } while (0)
#define PG8_MMA(ai, bj, At, Bt) do { __builtin_amdgcn_s_setprio(1); _Pragma("unroll") for (int m = 0; m < 4; ++m) _Pragma("unroll") for (int n = 0; n < 2; ++n) _Pragma("unroll") for (int k = 0; k < 2; ++k) \
        acc[ai][bj][m][n] = __builtin_amdgcn_mfma_f32_16x16x32_bf16(Bt[n][k], At[m][k], acc[ai][bj][m][n], 0, 0, 0); __builtin_amdgcn_s_setprio(0); } while (0)
#define PG8_WAIT_V(n) asm volatile("s_waitcnt vmcnt(" #n ")" ::: "memory")
#define PG8_WAIT_L(n) asm volatile("s_waitcnt lgkmcnt(" #n ")" ::: "memory")
#define PG8_BAR __builtin_amdgcn_s_barrier()
#define PG8_SCHED __builtin_amdgcn_sched_barrier(0)
    Unit cur, nxt; int ui = 0;
    if (!S.next(0, cur)) return;
    f32x4 acc[2][2][4][2];
#pragma unroll
    for (int a = 0; a < 2; ++a)
#pragma unroll
        for (int b = 0; b < 2; ++b)
#pragma unroll
            for (int m = 0; m < 4; ++m)
#pragma unroll
                for (int n = 0; n < 2; ++n) acc[a][b][m][n] = (f32x4){0.f, 0.f, 0.f, 0.f};
    bf16x8 At[4][2], B0[2][2], B1[2][2];
    unsigned oc[2][2] = {{0u, 0u}, {0u, 0u}}, on[2][2] = {{0u, 0u}, {0u, 0u}};
#define PG8_GOFF(dst, ui_) do { if constexpr (GATHER) { _Pragma("unroll") for (int _h = 0; _h < 2; ++_h) _Pragma("unroll") for (int _i = 0; _i < 2; ++_i) \
        dst[_h][_i] = (unsigned)idxl[(ui_) * BM + _h * HALF + RA[_i]] * (unsigned)(K * 2) + voffA[_i]; } } while (0)
    if constexpr (GATHER) {
        for (int i = 0; i < 16; ++i) { Unit uu; if (!S.next(i, uu)) break; if (tid < BM) idxl[i * BM + tid] = g.rowidx[uu.pm * BM + tid]; }
        __syncthreads();
    }
    PG8_GOFF(oc, 0);
    const char* cA = GATHER ? (const char*)g.A : (const char*)g.A + (size_t)cur.pm * tstep; const char* cB = (const char*)g.Bt + (size_t)cur.pn * tstep;
    PG8_STAGE(PG8_SB(0, 0), cB, voffB); PG8_STAGE(PG8_SB(0, 1), cB + hstep, voffB); PG8_STAGE_A(PG8_SA(0, 0), 0, cA, oc); PG8_STAGE_A(PG8_SA(0, 1), 1, cA, oc);
    if (wr == 1) PG8_BAR;
    PG8_WAIT_V(2); PG8_BAR;
    PG8_STAGE(PG8_SB(1, 0), cB + kstep, voffB); PG8_STAGE_A(PG8_SA(1, 0), 0, cA + kstep, oc); PG8_STAGE(PG8_SB(1, 1), cB + hstep + kstep, voffB);
    PG8_WAIT_V(6); PG8_BAR;
    for (;;) {
        const bool has_next = S.next(ui + 1, nxt);
        if (has_next) PG8_GOFF(on, ui + 1); else { if constexpr (GATHER) { on[0][0] = oc[0][0]; on[0][1] = oc[0][1]; on[1][0] = oc[1][0]; on[1][1] = oc[1][1]; } }
        const char* nA = GATHER ? (const char*)g.A : (has_next ? (const char*)g.A + (size_t)nxt.pm * tstep : cA);
        const char* nB = has_next ? (const char*)g.Bt + (size_t)nxt.pn * tstep : cB;
        for (int t = 0; t < nt; t += 2) {
            const bool last = (t == nt - 2);
            const char* a1 = cA + (size_t)(t + 1) * kstep;
            const char* a2 = last ? nA : cA + (size_t)(t + 2) * kstep; const char* b2 = last ? nB : cB + (size_t)(t + 2) * kstep;
            const char* a3 = a2 + kstep; const char* b3 = b2 + kstep;
            unsigned o2[2][2];
#pragma unroll
            for (int _h = 0; _h < 2; ++_h)
#pragma unroll
                for (int _i = 0; _i < 2; ++_i) o2[_h][_i] = last ? on[_h][_i] : oc[_h][_i];
            PG8_LDB(B0, 0, 0); PG8_LDB(B1, 0, 1); PG8_SCHED; PG8_LDA(At, 0, 0); PG8_STAGE_A(PG8_SA(1, 1), 1, a1, oc);
            PG8_WAIT_V(8); PG8_WAIT_L(0); PG8_BAR; PG8_MMA(0, 0, At, B0); PG8_MMA(0, 1, At, B1); PG8_BAR; PG8_SCHED;
            PG8_LDA(At, 0, 1); PG8_STAGE(PG8_SB(0, 0), b2, voffB); PG8_STAGE(PG8_SB(0, 1), b2 + hstep, voffB); PG8_STAGE_A(PG8_SA(0, 0), 0, a2, o2);
            PG8_WAIT_V(8); PG8_WAIT_L(0); PG8_BAR; PG8_MMA(1, 0, At, B0); PG8_MMA(1, 1, At, B1); PG8_BAR; PG8_SCHED;
            PG8_LDB(B0, 1, 0); PG8_LDB(B1, 1, 1); PG8_SCHED; PG8_LDA(At, 1, 0); PG8_STAGE_A(PG8_SA(0, 1), 1, a2, o2);
            PG8_WAIT_V(8); PG8_WAIT_L(0); PG8_BAR; PG8_MMA(0, 0, At, B0); PG8_MMA(0, 1, At, B1); PG8_BAR; PG8_SCHED;
            PG8_LDA(At, 1, 1); PG8_STAGE(PG8_SB(1, 0), b3, voffB); PG8_STAGE(PG8_SB(1, 1), b3 + hstep, voffB); PG8_STAGE_A(PG8_SA(1, 0), 0, a3, o2);
            PG8_WAIT_V(8); PG8_WAIT_L(0); PG8_BAR; PG8_MMA(1, 0, At, B0); PG8_MMA(1, 1, At, B1); PG8_BAR; PG8_SCHED;
        }
        if (wr == 0) PG8_BAR;
        if constexpr (!NOEPI) E(acc, cur, wr, wc, fr, fq); else { float d_ = 0.f; _Pragma("unroll") for (int a_ = 0; a_ < 2; ++a_) _Pragma("unroll") for (int b_ = 0; b_ < 2; ++b_) _Pragma("unroll") for (int m_ = 0; m_ < 4; ++m_) _Pragma("unroll") for (int n_ = 0; n_ < 2; ++n_) d_ += acc[a_][b_][m_][n_][0] + acc[a_][b_][m_][n_][3]; if (d_ == 1.2345e30f) ((float*)g.A)[0] = d_; }
#ifdef EXP_EPI2
        if constexpr (Epi::PERM && !GATHER && sizeof(Epi) == 16) { asm volatile("" ::: "memory"); E(acc, cur, wr, wc, fr, fq); }
#endif
        if (!has_next) break;
#pragma unroll
        for (int a = 0; a < 2; ++a)
#pragma unroll
            for (int b = 0; b < 2; ++b)
#pragma unroll
                for (int m = 0; m < 4; ++m)
#pragma unroll
                    for (int n = 0; n < 2; ++n) acc[a][b][m][n] = (f32x4){0.f, 0.f, 0.f, 0.f};
        cur = nxt; cA = nA; cB = nB; ++ui;
        if constexpr (GATHER) { oc[0][0] = on[0][0]; oc[0][1] = on[0][1]; oc[1][0] = on[1][0]; oc[1][1] = on[1][1]; }
        if (wr == 1) PG8_BAR;
    }
    PG8_WAIT_V(0);
    PG8_BAR;
#undef PG8_SA
#undef PG8_SB
#undef PG8_STAGE
#undef PG8_STAGE_A
#undef PG8_GOFF
#undef PG8_LDA
#undef PG8_LDB
#undef PG8_MMA
#undef PG8_WAIT_V
#undef PG8_WAIT_L
#undef PG8_BAR
#undef PG8_SCHED
}

__device__ __forceinline__ u32x4 pack8(const f32x4 a, const f32x4 b) { u32x4 w; w.x = cvt_pk_bf16(a[0], a[1]); w.y = cvt_pk_bf16(a[2], a[3]); w.z = cvt_pk_bf16(b[0], b[1]); w.w = cvt_pk_bf16(b[2], b[3]); return w; }

struct EpiInProj {
    static constexpr bool PERM = true;
    bf16_t* P; const float* rope;
    unsigned* kmax;
    __device__ __forceinline__ void operator()(const f32x4 (&acc)[2][2][4][2], const Unit& u, int wr, int wc, int fr, int fq) const {
        const int pn = u.pn; const bool lat = u.pm < (NLAT / 256);
        const int kind = (pn >= 6 && pn <= 9) ? 2 : (((pn >= 12 && pn <= 15) || (pn >= 20 && pn <= 22)) ? 1 : 0);
        const int row0 = u.pm * BM + wr * 64 + fr;
        if (kind == 0) {
            const int col0 = pn * 256 + wc * 32 + 8 * fq;
#pragma unroll
            for (int ai = 0; ai < 2; ++ai)
#pragma unroll
                for (int m = 0; m < 4; ++m) { bf16_t* rowp = P + (size_t)(row0 + ai * HALF + m * 16) * INW + col0;
#pragma unroll
                    for (int bj = 0; bj < 2; ++bj) *(u32x4*)(rowp + bj * HALF) = pack8(acc[ai][bj][m][0], acc[ai][bj][m][1]); }
        } else {
            const bool k1 = kind == 1; const int nf = k1 ? 32 : 16, pstep = k1 ? 32 : 16;
            const int cu1 = k1 ? pn * 256 + (wc >> 1) * 128 + (wc & 1) * 64 + 8 * fq : pn * 256 + wc * 64 + (fq >> 1) * 32 + 8 * (fq & 1);
            const int i0 = k1 ? 8 * fq : 8 * (fq & 1); const bool colp = k1 ? ((wc & 1) != 0) : ((fq >> 1) != 0);
            const float* TC = k1 ? rope : rope + 2 * 256 * 32; const float* TS = TC + 256 * nf;
            const int trow0 = ((u.pm * BM) & (SEQ - 1)) / 64 + wr;
            f32x4 nc0, nc1, ns0, ns1; float kq = 0.f;
#define RP_LOAD(g_) do { const int pos_ = colp ? (fr + 16 * ((g_) & 3)) : (trow0 + 2 * ((g_) >> 2)); const float* pc_ = TC + pos_ * nf + i0; const float* ps_ = TS + pos_ * nf + i0; \
                nc0 = *(const f32x4*)(pc_); nc1 = *(const f32x4*)(pc_ + 4); ns0 = *(const f32x4*)(ps_); ns1 = *(const f32x4*)(ps_ + 4); } while (0)
            if (lat) RP_LOAD(0);
#pragma unroll
            for (int gidx = 0; gidx < 8; ++gidx) { const int ai = gidx >> 2, m = gidx & 3; const int row = row0 + ai * HALF + m * 16;
                f32x4 a0 = acc[ai][0][m][0], a1 = acc[ai][0][m][1], b0 = acc[ai][1][m][0], b1 = acc[ai][1][m][1];
                if (lat) { const f32x4 c0 = nc0, c1 = nc1, s0 = ns0, s1 = ns1;
                    if (gidx < 7) RP_LOAD(gidx + 1);
                    const f32x4 x0 = a0 * c0 - b0 * s0, x1 = a1 * c1 - b1 * s1, y0 = b0 * c0 + a0 * s0, y1 = b1 * c1 + a1 * s1; a0 = x0; a1 = x1; b0 = y0; b1 = y1; }
                bf16_t* rowp = P + (size_t)row * INW + cu1;
                const u32x4 w0 = pack8(a0, a1), w1 = pack8(b0, b1); *(u32x4*)(rowp) = w0; *(u32x4*)(rowp + pstep) = w1;
                if (pn == 8 || pn == 9) {
                    float q2 = bflo(w0.x) * bflo(w0.x) + bfhi(w0.x) * bfhi(w0.x) + bflo(w0.y) * bflo(w0.y) + bfhi(w0.y) * bfhi(w0.y) + bflo(w0.z) * bflo(w0.z) + bfhi(w0.z) * bfhi(w0.z) + bflo(w0.w) * bflo(w0.w) + bfhi(w0.w) * bfhi(w0.w)
                             + bflo(w1.x) * bflo(w1.x) + bfhi(w1.x) * bfhi(w1.x) + bflo(w1.y) * bflo(w1.y) + bfhi(w1.y) * bfhi(w1.y) + bflo(w1.z) * bflo(w1.z) + bfhi(w1.z) * bfhi(w1.z) + bflo(w1.w) * bflo(w1.w) + bfhi(w1.w) * bfhi(w1.w);
                    q2 += xshf<16>(q2); { auto rr = __builtin_amdgcn_permlane32_swap(__float_as_uint(q2), __float_as_uint(q2), false, false); q2 = __uint_as_float(rr[0]) + __uint_as_float(rr[1]); }
                    kq = fmaxf(kq, q2); } }
            if (pn == 8 || pn == 9) {
                kq = fmaxf(kq, xshf<1>(kq)); kq = fmaxf(kq, xshf<2>(kq)); kq = fmaxf(kq, xshf<4>(kq)); kq = fmaxf(kq, xshf<8>(kq));
                if (fr == 0 && fq == 0) __hip_atomic_fetch_max(kmax + (lat ? (u.pm >> 6) : (u.pm - NLAT / 256)) * 8 + (pn - 8) * 4 + wc, __float_as_uint(kq), __ATOMIC_RELAXED, __HIP_MEMORY_SCOPE_AGENT); }
#undef RP_LOAD
        }
    }
};
struct EpiOutProj {
    static constexpr bool PERM = true;
    const float* xin_f32; const bf16_t* xin_bf; bf16_t* xout_bf; const float* xin_ctx; float* xout_ctx; const float* modl;
    __device__ __forceinline__ void operator()(const f32x4 (&acc)[2][2][4][2], const Unit& u, int wr, int wc, int fr, int fq) const {
        const bool lat = u.pm < (NLAT / 256); const int v = lat ? (u.pm >> 6) : 2;
        const float* g1 = modl + v * 12288 + 2 * DM;
        const int rloc = (lat ? u.pm : (u.pm - NLAT / 256)) * BM + wr * 64 + fr; const int col0 = u.pn * BM + wc * 32 + 8 * fq;
        f32x4 gv[2][2];
#pragma unroll
        for (int bj = 0; bj < 2; ++bj)
#pragma unroll
            for (int n = 0; n < 2; ++n) gv[bj][n] = *(const f32x4*)(g1 + col0 + bj * HALF + 4 * n);
        if (lat && xin_f32 == nullptr) {
#pragma unroll
            for (int ai = 0; ai < 2; ++ai) { u32x4 x[4][2];
#pragma unroll
                for (int m = 0; m < 4; ++m)
#pragma unroll
                    for (int bj = 0; bj < 2; ++bj) x[m][bj] = *(const u32x4*)(xin_bf + (size_t)(rloc + ai * HALF + m * 16) * DM + col0 + bj * HALF);
#pragma unroll
                for (int m = 0; m < 4; ++m)
#pragma unroll
                    for (int bj = 0; bj < 2; ++bj) { asm volatile("" : "+v"(x[m][bj])); const u32x4 w = x[m][bj];
                        const f32x4 x0 = (f32x4){bflo(w.x), bfhi(w.x), bflo(w.y), bfhi(w.y)}, x1 = (f32x4){bflo(w.z), bfhi(w.z), bflo(w.w), bfhi(w.w)};
                        *(u32x4*)(xout_bf + (size_t)(rloc + ai * HALF + m * 16) * DM + col0 + bj * HALF) = pack8(x0 + gv[bj][0] * acc[ai][bj][m][0], x1 + gv[bj][1] * acc[ai][bj][m][1]); }
            }
        } else {
            const float* xi = lat ? xin_f32 : xin_ctx;
#pragma unroll
            for (int ai = 0; ai < 2; ++ai) { f32x4 x[4][2][2];
#pragma unroll
                for (int m = 0; m < 4; ++m)
#pragma unroll
                    for (int bj = 0; bj < 2; ++bj)
#pragma unroll
                        for (int n = 0; n < 2; ++n) x[m][bj][n] = *(const f32x4*)(xi + (size_t)(rloc + ai * HALF + m * 16) * DM + col0 + bj * HALF + 4 * n);
#pragma unroll
                for (int m = 0; m < 4; ++m)
#pragma unroll
                    for (int bj = 0; bj < 2; ++bj) { asm volatile("" : "+v"(x[m][bj][0]), "+v"(x[m][bj][1]));
                        const f32x4 y0 = x[m][bj][0] + gv[bj][0] * acc[ai][bj][m][0], y1 = x[m][bj][1] + gv[bj][1] * acc[ai][bj][m][1]; const size_t off = (size_t)(rloc + ai * HALF + m * 16) * DM + col0 + bj * HALF;
                        if (lat) *(u32x4*)(xout_bf + off) = pack8(y0, y1); else { *(f32x4*)(xout_ctx + off) = y0; *(f32x4*)(xout_ctx + off + 4) = y1; } }
            }
        }
    }
};
struct EpiSwiGLU {
    static constexpr bool PERM = true;
    bf16_t* ACT;
    __device__ __forceinline__ void operator()(const f32x4 (&acc)[2][2][4][2], const Unit& u, int wr, int wc, int fr, int fq) const {
        const int pnl = u.pn & 7; const int row0 = u.pm * BM + wr * 64 + fr; const int col0 = pnl * 128 + wc * 32 + 8 * fq;
#pragma unroll
        for (int ai = 0; ai < 2; ++ai)
#pragma unroll
            for (int m = 0; m < 4; ++m) { f32x4 o[2];
#pragma unroll
                for (int n = 0; n < 2; ++n) { const f32x4 gt = acc[ai][0][m][n], up = acc[ai][1][m][n];
#pragma unroll
                    for (int j = 0; j < 4; ++j) o[n][j] = gt[j] * __builtin_amdgcn_rcpf(1.0f + __builtin_amdgcn_exp2f(-gt[j] * LOG2E)) * up[j]; }
                *(u32x4*)(ACT + (size_t)(row0 + ai * HALF + m * 16) * FF + col0) = pack8(o[0], o[1]); }
    }
};
struct EpiDown {
    static constexpr bool PERM = true;
    bf16_t* Y; const float* gatev;
    __device__ __forceinline__ void operator()(const f32x4 (&acc)[2][2][4][2], const Unit& u, int wr, int wc, int fr, int fq) const {
        const int pnl = u.pn & 7; const int row0 = u.pm * BM + wr * 64 + fr; const int col0 = pnl * 256 + wc * 32 + 8 * fq;
        float gs[2][4];
#pragma unroll
        for (int ai = 0; ai < 2; ++ai)
#pragma unroll
            for (int m = 0; m < 4; ++m) gs[ai][m] = gatev[row0 + ai * HALF + m * 16];
#pragma unroll
        for (int ai = 0; ai < 2; ++ai)
#pragma unroll
            for (int m = 0; m < 4; ++m) { asm volatile("" : "+v"(gs[ai][m]));
#pragma unroll
                for (int bj = 0; bj < 2; ++bj) *(u32x4*)(Y + (size_t)(row0 + ai * HALF + m * 16) * DM + col0 + bj * HALF) = pack8(acc[ai][bj][m][0] * gs[ai][m], acc[ai][bj][m][1] * gs[ai][m]); }
    }
};
}
namespace att {
constexpr int LDP = INW, LDOUT = DM, KVBLK = 64;
constexpr size_t SHM_V = KVBLK * 128 * 2, SHM_K = KVBLK * 128 * 2, SHM_ATTN = 2 * SHM_V + 2 * SHM_K + 8 * 64 * 4;
constexpr size_t QL_OFF = 73728, QL_STRIDE = 272;
constexpr size_t BIAS_OFF = SHM_ATTN;
constexpr float THR_L2 = 8.f * LOG2E;
#define KSWZ(row, colB) ((row) * 256 + ((colB) ^ (((row) & 7) << 4)))
#define SBAR() __builtin_amdgcn_sched_barrier(0)

struct Tiles { const bf16_t* kctx; const bf16_t* klat; long vdelta; int lat0, nt, nctx; };
struct MP {
    bool masked;
    int tq;
    int qr, rs, qc, cs;
    const LAS float* bias;
    float sink_l2;
    float lam, post;
    const float* normg;
};

__device__ __forceinline__ const bf16_t* tile_ptr(const Tiles& T, int j) { return (j < T.nctx) ? T.kctx + (long)j * KVBLK * LDP : T.klat + (long)(T.lat0 + j - T.nctx) * KVBLK * LDP; }

template <int MODE> __device__ __forceinline__ void apply_mask(f32x16& p0, f32x16& p1, int j, const Tiles& T, const MP& mp, int hi) {
  if constexpr (MODE == 1) return;
  if (!mp.masked || j < T.nctx) return;
  const int kt = T.lat0 + j - T.nctx;
  if constexpr (MODE == 2) {
    const int base = kt * KVBLK - mp.tq + 128;
#pragma unroll
    for (int r = 0; r < 16; ++r) { const int kk = crow(r, hi); if ((unsigned)(base + kk) > 256u) p0[r] = NEGBIG; if ((unsigned)(base + kk + 32) > 256u) p1[r] = NEGBIG; }
  }
  if constexpr (MODE == 0) {
    const bool rowok = (unsigned)(kt - mp.rs) < 8u; const LAS float* bp = mp.bias + ((kt - mp.qr + 7) * 31 + 15 - mp.qc + 4 * hi);
    const int t = rowok ? (4 * hi - mp.cs) : 0x40000000;
#pragma unroll
    for (int g = 0; g < 4; ++g) {
#pragma unroll
      for (int rr = 0; rr < 4; ++rr) { const int r = g * 4 + rr; const int c0 = (r & 3) + 8 * (r >> 2);
        const float b0 = bp[c0], b1 = bp[c0 + 32];
        p0[r] = ((unsigned)(t + c0) < 16u) ? p0[r] + b0 : NEGBIG; p1[r] = ((unsigned)(t + c0 + 32) < 16u) ? p1[r] + b1 : NEGBIG; }
      asm volatile("" ::: "memory");
    }
  }
}
template <int MODE> __device__ __forceinline__ void partialSM(f32x16& p0, f32x16& p1, float& m_reg, float& mn, float& alpha, int j, const Tiles& T, const MP& mp, int hi) {
  apply_mask<MODE>(p0, p1, j, T, mp, hi);
  float pmax = p0[0];
#pragma unroll
  for (int r = 1; r < 16; ++r) pmax = fmaxf(pmax, p0[r]);
#pragma unroll
  for (int r = 0; r < 16; ++r) pmax = fmaxf(pmax, p1[r]);
  { auto rr = __builtin_amdgcn_permlane32_swap(__float_as_uint(pmax), __float_as_uint(pmax), false, false);
    pmax = fmaxf(__uint_as_float(rr[0]), __uint_as_float(rr[1])); }
  if (__builtin_expect(__all(pmax - m_reg <= THR_L2), 1)) { mn = m_reg; alpha = 1.f; }
  else { mn = fmaxf(m_reg, pmax); alpha = __builtin_amdgcn_exp2f(m_reg - mn); m_reg = mn; }
#pragma unroll
  for (int r = 0; r < 16; ++r) p0[r] = p0[r] - mn;
#pragma unroll
  for (int r = 0; r < 16; ++r) p1[r] = p1[r] - mn;
#pragma unroll
  for (int r = 0; r < 16; ++r) p0[r] = __builtin_amdgcn_exp2f(p0[r]);
}
__device__ __forceinline__ void finishSM(f32x16& p0, f32x16& p1, float alpha, float& l_reg, bf16x8& pa0, bf16x8& pa1, bf16x8& pa2, bf16x8& pa3) {
#pragma unroll
  for (int r = 0; r < 16; ++r) p1[r] = __builtin_amdgcn_exp2f(p1[r]);
  float ps = 0;
#pragma unroll
  for (int r = 0; r < 16; ++r) ps += p0[r];
#pragma unroll
  for (int r = 0; r < 16; ++r) ps += p1[r];
  { auto rr = __builtin_amdgcn_permlane32_swap(__float_as_uint(ps), __float_as_uint(ps), false, false);
    ps = __uint_as_float(rr[0]) + __uint_as_float(rr[1]); }
  l_reg = l_reg * alpha + ps;
#define PK4(P, BASE, OUT) do { unsigned a0 = cvt_pk_bf16(P[BASE + 0], P[BASE + 1]), a1 = cvt_pk_bf16(P[BASE + 2], P[BASE + 3]);   \
    unsigned b0 = cvt_pk_bf16(P[BASE + 4], P[BASE + 5]), b1 = cvt_pk_bf16(P[BASE + 6], P[BASE + 7]);                              \
    auto r0 = __builtin_amdgcn_permlane32_swap(a0, b0, false, false); auto r1 = __builtin_amdgcn_permlane32_swap(a1, b1, false, false); \
    u32x4 w = {r0[0], r1[0], r0[1], r1[1]}; OUT = *reinterpret_cast<bf16x8*>(&w); } while (0)
  PK4(p0, 0, pa0); PK4(p0, 8, pa1); PK4(p1, 0, pa2); PK4(p1, 8, pa3);
#undef PK4
}
template <int NQ> __device__ __forceinline__ void qkt(f32x16& p0, f32x16& p1, const char* Ks, const bf16x8* qr, int r32, int hi, int cboff) {
  p0 = f32x16{}; p1 = f32x16{};
#pragma unroll
  for (int d0 = 0; d0 < NQ; ++d0) { const int cb = (d0 * 16 + hi * 8) * 2 + cboff;
    bf16x8 b0 = *reinterpret_cast<const bf16x8*>(Ks + KSWZ(r32, cb));
    bf16x8 b1 = *reinterpret_cast<const bf16x8*>(Ks + KSWZ(32 + r32, cb));
    p0 = __builtin_amdgcn_mfma_f32_32x32x16_bf16(b0, qr[d0], p0, 0, 0, 0);
    p1 = __builtin_amdgcn_mfma_f32_32x32x16_bf16(b1, qr[d0], p1, 0, 0, 0); }
}
__device__ __forceinline__ int v_st(int k, int c) { const int kk = (k & ~0xC) | ((k & 4) << 1) | ((k & 8) >> 1); return ((kk >> 3) * 4 + (c >> 5)) * 512 + ((kk & 7) * 32 + (c & 31)) * 2; }
__device__ __forceinline__ int v_rd_base(int lane) { return ((lane & 3) << 3) | (((lane >> 2) & 3) << 6) | (((lane >> 4) & 1) << 5) | (((lane >> 5) & 1) << 8); }
constexpr int v_rd_off(int d0, int ks, int half) { return d0 * 512 + ks * 4096 + half * 2048; }
template <int OFF> __device__ __forceinline__ s16x4 tr_read(int vb) {
  s16x4 r; asm volatile("ds_read_b64_tr_b16 %0, %1 offset:%2" : "=&v"(r) : "v"(vb), "i"(OFF) : "memory"); return r;
}
template <int D0> __device__ __forceinline__ void pv_one(f32x16& od, int vb, bf16x8 pa0, bf16x8 pa1, bf16x8 pa2, bf16x8 pa3) {
  const s16x4 l0 = tr_read<v_rd_off(D0, 0, 0)>(vb), h0 = tr_read<v_rd_off(D0, 0, 1)>(vb), l1 = tr_read<v_rd_off(D0, 1, 0)>(vb), h1 = tr_read<v_rd_off(D0, 1, 1)>(vb);
  const s16x4 l2 = tr_read<v_rd_off(D0, 2, 0)>(vb), h2 = tr_read<v_rd_off(D0, 2, 1)>(vb), l3 = tr_read<v_rd_off(D0, 3, 0)>(vb), h3 = tr_read<v_rd_off(D0, 3, 1)>(vb);
  asm volatile("s_waitcnt lgkmcnt(0)" ::: "memory"); SBAR();
#define PK(L, H) (bf16x8){L[0], L[1], L[2], L[3], H[0], H[1], H[2], H[3]}
  od = __builtin_amdgcn_mfma_f32_32x32x16_bf16(pa0, PK(l0, h0), od, 0, 0, 0);
  od = __builtin_amdgcn_mfma_f32_32x32x16_bf16(pa1, PK(l1, h1), od, 0, 0, 0);
  od = __builtin_amdgcn_mfma_f32_32x32x16_bf16(pa2, PK(l2, h2), od, 0, 0, 0);
  od = __builtin_amdgcn_mfma_f32_32x32x16_bf16(pa3, PK(l3, h3), od, 0, 0, 0);
#undef PK
}
__device__ __forceinline__ void pv_d0(f32x16* o, int vb, bf16x8 pa0, bf16x8 pa1, bf16x8 pa2, bf16x8 pa3) {
  pv_one<0>(o[0], vb, pa0, pa1, pa2, pa3); pv_one<1>(o[1], vb, pa0, pa1, pa2, pa3); pv_one<2>(o[2], vb, pa0, pa1, pa2, pa3); pv_one<3>(o[3], vb, pa0, pa1, pa2, pa3);
}

template <int MODE>
__device__ __forceinline__ void attn_unit_simple(const bf16_t* __restrict__ Qrow0, const Tiles T, bf16_t* __restrict__ Orow0, const MP mp, char* lds, const int tid) {
  const int wid = tid >> 6, lane = tid & 63, r32 = lane & 31, hi = lane >> 5;
  char* V_lds = lds; char* K_lds = lds + 2 * SHM_V;
  float* wsf = (float*)(lds + 2 * SHM_V + 2 * SHM_K) + wid * 64; float* li_l = wsf; float* al_l = wsf + 32;
  float m_reg = NEGBIG, l_reg = 0; f32x16 o[4] = {};
  const int sr = tid >> 4, sc = (tid & 15) * 8, vst0 = v_st(sr, sc), kst0 = KSWZ(sr, sc * 2);
  const int vb0 = (int)(uintptr_t)V_lds + v_rd_base(lane);
  const char* Qr = lds + QL_OFF + (wid * 32 + r32) * QL_STRIDE + hi * 16;
  bf16x8 vs0, vs1, ks0, ks1;
#define SLOAD1(j_) do { const bf16_t* kp_ = tile_ptr(T, (j_)) + (long)sr * LDP + sc; \
    vs0 = *reinterpret_cast<const bf16x8*>(kp_ + T.vdelta); vs1 = *reinterpret_cast<const bf16x8*>(kp_ + T.vdelta + 32L * LDP); \
    ks0 = *reinterpret_cast<const bf16x8*>(kp_); ks1 = *reinterpret_cast<const bf16x8*>(kp_ + 32L * LDP); } while (0)
#define SWRITE1(b) do { *(bf16x8*)(V_lds + (b) * SHM_V + vst0) = vs0; *(bf16x8*)(V_lds + (b) * SHM_V + vst0 + 8192) = vs1; \
    *(bf16x8*)(K_lds + (b) * SHM_K + kst0) = ks0; *(bf16x8*)(K_lds + (b) * SHM_K + kst0 + 8192) = ks1; } while (0)
  const int NT = T.nt;
  __syncthreads();
#pragma unroll
  for (int p = 0; p < 8; ++p) { const int idx = tid + 512 * p; *(bf16x8*)(lds + QL_OFF + (idx >> 4) * QL_STRIDE + (idx & 15) * 16) = *reinterpret_cast<const bf16x8*>(Qrow0 + (long)(idx >> 4) * LDP + (idx & 15) * 8); }
  SLOAD1(0); SWRITE1(0); __syncthreads();
  for (int j = 0; j < NT; ++j) {
    const int buf = j & 1;
    if (j + 1 < NT) SLOAD1(j + 1);
    bool live = true;
    if (mp.masked && j >= T.nctx) { const int kt = T.lat0 + j - T.nctx;
      if constexpr (MODE == 0) live = (unsigned)(kt - mp.rs) < 8u;
      if constexpr (MODE == 2) { const int q0w = __builtin_amdgcn_readfirstlane(mp.tq - r32); live = (kt * KVBLK + 63 >= q0w - 128) && (kt * KVBLK <= q0w + 31 + 128); } }
    if (live) {
    f32x16 p0, p1; float mn, al; bf16x8 pa0, pa1, pa2, pa3;
    { p0 = f32x16{}; p1 = f32x16{}; const char* Ks = K_lds + buf * SHM_K;
#pragma unroll
      for (int d0 = 0; d0 < 8; ++d0) { const int cb = (d0 * 16 + hi * 8) * 2; const bf16x8 q = *reinterpret_cast<const bf16x8*>(Qr + d0 * 32);
        const bf16x8 b0 = *reinterpret_cast<const bf16x8*>(Ks + KSWZ(r32, cb)), b1 = *reinterpret_cast<const bf16x8*>(Ks + KSWZ(32 + r32, cb));
        p0 = __builtin_amdgcn_mfma_f32_32x32x16_bf16(b0, q, p0, 0, 0, 0); p1 = __builtin_amdgcn_mfma_f32_32x32x16_bf16(b1, q, p1, 0, 0, 0); } }
    partialSM<MODE>(p0, p1, m_reg, mn, al, j, T, mp, hi);
    if (__any(al < 1.f)) { if (hi == 0) al_l[r32] = al; asm volatile("s_waitcnt lgkmcnt(0)" ::: "memory");
#pragma unroll
      for (int d = 0; d < 4; ++d)
#pragma unroll
        for (int r = 0; r < 16; ++r) o[d][r] *= al_l[crow(r, hi)]; }
    finishSM(p0, p1, al, l_reg, pa0, pa1, pa2, pa3);
    pv_d0(o, vb0 + buf * (int)SHM_V, pa0, pa1, pa2, pa3);
    }
    if (j + 1 < NT) SWRITE1(buf ^ 1);
    __syncthreads();
  }
  if constexpr (MODE == 2) l_reg += __builtin_amdgcn_exp2f(mp.sink_l2 - m_reg);
  if (hi == 0) li_l[r32] = l_reg; asm volatile("s_waitcnt lgkmcnt(0)" ::: "memory");
  bf16_t* Ow = Orow0 + (long)(wid * 32) * LDOUT;
#pragma unroll
  for (int r = 0; r < 16; ++r) { const int orow = crow(r, hi); const float rl = __builtin_amdgcn_rcpf(li_l[orow]);
#pragma unroll
    for (int d0 = 0; d0 < 4; ++d0) Ow[(long)orow * LDOUT + d0 * 32 + r32] = f2bf(o[d0][r] * rl); }
#undef SLOAD1
#undef SWRITE1
}
__device__ __forceinline__ void qktB(f32x16& p0, f32x16& p1, const char* Ks, const bf16x8* qr, int r32, int hi, int cboff, const f32x16& nb) {
  { const int cb = (hi * 8) * 2 + cboff;
    bf16x8 b0 = *reinterpret_cast<const bf16x8*>(Ks + KSWZ(r32, cb)), b1 = *reinterpret_cast<const bf16x8*>(Ks + KSWZ(32 + r32, cb));
    p0 = __builtin_amdgcn_mfma_f32_32x32x16_bf16(b0, qr[0], nb, 0, 0, 0); p1 = __builtin_amdgcn_mfma_f32_32x32x16_bf16(b1, qr[0], nb, 0, 0, 0); }
#pragma unroll
  for (int d0 = 1; d0 < 4; ++d0) { const int cb = (d0 * 16 + hi * 8) * 2 + cboff;
    bf16x8 b0 = *reinterpret_cast<const bf16x8*>(Ks + KSWZ(r32, cb)), b1 = *reinterpret_cast<const bf16x8*>(Ks + KSWZ(32 + r32, cb));
    p0 = __builtin_amdgcn_mfma_f32_32x32x16_bf16(b0, qr[d0], p0, 0, 0, 0); p1 = __builtin_amdgcn_mfma_f32_32x32x16_bf16(b1, qr[d0], p1, 0, 0, 0); }
}
__device__ __forceinline__ void expA(f32x16& p0) {
#pragma unroll
  for (int r = 0; r < 16; ++r) p0[r] = __builtin_amdgcn_exp2f(p0[r]);
}
__device__ __forceinline__ void finishB(f32x16& p0, f32x16& p1, float& l_reg, bf16x8& pa0, bf16x8& pa1, bf16x8& pa2, bf16x8& pa3) {
#pragma unroll
  for (int r = 0; r < 16; ++r) p1[r] = __builtin_amdgcn_exp2f(p1[r]);
  float ps = 0;
#pragma unroll
  for (int r = 0; r < 16; ++r) ps += p0[r];
#pragma unroll
  for (int r = 0; r < 16; ++r) ps += p1[r];
  l_reg += ps;
#define PK4(P, BASE, OUT) do { unsigned a0 = cvt_pk_bf16(P[BASE + 0], P[BASE + 1]), a1 = cvt_pk_bf16(P[BASE + 2], P[BASE + 3]);   \
    unsigned b0 = cvt_pk_bf16(P[BASE + 4], P[BASE + 5]), b1 = cvt_pk_bf16(P[BASE + 6], P[BASE + 7]);                              \
    auto r0 = __builtin_amdgcn_permlane32_swap(a0, b0, false, false); auto r1 = __builtin_amdgcn_permlane32_swap(a1, b1, false, false); \
    u32x4 w = {r0[0], r1[0], r0[1], r1[1]}; OUT = *reinterpret_cast<bf16x8*>(&w); } while (0)
  PK4(p0, 0, pa0); PK4(p0, 8, pa1); PK4(p1, 0, pa2); PK4(p1, 8, pa3);
#undef PK4
}

typedef short v4i16_t __attribute__((ext_vector_type(4)));
__device__ __forceinline__ s16x4 vtr(int addr) { return __builtin_bit_cast(s16x4, __builtin_amdgcn_ds_read_tr16_b64_v4i16((LAS v4i16_t*)(uintptr_t)(unsigned)addr)); }
template <int D0> __device__ __forceinline__ void pv_one_v(f32x16& od, int vb, bf16x8 pa0, bf16x8 pa1, bf16x8 pa2, bf16x8 pa3) {
  const s16x4 l0 = vtr(vb + v_rd_off(D0, 0, 0)), h0 = vtr(vb + v_rd_off(D0, 0, 1)), l1 = vtr(vb + v_rd_off(D0, 1, 0)), h1 = vtr(vb + v_rd_off(D0, 1, 1));
  const s16x4 l2 = vtr(vb + v_rd_off(D0, 2, 0)), h2 = vtr(vb + v_rd_off(D0, 2, 1)), l3 = vtr(vb + v_rd_off(D0, 3, 0)), h3 = vtr(vb + v_rd_off(D0, 3, 1));
#define PK(L, H) (bf16x8){L[0], L[1], L[2], L[3], H[0], H[1], H[2], H[3]}
  od = __builtin_amdgcn_mfma_f32_32x32x16_bf16(pa0, PK(l0, h0), od, 0, 0, 0);
  od = __builtin_amdgcn_mfma_f32_32x32x16_bf16(pa1, PK(l1, h1), od, 0, 0, 0);
  od = __builtin_amdgcn_mfma_f32_32x32x16_bf16(pa2, PK(l2, h2), od, 0, 0, 0);
  od = __builtin_amdgcn_mfma_f32_32x32x16_bf16(pa3, PK(l3, h3), od, 0, 0, 0);
#undef PK
}
__device__ __forceinline__ void pv_d0_v(f32x16* o, int vb, bf16x8 pa0, bf16x8 pa1, bf16x8 pa2, bf16x8 pa3) {
  pv_one_v<0>(o[0], vb, pa0, pa1, pa2, pa3); pv_one_v<1>(o[1], vb, pa0, pa1, pa2, pa3); pv_one_v<2>(o[2], vb, pa0, pa1, pa2, pa3); pv_one_v<3>(o[3], vb, pa0, pa1, pa2, pa3);
}
__device__ __forceinline__ void glds16(const void* g, unsigned lds_base) {
    unsigned sv; asm volatile("s_mov_b32 %0, m0\n\ts_mov_b32 m0, %2\n\ts_nop 0\n\tglobal_load_lds_dwordx4 %1, off\n\ts_mov_b32 m0, %0" : "=&s"(sv) : "v"(g), "s"(lds_base) : "memory"); }
__device__ __forceinline__ void glds16s(const void* gbase, unsigned voff, unsigned lds_base) {
    unsigned sv; asm volatile("s_mov_b32 %0, m0\n\ts_mov_b32 m0, %3\n\ts_nop 0\n\tglobal_load_lds_dwordx4 %1, %2\n\ts_mov_b32 m0, %0" : "=&s"(sv) : "v"(voff), "s"(gbase), "s"(lds_base) : "memory"); }
__device__ __forceinline__ int v_st_u(int k, int c) { return ((k >> 3) * 4 + (c >> 5)) * 512 + ((k & 7) * 32 + (c & 31)) * 2; }
__device__ __forceinline__ void attn_unit_a2(const bf16_t* __restrict__ Qrow0, const Tiles T, bf16_t* __restrict__ Orow0, const bool masked, const LAS float* bias, const int qr0, char* lds, const int tid) {
  const int wid = __builtin_amdgcn_readfirstlane(tid >> 6), lane = tid & 63, r32 = lane & 31, hi = lane >> 5;
  char* V_lds = lds; char* K_lds = lds + 2 * SHM_V;
  float* wsf = (float*)(lds + 2 * SHM_V + 2 * SHM_K) + wid * 64; float* li_l = wsf; float* al_l = wsf + 32;
  const int rp = wid >> 2, cbk = wid & 3;
  const int qloc = (2 * rp + (r32 >> 4)) * 64 + 16 * cbk + (r32 & 15);
  const int qr = qr0 + 2 * rp + (r32 >> 4), qc = 16 * cbk + (r32 & 15);
  const int rs = qr - 4 < 0 ? 0 : (qr - 4 > 248 ? 248 : qr - 4), cs = qc - 8 < 0 ? 0 : (qc - 8 > 48 ? 48 : qc - 8);
  const int kb = 16 * cbk - 8 < 0 ? 0 : (16 * cbk - 8 > 32 ? 32 : 16 * cbk - 8);
  const int rsa = (qr0 + 2 * rp - 4) < 0 ? 0 : ((qr0 + 2 * rp - 4) > 248 ? 248 : (qr0 + 2 * rp - 4)), rsb = (qr0 + 2 * rp - 3) < 0 ? 0 : ((qr0 + 2 * rp - 3) > 248 ? 248 : (qr0 + 2 * rp - 3));
  float m_reg = NEGBIG, l_reg = 0; f32x16 o[4] = {};
  const int sr = tid >> 4, sc = (tid & 15) * 8, vst0 = v_st_u(sr, sc), kst0 = KSWZ(sr, sc * 2);
  const int vb0 = (int)(uintptr_t)V_lds + v_rd_base(lane);
  const char* Qr = lds + QL_OFF + qloc * QL_STRIDE + hi * 16;
  bf16x8 vs0, vs1, ks0, ks1;
#define SLOAD1(j_) do { const bf16_t* kp_ = tile_ptr(T, (j_)) + (long)sr * LDP + sc; \
    vs0 = *reinterpret_cast<const bf16x8*>(kp_ + T.vdelta); vs1 = *reinterpret_cast<const bf16x8*>(kp_ + T.vdelta + 32L * LDP); \
    ks0 = *reinterpret_cast<const bf16x8*>(kp_); ks1 = *reinterpret_cast<const bf16x8*>(kp_ + 32L * LDP); } while (0)
#define SWRITE1(b) do { *(bf16x8*)(V_lds + (b) * SHM_V + vst0) = vs0; *(bf16x8*)(V_lds + (b) * SHM_V + vst0 + 8192) = vs1; \
    *(bf16x8*)(K_lds + (b) * SHM_K + kst0) = ks0; *(bf16x8*)(K_lds + (b) * SHM_K + kst0 + 8192) = ks1; } while (0)
  const int NT = T.nt;
  __syncthreads();
#pragma unroll
  for (int p = 0; p < 8; ++p) { const int idx = tid + 512 * p; *(bf16x8*)(lds + QL_OFF + (idx >> 4) * QL_STRIDE + (idx & 15) * 16) = *reinterpret_cast<const bf16x8*>(Qrow0 + (long)(idx >> 4) * LDP + (idx & 15) * 8); }
  SLOAD1(0); SWRITE1(0); __syncthreads();
  for (int j = 0; j < NT; ++j) {
    const int buf = j & 1;
    if (j + 1 < NT) SLOAD1(j + 1);
    const bool ctxt = j < T.nctx; const int kr = T.lat0 + j - T.nctx;
    const bool live = ctxt || !masked || ((unsigned)(kr - rsa) < 8u) || ((unsigned)(kr - rsb) < 8u);
    if (live) {
      const int nblk = (ctxt || !masked) ? 2 : 1;
      for (int blk = 0; blk < nblk; ++blk) {
        const int kbb = (ctxt || !masked) ? 32 * blk : kb;
        f32x16 p = {}; const char* Ks = K_lds + buf * SHM_K;
#pragma unroll
        for (int d0 = 0; d0 < 8; ++d0) { const int cb = (d0 * 16 + hi * 8) * 2; const bf16x8 q = *reinterpret_cast<const bf16x8*>(Qr + d0 * 32);
          const bf16x8 b0 = *reinterpret_cast<const bf16x8*>(Ks + KSWZ(kbb + r32, cb)); p = __builtin_amdgcn_mfma_f32_32x32x16_bf16(b0, q, p, 0, 0, 0); }
        if (masked && !ctxt) {
          const bool rowok = (unsigned)(kr - rs) < 8u; const LAS float* bp = bias + ((kr - qr + 7) * 31 + 15 - qc + kbb + 4 * hi);
          const int t = rowok ? (kbb + 4 * hi - cs) : 0x40000000;
#pragma unroll
          for (int r = 0; r < 16; ++r) { const int c0 = (r & 3) + 8 * (r >> 2); const float bv = bp[c0]; p[r] = ((unsigned)(t + c0) < 16u) ? p[r] + bv : NEGBIG; }
        }
        float pmax = p[0];
#pragma unroll
        for (int r = 1; r < 16; ++r) pmax = fmaxf(pmax, p[r]);
        { auto rr = __builtin_amdgcn_permlane32_swap(__float_as_uint(pmax), __float_as_uint(pmax), false, false); pmax = fmaxf(__uint_as_float(rr[0]), __uint_as_float(rr[1])); }
        float mn, al;
        if (__builtin_expect(__all(pmax - m_reg <= THR_L2), 1)) { mn = m_reg; al = 1.f; } else { mn = fmaxf(m_reg, pmax); al = __builtin_amdgcn_exp2f(m_reg - mn); m_reg = mn; }
        float ps = 0.f;
#pragma unroll
        for (int r = 0; r < 16; ++r) { p[r] = __builtin_amdgcn_exp2f(p[r] - mn); ps += p[r]; }
        { auto rr = __builtin_amdgcn_permlane32_swap(__float_as_uint(ps), __float_as_uint(ps), false, false); ps = __uint_as_float(rr[0]) + __uint_as_float(rr[1]); }
        l_reg = l_reg * al + ps;
        if (__any(al < 1.f)) { if (hi == 0) al_l[r32] = al; asm volatile("s_waitcnt lgkmcnt(0)" ::: "memory");
#pragma unroll
          for (int d = 0; d < 4; ++d)
#pragma unroll
            for (int r = 0; r < 16; ++r) o[d][r] *= al_l[crow(r, hi)]; }
        u32x4 w0 = {cvt_pk_bf16(p[0], p[1]), cvt_pk_bf16(p[2], p[3]), cvt_pk_bf16(p[4], p[5]), cvt_pk_bf16(p[6], p[7])}, w1 = {cvt_pk_bf16(p[8], p[9]), cvt_pk_bf16(p[10], p[11]), cvt_pk_bf16(p[12], p[13]), cvt_pk_bf16(p[14], p[15])};
        const bf16x8 pa0 = *reinterpret_cast<bf16x8*>(&w0), pa1 = *reinterpret_cast<bf16x8*>(&w1);
        const int vb = vb0 + buf * (int)SHM_V + (kbb >> 3) * 2048;
#pragma unroll
        for (int d0 = 0; d0 < 4; ++d0) { const s16x4 l0 = vtr(vb + d0 * 512), h0 = vtr(vb + d0 * 512 + 2048), l1 = vtr(vb + d0 * 512 + 4096), h1 = vtr(vb + d0 * 512 + 6144);
          o[d0] = __builtin_amdgcn_mfma_f32_32x32x16_bf16(pa0, (bf16x8){l0[0], l0[1], l0[2], l0[3], h0[0], h0[1], h0[2], h0[3]}, o[d0], 0, 0, 0);
          o[d0] = __builtin_amdgcn_mfma_f32_32x32x16_bf16(pa1, (bf16x8){l1[0], l1[1], l1[2], l1[3], h1[0], h1[1], h1[2], h1[3]}, o[d0], 0, 0, 0); }
      }
    }
    if (j + 1 < NT) SWRITE1(buf ^ 1);
    __syncthreads();
  }
  if (hi == 0) li_l[r32] = l_reg; asm volatile("s_waitcnt lgkmcnt(0)" ::: "memory");
#pragma unroll
  for (int r = 0; r < 16; ++r) { const int i = crow(r, hi); const float rl = __builtin_amdgcn_rcpf(li_l[i]);
    bf16_t* Ow = Orow0 + (long)((2 * rp + (i >> 4)) * 64 + 16 * cbk + (i & 15)) * LDOUT;
#pragma unroll
    for (int d0 = 0; d0 < 4; ++d0) Ow[d0 * 32 + r32] = f2bf(o[d0][r] * rl); }
#undef SLOAD1
#undef SWRITE1
}

#define B3_MF(a, b, c) __builtin_amdgcn_mfma_f32_32x32x16_bf16(a, b, c, 0, 0, 0)
#define B3_PIN(x) asm volatile("" : "+v"(x))
#define B3_WAITBAR(N) asm volatile("s_waitcnt vmcnt(" #N ") lgkmcnt(0)\n\ts_barrier" ::: "memory")
struct TilesB3 { const bf16_t* kctx; const bf16_t* klat; long vdelta; int nt; };
__device__ __forceinline__ void attn_unit_b3(const bf16_t* __restrict__ Qrow0, const TilesB3 T, bf16_t* __restrict__ Orow0, const MP mp, const unsigned* __restrict__ kmax2, char* lds, const int tid) {
  const int wid = __builtin_amdgcn_readfirstlane(tid >> 6), lane = tid & 63, r32 = lane & 31, hi = lane >> 5;
  constexpr int KRING = 0, VRING = 65536, WSF = 131072, SLOT = 16384;
  float* li_l = (float*)(lds + WSF) + wid * 64;
  float l_reg = 0; f32x16 o[4] = {}; bf16x8 qr[4];
  const int qrow = (wid & 3) * 32 + r32, map = wid >> 2, mapoff = map * 64;
  const bf16_t* Qw = Qrow0 + (long)qrow * LDP + mapoff + hi * 8;
#pragma unroll
  for (int d0 = 0; d0 < 4; ++d0) qr[d0] = *reinterpret_cast<const bf16x8*>(Qw + d0 * 16);
  f32x16 nb;
  { float q2 = 0.f;
#pragma unroll
    for (int d0 = 0; d0 < 4; ++d0) { const u32x4 w = *reinterpret_cast<const u32x4*>(&qr[d0]);
      q2 += bflo(w.x) * bflo(w.x) + bfhi(w.x) * bfhi(w.x) + bflo(w.y) * bflo(w.y) + bfhi(w.y) * bfhi(w.y) + bflo(w.z) * bflo(w.z) + bfhi(w.z) * bfhi(w.z) + bflo(w.w) * bflo(w.w) + bfhi(w.w) * bfhi(w.w); }
    { auto rr = __builtin_amdgcn_permlane32_swap(__float_as_uint(q2), __float_as_uint(q2), false, false); q2 = __uint_as_float(rr[0]) + __uint_as_float(rr[1]); }
    const float negb = -sqrtf(q2 * __uint_as_float(kmax2[map])) * 1.0001f;
#pragma unroll
    for (int r = 0; r < 16; ++r) nb[r] = negb; }
  B3_PIN(nb);
  const int rowk = 4 * wid + (lane >> 4); const unsigned koff = (unsigned)(rowk * LDP + (((lane & 15) ^ (rowk & 7)) * 8)) * 2u;
  const int sub0 = 2 * wid + (lane >> 5), key0 = (sub0 >> 2) * 8 + ((lane & 31) >> 2);
  const unsigned voff = (unsigned)(key0 * LDP + (sub0 & 3) * 32 + (lane & 3) * 8) * 2u + (unsigned)(T.vdelta * 2);
  const unsigned lds0 = (unsigned)(uintptr_t)lds; const unsigned kdst = lds0 + KRING + (unsigned)wid * 1024u, vdst = lds0 + VRING + (unsigned)wid * 1024u;
#define B3_TPTR(j_) ((const char*)(((j_) < 4) ? T.kctx + (long)(j_) * 64 * LDP : T.klat + (long)((j_) - 4) * 64 * LDP))
#define B3_DMAK(j_, sl_) do { const char* sp_ = B3_TPTR(j_); glds16s(sp_, koff, (unsigned)__builtin_amdgcn_readfirstlane(kdst + (sl_))); glds16s(sp_ + (size_t)32 * LDP * 2, koff, (unsigned)__builtin_amdgcn_readfirstlane(kdst + (sl_) + 8192)); } while (0)
#define B3_DMAV(j_, sl_) do { const char* sp_ = B3_TPTR(j_); glds16s(sp_, voff, (unsigned)__builtin_amdgcn_readfirstlane(vdst + (sl_))); glds16s(sp_ + (size_t)32 * LDP * 2, voff, (unsigned)__builtin_amdgcn_readfirstlane(vdst + (sl_) + 8192)); } while (0)
  int kro[4];
#pragma unroll
  for (int d0 = 0; d0 < 4; ++d0) kro[d0] = r32 * 256 + (((d0 * 16 + hi * 8) * 2 + mapoff * 2) ^ ((r32 & 7) << 4));
  const LAS char* kring = (const LAS char*)(uintptr_t)(lds0 + KRING);
  const int vbase = (int)lds0 + VRING + v_rd_base(lane);
#define B3_KF(kp_, n_, d0_) (*(const LAS bf16x8*)((kp_) + kro[d0_] + (n_) * 8192))
#define B3_VF(dst_, vp_, g_) do { const s16x4 lo_ = vtr((vp_) + v_rd_off((g_) & 3, (g_) >> 2, 0)), hi_ = vtr((vp_) + v_rd_off((g_) & 3, (g_) >> 2, 1)); dst_ = (bf16x8){lo_[0], lo_[1], lo_[2], lo_[3], hi_[0], hi_[1], hi_[2], hi_[3]}; } while (0)
  const int NT = T.nt;
#define B3_SL(j_) (((j_) & 3) * SLOT)
  f32x16 pA0, pA1, pB0, pB1; bf16x8 pa0, pa1, pa2, pa3;
  __syncthreads();
  B3_DMAK(0, B3_SL(0)); B3_DMAV(0, B3_SL(0)); B3_DMAK(1, B3_SL(1)); B3_DMAK(2, B3_SL(2)); B3_DMAV(1, B3_SL(1));
  B3_WAITBAR(8);
  { const LAS char* kp = kring + B3_SL(0); bf16x8 kf[8];
#pragma unroll
    for (int d0 = 0; d0 < 4; ++d0) { kf[2 * d0] = B3_KF(kp, 0, d0); kf[2 * d0 + 1] = B3_KF(kp, 1, d0); }
    pA0 = B3_MF(kf[0], qr[0], nb); pA1 = B3_MF(kf[1], qr[0], nb); pA0 = B3_MF(kf[2], qr[1], pA0); pA1 = B3_MF(kf[3], qr[1], pA1);
    pA0 = B3_MF(kf[4], qr[2], pA0); pA1 = B3_MF(kf[5], qr[2], pA1); pA0 = B3_MF(kf[6], qr[3], pA0); pA1 = B3_MF(kf[7], qr[3], pA1);
#pragma unroll
    for (int r = 0; r < 16; ++r) { pA0[r] = __builtin_amdgcn_exp2f(pA0[r]); pA1[r] = __builtin_amdgcn_exp2f(pA1[r]); l_reg += pA0[r] + pA1[r]; } }
  B3_WAITBAR(0);
#define B3_GA(MFS, P, i_, CA, CB) do { MFS; CA = cvt_pk_bf16(P[i_], P[(i_) + 1]); CB = cvt_pk_bf16(P[(i_) + 2], P[(i_) + 3]); } while (0)
#define B3_SW(OUT, c0_, c1_, c2_, c3_) do { u32x4 w_ = {c0_, c1_, c2_, c3_}; OUT = *reinterpret_cast<bf16x8*>(&w_); B3_PIN(OUT); } while (0)
#define B3_GB(MFS, X, i_) do { MFS; X[i_] = __builtin_amdgcn_exp2f(X[i_]); X[(i_) + 1] = __builtin_amdgcn_exp2f(X[(i_) + 1]); sacc += X[i_]; sacc += X[(i_) + 1]; B3_PIN(X); B3_PIN(sacc); SBAR(); } while (0)
#define B3_STEP(C0, C1, P0, P1, t_) do { SBAR(); \
    const LAS char* kp_ = kring + B3_SL(t_); const int vp_ = vbase + B3_SL((t_) - 1); bf16x8 kf[8], vf[8]; unsigned c0_, c1_, c2_, c3_; float sacc = 0.f; \
    _Pragma("unroll") for (int d0 = 0; d0 < 4; ++d0) { kf[2 * d0] = B3_KF(kp_, 0, d0); kf[2 * d0 + 1] = B3_KF(kp_, 1, d0); } SBAR(); \
    B3_GA(C0 = B3_MF(kf[0], qr[0], nb), P0, 0, c0_, c1_); SBAR(); \
    B3_GA(C1 = B3_MF(kf[1], qr[0], nb), P0, 4, c2_, c3_); B3_SW(pa0, c0_, c1_, c2_, c3_); SBAR(); \
    B3_GA(C0 = B3_MF(kf[2], qr[1], C0), P0, 8, c0_, c1_); SBAR(); \
    B3_GA(C1 = B3_MF(kf[3], qr[1], C1), P0, 12, c2_, c3_); B3_SW(pa1, c0_, c1_, c2_, c3_); SBAR(); \
    B3_VF(vf[0], vp_, 0); B3_GA(C0 = B3_MF(kf[4], qr[2], C0), P1, 0, c0_, c1_); SBAR(); \
    B3_VF(vf[1], vp_, 1); B3_GA(C1 = B3_MF(kf[5], qr[2], C1), P1, 4, c2_, c3_); B3_SW(pa2, c0_, c1_, c2_, c3_); SBAR(); \
    B3_VF(vf[2], vp_, 2); B3_GA(C0 = B3_MF(kf[6], qr[3], C0), P1, 8, c0_, c1_); SBAR(); \
    B3_VF(vf[3], vp_, 3); B3_GA(C1 = B3_MF(kf[7], qr[3], C1), P1, 12, c2_, c3_); B3_SW(pa3, c0_, c1_, c2_, c3_); SBAR(); \
    B3_VF(vf[4], vp_, 4);  B3_GB(o[0] = B3_MF(pa0, vf[0], o[0]), C0, 0); \
    B3_VF(vf[5], vp_, 5);  B3_GB(o[1] = B3_MF(pa0, vf[1], o[1]), C0, 2); \
    B3_VF(vf[6], vp_, 6);  B3_GB(o[2] = B3_MF(pa0, vf[2], o[2]), C0, 4); \
    B3_VF(vf[7], vp_, 7);  B3_GB(o[3] = B3_MF(pa0, vf[3], o[3]), C0, 6); \
    B3_VF(vf[0], vp_, 8);  B3_GB(o[0] = B3_MF(pa1, vf[4], o[0]), C0, 8); \
    B3_VF(vf[1], vp_, 9);  B3_GB(o[1] = B3_MF(pa1, vf[5], o[1]), C0, 10); \
    B3_VF(vf[2], vp_, 10); B3_GB(o[2] = B3_MF(pa1, vf[6], o[2]), C0, 12); \
    B3_VF(vf[3], vp_, 11); B3_GB(o[3] = B3_MF(pa1, vf[7], o[3]), C0, 14); \
    B3_VF(vf[4], vp_, 12); B3_GB(o[0] = B3_MF(pa2, vf[0], o[0]), C1, 0); \
    B3_VF(vf[5], vp_, 13); B3_GB(o[1] = B3_MF(pa2, vf[1], o[1]), C1, 2); \
    B3_VF(vf[6], vp_, 14); B3_GB(o[2] = B3_MF(pa2, vf[2], o[2]), C1, 4); \
    B3_VF(vf[7], vp_, 15); B3_GB(o[3] = B3_MF(pa2, vf[3], o[3]), C1, 6); \
    B3_GB(o[0] = B3_MF(pa3, vf[4], o[0]), C1, 8); \
    B3_GB(o[1] = B3_MF(pa3, vf[5], o[1]), C1, 10); \
    B3_GB(o[2] = B3_MF(pa3, vf[6], o[2]), C1, 12); \
    B3_GB(o[3] = B3_MF(pa3, vf[7], o[3]), C1, 14); \
    l_reg += sacc; } while (0)
  int t = 1;
  for (; t + 3 < NT; t += 2) {
    B3_DMAK(t + 2, B3_SL(t + 2)); B3_DMAK(t + 3, B3_SL(t + 3)); B3_DMAV(t + 1, B3_SL(t + 1)); B3_DMAV(t + 2, B3_SL(t + 2));
    B3_STEP(pB0, pB1, pA0, pA1, t); B3_STEP(pA0, pA1, pB0, pB1, t + 1);
    B3_WAITBAR(0);
  }
  B3_DMAK(t + 2, B3_SL(t + 2)); B3_DMAV(t + 1, B3_SL(t + 1)); B3_DMAV(t + 2, B3_SL(t + 2));
  B3_STEP(pB0, pB1, pA0, pA1, t); B3_STEP(pA0, pA1, pB0, pB1, t + 1);
  B3_WAITBAR(0);
  B3_STEP(pB0, pB1, pA0, pA1, t + 2);
  { unsigned c[16];
#pragma unroll
    for (int i = 0; i < 8; ++i) { c[i] = cvt_pk_bf16(pB0[2 * i], pB0[2 * i + 1]); c[8 + i] = cvt_pk_bf16(pB1[2 * i], pB1[2 * i + 1]); }
    B3_SW(pa0, c[0], c[1], c[2], c[3]); B3_SW(pa1, c[4], c[5], c[6], c[7]); B3_SW(pa2, c[8], c[9], c[10], c[11]); B3_SW(pa3, c[12], c[13], c[14], c[15]);
    pv_d0_v(o, vbase + B3_SL(NT - 1), pa0, pa1, pa2, pa3); }
#undef B3_STEP
#undef B3_GA
#undef B3_GB
#undef B3_SW
  { auto rr = __builtin_amdgcn_permlane32_swap(__float_as_uint(l_reg), __float_as_uint(l_reg), false, false); l_reg = __uint_as_float(rr[0]) + __uint_as_float(rr[1]); }
  if (hi == 0) li_l[r32] = l_reg; asm volatile("s_waitcnt lgkmcnt(0)" ::: "memory");
#pragma unroll
  for (int r = 0; r < 16; ++r) { const float rl = __builtin_amdgcn_rcpf(li_l[crow(r, hi)]);
#pragma unroll
    for (int d0 = 0; d0 < 4; ++d0) o[d0][r] *= rl; }
  __syncthreads();
  float* X = (float*)lds + (size_t)(wid & 3) * 32 * 128;
  if (wid >= 4) {
#pragma unroll
    for (int d0 = 0; d0 < 4; ++d0)
#pragma unroll
      for (int r = 0; r < 16; ++r) X[crow(r, hi) * 128 + d0 * 32 + r32] = o[d0][r];
  }
  __syncthreads();
  if (wid < 4) {
    float ss[16];
#pragma unroll
    for (int r = 0; r < 16; ++r) { float s = 0.f;
#pragma unroll
      for (int d0 = 0; d0 < 4; ++d0) { const float v = o[d0][r] - mp.lam * X[crow(r, hi) * 128 + d0 * 32 + r32]; o[d0][r] = v; s += v * v; }
      ss[r] = s; }
#pragma unroll
    for (int r = 0; r < 16; ++r) ss[r] = rsqrtf(sum32(ss[r]) * (1.0f / 128.0f) + 1e-6f) * mp.post;
    float gcol[4];
#pragma unroll
    for (int d0 = 0; d0 < 4; ++d0) gcol[d0] = mp.normg[d0 * 32 + r32];
    bf16_t* Ow = Orow0 + (long)(wid * 32) * LDOUT;
#pragma unroll
    for (int r = 0; r < 16; ++r) { const int orow = crow(r, hi);
#pragma unroll
      for (int d0 = 0; d0 < 4; ++d0) Ow[(long)orow * LDOUT + d0 * 32 + r32] = f2bf(o[d0][r] * ss[r] * gcol[d0]); }
  }
}
}
struct Args { const float* in[23]; float* out; unsigned char* ws; int ph_lo, ph_hi; };
typedef const Args __attribute__((address_space(4)))* KArgs;
struct Ctx {
    KArgs ka; LAS unsigned char* lds; char* ldsg; int tid, lane, wave, G, wg;
    __device__ __forceinline__ const float* in(int k) const { return ka->in[k]; }
    __device__ __forceinline__ float* out() const { return ka->out; }
    __device__ __forceinline__ unsigned char* ws() const { return ka->ws; }
    __device__ __forceinline__ float* modp() const { return (float*)(ws() + WS_MODP); }
    __device__ __forceinline__ float* mod() const { return (float*)(ws() + WS_MOD); }
    __device__ __forceinline__ float* misc() const { return (float*)(ws() + WS_MISC); }
    __device__ __forceinline__ float* rope() const { return (float*)(ws() + WS_ROPE); }
    __device__ __forceinline__ float* xc() const { return (float*)(ws() + WS_XC); }
    __device__ __forceinline__ bf16_t* xb() const { return (bf16_t*)(ws() + WS_XB); }
    __device__ __forceinline__ float* aff() const { return (float*)(ws() + WS_AFF); }
    __device__ __forceinline__ int* rowidx() const { return (int*)(ws() + WS_ROWIDX); }
    __device__ __forceinline__ float* gatev() const { return (float*)(ws() + WS_GATEV); }
    __device__ __forceinline__ int* slot() const { return (int*)(ws() + WS_SLOT); }
    __device__ __forceinline__ bf16_t* H() const { return (bf16_t*)(ws() + WS_H); }
    __device__ __forceinline__ bf16_t* P() const { return (bf16_t*)(ws() + WS_P); }
    __device__ __forceinline__ bf16_t* O() const { return (bf16_t*)(ws() + WS_O); }
    __device__ __forceinline__ bf16_t* S() const { return (bf16_t*)(ws() + WS_S); }
    __device__ __forceinline__ bf16_t* U() const { return (bf16_t*)(ws() + WS_H); }
    __device__ __forceinline__ bf16_t* ACT() const { return (bf16_t*)(ws() + WS_P + ACT_OFF); }
    __device__ __forceinline__ bf16_t* Y() const { return (bf16_t*)(ws() + WS_P + Y_OFF); }
    __device__ __forceinline__ bf16_t* w_in_t(int l) const { return (bf16_t*)(ws() + WS_W + (size_t)l * WL_BYTES + WL_IN); }
    __device__ __forceinline__ bf16_t* w_out_t(int l) const { return (bf16_t*)(ws() + WS_W + (size_t)l * WL_BYTES + WL_OUT); }
    __device__ __forceinline__ bf16_t* w_gu_t(int l) const { return (bf16_t*)(ws() + WS_W + (size_t)l * WL_BYTES + WL_GU); }
    __device__ __forceinline__ bf16_t* w_dn_t(int l) const { return (bf16_t*)(ws() + WS_W + (size_t)l * WL_BYTES + WL_DN); }
};
__device__ __forceinline__ int hw_lane() { int l; asm volatile("v_mbcnt_lo_u32_b32 %0, -1, 0\n\tv_mbcnt_hi_u32_b32 %0, -1, %0" : "=v"(l)); return l; }
__device__ __forceinline__ Ctx make_ctx(unsigned char* lds_raw, int wave_s) {
    Ctx F; KArgs p = (KArgs)__builtin_amdgcn_kernarg_segment_ptr(); asm volatile("" : "+s"(p));
    F.ka = p; F.lds = (LAS unsigned char*)lds_raw; F.ldsg = (char*)lds_raw;
    F.lane = hw_lane(); F.wave = wave_s; F.tid = wave_s * 64 + F.lane; F.G = gridDim.x; F.wg = blockIdx.x; return F;
}
enum { I_X = 0, I_C, I_CTX, I_CCTX, I_WMOD, I_BMOD, I_N1G, I_WIN, I_RPB, I_DLAM, I_DNG, I_RDF, I_RDB, I_GNG, I_GNB, I_SINK, I_WOUT, I_N2G, I_WR, I_WG, I_WU, I_WD, I_FNG };

__device__ __forceinline__ void ph_mod_partial(const Ctx& F) {
    const float* c = F.in(I_C); const float* cc = F.in(I_CCTX); const float* wm = F.in(I_WMOD);
    for (int gid = F.wg * 512 + F.tid; gid < 2 * 16 * 3072; gid += F.G * 512) {
        const int cg = gid % 3072, ks = (gid / 3072) % 16, l = gid / (3072 * 16);
        const float* w = wm + (size_t)l * DM * 12288 + (size_t)(ks * 128) * 12288 + cg * 4;
        f32x4 a0 = {0.f, 0.f, 0.f, 0.f}, a1 = a0, a2 = a0;
#pragma unroll 8
        for (int k = 0; k < 128; ++k) { const f32x4 wv = *(const f32x4*)(w + (size_t)k * 12288); const int kk = ks * 128 + k;
            const float s0 = siluf(c[kk]), s1 = siluf(c[DM + kk]), s2 = siluf(cc[kk]); a0 += s0 * wv; a1 += s1 * wv; a2 += s2 * wv; }
        float* o = F.modp() + (size_t)((ks * 2 + l) * 3) * 12288 + cg * 4;
        *(f32x4*)(o) = a0; *(f32x4*)(o + 12288) = a1; *(f32x4*)(o + 2 * 12288) = a2;
    }
}
__device__ __forceinline__ void ph_mod_reduce(const Ctx& F) {
    const int NMOD = 2 * 3 * 12288, NR128 = 256 * 32, NR64 = 256 * 16;
    for (int idx = F.wg * 512 + F.tid; idx < NMOD + NR128 + NR64 + 2; idx += F.G * 512) {
        if (idx < NMOD) { const int l = idx / (3 * 12288), v = (idx / 12288) % 3, col = idx % 12288; float s = F.in(I_BMOD)[l * 12288 + col];
            for (int ks = 0; ks < 16; ++ks) s += F.modp()[(size_t)((ks * 2 + l) * 3 + v) * 12288 + col];
            F.mod()[idx] = s;
        } else if (idx < NMOD + NR128) { const int e = idx - NMOD, pos = e >> 5, i = e & 31; const float inv = powf(10000.0f, -(float)i / 32.0f); const float a = (float)pos * inv;
            F.rope()[e] = cosf(a); F.rope()[NR128 + e] = sinf(a);
        } else if (idx < NMOD + NR128 + NR64) { const int e = idx - NMOD - NR128, pos = e >> 4, i = e & 15; const float inv = powf(10000.0f, -(float)i / 16.0f); const float a = (float)pos * inv;
            F.rope()[2 * NR128 + e] = cosf(a); F.rope()[2 * NR128 + NR64 + e] = sinf(a);
        } else { const int l = idx - (NMOD + NR128 + NR64); const float* dl = F.in(I_DLAM) + l * 4 * 64; float s1 = 0.f, s2 = 0.f;
            for (int i = 0; i < 64; ++i) { s1 += dl[i] * dl[64 + i]; s2 += dl[128 + i] * dl[192 + i]; }
            const float lam_init = 0.8f - 0.6f * expf(-0.3f * (float)l);
            F.misc()[l * 2] = expf(s1) - expf(s2) + lam_init; F.misc()[l * 2 + 1] = lam_init; }
    }
}
__device__ __forceinline__ int inproj_perm(int np) {
    const int pn = np >> 8, p = np & 255;
    if (pn >= 6 && pn <= 9) { const int half = p >> 7, pp = p & 127, sh = pp >> 5, rc = (pp >> 4) & 1, i = pp & 15; return pn * 256 + sh * 64 + rc * 32 + half * 16 + i; }
    if ((pn >= 12 && pn <= 15) || (pn >= 20 && pn <= 22)) { const int half = p >> 7, pp = p & 127, hs = pp >> 6, rc = (pp >> 5) & 1, i = pp & 31; return pn * 256 + hs * 128 + rc * 64 + half * 32 + i; }
    return np;
}
__device__ __forceinline__ float inproj_scale(int col) {
    if (col < C_AK) return 0.08838834764831845f * LOG2E;
    if (col >= C_BQ && col < C_BK) return 0.125f * LOG2E;
    if (col >= C_CK && col < C_CV) return 0.08838834764831845f;
    if (col >= C_DQ && col < C_DK) return 0.08838834764831845f * LOG2E;
    return 1.0f;
}
struct CvTile { const float* src; bf16_t* dst; int nsrc, K, n0, k0, kind; };
__device__ __forceinline__ CvTile cv_tile(const Ctx& F, int t) {
    const int T_IN = 96 * 32, T_OUT = 32 * 32, T_GU = 16 * 32 * 32, T_DN = 16 * 32 * 16, TL = T_IN + T_OUT + T_GU + T_DN;
    const int l = t / TL; int r = t % TL; CvTile c;
    if (r < T_IN) { c.kind = 0; c.n0 = (r % 96) * 64; c.k0 = (r / 96) * 64; c.src = F.in(I_WIN) + (size_t)l * DM * INW; c.nsrc = INW; c.K = DM; c.dst = F.w_in_t(l); }
    else if (r < T_IN + T_OUT) { r -= T_IN; c.kind = 1; c.n0 = (r % 32) * 64; c.k0 = (r / 32) * 64; c.src = F.in(I_WOUT) + (size_t)l * DM * DM; c.nsrc = DM; c.K = DM; c.dst = F.w_out_t(l); }
    else if (r < T_IN + T_OUT + T_GU) { r -= T_IN + T_OUT; c.kind = 2; const int e = r / 1024, rr = r % 1024; c.n0 = (rr % 32) * 64; c.k0 = (rr / 32) * 64;
        const int half = (c.n0 & 255) >> 7; c.src = (half ? F.in(I_WU) : F.in(I_WG)) + (size_t)(l * NE + e) * DM * FF; c.nsrc = FF; c.K = DM; c.dst = F.w_gu_t(l) + (size_t)e * 2048 * DM; }
    else { r -= T_IN + T_OUT + T_GU; c.kind = 3; const int e = r / 512, rr = r % 512; c.n0 = (rr % 32) * 64; c.k0 = (rr / 32) * 64; c.src = F.in(I_WD) + (size_t)(l * NE + e) * FF * DM; c.nsrc = DM; c.K = FF; c.dst = F.w_dn_t(l) + (size_t)e * DM * FF; }
    return c;
}
__device__ __forceinline__ void ph_convert(const Ctx& F) {
    LAS float* tile = (LAS float*)F.lds;
    const int TL = 96 * 32 + 32 * 32 + 16 * 32 * 32 + 16 * 32 * 16, NT = 2 * TL;
    const int tx = F.tid & 63, ty = F.tid >> 6, kx2 = F.tid & 31, ny = F.tid >> 5;
    float v[4][8]; float sc[4];
#define CV_LOAD(t0_) do { _Pragma("unroll") for (int u = 0; u < 4; ++u) { const int t = (t0_) + u; if (t < NT) { const CvTile c = cv_tile(F, t); \
            const int np = c.n0 + tx; int scol = np; sc[u] = 1.0f; \
            if (c.kind == 0) { scol = inproj_perm(np); sc[u] = inproj_scale(scol); } else if (c.kind == 2) { scol = (np >> 8) * 128 + (np & 127); } \
            _Pragma("unroll") for (int i = 0; i < 8; ++i) v[u][i] = c.src[(size_t)(c.k0 + ty + 8 * i) * c.nsrc + scol]; } } } while (0)
    int t0 = F.wg * 4;
    __syncthreads();
    if (t0 < NT) CV_LOAD(t0);
    for (; t0 < NT; t0 += 4 * F.G) {
#pragma unroll
        for (int u = 0; u < 4; ++u) { const int t = t0 + u; if (t < NT) {
#pragma unroll
            for (int i = 0; i < 8; ++i) tile[u * (64 * 65) + (ty + 8 * i) * 65 + tx] = v[u][i] * sc[u]; } }
        if (t0 + 4 * F.G < NT) CV_LOAD(t0 + 4 * F.G);
        asm volatile("s_waitcnt lgkmcnt(0)" ::: "memory"); __builtin_amdgcn_s_barrier();
#pragma unroll
        for (int u = 0; u < 4; ++u) { const int t = t0 + u; if (t < NT) { const CvTile c = cv_tile(F, t);
#pragma unroll
            for (int i = 0; i < 4; ++i) { const int nn = ny + 16 * i; const float lo = tile[u * (64 * 65) + (2 * kx2) * 65 + nn], hi = tile[u * (64 * 65) + (2 * kx2 + 1) * 65 + nn];
                *(unsigned*)(c.dst + (size_t)(c.n0 + nn) * c.K + c.k0 + 2 * kx2) = cvt_pk_bf16(lo, hi); } } }
        asm volatile("s_waitcnt lgkmcnt(0)" ::: "memory"); __builtin_amdgcn_s_barrier();
    }
#undef CV_LOAD
    __syncthreads();
}

__device__ __forceinline__ float wave_sum(float s) { return sum64(s); }
__device__ __forceinline__ void load_x(const Ctx& F, const void* xrow, bool bf, f32x4 (&x)[8]) {
    const int lane = F.lane;
    if (bf) {
#pragma unroll
        for (int j = 0; j < 8; ++j) { const u32x2 w = *(const u32x2*)((const bf16_t*)xrow + j * 256 + lane * 4); x[j] = (f32x4){bflo(w.x), bfhi(w.x), bflo(w.y), bfhi(w.y)}; }
    } else {
#pragma unroll
        for (int j = 0; j < 8; ++j) x[j] = *(const f32x4*)((const float*)xrow + j * 256 + lane * 4);
    }
}
__device__ __forceinline__ void ld_y(const Ctx& F, int s, u32x2 (&w)[8]) {
    const bf16_t* y = F.Y() + (size_t)s * DM + F.lane * 4;
#pragma unroll
    for (int j = 0; j < 8; ++j) w[j] = *(const u32x2*)(y + j * 256);
}
__device__ __forceinline__ void acc_y(f32x4 (&ys)[8], const u32x2 (&w)[8]) {
#pragma unroll
    for (int j = 0; j < 8; ++j) ys[j] += (f32x4){bflo(w[j].x), bfhi(w[j].x), bflo(w[j].y), bfhi(w[j].y)};
}
__device__ __forceinline__ int load_slots(const Ctx& F, int row) { return F.slot()[(size_t)row * NE + (F.lane & 15)]; }
__device__ __forceinline__ void moe_fold2(const Ctx& F, const LAS float* g2, int sva, int svb, f32x4 (&xa)[8], f32x4 (&xb)[8]) {
    f32x4 ya[8], yb[8];
#pragma unroll
    for (int j = 0; j < 8; ++j) { ya[j] = (f32x4){0.f, 0.f, 0.f, 0.f}; yb[j] = (f32x4){0.f, 0.f, 0.f, 0.f}; }
    unsigned ma = (unsigned)__builtin_amdgcn_ballot_w64(sva >= 0) & 0xFFFFu, mb = (unsigned)__builtin_amdgcn_ballot_w64(svb >= 0) & 0xFFFFu;
    while ((ma | mb) != 0u) {
        const bool ha = ma != 0u, hb = mb != 0u; u32x2 wa[8], wb[8];
        if (ha) { const int e = __builtin_ctz(ma); ma &= ma - 1u; ld_y(F, __builtin_amdgcn_readlane(sva, e), wa); }
        if (hb) { const int e = __builtin_ctz(mb); mb &= mb - 1u; ld_y(F, __builtin_amdgcn_readlane(svb, e), wb); }
        if (ha) acc_y(ya, wa);
        if (hb) acc_y(yb, wb);
    }
#pragma unroll
    for (int j = 0; j < 8; ++j) { const f32x4 g = *(const LAS f32x4*)(g2 + j * 256 + F.lane * 4); xa[j] += g * ya[j]; xb[j] += g * yb[j]; }
}
__device__ __forceinline__ float row_rstd(const f32x4 (&x)[8]) {
    float s = 0.f;
#pragma unroll
    for (int j = 0; j < 8; ++j) s += x[j][0] * x[j][0] + x[j][1] * x[j][1] + x[j][2] * x[j][2] + x[j][3] * x[j][3];
    s = wave_sum(s); return rsqrtf(s * (1.0f / DM) + 1e-6f);
}
__device__ __forceinline__ void norm1_row(const Ctx& F, int li, int row, const float* ng, f32x4 (&x)[8]) {
    const bool lat = row < NLAT; const int v = lat ? row / SEQ : 2;
    if (li != 0) {
        if (lat) { bf16_t* xo = F.xb() + (size_t)row * DM;
#pragma unroll
            for (int j = 0; j < 8; ++j) { u32x2 w; w.x = cvt_pk_bf16(x[j][0], x[j][1]); w.y = cvt_pk_bf16(x[j][2], x[j][3]); *(u32x2*)(xo + j * 256 + F.lane * 4) = w;
                x[j] = (f32x4){bflo(w.x), bfhi(w.x), bflo(w.y), bfhi(w.y)}; }
        } else { float* xo = F.xc() + (size_t)(row - NLAT) * DM;
#pragma unroll
            for (int j = 0; j < 8; ++j) *(f32x4*)(xo + j * 256 + F.lane * 4) = x[j]; } }
    const float rs = row_rstd(x);
    const LAS float* gs = (const LAS float*)F.lds + v * (2 * DM); const LAS float* s0p = gs + DM;
    bf16_t* h = F.H() + (size_t)row * DM;
#pragma unroll
    for (int j = 0; j < 8; ++j) { const int c = j * 256 + F.lane * 4; const f32x4 g = *(const LAS f32x4*)(gs + c), s0 = *(const LAS f32x4*)(s0p + c);
        const f32x4 y = x[j] * rs * g + s0; u32x2 w; w.x = cvt_pk_bf16(y[0], y[1]); w.y = cvt_pk_bf16(y[2], y[3]); *(u32x2*)(h + c) = w; }
}
__device__ __forceinline__ const void* norm1_src(const Ctx& F, int li, int row, bool& bf) {
    const bool lat = row < NLAT; bf = (li != 0) && lat;
    if (li == 0) return lat ? (const void*)(F.in(I_X) + (size_t)row * DM) : (const void*)(F.in(I_CTX) + (size_t)(row - NLAT) * DM);
    return lat ? (const void*)(F.xb() + (size_t)row * DM) : (const void*)(F.xc() + (size_t)(row - NLAT) * DM);
}
__device__ __forceinline__ void ph_norm1(const Ctx& F, int li) {
    const float* ng = F.in(I_N1G) + li * DM;
    __syncthreads();
    for (int i = F.tid; i < 3 * DM; i += 512) { const int v = i / DM, c = i - v * DM; const float* sh = F.mod() + (size_t)(li * 3 + v) * 12288;
        ((LAS float*)F.lds)[v * (2 * DM) + c] = ng[c] * (1.0f + sh[DM + c]); ((LAS float*)F.lds)[v * (2 * DM) + DM + c] = sh[c];
        if (li != 0) ((LAS float*)F.lds)[6 * DM + i] = F.mod()[(size_t)((li - 1) * 3 + v) * 12288 + 5 * DM + c]; }
    __syncthreads();
    for (int row = (F.wg * 8 + F.wave) * 2; row < MTOT; row += F.G * 16) {
        f32x4 xa[8], xb[8]; bool bfa, bfb; const void* pa = norm1_src(F, li, row, bfa); const void* pb = norm1_src(F, li, row + 1, bfb);
        int sva = -1, svb = -1; if (li != 0) { sva = load_slots(F, row); svb = load_slots(F, row + 1); }
        load_x(F, pa, bfa, xa); load_x(F, pb, bfb, xb);
        if (li != 0) moe_fold2(F, (const LAS float*)F.lds + 6 * DM + (row < NLAT ? row / SEQ : 2) * DM, sva, svb, xa, xb);
        norm1_row(F, li, row, ng, xa); norm1_row(F, li, row + 1, ng, xb);
    }
}
__device__ __forceinline__ void ph_final(const Ctx& F) {
    __syncthreads();
    for (int i = F.tid; i < 3 * DM; i += 512) ((LAS float*)F.lds)[i] = i < DM ? F.in(I_FNG)[i] : F.mod()[(size_t)(3 + (i / DM - 1)) * 12288 + 5 * DM + (i & (DM - 1))];
    __syncthreads();
    const LAS float* ng = (const LAS float*)F.lds;
    for (int row = (F.wg * 8 + F.wave) * 2; row < NLAT; row += F.G * 16) {
        f32x4 xa[8], xb[8]; const int sva = load_slots(F, row), svb = load_slots(F, row + 1);
        load_x(F, F.xb() + (size_t)row * DM, true, xa); load_x(F, F.xb() + (size_t)(row + 1) * DM, true, xb);
        moe_fold2(F, ng + DM + (row / SEQ) * DM, sva, svb, xa, xb);
        const float ra = row_rstd(xa), rb = row_rstd(xb); float* xr = F.out() + (size_t)row * DM;
#pragma unroll
        for (int j = 0; j < 8; ++j) { const int c = j * 256 + F.lane * 4; const f32x4 g = *(const LAS f32x4*)(ng + c); *(f32x4*)(xr + c) = xa[j] * ra * g; *(f32x4*)(xr + DM + c) = xb[j] * rb * g; }
    }
}
__device__ __forceinline__ void router_reduce_store(float (&v)[16], int lane, float* affrow) {
    float a[8];
#pragma unroll
    for (int i = 0; i < 8; ++i) { auto rr = __builtin_amdgcn_permlane32_swap(__float_as_uint(v[i]), __float_as_uint(v[i + 8]), false, false); a[i] = __uint_as_float(rr[0]) + __uint_as_float(rr[1]); }
    float b[4]; const bool b16 = (lane & 16) != 0;
#pragma unroll
    for (int i = 0; i < 4; ++i) { const float keep = b16 ? a[i + 4] : a[i], send = b16 ? a[i] : a[i + 4]; b[i] = keep + xshf<16>(send); }
    float c[2]; const bool b8 = (lane & 8) != 0;
#pragma unroll
    for (int i = 0; i < 2; ++i) { const float keep = b8 ? b[i + 2] : b[i], send = b8 ? b[i] : b[i + 2]; c[i] = keep + xshf<8>(send); }
    const bool b4 = (lane & 4) != 0; float lg = (b4 ? c[1] : c[0]) + xshf<4>(b4 ? c[0] : c[1]);
    lg += xshf<2>(lg); lg += xshf<1>(lg);
    float mx = lg; mx = fmaxf(mx, xshf<4>(mx)); mx = fmaxf(mx, xshf<8>(mx)); mx = fmaxf(mx, xshf<16>(mx));
    { auto rr = __builtin_amdgcn_permlane32_swap(__float_as_uint(mx), __float_as_uint(mx), false, false); mx = fmaxf(__uint_as_float(rr[0]), __uint_as_float(rr[1])); }
    const float ex = expf(lg - mx); float den = ex; den += xshf<4>(den); den += xshf<8>(den); den += xshf<16>(den);
    { auto rr = __builtin_amdgcn_permlane32_swap(__float_as_uint(den), __float_as_uint(den), false, false); den = __uint_as_float(rr[0]) + __uint_as_float(rr[1]); }
    const int e = ((lane >> 5) & 1) * 8 + ((lane >> 4) & 1) * 4 + ((lane >> 3) & 1) * 2 + ((lane >> 2) & 1);
    if ((lane & 3) == 0) affrow[e] = ex / den;
}
__device__ __forceinline__ void ph_norm2(const Ctx& F, int li, int rbeg, int rend, int wg0, int nwg) {
    const float* ng = F.in(I_N2G) + li * DM; const float* wr = F.in(I_WR) + (size_t)li * DM * NE; LAS float* wl = (LAS float*)F.lds;
    __syncthreads();
    int ts_ = F.tid; asm volatile("" : "+v"(ts_));
    for (int h = 0; h < 2; ++h) { f32x4 wv[8];
#pragma unroll
      for (int q = 0; q < 8; ++q) wv[q] = *(const f32x4*)(wr + (size_t)(ts_ + 512 * (h * 8 + q)) * 4);
#pragma unroll
      for (int q = 0; q < 8; ++q) { const int i4 = ts_ + 512 * (h * 8 + q), k = i4 >> 2, e0 = (i4 & 3) * 4; wl[(e0 + 0) * DM + k] = wv[q][0]; wl[(e0 + 1) * DM + k] = wv[q][1]; wl[(e0 + 2) * DM + k] = wv[q][2]; wl[(e0 + 3) * DM + k] = wv[q][3]; } }
    LAS float* gsl = wl + NE * DM;
    for (int i = F.tid; i < 2 * DM; i += 512) { const int v = (rbeg < NLAT) ? i / DM : 2, c = i & (DM - 1); gsl[i] = ng[c] * (1.0f + F.mod()[(size_t)(li * 3 + v) * 12288 + 4 * DM + c]); }
    __syncthreads();
    for (int row0 = rbeg + ((F.wg - wg0) * 8 + F.wave) * 4; row0 < rend; row0 += nwg * 32) {
        const bool lat = row0 < NLAT; const int v = lat ? row0 / SEQ : 2;
        const float* sh = F.mod() + (size_t)(li * 3 + v) * 12288 + 3 * DM; const LAS float* gsv = gsl + (lat ? v * DM : 0);
        f32x4 x[4][8];
        if (lat) { const bf16_t* xin = F.xb() + (size_t)row0 * DM;
#pragma unroll
            for (int r = 0; r < 4; ++r)
#pragma unroll
                for (int j = 0; j < 8; ++j) { const u32x2 w = *(const u32x2*)(xin + (size_t)r * DM + j * 256 + F.lane * 4); x[r][j] = (f32x4){bflo(w.x), bfhi(w.x), bflo(w.y), bfhi(w.y)}; }
        } else { const float* xin = F.xc() + (size_t)(row0 - NLAT) * DM;
#pragma unroll
            for (int r = 0; r < 4; ++r)
#pragma unroll
                for (int j = 0; j < 8; ++j) x[r][j] = *(const f32x4*)(xin + (size_t)r * DM + j * 256 + F.lane * 4); }
        float rs[4];
#pragma unroll
        for (int r = 0; r < 4; ++r) rs[r] = row_rstd(x[r]);
#pragma unroll
        for (int j = 0; j < 8; ++j) { const int c = j * 256 + F.lane * 4; const f32x4 s0 = *(const f32x4*)(sh + c); const f32x4 gs = *(const LAS f32x4*)(gsv + c);
#pragma unroll
            for (int r = 0; r < 4; ++r) { const f32x4 y = x[r][j] * rs[r] * gs + s0; x[r][j] = y; u32x2 w; w.x = cvt_pk_bf16(y[0], y[1]); w.y = cvt_pk_bf16(y[2], y[3]); *(u32x2*)(F.H() + (size_t)(row0 + r) * DM + c) = w; } }
        float lg[4][16];
#pragma unroll
        for (int e = 0; e < NE; ++e) { f32x2 a0 = {0.f, 0.f}, a1 = {0.f, 0.f}, a2 = {0.f, 0.f}, a3 = {0.f, 0.f};
#pragma unroll
            for (int j = 0; j < 8; ++j) { const f32x4 w = *(const LAS f32x4*)(wl + e * DM + j * 256 + F.lane * 4); const f32x2 wlo = __builtin_shufflevector(w, w, 0, 1), whi = __builtin_shufflevector(w, w, 2, 3);
                a0 += __builtin_shufflevector(x[0][j], x[0][j], 0, 1) * wlo; a0 += __builtin_shufflevector(x[0][j], x[0][j], 2, 3) * whi;
                a1 += __builtin_shufflevector(x[1][j], x[1][j], 0, 1) * wlo; a1 += __builtin_shufflevector(x[1][j], x[1][j], 2, 3) * whi;
                a2 += __builtin_shufflevector(x[2][j], x[2][j], 0, 1) * wlo; a2 += __builtin_shufflevector(x[2][j], x[2][j], 2, 3) * whi;
                a3 += __builtin_shufflevector(x[3][j], x[3][j], 0, 1) * wlo; a3 += __builtin_shufflevector(x[3][j], x[3][j], 2, 3) * whi; }
            float s0 = a0[0] + a0[1], s1 = a1[0] + a1[1], s2 = a2[0] + a2[1], s3 = a3[0] + a3[1];
            asm volatile("" : "+v"(s0), "+v"(s1), "+v"(s2), "+v"(s3) :: "memory"); __builtin_amdgcn_sched_barrier(0);
            lg[0][e] = s0; lg[1][e] = s1; lg[2][e] = s2; lg[3][e] = s3; }
#pragma unroll
        for (int r = 0; r < 4; ++r) router_reduce_store(lg[r], F.lane, F.aff() + (size_t)(row0 + r) * NE);
    }
}

__device__ __forceinline__ void topk_group(const Ctx& F, int N, int k, int row_base  , int e, int out_base  ) {
    LAS unsigned* keys = (LAS unsigned*)F.lds; LAS unsigned* hist = keys + 16384; LAS unsigned* sh = hist + 256;
    const int tid = F.tid;
    __syncthreads();
    for (int i = tid; i < N; i += 512) keys[i] = __float_as_uint(F.aff()[(size_t)(row_base + i) * NE + e]);
    unsigned prefix = 0u, need = (unsigned)k;
    for (int shift = 24; shift >= 0; shift -= 8) {
        if (tid < 256) hist[tid] = 0u;
        __syncthreads();
        for (int i = tid; i < N; i += 512) { const unsigned key = keys[i]; if (shift == 24 || (key >> (shift + 8)) == (prefix >> (shift + 8))) atomicAdd((unsigned*)&hist[(key >> shift) & 255u], 1u); }
        __syncthreads();
        if (tid < 64) {
            const int b0 = 255 - 4 * tid; const unsigned c0 = hist[b0], c1 = hist[b0 - 1], c2 = hist[b0 - 2], c3 = hist[b0 - 3]; const unsigned loc = c0 + c1 + c2 + c3;
            unsigned inc = loc;
#pragma unroll
            for (int o = 1; o < 64; o <<= 1) { const unsigned t = lane_up(inc, tid, o); if (tid >= o) inc += t; }
            const unsigned before = inc - loc;
            if (before < need && need <= inc) { unsigned cum = before; int d;
                if (cum + c0 >= need) d = b0; else { cum += c0; if (cum + c1 >= need) d = b0 - 1; else { cum += c1; if (cum + c2 >= need) d = b0 - 2; else { cum += c2; d = b0 - 3; } } }
                sh[0] = prefix | ((unsigned)d << shift); sh[1] = need - cum; }
        }
        __syncthreads();
        prefix = sh[0]; need = sh[1];
        __syncthreads();
    }
    const int per = N >= 512 ? N / 512 : 1; const int nact = N / per; unsigned cg = 0u, ce = 0u;
    if (tid < nact) for (int i = 0; i < per; ++i) { const unsigned key = keys[tid * per + i]; cg += key > prefix; ce += key == prefix; }
    unsigned pk = cg | (ce << 16), inc = pk;
#pragma unroll
    for (int o = 1; o < 64; o <<= 1) { const unsigned t = lane_up(inc, F.lane, o); if (F.lane >= o) inc += t; }
    if (F.lane == 63) sh[8 + F.wave] = inc;
    __syncthreads();
    unsigned woff = 0u;
    for (int w = 0; w < F.wave; ++w) woff += sh[8 + w];
    const unsigned exc = inc - pk + woff; unsigned gb = exc & 0xffffu, eb = exc >> 16; const unsigned ngt = (unsigned)k - need;
    if (tid < nact) for (int i = 0; i < per; ++i) { const int ti = tid * per + i; const unsigned key = keys[ti]; int s = -1;
        if (key > prefix) { s = (int)gb; ++gb; } else if (key == prefix) { if (eb < need) s = (int)(ngt + eb); ++eb; }
        const int row = row_base + ti;
        if (s >= 0) { F.rowidx()[out_base + s] = row; F.gatev()[out_base + s] = __uint_as_float(key); }
        F.slot()[(size_t)row * NE + e] = s >= 0 ? out_base + s : -1; }
    __syncthreads();
}
__device__ __forceinline__ void ph_topk(const Ctx& F, int li) {
    const int ngroups = (li == 0) ? 64 : 32;
    for (int g = F.wg; g < ngroups; g += F.G) {
        if (g < 32) { const int b = g >> 4, e = g & 15; topk_group(F, SEQ, CAP, b * SEQ, e, g * CAP); }
        else { const int b = (g - 32) >> 4, e = (g - 32) & 15; const int base = NBATCH * NE * CAP + e * 256;
            topk_group(F, LCTX, CAPC, NLAT + b * LCTX, e, base + b * CAPC);
            if (b == 0 && F.tid < 192) { F.rowidx()[base + 64 + F.tid] = 0; F.gatev()[base + 64 + F.tid] = 0.f; } }
    }
}

constexpr size_t CTL_KMAX = 16384;
namespace ret {
constexpr int TS = 136;
constexpr int TILE_B = 128 * TS * 2;
__device__ __forceinline__ float log2_gamma(float decay) { return -log1pf(expf(-decay)) * LOG2E; }
__device__ __forceinline__ int chunk_row0(int b, int c) { return c < 2 ? NLAT + b * LCTX + c * 128 : b * SEQ + (c - 2) * 128; }
__device__ __forceinline__ f32x16 mm_block(const LAS bf16_t* A, int ra, const LAS bf16_t* B, int rb, int r32, int hi, f32x16 acc) {
#pragma unroll
    for (int s = 0; s < 8; ++s) { const bf16x8 a = *(const LAS bf16x8*)(A + (ra + r32) * TS + 16 * s + 8 * hi), b = *(const LAS bf16x8*)(B + (rb + r32) * TS + 16 * s + 8 * hi);
        acc = __builtin_amdgcn_mfma_f32_32x32x16_bf16(a, b, acc, 0, 0, 0); }
    return acc;
}
__device__ __forceinline__ bf16x8 scale8(bf16x8 v, float s) {
    const u32x4 w = *reinterpret_cast<const u32x4*>(&v); u32x4 o;
    o.x = cvt_pk_bf16(bflo(w.x) * s, bfhi(w.x) * s); o.y = cvt_pk_bf16(bflo(w.y) * s, bfhi(w.y) * s); o.z = cvt_pk_bf16(bflo(w.z) * s, bfhi(w.z) * s); o.w = cvt_pk_bf16(bflo(w.w) * s, bfhi(w.w) * s);
    return *reinterpret_cast<const bf16x8*>(&o);
}
__device__ __forceinline__ f32x16 mm_block_rowscaled(const LAS bf16_t* A, int ra, float rowscale, const LAS bf16_t* B, int rb, int r32, int hi, f32x16 acc) {
#pragma unroll
    for (int s = 0; s < 8; ++s) { const bf16x8 a = scale8(*(const LAS bf16x8*)(A + (ra + r32) * TS + 16 * s + 8 * hi), rowscale), b = *(const LAS bf16x8*)(B + (rb + r32) * TS + 16 * s + 8 * hi);
        acc = __builtin_amdgcn_mfma_f32_32x32x16_bf16(a, b, acc, 0, 0, 0); }
    return acc;
}
__device__ __forceinline__ void ld4(const bf16_t* src, int ld, int tid, bf16x8 (&v)[4]) {
#pragma unroll
    for (int p = 0; p < 4; ++p) { const int idx = tid + 512 * p; v[p] = *reinterpret_cast<const bf16x8*>(src + (size_t)(idx >> 4) * ld + (idx & 15) * 8); }
}
__device__ __forceinline__ void st4_nat(LAS bf16_t* dst, int tid, const bf16x8 (&v)[4]) {
#pragma unroll
    for (int p = 0; p < 4; ++p) { const int idx = tid + 512 * p; *(LAS bf16x8*)(dst + (idx >> 4) * TS + (idx & 15) * 8) = v[p]; }
}
__device__ __forceinline__ void st4_tr(LAS bf16_t* dst, int tid, const bf16x8 (&v)[4], float e0, float e1) {
#pragma unroll
    for (int p = 0; p < 4; ++p) { const int idx = tid + 512 * p; const int m = idx >> 4, c0 = (idx & 15) * 8; const float sc = __builtin_amdgcn_exp2f(e0 + e1 * (float)m);
#pragma unroll
        for (int i = 0; i < 8; ++i) dst[(c0 + i) * TS + m] = f2bf(bf2f((bf16_t)v[p][i]) * sc); }
}

__device__ __forceinline__ void st4_vst(LAS bf16_t* dst, int tid, const bf16x8 (&v)[4]) {
#pragma unroll
    for (int p = 0; p < 4; ++p) { const int idx = tid + 512 * p; const int m = idx >> 4, c0 = (idx & 15) * 8; *(LAS bf16x8*)((LAS char*)dst + (m >> 6) * 16384 + att::v_st(m & 63, c0)) = v[p]; }
}
__device__ __forceinline__ void st4_vst_scaled(LAS bf16_t* dst, int tid, const bf16x8 (&v)[4], float e0, float e1) {
#pragma unroll
    for (int p = 0; p < 4; ++p) { const int idx = tid + 512 * p; const int m = idx >> 4, c0 = (idx & 15) * 8; *(LAS bf16x8*)((LAS char*)dst + (m >> 6) * 16384 + att::v_st(m & 63, c0)) = scale8(v[p], __builtin_amdgcn_exp2f(e0 + e1 * (float)m)); }
}
template <int KS> __device__ __forceinline__ bf16x8 trfrag(int base) {
    const s16x4 lo = att::vtr(base + (KS >> 2) * 16384 + att::v_rd_off(0, KS & 3, 0)), hi = att::vtr(base + (KS >> 2) * 16384 + att::v_rd_off(0, KS & 3, 1));
    return (bf16x8){lo[0], lo[1], lo[2], lo[3], hi[0], hi[1], hi[2], hi[3]};
}
__device__ __forceinline__ f32x16 mm_block_trB(const LAS bf16_t* A, int ra, int tb, int r32, int hi, f32x16 acc) {
#define RET_STEP(KS) acc = __builtin_amdgcn_mfma_f32_32x32x16_bf16(*(const LAS bf16x8*)(A + (ra + r32) * TS + 16 * KS + 8 * hi), trfrag<KS>(tb), acc, 0, 0, 0)
    RET_STEP(0); RET_STEP(1); RET_STEP(2); RET_STEP(3); RET_STEP(4); RET_STEP(5); RET_STEP(6); RET_STEP(7);
#undef RET_STEP
    return acc;
}

__device__ __forceinline__ void c1_unit(const Ctx& F, int li, int bh, int c) {
    const int b = bh >> 2, h = bh & 3, tid = F.tid, wid = F.wave, r32 = F.lane & 31, hi = F.lane >> 5;
    LAS bf16_t* TVt = (LAS bf16_t*)F.lds; LAS bf16_t* KF = TVt + 16384; LAS bf16_t* KB = KF + 16384;
    const float lf = log2_gamma(F.in(I_RDF)[li * 4 + h]), lb = log2_gamma(F.in(I_RDB)[li * 4 + h]);
    const bf16_t* base = F.P() + (size_t)chunk_row0(b, c) * INW + h * HD;
    bf16x8 kv[4], vv[4]; ld4(base + C_CK, INW, tid, kv); ld4(base + C_CV, INW, tid, vv);
    __syncthreads();
    st4_vst(TVt, tid, vv); st4_vst_scaled(KF, tid, kv, 127.f * lf, -lf); st4_vst_scaled(KB, tid, kv, 0.f, lb);
    __syncthreads();
    const int dvb = wid >> 1, dk0 = 2 * (wid & 1); const int l0 = (int)(uintptr_t)F.lds + att::v_rd_base(F.lane);
    const int av = l0 + dvb * 512, bf0 = l0 + 32768 + dk0 * 512, bb0 = l0 + 65536 + dk0 * 512;
    f32x16 f0 = {}, f1 = {}, g0 = {}, g1 = {};
#define C1_STEP(KS) do { const bf16x8 a_ = trfrag<KS>(av); f0 = __builtin_amdgcn_mfma_f32_32x32x16_bf16(a_, trfrag<KS>(bf0), f0, 0, 0, 0); f1 = __builtin_amdgcn_mfma_f32_32x32x16_bf16(a_, trfrag<KS>(bf0 + 512), f1, 0, 0, 0); \
        g0 = __builtin_amdgcn_mfma_f32_32x32x16_bf16(a_, trfrag<KS>(bb0), g0, 0, 0, 0); g1 = __builtin_amdgcn_mfma_f32_32x32x16_bf16(a_, trfrag<KS>(bb0 + 512), g1, 0, 0, 0); } while (0)
    C1_STEP(0); C1_STEP(1); C1_STEP(2); C1_STEP(3); C1_STEP(4); C1_STEP(5); C1_STEP(6); C1_STEP(7);
#undef C1_STEP
    bf16_t* Uf = F.U() + ((size_t)(0 * 8 + bh) * NCH + c) * 16384; bf16_t* Ub = F.U() + ((size_t)(1 * 8 + bh) * NCH + c) * 16384;
#pragma unroll
    for (int r = 0; r < 16; ++r) { const int o_ = (dvb * 32 + crow(r, hi)) * 128 + dk0 * 32 + r32; Uf[o_] = f2bf(f0[r]); Uf[o_ + 32] = f2bf(f1[r]); Ub[o_] = f2bf(g0[r]); Ub[o_ + 32] = f2bf(g1[r]); }
}
__device__ __forceinline__ void c2_scan(const Ctx& F, int li) {
    for (int gid = F.wg * 512 + F.tid; gid < 2 * 8 * 16384; gid += F.G * 512) {
        const int dir = gid >> 17, bh = (gid >> 14) & 7, el = gid & 16383, h = bh & 3;
        const float lg = log2_gamma((dir ? F.in(I_RDB) : F.in(I_RDF))[li * 4 + h]); const float cd = __builtin_amdgcn_exp2f(128.f * lg);
        const bf16_t* U = F.U() + (size_t)(dir * 8 + bh) * NCH * 16384 + el; bf16_t* S = F.S() + (size_t)(dir * 8 + bh) * NCH * 16384 + el;
        float s = 0.f;
        if (dir == 0) {
#pragma unroll 8
            for (int c = 0; c < NCH; ++c) { const float u = bf2f(U[(size_t)c * 16384]); S[(size_t)c * 16384] = f2bf(s); s = cd * s + u; }
        } else {
            { const float u1 = bf2f(U[(size_t)1 * 16384]), u0 = bf2f(U[0]); S[(size_t)1 * 16384] = f2bf(0.f); s = u1; S[0] = f2bf(s); s = cd * s + u0; }
#pragma unroll 8
            for (int c = NCH - 1; c >= 2; --c) { const float u = bf2f(U[(size_t)c * 16384]); S[(size_t)c * 16384] = f2bf(s); s = cd * s + u; }
        }
    }
}
__device__ __forceinline__ void c3_unit(const Ctx& F, int li, int bh, int c) {
    int tid_ = F.tid, lane_ = F.lane; asm volatile("" : "+v"(tid_), "+v"(lane_));
    const int b = bh >> 2, h = bh & 3, tid = tid_, wid = F.wave, lane = lane_, r32 = lane & 31, hi = lane >> 5;
    LAS bf16_t* TQ = (LAS bf16_t*)F.lds; LAS bf16_t* TK = TQ + 128 * TS; LAS bf16_t* TV = TK + 128 * TS; LAS bf16_t* TP = TV + 128 * TS; LAS float* ST = (LAS float*)(TP + 128 * TS);
    const float lf = log2_gamma(F.in(I_RDF)[li * 4 + h]), lb = log2_gamma(F.in(I_RDB)[li * 4 + h]);
    const int row0 = chunk_row0(b, c);
    const bf16_t* base = F.P() + (size_t)row0 * INW + h * HD;
    bf16x8 qv[4], kv[4], vv[4], sf[4], sb[4], gv[4];
    ld4(base + C_CQ, INW, tid, qv); ld4(base + C_CK, INW, tid, kv); ld4(base + C_CV, INW, tid, vv);
    ld4(F.S() + ((size_t)(0 * 8 + bh) * NCH + c) * 16384, 128, tid, sf);
    __syncthreads();
    st4_nat(TQ, tid, qv); st4_nat(TK, tid, kv); st4_vst(TV, tid, vv);
    __syncthreads();
    const int rb = wid >> 1, cb0 = 2 * (wid & 1);
    {
        f32x16 s0 = {}, s1 = {}; s0 = mm_block(TQ, rb * 32, TK, cb0 * 32, r32, hi, s0); s1 = mm_block(TQ, rb * 32, TK, (cb0 + 1) * 32, r32, hi, s1);
#pragma unroll
        for (int r = 0; r < 16; ++r) { const int n = rb * 32 + crow(r, hi);
#pragma unroll
            for (int i = 0; i < 2; ++i) { const int m = (cb0 + i) * 32 + r32; const int d = n - m; float w = __builtin_amdgcn_exp2f((float)d * (d > 0 ? lf : -lb)); w = (d == 0) ? 2.0f : w;
                TP[n * TS + m] = f2bf((i ? s1[r] : s0[r]) * w); } }
    }
    __syncthreads();
    st4_nat(TK, tid, sf);
    asm volatile("" ::: "memory");
    ld4(F.S() + ((size_t)(1 * 8 + bh) * NCH + c) * 16384, 128, tid, sb);
    ld4(base + C_CG, INW, tid, gv);
    __syncthreads();
    const int nrow = rb * 32 + r32;
    f32x16 o0 = {}, o1 = {};
    { const int tvb = (int)(uintptr_t)F.lds + 2 * TILE_B + att::v_rd_base(lane) + cb0 * 512;
      o0 = mm_block_trB(TP, rb * 32, tvb, r32, hi, o0); o1 = mm_block_trB(TP, rb * 32, tvb + 512, r32, hi, o1); }
    { const float qs = __builtin_amdgcn_exp2f((float)(nrow + 1) * lf);
      o0 = mm_block_rowscaled(TQ, rb * 32, qs, TK, cb0 * 32, r32, hi, o0); o1 = mm_block_rowscaled(TQ, rb * 32, qs, TK, (cb0 + 1) * 32, r32, hi, o1); }
    __syncthreads();
    st4_nat(TK, tid, sb);
    __syncthreads();
    { const float qs = __builtin_amdgcn_exp2f((float)(128 - nrow) * lb);
      o0 = mm_block_rowscaled(TQ, rb * 32, qs, TK, cb0 * 32, r32, hi, o0); o1 = mm_block_rowscaled(TQ, rb * 32, qs, TK, (cb0 + 1) * 32, r32, hi, o1); }
#pragma unroll
    for (int r = 0; r < 16; ++r) { float s1 = o0[r] + o1[r], s2 = o0[r] * o0[r] + o1[r] * o1[r];
        s1 = sum32(s1); s2 = sum32(s2);
        if (r32 == 0) { ST[(rb * 32 + crow(r, hi)) * 4 + (wid & 1) * 2] = s1; ST[(rb * 32 + crow(r, hi)) * 4 + (wid & 1) * 2 + 1] = s2; } }
    __syncthreads();
    st4_nat(TQ, tid, gv);
    __syncthreads();
    const float* gg = F.in(I_GNG) + li * 512 + h * HD; const float* gb = F.in(I_GNB) + li * 512 + h * HD;
    float g0 = gg[cb0 * 32 + r32], g1 = gg[(cb0 + 1) * 32 + r32], b0 = gb[cb0 * 32 + r32], b1 = gb[(cb0 + 1) * 32 + r32];
#pragma unroll
    for (int r = 0; r < 16; ++r) { const int n = rb * 32 + crow(r, hi); const f32x4 st = *(const LAS f32x4*)(ST + n * 4);
        const float mean = (st[0] + st[2]) * (1.0f / 128.0f), var = (st[1] + st[3]) * (1.0f / 128.0f) - mean * mean, rstd = rsqrtf(var + 1e-5f);
        bf16_t* op = F.O() + (size_t)(row0 + n) * DM + 1024 + h * HD;
        const float gt0 = bf2f(TQ[n * TS + cb0 * 32 + r32]), gt1 = bf2f(TQ[n * TS + (cb0 + 1) * 32 + r32]);
        op[cb0 * 32 + r32] = f2bf(siluf(gt0) * ((o0[r] - mean) * rstd * g0 + b0)); op[(cb0 + 1) * 32 + r32] = f2bf(siluf(gt1) * ((o1[r] - mean) * rstd * g1 + b1)); }
}
}
__device__ __forceinline__ int clampi(int x, int lo, int hi) { return x < lo ? lo : (x > hi ? hi : x); }
__device__ __forceinline__ void unitA(const Ctx& F, int li, int idx) {
    const bool ctxq = idx >= 512; const int bh = ctxq ? idx - 512 : (idx & 7), qb = ctxq ? 0 : (idx >> 3), b = bh >> 2, h = bh & 3;
    LAS float* biasL = (LAS float*)(F.lds + att::BIAS_OFF);
    __syncthreads();
    { const float* rp = F.in(I_RPB) + (size_t)(li * 4 + h) * 15 * 31; for (int i = F.tid; i < 15 * 31; i += 512) biasL[i] = rp[i] * LOG2E; }
    att::Tiles T; att::MP mp{};
    const bf16_t* ctxrow = F.P() + (size_t)(NLAT + b * LCTX) * INW; const bf16_t* latrow = F.P() + (size_t)(b * SEQ) * INW;
    T.kctx = ctxrow + C_AK + h * HD; T.klat = latrow + C_AK + h * HD; T.vdelta = C_AV - C_AK; T.nctx = 4;
    const int r32 = F.lane & 31;
    const int qr0 = qb * 4; const int lo = clampi(qr0 - 4, 0, 248), hi_ = clampi(qr0 - 1, 0, 248) + 7;
    T.lat0 = lo; T.nt = ctxq ? 4 : 4 + (hi_ - lo + 1);
    const size_t qrow = ctxq ? (size_t)(NLAT + b * LCTX) : (size_t)(b * SEQ + qb * 256);
    int tidA_ = F.tid; asm volatile("" : "+v"(tidA_));
    att::attn_unit_a2(F.P() + qrow * INW + C_AQ + h * HD, T, F.O() + qrow * DM + h * HD, !ctxq, (const LAS float*)(F.lds + att::BIAS_OFF), qr0, F.ldsg, tidA_);
}
__device__ __forceinline__ void unitD(const Ctx& F, int li, int idx) {
    const bool ctxq = idx >= 512; const int bh = ctxq ? idx - 512 : (idx & 7), qb = ctxq ? 0 : (idx >> 3), b = bh >> 2, h = bh & 3, kv = h >> 1;
    att::Tiles T; att::MP mp{};
    const bf16_t* ctxrow = F.P() + (size_t)(NLAT + b * LCTX) * INW; const bf16_t* latrow = F.P() + (size_t)(b * SEQ) * INW;
    T.kctx = ctxrow + C_DK + kv * HD; T.klat = latrow + C_DK + kv * HD; T.vdelta = C_DV - C_DK; T.nctx = 4;
    mp.sink_l2 = F.in(I_SINK)[li * 4 + h] * LOG2E;
    const int lo = qb * 4 - 2 < 0 ? 0 : qb * 4 - 2, hi_ = qb * 4 + 5 > 255 ? 255 : qb * 4 + 5;
    T.lat0 = lo; T.nt = ctxq ? 4 : 4 + (hi_ - lo + 1); mp.masked = !ctxq; mp.tq = qb * 256 + F.wave * 32 + (F.lane & 31);
    const size_t qrow = ctxq ? (size_t)(NLAT + b * LCTX) : (size_t)(b * SEQ + qb * 256);
    int tidD_ = F.tid; asm volatile("" : "+v"(tidD_));
    att::attn_unit_simple<2>(F.P() + qrow * INW + C_DQ + h * HD, T, F.O() + qrow * DM + 1536 + h * HD, mp, F.ldsg, tidD_);
}
__device__ __forceinline__ void unitB(const Ctx& F, int li, int idx) {
    const bool ctxq = idx >= 1024; const int j = ctxq ? idx - 1024 : idx; const int bh = j & 7, qb = j >> 3, b = bh >> 2, h = bh & 3;
    att::TilesB3 T; att::MP mp{};
    const bf16_t* ctxrow = F.P() + (size_t)(NLAT + b * LCTX) * INW; const bf16_t* latrow = F.P() + (size_t)(b * SEQ) * INW;
    T.kctx = ctxrow + C_BK + h * HD; T.klat = latrow + C_BK + h * HD; T.vdelta = C_BV - C_BK; T.nt = ctxq ? 4 : 4 + SEQ / 64;
    mp.lam = F.misc()[li * 2]; mp.post = 1.0f - F.misc()[li * 2 + 1]; mp.normg = F.in(I_DNG) + li * HD;
    const size_t qrow = (ctxq ? (size_t)(NLAT + b * LCTX) : (size_t)(b * SEQ)) + (size_t)qb * 128;
    att::attn_unit_b3(F.P() + qrow * INW + C_BQ + h * HD, T, F.O() + qrow * DM + 512 + h * HD, mp, (const unsigned*)(F.ws() + WS_CTL + CTL_KMAX) + li * 16 + b * 8 + h * 2, F.ldsg, F.tid);
}

#define DYN_UNITS(ctr_, n_, slot_, BODY) do { unsigned nx_ = 0u; if (F.tid == 0) nx_ = __hip_atomic_fetch_add((ctr_), 1u, __ATOMIC_RELAXED, __HIP_MEMORY_SCOPE_AGENT); \
    for (;;) { __syncthreads(); if (F.tid == 0) (slot_)[0] = nx_; __syncthreads(); const int idx = (int)__builtin_amdgcn_readfirstlane((slot_)[0]); if (idx >= (n_)) break; \
        if (F.tid == 0) nx_ = __hip_atomic_fetch_add((ctr_), 1u, __ATOMIC_RELAXED, __HIP_MEMORY_SCOPE_AGENT); BODY } } while (0)
#define DYN_UNITS_X(ctr_, nper_, slot_, BODY) do { const unsigned x0_ = xb_xcc_id() & 7u; unsigned left_ = 0xFFu; \
    for (unsigned r_ = 0; r_ < 8u; ++r_) { const unsigned x_ = (x0_ + r_) & 7u; \
        if (r_ == 1u) { __syncthreads(); if (F.tid < 8) { const unsigned c_ = __hip_atomic_load((ctr_) + F.tid * 8, __ATOMIC_RELAXED, __HIP_MEMORY_SCOPE_AGENT); if (c_ >= (unsigned)(nper_)) atomicAnd((unsigned*)&(slot_)[2], ~(1u << F.tid)); } \
            __syncthreads(); left_ = __builtin_amdgcn_readfirstlane((slot_)[2]); } \
        if (r_ >= 1u && !((left_ >> x_) & 1u)) continue; \
        unsigned* cx_ = (ctr_) + x_ * 8; unsigned nx_ = 0u; if (F.tid == 0) nx_ = __hip_atomic_fetch_add(cx_, 1u, __ATOMIC_RELAXED, __HIP_MEMORY_SCOPE_AGENT); \
        for (;;) { __syncthreads(); if (F.tid == 0) (slot_)[0] = nx_; __syncthreads(); const int j_ = (int)__builtin_amdgcn_readfirstlane((slot_)[0]); if (j_ >= (nper_)) break; \
            if (F.tid == 0) nx_ = __hip_atomic_fetch_add(cx_, 1u, __ATOMIC_RELAXED, __HIP_MEMORY_SCOPE_AGENT); const int idx = j_ * 8 + (int)x_; BODY } } } while (0)
constexpr size_t CTL_DYN = 32768;
constexpr int LDS_SCRATCH = 147456, LDS_BYTES = LDS_SCRATCH + 256, IDXL_OFF = 131072;
constexpr int N_PHASES = 23;
__global__ void __launch_bounds__(512, 2) fwd_kernel(Args a) {
    extern __shared__ __attribute__((aligned(16))) unsigned char lds_raw[];
    volatile LAS unsigned* misc = (volatile LAS unsigned*)((LAS unsigned char*)lds_raw + LDS_SCRATCH);
    const int wave_s = __builtin_amdgcn_readfirstlane(threadIdx.x >> 6);
    if (wave_s == 0) { const int l0 = hw_lane(); if (l0 < 4) misc[l0] = 0u; }
    __syncthreads();
    const int lo = a.ph_lo, hi = a.ph_hi;
#ifdef DIAG_BARWAIT
    unsigned barwait_ = 0u;
#endif
    const bool use_bar = (hi - lo) > 1;
    XcdBarrier bar; bar.bar = (unsigned*)(a.ws + WS_CTL); bar.x = 0; bar.st = misc;
    if (use_bar) bar = xcd_barrier_post((unsigned*)(a.ws + WS_CTL), misc, wave_s == 0 && hw_lane() == 0);
#define FCTX const Ctx F = make_ctx(lds_raw, wave_s)
#ifndef PHMASK
#define PHMASK 0xFFFFFFFFu
#endif
#define EN(j) (((PHMASK) >> (j)) & 1u)
#ifndef REPMASK
#define REPMASK 0u
#endif
#define NREP(j) ((((REPMASK) >> (j)) & 1u) ? 2 : 1)
#define IN(k) (lo <= (k) && (k) < hi)
#ifdef EXP_BAR2
#define SEAM(k) do { if (IN(k) && IN((k) + 1)) { xcd_barrier(bar, wave_s == 0 && hw_lane() == 0); xcd_barrier(bar, wave_s == 0 && hw_lane() == 0); } } while (0)
#else
#ifdef DIAG_BARWAIT
#define SEAM(k) do { if (IN(k) && IN((k) + 1)) { const unsigned long long w0_ = wall_clock64(); xcd_barrier(bar, wave_s == 0 && hw_lane() == 0); if ((DIAG_SEAMS >> (k)) & 1u) barwait_ += (unsigned)(wall_clock64() - w0_); } } while (0)
#else
#define SEAM(k) do { if (IN(k) && IN((k) + 1)) xcd_barrier(bar, wave_s == 0 && hw_lane() == 0); } while (0)
#endif
#endif
    for (int rep_ = 0; rep_ < NREP(0); ++rep_) if (EN(0) && IN(0)) { FCTX; ph_mod_partial(F); } SEAM(0);
    for (int rep_ = 0; rep_ < NREP(1); ++rep_) if (EN(1) && IN(1)) { FCTX; ph_mod_reduce(F); ph_convert(F); } SEAM(1);
    const int F_G = gridDim.x;
    for (int li = 0; li < DEPTH; ++li) {
        const int pb = 2 + li * 10;
        for (int rep_ = 0; rep_ < (li == 0 ? NREP(2) : 1); ++rep_) if (EN(2) && IN(pb + 0)) { FCTX; ph_norm1(F, li); } SEAM(pb + 0);
        const bool split_in = use_bar && EN(3) && EN(4) && IN(pb + 1) && IN(pb + 2) && F_G >= 96;
        for (int rep_ = 0; rep_ < NREP(3); ++rep_) if (EN(3) && IN(pb + 1)) {
            if (split_in) {
                { FCTX; pg8::Gemm g{F.H(), F.w_in_t(li), DM, nullptr}; pg8::EpiInProj E{F.P(), F.rope(), (unsigned*)(F.ws() + WS_CTL + CTL_KMAX) + li * 16};
                  pg8::StaticOrder S; S.init(NLAT / 256, INW / 256, F.G, F.wg); pg8::gemm_phase<pg8::EpiInProj, pg8::StaticOrder, false>(F.lds, g, S, E, nullptr, F.tid); }
                xcd_barrier(bar, wave_s == 0 && hw_lane() == 0);
                if (blockIdx.x < 48) { FCTX; pg8::Gemm g{F.H(), F.w_in_t(li), DM, nullptr}; pg8::EpiInProj E{F.P(), F.rope(), (unsigned*)(F.ws() + WS_CTL + CTL_KMAX) + li * 16};
                  pg8::OffsetOrder S; S.init(NCTX / 256, INW / 256, 48, F.wg); S.pm0 = NLAT / 256; pg8::gemm_phase<pg8::EpiInProj, pg8::OffsetOrder, false>(F.lds, g, S, E, nullptr, F.tid); }
                else { FCTX; for (int idx = F.wg - 48; idx < 8 * (NCH - 2); idx += F.G - 48) ret::c1_unit(F, li, idx & 7, 2 + (idx >> 3)); }
            } else {
                FCTX; pg8::Gemm g{F.H(), F.w_in_t(li), DM, nullptr}; pg8::EpiInProj E{F.P(), F.rope(), (unsigned*)(F.ws() + WS_CTL + CTL_KMAX) + li * 16};
                pg8::StaticOrder S; S.init(MTOT / 256, INW / 256, F.G, F.wg);
#ifdef EXP_NOEPI_REP
                if (rep_ == 1) pg8::gemm_phase<pg8::EpiInProj, pg8::StaticOrder, false, true>(F.lds, g, S, E, nullptr, F.tid); else
#endif
                pg8::gemm_phase<pg8::EpiInProj, pg8::StaticOrder, false>(F.lds, g, S, E, nullptr, F.tid);
            }
        } SEAM(pb + 1);
        for (int rep_ = 0; rep_ < NREP(4); ++rep_) if (EN(4) && IN(pb + 2)) {
            FCTX;
            for (int r2_ = 0; r2_ < NREP(15); ++r2_) if (EN(15)) { if (split_in) { for (int idx = (F.wg + F.G - 120) % F.G; idx < 16; idx += F.G) ret::c1_unit(F, li, idx & 7, idx >> 3); }   else { for (int idx = F.wg; idx < 8 * NCH; idx += F.G) ret::c1_unit(F, li, idx & 7, idx >> 3); } }
            const int nAD = (li == 0) ? 520 : 512;
            if (!(split_in && EN(13) && EN(14) && EN(16) && EN(17) && IN(pb + 4))) {
            for (int r2_ = 0; r2_ < NREP(13); ++r2_) if (EN(13)) for (int idx = (F.wg + 8) % F.G; idx < nAD; idx += F.G) unitA(F, li, idx);
            for (int r2_ = 0; r2_ < NREP(14); ++r2_) if (EN(14)) for (int idx = F.wg; idx < nAD; idx += F.G) unitD(F, li, idx); }
        } SEAM(pb + 2);
        for (int rep_ = 0; rep_ < NREP(5); ++rep_) if (EN(5) && IN(pb + 3)) { FCTX; ret::c2_scan(F, li); } SEAM(pb + 3);
        for (int rep_ = 0; rep_ < NREP(6); ++rep_) if (EN(6) && IN(pb + 4)) {
            FCTX; const int nB = (li == 0) ? 1040 : 1024;
            if (EN(16)) for (int idx = F.wg; idx < nB; idx += F.G) unitB(F, li, idx);
            if (split_in && EN(13) && EN(14) && EN(16) && EN(17) && IN(pb + 2)) {
                unsigned* ctr = (unsigned*)(F.ws() + WS_CTL + CTL_DYN) + (li * 4 + 0) * 64; volatile LAS unsigned* slot = misc + 8; const int nAD = (li == 0) ? 520 : 512;
                __syncthreads(); if (F.tid == 0) slot[2] = 0xFFu; DYN_UNITS_X(ctr, nAD / 8, slot, { unitA(F, li, idx); });
                __syncthreads(); if (F.tid == 0) slot[2] = 0xFFu; DYN_UNITS_X(ctr + 128, nAD / 8, slot, { unitD(F, li, idx); }); }
            if (EN(17)) { if (use_bar) { unsigned* ctr = (unsigned*)(F.ws() + WS_CTL + CTL_DYN) + (li * 4 + 1) * 64; volatile LAS unsigned* slot = misc + 8;
                    DYN_UNITS(ctr, nB, slot, { if (idx < 1024) ret::c3_unit(F, li, idx & 7, 2 + (idx >> 3)); else ret::c3_unit(F, li, (idx - 1024) & 7, (idx - 1024) >> 3); }); }
                else for (int idx = F.wg; idx < nB; idx += F.G) { if (idx < 1024) ret::c3_unit(F, li, idx & 7, 2 + (idx >> 3)); else ret::c3_unit(F, li, (idx - 1024) & 7, (idx - 1024) >> 3); } }
        } SEAM(pb + 4);
        const bool split_out = use_bar && li == 0 && EN(7) && EN(8) && IN(pb + 5) && IN(pb + 6) && F_G >= 64;
        for (int rep_ = 0; rep_ < (li == 0 ? NREP(7) : 1); ++rep_) if (EN(7) && IN(pb + 5)) {
            FCTX; pg8::Gemm g{F.O(), F.w_out_t(li), DM, nullptr};
            pg8::EpiOutProj E{li == 0 ? F.in(I_X) : nullptr, F.xb(), F.xb(), F.in(I_CTX), F.xc(), F.mod() + (size_t)li * 3 * 12288};
            pg8::StaticOrder S; S.init((li == 0 && !split_out) ? MTOT / 256 : NLAT / 256, DM / 256, F.G, F.wg);
            pg8::gemm_phase<pg8::EpiOutProj, pg8::StaticOrder, false>(F.lds, g, S, E, nullptr, F.tid);
        } SEAM(pb + 5);
        for (int rep_ = 0; rep_ < NREP(8); ++rep_) if (EN(8) && IN(pb + 6)) {
            if (split_out) {
                if (blockIdx.x < 16) { FCTX; pg8::Gemm g{F.O(), F.w_out_t(li), DM, nullptr}; pg8::EpiOutProj E{F.in(I_X), F.xb(), F.xb(), F.in(I_CTX), F.xc(), F.mod() + (size_t)li * 3 * 12288};
                    pg8::OffsetOrder S; S.init(NCTX / 256, DM / 256, 16, F.wg); S.pm0 = NLAT / 256; pg8::gemm_phase<pg8::EpiOutProj, pg8::OffsetOrder, false>(F.lds, g, S, E, nullptr, F.tid); }
                else { FCTX; ph_norm2(F, li, 0, NLAT, 16, F.G - 16); }
                xcd_barrier(bar, wave_s == 0 && hw_lane() == 0);
                if (blockIdx.x < 16) { FCTX; ph_norm2(F, li, NLAT, MTOT, 0, 16); }
            } else { FCTX; ph_norm2(F, li, 0, NLAT, 0, F.G); if (li == 0) ph_norm2(F, li, NLAT, MTOT, 0, F.G); }
        } SEAM(pb + 6);
        for (int rep_ = 0; rep_ < NREP(9); ++rep_) if (EN(9) && IN(pb + 7)) { FCTX; ph_topk(F, li); } SEAM(pb + 7);
        for (int rep_ = 0; rep_ < NREP(10); ++rep_) if (EN(10) && IN(pb + 8)) {
            FCTX; pg8::Gemm g{F.H(), F.w_gu_t(li), DM, F.rowidx()}; pg8::MoeOrder S; S.init(li == 0 ? 272 : 256, 8, F.G, F.wg); pg8::EpiSwiGLU E{F.ACT()};
            pg8::gemm_phase<pg8::EpiSwiGLU, pg8::MoeOrder, true>(F.lds, g, S, E, (LAS int*)(F.lds + IDXL_OFF), F.tid);
        } SEAM(pb + 8);
        for (int rep_ = 0; rep_ < NREP(11); ++rep_) if (EN(11) && IN(pb + 9)) {
            FCTX; pg8::Gemm g{F.ACT(), F.w_dn_t(li), FF, nullptr}; pg8::MoeOrder S; S.init(li == 0 ? 272 : 256, 8, F.G, F.wg); pg8::EpiDown E{F.Y(), F.gatev()};
            pg8::gemm_phase<pg8::EpiDown, pg8::MoeOrder, false>(F.lds, g, S, E, nullptr, F.tid);
        } SEAM(pb + 9);
    }
    for (int rep_ = 0; rep_ < NREP(12); ++rep_) if (EN(12) && IN(22)) { FCTX; ph_final(F); }
#ifdef DIAG_BARWAIT
    if (blockIdx.x == DIAG_WG && wave_s == 0 && hw_lane() == 0 && barwait_ > (unsigned)DIAG_BARWAIT) a.out[(size_t)DIAG_WG * 3] += 1000.0f;
#endif
#undef IN
#undef SEAM
#undef FCTX
}

#ifndef N_LAUNCHES
#define N_LAUNCHES 1
#endif
extern "C" void kernel_launch(void* const* d_in, const int* in_sizes, int n_in, void* d_out, int out_size, void* d_ws, size_t ws_size, hipStream_t stream) {
    static int grid = 0;
    if (grid == 0) {
        if (n_in != 23 || out_size != NLAT * DM || ws_size < WS_END) { fprintf(stderr, "kernel_launch: unexpected shapes: n_in %d out %d ws %zu (need %zu)\n", n_in, out_size, ws_size, (size_t)WS_END); grid = -1; return; }
        int dev = 0, cus = 0, per_cu = 0;
        if (hipGetDevice(&dev) != hipSuccess || hipDeviceGetAttribute(&cus, hipDeviceAttributeMultiprocessorCount, dev) != hipSuccess) { grid = -1; return; }
        if (hipFuncSetAttribute((const void*)fwd_kernel, hipFuncAttributeMaxDynamicSharedMemorySize, LDS_BYTES) != hipSuccess) { fprintf(stderr, "kernel_launch: hipFuncSetAttribute failed\n"); grid = -1; return; }
        if (hipOccupancyMaxActiveBlocksPerMultiprocessor(&per_cu, (const void*)fwd_kernel, 512, LDS_BYTES) != hipSuccess || per_cu < 1) fprintf(stderr, "kernel_launch: occupancy query says %d\n", per_cu);
        (void)hipGetLastError();
        grid = cus;
    }
    if (grid < 0) return;
    hipMemsetAsync((char*)d_ws + WS_CTL, 0, CTL_BYTES, stream);
    Args a{};
    for (int i = 0; i < 23; ++i) a.in[i] = (const float*)d_in[i];
    a.out = (float*)d_out; a.ws = (unsigned char*)d_ws;
    for (int k = 0; k < N_LAUNCHES; ++k) {
        a.ph_lo = (N_LAUNCHES == 1) ? 0 : k; a.ph_hi = (N_LAUNCHES == 1) ? N_PHASES : k + 1;
        hipLaunchKernelGGL(fwd_kernel, dim3(grid), dim3(512), LDS_BYTES, stream, a);
    }
    const hipError_t le = hipPeekAtLastError();
    if (le != hipSuccess) fprintf(stderr, "kernel_launch: launch failed: %s\n", hipGetErrorName(le));
}
```

```cpp
#include <hip/hip_runtime.h>
#include <cstdio>
#include <cstdint>

#define LAS __attribute__((address_space(3)))
typedef unsigned short bf16_t;
typedef short bf16x8 __attribute__((ext_vector_type(8)));
typedef short s16x4 __attribute__((ext_vector_type(4)));
typedef float f32x4 __attribute__((ext_vector_type(4)));
typedef float f32x2 __attribute__((ext_vector_type(2)));
typedef float f32x16 __attribute__((ext_vector_type(16)));
typedef unsigned u32x4 __attribute__((ext_vector_type(4)));
typedef unsigned u32x2 __attribute__((ext_vector_type(2)));

constexpr int DM = 2048, NBATCH = 2, SEQ = 16384, LCTX = 256, DEPTH = 2;
constexpr int NLAT = NBATCH * SEQ;
constexpr int NCTX = NBATCH * LCTX;
constexpr int MTOT = NLAT + NCTX;
constexpr int INW = 6144;
constexpr int HD = 128;
constexpr int NE = 16, FF = 1024, CAP = 2048, CAPC = 32;
constexpr int MOE_ROWS = NBATCH * NE * CAP + NE * 256;
constexpr int NCH = 130;
constexpr int C_AQ = 0, C_AK = 512, C_AV = 1024, C_BQ = 1536, C_BK = 2048, C_BV = 2560, C_CQ = 3072, C_CK = 3584, C_CV = 4096, C_CG = 4608, C_DQ = 5120, C_DK = 5632, C_DV = 5888;
constexpr float LOG2E = 1.4426950408889634f;
constexpr float NEGBIG = -1e30f;

constexpr size_t al256(size_t x) { return (x + 255) / 256 * 256; }
constexpr size_t WS_CTL = 0;
constexpr size_t CTL_BYTES = 65536;
constexpr size_t WS_MODP = WS_CTL + CTL_BYTES;
constexpr size_t WS_MOD = WS_MODP + al256((size_t)16 * 2 * 3 * 12288 * 4);
constexpr size_t WS_MISC = WS_MOD + al256((size_t)2 * 3 * 12288 * 4);
constexpr size_t WS_ROPE = WS_MISC + 256;
constexpr size_t WS_XC = WS_ROPE + al256((size_t)(256 * 32 * 2 + 256 * 16 * 2) * 4);
constexpr size_t WS_AFF = WS_XC + al256((size_t)NCTX * DM * 4);
constexpr size_t WS_ROWIDX = WS_AFF + al256((size_t)MTOT * NE * 4);
constexpr size_t WS_GATEV = WS_ROWIDX + al256((size_t)MOE_ROWS * 4);
constexpr size_t WS_SLOT = WS_GATEV + al256((size_t)MOE_ROWS * 4);
constexpr size_t WS_H = WS_SLOT + al256((size_t)MTOT * NE * 4);
constexpr size_t H_BYTES = (size_t)MTOT * DM * 2;
constexpr size_t WS_P = WS_H + al256(H_BYTES);
constexpr size_t P_BYTES = (size_t)MTOT * INW * 2;
constexpr size_t WS_O = WS_P + al256(P_BYTES);
constexpr size_t WS_S = WS_O + al256(H_BYTES);
constexpr size_t S_BYTES = (size_t)2 * 8 * NCH * 16384 * 2;
constexpr size_t WS_W = WS_S + al256(S_BYTES);
constexpr size_t W_IN_B = (size_t)INW * DM * 2, W_OUT_B = (size_t)DM * DM * 2, W_GU_B = (size_t)NE * 2048 * DM * 2, W_DN_B = (size_t)NE * DM * FF * 2;
constexpr size_t WL_IN = 0, WL_OUT = WL_IN + W_IN_B, WL_GU = WL_OUT + W_OUT_B, WL_DN = WL_GU + W_GU_B, WL_BYTES = WL_DN + W_DN_B;
constexpr size_t WS_XB = WS_W + 2 * WL_BYTES;
constexpr size_t WS_END = WS_XB + al256((size_t)NLAT * DM * 2);
constexpr size_t ACT_OFF = 0;
constexpr size_t Y_OFF = al256((size_t)MOE_ROWS * FF * 2);
static_assert(Y_OFF + (size_t)MOE_ROWS * DM * 2 <= al256(P_BYTES) + H_BYTES, "Y must fit in P + O");
static_assert((size_t)2 * 8 * NCH * 16384 * 2 <= (size_t)NLAT * DM * 2, "retention U (bf16) must fit in the latent part of H");

__device__ __forceinline__ unsigned cvt_pk_bf16(float lo, float hi) { unsigned r; asm volatile("v_cvt_pk_bf16_f32 %0, %1, %2" : "=v"(r) : "v"(lo), "v"(hi)); return r; }
__device__ __forceinline__ bf16_t f2bf(float f) { return (bf16_t)(cvt_pk_bf16(f, 0.f) & 0xffffu); }
__device__ __forceinline__ float bf2f(bf16_t b) { return __uint_as_float(((unsigned)b) << 16); }
__device__ __forceinline__ float bflo(unsigned w) { return __uint_as_float(w << 16); }
__device__ __forceinline__ float bfhi(unsigned w) { return __uint_as_float(w & 0xffff0000u); }
__device__ __forceinline__ float siluf(float x) { return x / (1.0f + __expf(-x)); }
template <int M> __device__ __forceinline__ float xshf(float v) { return __int_as_float(__builtin_amdgcn_ds_swizzle(__float_as_int(v), (M << 10) | 0x1f)); }
__device__ __forceinline__ float sum32(float s) { s += xshf<1>(s); s += xshf<2>(s); s += xshf<4>(s); s += xshf<8>(s); s += xshf<16>(s); return s; }
__device__ __forceinline__ float sum64(float s) { s = sum32(s); auto rr = __builtin_amdgcn_permlane32_swap(__float_as_uint(s), __float_as_uint(s), false, false); return __uint_as_float(rr[0]) + __uint_as_float(rr[1]); }
__device__ __forceinline__ unsigned lane_up(unsigned v, int lane, int o) { return (unsigned)__builtin_amdgcn_ds_bpermute((lane - o) << 2, (int)v); }
__device__ __forceinline__ int crow(int r, int hi) { return (r & 3) + 8 * (r >> 2) + 4 * hi; }

#define XB_TMO      128
#define XB_XCNT(j)  (256  + 64 * (j))
#define XB_XSUB(j)  (1280 + 64 * (j))
#define XB_XGEN(j)  (2304 + 64 * (j))
#define XB_TOP      3328
#define XB_TOPGEN   3392
#define XCD_BAR_WORDS 3456
#define XB_SPIN_CAP (1u << 24)
__device__ __forceinline__ unsigned xb_ld(unsigned* p)              { return __hip_atomic_load(p, __ATOMIC_RELAXED, __HIP_MEMORY_SCOPE_AGENT); }
__device__ __forceinline__ unsigned xb_add(unsigned* p, unsigned v) { return __hip_atomic_fetch_add(p, v, __ATOMIC_RELAXED, __HIP_MEMORY_SCOPE_AGENT); }
__device__ __forceinline__ unsigned xb_xcc_id() { return (unsigned)__builtin_amdgcn_s_getreg((3 << 11) | 20) & 0xFu; }
#define XB_SPIN(cond, bar) do { unsigned _sp = 0; while (cond) { __builtin_amdgcn_s_sleep(1); \
    if ((++_sp & 255u) == 0u) { if (xb_ld(&(bar)[XB_TMO])) break; if (_sp > XB_SPIN_CAP) { atomicAdd(&(bar)[XB_TMO], 1u); break; } } } } while (0)
struct XcdBarrier { unsigned* bar; unsigned x; volatile LAS unsigned* st; };
__device__ __forceinline__ XcdBarrier xcd_barrier_post(unsigned* bar, volatile LAS unsigned* st, bool leader) {
    XcdBarrier b; b.bar = bar; b.x = xb_xcc_id(); b.st = st;
    if (leader) (void)xb_add(&bar[XB_XCNT(b.x)], 1u);
    return b;
}
__device__ __forceinline__ void xcd_barrier_complete(unsigned* bar, unsigned x, unsigned& nloc, unsigned& nx) {
    const unsigned G = gridDim.x * gridDim.y * gridDim.z;
    unsigned sum, cnt, mine, sp = 0u;
    for (;;) {
        sum = 0u; cnt = 0u; mine = 0u;
#pragma unroll
        for (unsigned j = 0; j < 16; ++j) { const unsigned c = xb_ld(&bar[XB_XCNT(j)]); sum += c; cnt += (c > 0u) ? 1u : 0u; mine = (j == x) ? c : mine; }
        if (sum == G) break;
        __builtin_amdgcn_s_sleep(1);
        if ((++sp & 255u) == 0u) { if (xb_ld(&bar[XB_TMO])) break; if (sp > XB_SPIN_CAP) { atomicAdd(&bar[XB_TMO], 1u); break; } }
    }
    nloc = mine > 0u ? mine : 1u; nx = cnt > 0u ? cnt : 1u;
}
__device__ __forceinline__ void xcd_barrier(const XcdBarrier& b, bool leader) {
    asm volatile("s_waitcnt vmcnt(0)" ::: "memory");
    __syncthreads();
    if (leader) {
        unsigned* bar = b.bar;
        __builtin_amdgcn_s_waitcnt(0);
        unsigned nloc = b.st[0], nx = b.st[1];
        if (nloc == 0u) { xcd_barrier_complete(bar, b.x, nloc, nx); b.st[0] = nloc; b.st[1] = nx; }
        const unsigned old = xb_add(&bar[XB_XSUB(b.x)], 1u);
        const unsigned gen = old / nloc;
        if (old + 1u == (gen + 1u) * nloc) {
            __builtin_amdgcn_fence(__ATOMIC_RELEASE, "agent");
            asm volatile("s_waitcnt vmcnt(0)" ::: "memory");
            const unsigned og = xb_add(&bar[XB_TOP], 1u);
            const unsigned tg = og / nx;
            if (og + 1u == (tg + 1u) * nx) xb_add(&bar[XB_TOPGEN], 1u);
            else XB_SPIN(xb_ld(&bar[XB_TOPGEN]) == tg, bar);
            __builtin_amdgcn_fence(__ATOMIC_ACQUIRE, "agent");
            xb_add(&bar[XB_XGEN(b.x)], 1u);
            asm volatile("s_waitcnt vmcnt(0)" ::: "memory");
        } else {
            XB_SPIN(xb_ld(&bar[XB_XGEN(b.x)]) == gen, bar);
            __builtin_amdgcn_fence(__ATOMIC_ACQUIRE, "agent");
            asm volatile("s_waitcnt vmcnt(0)" ::: "memory");
        }
    }
    __syncthreads();
}
namespace pg8 {
constexpr int BM = 256, BK = 64, HALF = 128, HTB = HALF * BK * 2, STAGE_BYTES = 8 * HTB, NXCD = 8, WGM = 8;
__host__ __device__ __forceinline__ int lds_byte(int r, int c) { const int st = (r >> 4) * 2 + (c >> 5), rr = r & 15, cc = c & 31, ob = rr * 64 + cc * 2; return st * 1024 + (ob ^ (((ob >> 9) & 1) << 5)); }
__host__ __device__ __forceinline__ void stage_rc(int b, int& R, int& C) { const int st = b / 1024, sb = b % 1024, swz = sb ^ (((sb >> 9) & 1) << 5); R = (st >> 1) * 16 + swz / 64; C = (st & 1) * 32 + (swz % 64) / 2; }
__host__ __device__ __forceinline__ int perm32(int rho) { const int n = rho >> 4, i = rho & 15; return 8 * (i >> 2) + 4 * n + (i & 3); }

struct Unit { int pm, pn; };
struct Gemm { const bf16_t* A; const bf16_t* Bt; int K; const int* rowidx; };

struct StaticOrder {
    int nM, nN, nwg, G, c;
    __device__ void init(int nM_, int nN_, int G_, int c_) { nM = nM_; nN = nN_; nwg = nM * nN; G = G_; c = c_; }
    __device__ bool next(int i, Unit& u) const {
        const long L = (long)i * G + c; if (L >= nwg) return false;
        int wgid = (int)L; { const int q = nwg / NXCD, r = nwg % NXCD, xcd = wgid % NXCD, off = wgid / NXCD; wgid = (xcd < r ? xcd * (q + 1) : r * (q + 1) + (xcd - r) * q) + off; }
        const int nig = WGM * nN, gid = wgid / nig, fm = gid * WGM, gsz = (nM - fm) < WGM ? (nM - fm) : WGM;
        u.pm = fm + ((wgid % nig) % gsz); u.pn = (wgid % nig) / gsz; return true;
    }
};
struct OffsetOrder : StaticOrder {
    int pm0;
    __device__ bool next(int i, Unit& u) const { if (!StaticOrder::next(i, u)) return false; u.pm += pm0; return true; }
};
__device__ __forceinline__ int moe_expert_of_tile(int pm) { return pm < 256 ? ((pm >> 3) & 15) : (pm - 256); }
struct MoeOrder : StaticOrder {
    __device__ bool next(int i, Unit& u) const { if (!StaticOrder::next(i, u)) return false; u.pn += moe_expert_of_tile(u.pm) * 8; return true; }
};

template <class Epi, class Sched, bool GATHER, bool NOEPI = false>
__device__ __forceinline__ void gemm_phase(LAS unsigned char* lds, const Gemm g, const Sched& S, const Epi& E, LAS int* idxl, const int tid) {
    const int wid = __builtin_amdgcn_readfirstlane(tid >> 6), lane = tid & 63, wr = wid >> 2, wc = wid & 3, fr = lane & 15, fq = lane >> 4;
    const int K = g.K, nt = K / BK;
    unsigned voffA[2], voffB[2]; int RA[2];
#pragma unroll
    for (int i = 0; i < 2; ++i) { int R, C; stage_rc(tid * 16 + i * 8192, R, C); const int Rb = Epi::PERM ? ((R & ~31) + perm32(R & 31)) : R;
        voffA[i] = (unsigned)(R * K + C) * 2u; voffB[i] = (unsigned)(Rb * K + C) * 2u; RA[i] = R; if (GATHER) voffA[i] = (unsigned)C * 2u; }
    const size_t kstep = (size_t)(BK * 2);
    const size_t hstep = (size_t)HALF * K * 2;
    const size_t tstep = 2 * hstep;
    const unsigned ldsw = (unsigned)wid * 1024u;
    const int aoff = lds_byte(wr * 64 + fr, fq * 8), boff = lds_byte(wc * 32 + fr, fq * 8);
#define PG8_SA(b, h) (((b) * 2 + (h)) * HTB)
#define PG8_SB(b, h) ((4 + (b) * 2 + (h)) * HTB)
#define PG8_STAGE(bufoff, gbase, voff) do { _Pragma("unroll") for (int _i = 0; _i < 2; ++_i) \
        __builtin_amdgcn_global_load_lds((const unsigned*)((const char*)(gbase) + (voff)[_i]), (LAS unsigned*)(lds + (bufoff) + ldsw + _i * 8192), 16, 0, 0); } while (0)
#define PG8_STAGE_A(bufoff, h, pA, offs) do { _Pragma("unroll") for (int _i = 0; _i < 2; ++_i) { const char* _p; \
        if constexpr (GATHER) _p = (const char*)(pA) + (offs)[h][_i]; else _p = (const char*)(pA) + (size_t)(h) * hstep + voffA[_i]; \
        __builtin_amdgcn_global_load_lds((const unsigned*)_p, (LAS unsigned*)(lds + (bufoff) + ldsw + _i * 8192), 16, 0, 0); } } while (0)
#define PG8_LDA(dst, b, h) do { _Pragma("unroll") for (int m = 0; m < 4; ++m) _Pragma("unroll") for (int k = 0; k < 2; ++k) dst[m][k] = *(const LAS bf16x8*)(lds + PG8_SA(b, h) + aoff + m * 2048 + k * 1024); } while (0)
#define PG8_LDB(dst, b, h) do { _Pragma("unroll") for (int n = 0; n < 2; ++n) _Pragma("unroll") for (int k = 0; k < 2; ++k) dst[n][k] = *(const LAS bf16x8*)(lds + PG8_SB(b, h) + boff + n * 2048 + k * 1024); } while (0)
#define PG8_MMA(ai, bj, At, Bt) do { __builtin_amdgcn_s_setprio(1); _Pragma("unroll") for (int m = 0; m < 4; ++m) _Pragma("unroll") for (int n = 0; n < 2; ++n) _Pragma("unroll") for (int k = 0; k < 2; ++k) \
        acc[ai][bj][m][n] = __builtin_amdgcn_mfma_f32_16x16x32_bf16(Bt[n][k], At[m][k], acc[ai][bj][m][n], 0, 0, 0); __builtin_amdgcn_s_setprio(0); } while (0)
#define PG8_WAIT_V(n) asm volatile("s_waitcnt vmcnt(" #n ")" ::: "memory")
#define PG8_WAIT_L(n) asm volatile("s_waitcnt lgkmcnt(" #n ")" ::: "memory")
#define PG8_BAR __builtin_amdgcn_s_barrier()
#define PG8_SCHED __builtin_amdgcn_sched_barrier(0)
    Unit cur, nxt; int ui = 0;
    if (!S.next(0, cur)) return;
    f32x4 acc[2][2][4][2];
#pragma unroll
    for (int a = 0; a < 2; ++a)
#pragma unroll
        for (int b = 0; b < 2; ++b)
#pragma unroll
            for (int m = 0; m < 4; ++m)
#pragma unroll
                for (int n = 0; n < 2; ++n) acc[a][b][m][n] = (f32x4){0.f, 0.f, 0.f, 0.f};
    bf16x8 At[4][2], B0[2][2], B1[2][2];
    unsigned oc[2][2] = {{0u, 0u}, {0u, 0u}}, on[2][2] = {{0u, 0u}, {0u, 0u}};
#define PG8_GOFF(dst, ui_) do { if constexpr (GATHER) { _Pragma("unroll") for (int _h = 0; _h < 2; ++_h) _Pragma("unroll") for (int _i = 0; _i < 2; ++_i) \
        dst[_h][_i] = (unsigned)idxl[(ui_) * BM + _h * HALF + RA[_i]] * (unsigned)(K * 2) + voffA[_i]; } } while (0)
    if constexpr (GATHER) {
        for (int i = 0; i < 16; ++i) { Unit uu; if (!S.next(i, uu)) break; if (tid < BM) idxl[i * BM + tid] = g.rowidx[uu.pm * BM + tid]; }
        __syncthreads();
    }
    PG8_GOFF(oc, 0);
    const char* cA = GATHER ? (const char*)g.A : (const char*)g.A + (size_t)cur.pm * tstep; const char* cB = (const char*)g.Bt + (size_t)cur.pn * tstep;
    PG8_STAGE(PG8_SB(0, 0), cB, voffB); PG8_STAGE(PG8_SB(0, 1), cB + hstep, voffB); PG8_STAGE_A(PG8_SA(0, 0), 0, cA, oc); PG8_STAGE_A(PG8_SA(0, 1), 1, cA, oc);
    if (wr == 1) PG8_BAR;
    PG8_WAIT_V(2); PG8_BAR;
    PG8_STAGE(PG8_SB(1, 0), cB + kstep, voffB); PG8_STAGE_A(PG8_SA(1, 0), 0, cA + kstep, oc); PG8_STAGE(PG8_SB(1, 1), cB + hstep + kstep, voffB);
    PG8_WAIT_V(6); PG8_BAR;
    for (;;) {
        const bool has_next = S.next(ui + 1, nxt);
        if (has_next) PG8_GOFF(on, ui + 1); else { if constexpr (GATHER) { on[0][0] = oc[0][0]; on[0][1] = oc[0][1]; on[1][0] = oc[1][0]; on[1][1] = oc[1][1]; } }
        const char* nA = GATHER ? (const char*)g.A : (has_next ? (const char*)g.A + (size_t)nxt.pm * tstep : cA);
        const char* nB = has_next ? (const char*)g.Bt + (size_t)nxt.pn * tstep : cB;
        for (int t = 0; t < nt; t += 2) {
            const bool last = (t == nt - 2);
            const char* a1 = cA + (size_t)(t + 1) * kstep;
            const char* a2 = last ? nA : cA + (size_t)(t + 2) * kstep; const char* b2 = last ? nB : cB + (size_t)(t + 2) * kstep;
            const char* a3 = a2 + kstep; const char* b3 = b2 + kstep;
            unsigned o2[2][2];
#pragma unroll
            for (int _h = 0; _h < 2; ++_h)
#pragma unroll
                for (int _i = 0; _i < 2; ++_i) o2[_h][_i] = last ? on[_h][_i] : oc[_h][_i];
            PG8_LDB(B0, 0, 0); PG8_LDB(B1, 0, 1); PG8_SCHED; PG8_LDA(At, 0, 0); PG8_STAGE_A(PG8_SA(1, 1), 1, a1, oc);
            PG8_WAIT_V(8); PG8_WAIT_L(0); PG8_BAR; PG8_MMA(0, 0, At, B0); PG8_MMA(0, 1, At, B1); PG8_BAR; PG8_SCHED;
            PG8_LDA(At, 0, 1); PG8_STAGE(PG8_SB(0, 0), b2, voffB); PG8_STAGE(PG8_SB(0, 1), b2 + hstep, voffB); PG8_STAGE_A(PG8_SA(0, 0), 0, a2, o2);
            PG8_WAIT_V(8); PG8_WAIT_L(0); PG8_BAR; PG8_MMA(1, 0, At, B0); PG8_MMA(1, 1, At, B1); PG8_BAR; PG8_SCHED;
            PG8_LDB(B0, 1, 0); PG8_LDB(B1, 1, 1); PG8_SCHED; PG8_LDA(At, 1, 0); PG8_STAGE_A(PG8_SA(0, 1), 1, a2, o2);
            PG8_WAIT_V(8); PG8_WAIT_L(0); PG8_BAR; PG8_MMA(0, 0, At, B0); PG8_MMA(0, 1, At, B1); PG8_BAR; PG8_SCHED;
            PG8_LDA(At, 1, 1); PG8_STAGE(PG8_SB(1, 0), b3, voffB); PG8_STAGE(PG8_SB(1, 1), b3 + hstep, voffB); PG8_STAGE_A(PG8_SA(1, 0), 0, a3, o2);
            PG8_WAIT_V(8); PG8_WAIT_L(0); PG8_BAR; PG8_MMA(1, 0, At, B0); PG8_MMA(1, 1, At, B1); PG8_BAR; PG8_SCHED;
        }
        if (wr == 0) PG8_BAR;
        if constexpr (!NOEPI) E(acc, cur, wr, wc, fr, fq); else { float d_ = 0.f; _Pragma("unroll") for (int a_ = 0; a_ < 2; ++a_) _Pragma("unroll") for (int b_ = 0; b_ < 2; ++b_) _Pragma("unroll") for (int m_ = 0; m_ < 4; ++m_) _Pragma("unroll") for (int n_ = 0; n_ < 2; ++n_) d_ += acc[a_][b_][m_][n_][0] + acc[a_][b_][m_][n_][3]; if (d_ == 1.2345e30f) ((float*)g.A)[0] = d_; }
#ifdef EXP_EPI2
        if constexpr (Epi::PERM && !GATHER && sizeof(Epi) == 16) { asm volatile("" ::: "memory"); E(acc, cur, wr, wc, fr, fq); }
#endif
        if (!has_next) break;
#pragma unroll
        for (int a = 0; a < 2; ++a)
#pragma unroll
            for (int b = 0; b < 2; ++b)
#pragma unroll
                for (int m = 0; m < 4; ++m)
#pragma unroll
                    for (int n = 0; n < 2; ++n) acc[a][b][m][n] = (f32x4){0.f, 0.f, 0.f, 0.f};
        cur = nxt; cA = nA; cB = nB; ++ui;
        if constexpr (GATHER) { oc[0][0] = on[0][0]; oc[0][1] = on[0][1]; oc[1][0] = on[1][0]; oc[1][1] = on[1][1]; }
        if (wr == 1) PG8_BAR;
    }
    PG8_WAIT_V(0);
    PG8_BAR;
#undef PG8_SA
#undef PG8_SB
#undef PG8_STAGE
#undef PG8_STAGE_A
#undef PG8_GOFF
#undef PG8_LDA
#undef PG8_LDB
#undef PG8_MMA
#undef PG8_WAIT_V
#undef PG8_WAIT_L
#undef PG8_BAR
#undef PG8_SCHED
}

__device__ __forceinline__ u32x4 pack8(const f32x4 a, const f32x4 b) { u32x4 w; w.x = cvt_pk_bf16(a[0], a[1]); w.y = cvt_pk_bf16(a[2], a[3]); w.z = cvt_pk_bf16(b[0], b[1]); w.w = cvt_pk_bf16(b[2], b[3]); return w; }

struct EpiInProj {
    static constexpr bool PERM = true;
    bf16_t* P; const float* rope;
    unsigned* kmax;
    __device__ __forceinline__ void operator()(const f32x4 (&acc)[2][2][4][2], const Unit& u, int wr, int wc, int fr, int fq) const {
        const int pn = u.pn; const bool lat = u.pm < (NLAT / 256);
        const int kind = (pn >= 6 && pn <= 9) ? 2 : (((pn >= 12 && pn <= 15) || (pn >= 20 && pn <= 22)) ? 1 : 0);
        const int row0 = u.pm * BM + wr * 64 + fr;
        if (kind == 0) {
            const int col0 = pn * 256 + wc * 32 + 8 * fq;
#pragma unroll
            for (int ai = 0; ai < 2; ++ai)
#pragma unroll
                for (int m = 0; m < 4; ++m) { bf16_t* rowp = P + (size_t)(row0 + ai * HALF + m * 16) * INW + col0;
#pragma unroll
                    for (int bj = 0; bj < 2; ++bj) *(u32x4*)(rowp + bj * HALF) = pack8(acc[ai][bj][m][0], acc[ai][bj][m][1]); }
        } else {
            const bool k1 = kind == 1; const int nf = k1 ? 32 : 16, pstep = k1 ? 32 : 16;
            const int cu1 = k1 ? pn * 256 + (wc >> 1) * 128 + (wc & 1) * 64 + 8 * fq : pn * 256 + wc * 64 + (fq >> 1) * 32 + 8 * (fq & 1);
            const int i0 = k1 ? 8 * fq : 8 * (fq & 1); const bool colp = k1 ? ((wc & 1) != 0) : ((fq >> 1) != 0);
            const float* TC = k1 ? rope : rope + 2 * 256 * 32; const float* TS = TC + 256 * nf;
            const int trow0 = ((u.pm * BM) & (SEQ - 1)) / 64 + wr;
            f32x4 nc0, nc1, ns0, ns1; float kq = 0.f;
#define RP_LOAD(g_) do { const int pos_ = colp ? (fr + 16 * ((g_) & 3)) : (trow0 + 2 * ((g_) >> 2)); const float* pc_ = TC + pos_ * nf + i0; const float* ps_ = TS + pos_ * nf + i0; \
                nc0 = *(const f32x4*)(pc_); nc1 = *(const f32x4*)(pc_ + 4); ns0 = *(const f32x4*)(ps_); ns1 = *(const f32x4*)(ps_ + 4); } while (0)
            if (lat) RP_LOAD(0);
#pragma unroll
            for (int gidx = 0; gidx < 8; ++gidx) { const int ai = gidx >> 2, m = gidx & 3; const int row = row0 + ai * HALF + m * 16;
                f32x4 a0 = acc[ai][0][m][0], a1 = acc[ai][0][m][1], b0 = acc[ai][1][m][0], b1 = acc[ai][1][m][1];
                if (lat) { const f32x4 c0 = nc0, c1 = nc1, s0 = ns0, s1 = ns1;
                    if (gidx < 7) RP_LOAD(gidx + 1);
                    const f32x4 x0 = a0 * c0 - b0 * s0, x1 = a1 * c1 - b1 * s1, y0 = b0 * c0 + a0 * s0, y1 = b1 * c1 + a1 * s1; a0 = x0; a1 = x1; b0 = y0; b1 = y1; }
                bf16_t* rowp = P + (size_t)row * INW + cu1;
                const u32x4 w0 = pack8(a0, a1), w1 = pack8(b0, b1); *(u32x4*)(rowp) = w0; *(u32x4*)(rowp + pstep) = w1;
                if (pn == 8 || pn == 9) {
                    float q2 = bflo(w0.x) * bflo(w0.x) + bfhi(w0.x) * bfhi(w0.x) + bflo(w0.y) * bflo(w0.y) + bfhi(w0.y) * bfhi(w0.y) + bflo(w0.z) * bflo(w0.z) + bfhi(w0.z) * bfhi(w0.z) + bflo(w0.w) * bflo(w0.w) + bfhi(w0.w) * bfhi(w0.w)
                             + bflo(w1.x) * bflo(w1.x) + bfhi(w1.x) * bfhi(w1.x) + bflo(w1.y) * bflo(w1.y) + bfhi(w1.y) * bfhi(w1.y) + bflo(w1.z) * bflo(w1.z) + bfhi(w1.z) * bfhi(w1.z) + bflo(w1.w) * bflo(w1.w) + bfhi(w1.w) * bfhi(w1.w);
                    q2 += xshf<16>(q2); { auto rr = __builtin_amdgcn_permlane32_swap(__float_as_uint(q2), __float_as_uint(q2), false, false); q2 = __uint_as_float(rr[0]) + __uint_as_float(rr[1]); }
                    kq = fmaxf(kq, q2); } }
            if (pn == 8 || pn == 9) {
                kq = fmaxf(kq, xshf<1>(kq)); kq = fmaxf(kq, xshf<2>(kq)); kq = fmaxf(kq, xshf<4>(kq)); kq = fmaxf(kq, xshf<8>(kq));
                if (fr == 0 && fq == 0) __hip_atomic_fetch_max(kmax + (lat ? (u.pm >> 6) : (u.pm - NLAT / 256)) * 8 + (pn - 8) * 4 + wc, __float_as_uint(kq), __ATOMIC_RELAXED, __HIP_MEMORY_SCOPE_AGENT); }
#undef RP_LOAD
        }
    }
};
struct EpiOutProj {
    static constexpr bool PERM = true;
    const float* xin_f32; const bf16_t* xin_bf; bf16_t* xout_bf; const float* xin_ctx; float* xout_ctx; const float* modl;
    __device__ __forceinline__ void operator()(const f32x4 (&acc)[2][2][4][2], const Unit& u, int wr, int wc, int fr, int fq) const {
        const bool lat = u.pm < (NLAT / 256); const int v = lat ? (u.pm >> 6) : 2;
        const float* g1 = modl + v * 12288 + 2 * DM;
        const int rloc = (lat ? u.pm : (u.pm - NLAT / 256)) * BM + wr * 64 + fr; const int col0 = u.pn * BM + wc * 32 + 8 * fq;
        f32x4 gv[2][2];
#pragma unroll
        for (int bj = 0; bj < 2; ++bj)
#pragma unroll
            for (int n = 0; n < 2; ++n) gv[bj][n] = *(const f32x4*)(g1 + col0 + bj * HALF + 4 * n);
        if (lat && xin_f32 == nullptr) {
#pragma unroll
            for (int ai = 0; ai < 2; ++ai) { u32x4 x[4][2];
#pragma unroll
                for (int m = 0; m < 4; ++m)
#pragma unroll
                    for (int bj = 0; bj < 2; ++bj) x[m][bj] = *(const u32x4*)(xin_bf + (size_t)(rloc + ai * HALF + m * 16) * DM + col0 + bj * HALF);
#pragma unroll
                for (int m = 0; m < 4; ++m)
#pragma unroll
                    for (int bj = 0; bj < 2; ++bj) { asm volatile("" : "+v"(x[m][bj])); const u32x4 w = x[m][bj];
                        const f32x4 x0 = (f32x4){bflo(w.x), bfhi(w.x), bflo(w.y), bfhi(w.y)}, x1 = (f32x4){bflo(w.z), bfhi(w.z), bflo(w.w), bfhi(w.w)};
                        *(u32x4*)(xout_bf + (size_t)(rloc + ai * HALF + m * 16) * DM + col0 + bj * HALF) = pack8(x0 + gv[bj][0] * acc[ai][bj][m][0], x1 + gv[bj][1] * acc[ai][bj][m][1]); }
            }
        } else {
            const float* xi = lat ? xin_f32 : xin_ctx;
#pragma unroll
            for (int ai = 0; ai < 2; ++ai) { f32x4 x[4][2][2];
#pragma unroll
                for (int m = 0; m < 4; ++m)
#pragma unroll
                    for (int bj = 0; bj < 2; ++bj)
#pragma unroll
                        for (int n = 0; n < 2; ++n) x[m][bj][n] = *(const f32x4*)(xi + (size_t)(rloc + ai * HALF + m * 16) * DM + col0 + bj * HALF + 4 * n);
#pragma unroll
                for (int m = 0; m < 4; ++m)
#pragma unroll
                    for (int bj = 0; bj < 2; ++bj) { asm volatile("" : "+v"(x[m][bj][0]), "+v"(x[m][bj][1]));
                        const f32x4 y0 = x[m][bj][0] + gv[bj][0] * acc[ai][bj][m][0], y1 = x[m][bj][1] + gv[bj][1] * acc[ai][bj][m][1]; const size_t off = (size_t)(rloc + ai * HALF + m * 16) * DM + col0 + bj * HALF;
                        if (lat) *(u32x4*)(xout_bf + off) = pack8(y0, y1); else { *(f32x4*)(xout_ctx + off) = y0; *(f32x4*)(xout_ctx + off + 4) = y1; } }
            }
        }
    }
};
struct EpiSwiGLU {
    static constexpr bool PERM = true;
    bf16_t* ACT;
    __device__ __forceinline__ void operator()(const f32x4 (&acc)[2][2][4][2], const Unit& u, int wr, int wc, int fr, int fq) const {
        const int pnl = u.pn & 7; const int row0 = u.pm * BM + wr * 64 + fr; const int col0 = pnl * 128 + wc * 32 + 8 * fq;
#pragma unroll
        for (int ai = 0; ai < 2; ++ai)
#pragma unroll
            for (int m = 0; m < 4; ++m) { f32x4 o[2];
#pragma unroll
                for (int n = 0; n < 2; ++n) { const f32x4 gt = acc[ai][0][m][n], up = acc[ai][1][m][n];
#pragma unroll
                    for (int j = 0; j < 4; ++j) o[n][j] = gt[j] * __builtin_amdgcn_rcpf(1.0f + __builtin_amdgcn_exp2f(-gt[j] * LOG2E)) * up[j]; }
                *(u32x4*)(ACT + (size_t)(row0 + ai * HALF + m * 16) * FF + col0) = pack8(o[0], o[1]); }
    }
};
struct EpiDown {
    static constexpr bool PERM = true;
    bf16_t* Y; const float* gatev;
    __device__ __forceinline__ void operator()(const f32x4 (&acc)[2][2][4][2], const Unit& u, int wr, int wc, int fr, int fq) const {
        const int pnl = u.pn & 7; const int row0 = u.pm * BM + wr * 64 + fr; const int col0 = pnl * 256 + wc * 32 + 8 * fq;
        float gs[2][4];
#pragma unroll
        for (int ai = 0; ai < 2; ++ai)
#pragma unroll
            for (int m = 0; m < 4; ++m) gs[ai][m] = gatev[row0 + ai * HALF + m * 16];
#pragma unroll
        for (int ai = 0; ai < 2; ++ai)
#pragma unroll
            for (int m = 0; m < 4; ++m) { asm volatile("" : "+v"(gs[ai][m]));
#pragma unroll
                for (int bj = 0; bj < 2; ++bj) *(u32x4*)(Y + (size_t)(row0 + ai * HALF + m * 16) * DM + col0 + bj * HALF) = pack8(acc[ai][bj][m][0] * gs[ai][m], acc[ai][bj][m][1] * gs[ai][m]); }
    }
};
}
namespace att {
constexpr int LDP = INW, LDOUT = DM, KVBLK = 64;
constexpr size_t SHM_V = KVBLK * 128 * 2, SHM_K = KVBLK * 128 * 2, SHM_ATTN = 2 * SHM_V + 2 * SHM_K + 8 * 64 * 4;
constexpr size_t QL_OFF = 73728, QL_STRIDE = 272;
constexpr size_t BIAS_OFF = SHM_ATTN;
constexpr float THR_L2 = 8.f * LOG2E;
#define KSWZ(row, colB) ((row) * 256 + ((colB) ^ (((row) & 7) << 4)))
#define SBAR() __builtin_amdgcn_sched_barrier(0)

struct Tiles { const bf16_t* kctx; const bf16_t* klat; long vdelta; int lat0, nt, nctx; };
struct MP {
    bool masked;
    int tq;
    int qr, rs, qc, cs;
    const LAS float* bias;
    float sink_l2;
    float lam, post;
    const float* normg;
};

__device__ __forceinline__ const bf16_t* tile_ptr(const Tiles& T, int j) { return (j < T.nctx) ? T.kctx + (long)j * KVBLK * LDP : T.klat + (long)(T.lat0 + j - T.nctx) * KVBLK * LDP; }

template <int MODE> __device__ __forceinline__ void apply_mask(f32x16& p0, f32x16& p1, int j, const Tiles& T, const MP& mp, int hi) {
  if constexpr (MODE == 1) return;
  if (!mp.masked || j < T.nctx) return;
  const int kt = T.lat0 + j - T.nctx;
  if constexpr (MODE == 2) {
    const int base = kt * KVBLK - mp.tq + 128;
#pragma unroll
    for (int r = 0; r < 16; ++r) { const int kk = crow(r, hi); if ((unsigned)(base + kk) > 256u) p0[r] = NEGBIG; if ((unsigned)(base + kk + 32) > 256u) p1[r] = NEGBIG; }
  }
  if constexpr (MODE == 0) {
    const bool rowok = (unsigned)(kt - mp.rs) < 8u; const LAS float* bp = mp.bias + ((kt - mp.qr + 7) * 31 + 15 - mp.qc + 4 * hi);
    const int t = rowok ? (4 * hi - mp.cs) : 0x40000000;
#pragma unroll
    for (int g = 0; g < 4; ++g) {
#pragma unroll
      for (int rr = 0; rr < 4; ++rr) { const int r = g * 4 + rr; const int c0 = (r & 3) + 8 * (r >> 2);
        const float b0 = bp[c0], b1 = bp[c0 + 32];
        p0[r] = ((unsigned)(t + c0) < 16u) ? p0[r] + b0 : NEGBIG; p1[r] = ((unsigned)(t + c0 + 32) < 16u) ? p1[r] + b1 : NEGBIG; }
      asm volatile("" ::: "memory");
    }
  }
}
template <int MODE> __device__ __forceinline__ void partialSM(f32x16& p0, f32x16& p1, float& m_reg, float& mn, float& alpha, int j, const Tiles& T, const MP& mp, int hi) {
  apply_mask<MODE>(p0, p1, j, T, mp, hi);
  float pmax = p0[0];
#pragma unroll
  for (int r = 1; r < 16; ++r) pmax = fmaxf(pmax, p0[r]);
#pragma unroll
  for (int r = 0; r < 16; ++r) pmax = fmaxf(pmax, p1[r]);
  { auto rr = __builtin_amdgcn_permlane32_swap(__float_as_uint(pmax), __float_as_uint(pmax), false, false);
    pmax = fmaxf(__uint_as_float(rr[0]), __uint_as_float(rr[1])); }
  if (__builtin_expect(__all(pmax - m_reg <= THR_L2), 1)) { mn = m_reg; alpha = 1.f; }
  else { mn = fmaxf(m_reg, pmax); alpha = __builtin_amdgcn_exp2f(m_reg - mn); m_reg = mn; }
#pragma unroll
  for (int r = 0; r < 16; ++r) p0[r] = p0[r] - mn;
#pragma unroll
  for (int r = 0; r < 16; ++r) p1[r] = p1[r] - mn;
#pragma unroll
  for (int r = 0; r < 16; ++r) p0[r] = __builtin_amdgcn_exp2f(p0[r]);
}
__device__ __forceinline__ void finishSM(f32x16& p0, f32x16& p1, float alpha, float& l_reg, bf16x8& pa0, bf16x8& pa1, bf16x8& pa2, bf16x8& pa3) {
#pragma unroll
  for (int r = 0; r < 16; ++r) p1[r] = __builtin_amdgcn_exp2f(p1[r]);
  float ps = 0;
#pragma unroll
  for (int r = 0; r < 16; ++r) ps += p0[r];
#pragma unroll
  for (int r = 0; r < 16; ++r) ps += p1[r];
  { auto rr = __builtin_amdgcn_permlane32_swap(__float_as_uint(ps), __float_as_uint(ps), false, false);
    ps = __uint_as_float(rr[0]) + __uint_as_float(rr[1]); }
  l_reg = l_reg * alpha + ps;
#define PK4(P, BASE, OUT) do { unsigned a0 = cvt_pk_bf16(P[BASE + 0], P[BASE + 1]), a1 = cvt_pk_bf16(P[BASE + 2], P[BASE + 3]);   \
    unsigned b0 = cvt_pk_bf16(P[BASE + 4], P[BASE + 5]), b1 = cvt_pk_bf16(P[BASE + 6], P[BASE + 7]);                              \
    auto r0 = __builtin_amdgcn_permlane32_swap(a0, b0, false, false); auto r1 = __builtin_amdgcn_permlane32_swap(a1, b1, false, false); \
    u32x4 w = {r0[0], r1[0], r0[1], r1[1]}; OUT = *reinterpret_cast<bf16x8*>(&w); } while (0)
  PK4(p0, 0, pa0); PK4(p0, 8, pa1); PK4(p1, 0, pa2); PK4(p1, 8, pa3);
#undef PK4
}
template <int NQ> __device__ __forceinline__ void qkt(f32x16& p0, f32x16& p1, const char* Ks, const bf16x8* qr, int r32, int hi, int cboff) {
  p0 = f32x16{}; p1 = f32x16{};
#pragma unroll
  for (int d0 = 0; d0 < NQ; ++d0) { const int cb = (d0 * 16 + hi * 8) * 2 + cboff;
    bf16x8 b0 = *reinterpret_cast<const bf16x8*>(Ks + KSWZ(r32, cb));
    bf16x8 b1 = *reinterpret_cast<const bf16x8*>(Ks + KSWZ(32 + r32, cb));
    p0 = __builtin_amdgcn_mfma_f32_32x32x16_bf16(b0, qr[d0], p0, 0, 0, 0);
    p1 = __builtin_amdgcn_mfma_f32_32x32x16_bf16(b1, qr[d0], p1, 0, 0, 0); }
}
__device__ __forceinline__ int v_st(int k, int c) { const int kk = (k & ~0xC) | ((k & 4) << 1) | ((k & 8) >> 1); return ((kk >> 3) * 4 + (c >> 5)) * 512 + ((kk & 7) * 32 + (c & 31)) * 2; }
__device__ __forceinline__ int v_rd_base(int lane) { return ((lane & 3) << 3) | (((lane >> 2) & 3) << 6) | (((lane >> 4) & 1) << 5) | (((lane >> 5) & 1) << 8); }
constexpr int v_rd_off(int d0, int ks, int half) { return d0 * 512 + ks * 4096 + half * 2048; }
template <int OFF> __device__ __forceinline__ s16x4 tr_read(int vb) {
  s16x4 r; asm volatile("ds_read_b64_tr_b16 %0, %1 offset:%2" : "=&v"(r) : "v"(vb), "i"(OFF) : "memory"); return r;
}
template <int D0> __device__ __forceinline__ void pv_one(f32x16& od, int vb, bf16x8 pa0, bf16x8 pa1, bf16x8 pa2, bf16x8 pa3) {
  const s16x4 l0 = tr_read<v_rd_off(D0, 0, 0)>(vb), h0 = tr_read<v_rd_off(D0, 0, 1)>(vb), l1 = tr_read<v_rd_off(D0, 1, 0)>(vb), h1 = tr_read<v_rd_off(D0, 1, 1)>(vb);
  const s16x4 l2 = tr_read<v_rd_off(D0, 2, 0)>(vb), h2 = tr_read<v_rd_off(D0, 2, 1)>(vb), l3 = tr_read<v_rd_off(D0, 3, 0)>(vb), h3 = tr_read<v_rd_off(D0, 3, 1)>(vb);
  asm volatile("s_waitcnt lgkmcnt(0)" ::: "memory"); SBAR();
#define PK(L, H) (bf16x8){L[0], L[1], L[2], L[3], H[0], H[1], H[2], H[3]}
  od = __builtin_amdgcn_mfma_f32_32x32x16_bf16(pa0, PK(l0, h0), od, 0, 0, 0);
  od = __builtin_amdgcn_mfma_f32_32x32x16_bf16(pa1, PK(l1, h1), od, 0, 0, 0);
  od = __builtin_amdgcn_mfma_f32_32x32x16_bf16(pa2, PK(l2, h2), od, 0, 0, 0);
  od = __builtin_amdgcn_mfma_f32_32x32x16_bf16(pa3, PK(l3, h3), od, 0, 0, 0);
#undef PK
}
__device__ __forceinline__ void pv_d0(f32x16* o, int vb, bf16x8 pa0, bf16x8 pa1, bf16x8 pa2, bf16x8 pa3) {
  pv_one<0>(o[0], vb, pa0, pa1, pa2, pa3); pv_one<1>(o[1], vb, pa0, pa1, pa2, pa3); pv_one<2>(o[2], vb, pa0, pa1, pa2, pa3); pv_one<3>(o[3], vb, pa0, pa1, pa2, pa3);
}

template <int MODE>
__device__ __forceinline__ void attn_unit_simple(const bf16_t* __restrict__ Qrow0, const Tiles T, bf16_t* __restrict__ Orow0, const MP mp, char* lds, const int tid) {
  const int wid = tid >> 6, lane = tid & 63, r32 = lane & 31, hi = lane >> 5;
  char* V_lds = lds; char* K_lds = lds + 2 * SHM_V;
  float* wsf = (float*)(lds + 2 * SHM_V + 2 * SHM_K) + wid * 64; float* li_l = wsf; float* al_l = wsf + 32;
  float m_reg = NEGBIG, l_reg = 0; f32x16 o[4] = {};
  const int sr = tid >> 4, sc = (tid & 15) * 8, vst0 = v_st(sr, sc), kst0 = KSWZ(sr, sc * 2);
  const int vb0 = (int)(uintptr_t)V_lds + v_rd_base(lane);
  const char* Qr = lds + QL_OFF + (wid * 32 + r32) * QL_STRIDE + hi * 16;
  bf16x8 vs0, vs1, ks0, ks1;
#define SLOAD1(j_) do { const bf16_t* kp_ = tile_ptr(T, (j_)) + (long)sr * LDP + sc; \
    vs0 = *reinterpret_cast<const bf16x8*>(kp_ + T.vdelta); vs1 = *reinterpret_cast<const bf16x8*>(kp_ + T.vdelta + 32L * LDP); \
    ks0 = *reinterpret_cast<const bf16x8*>(kp_); ks1 = *reinterpret_cast<const bf16x8*>(kp_ + 32L * LDP); } while (0)
#define SWRITE1(b) do { *(bf16x8*)(V_lds + (b) * SHM_V + vst0) = vs0; *(bf16x8*)(V_lds + (b) * SHM_V + vst0 + 8192) = vs1; \
    *(bf16x8*)(K_lds + (b) * SHM_K + kst0) = ks0; *(bf16x8*)(K_lds + (b) * SHM_K + kst0 + 8192) = ks1; } while (0)
  const int NT = T.nt;
  __syncthreads();
#pragma unroll
  for (int p = 0; p < 8; ++p) { const int idx = tid + 512 * p; *(bf16x8*)(lds + QL_OFF + (idx >> 4) * QL_STRIDE + (idx & 15) * 16) = *reinterpret_cast<const bf16x8*>(Qrow0 + (long)(idx >> 4) * LDP + (idx & 15) * 8); }
  SLOAD1(0); SWRITE1(0); __syncthreads();
  for (int j = 0; j < NT; ++j) {
    const int buf = j & 1;
    if (j + 1 < NT) SLOAD1(j + 1);
    bool live = true;
    if (mp.masked && j >= T.nctx) { const int kt = T.lat0 + j - T.nctx;
      if constexpr (MODE == 0) live = (unsigned)(kt - mp.rs) < 8u;
      if constexpr (MODE == 2) { const int q0w = __builtin_amdgcn_readfirstlane(mp.tq - r32); live = (kt * KVBLK + 63 >= q0w - 128) && (kt * KVBLK <= q0w + 31 + 128); } }
    if (live) {
    f32x16 p0, p1; float mn, al; bf16x8 pa0, pa1, pa2, pa3;
    { p0 = f32x16{}; p1 = f32x16{}; const char* Ks = K_lds + buf * SHM_K;
#pragma unroll
      for (int d0 = 0; d0 < 8; ++d0) { const int cb = (d0 * 16 + hi * 8) * 2; const bf16x8 q = *reinterpret_cast<const bf16x8*>(Qr + d0 * 32);
        const bf16x8 b0 = *reinterpret_cast<const bf16x8*>(Ks + KSWZ(r32, cb)), b1 = *reinterpret_cast<const bf16x8*>(Ks + KSWZ(32 + r32, cb));
        p0 = __builtin_amdgcn_mfma_f32_32x32x16_bf16(b0, q, p0, 0, 0, 0); p1 = __builtin_amdgcn_mfma_f32_32x32x16_bf16(b1, q, p1, 0, 0, 0); } }
    partialSM<MODE>(p0, p1, m_reg, mn, al, j, T, mp, hi);
    if (__any(al < 1.f)) { if (hi == 0) al_l[r32] = al; asm volatile("s_waitcnt lgkmcnt(0)" ::: "memory");
#pragma unroll
      for (int d = 0; d < 4; ++d)
#pragma unroll
        for (int r = 0; r < 16; ++r) o[d][r] *= al_l[crow(r, hi)]; }
    finishSM(p0, p1, al, l_reg, pa0, pa1, pa2, pa3);
    pv_d0(o, vb0 + buf * (int)SHM_V, pa0, pa1, pa2, pa3);
    }
    if (j + 1 < NT) SWRITE1(buf ^ 1);
    __syncthreads();
  }
  if constexpr (MODE == 2) l_reg += __builtin_amdgcn_exp2f(mp.sink_l2 - m_reg);
  if (hi == 0) li_l[r32] = l_reg; asm volatile("s_waitcnt lgkmcnt(0)" ::: "memory");
  bf16_t* Ow = Orow0 + (long)(wid * 32) * LDOUT;
#pragma unroll
  for (int r = 0; r < 16; ++r) { const int orow = crow(r, hi); const float rl = __builtin_amdgcn_rcpf(li_l[orow]);
#pragma unroll
    for (int d0 = 0; d0 < 4; ++d0) Ow[(long)orow * LDOUT + d0 * 32 + r32] = f2bf(o[d0][r] * rl); }
#undef SLOAD1
#undef SWRITE1
}
__device__ __forceinline__ void qktB(f32x16& p0, f32x16& p1, const char* Ks, const bf16x8* qr, int r32, int hi, int cboff, const f32x16& nb) {
  { const int cb = (hi * 8) * 2 + cboff;
    bf16x8 b0 = *reinterpret_cast<const bf16x8*>(Ks + KSWZ(r32, cb)), b1 = *reinterpret_cast<const bf16x8*>(Ks + KSWZ(32 + r32, cb));
    p0 = __builtin_amdgcn_mfma_f32_32x32x16_bf16(b0, qr[0], nb, 0, 0, 0); p1 = __builtin_amdgcn_mfma_f32_32x32x16_bf16(b1, qr[0], nb, 0, 0, 0); }
#pragma unroll
  for (int d0 = 1; d0 < 4; ++d0) { const int cb = (d0 * 16 + hi * 8) * 2 + cboff;
    bf16x8 b0 = *reinterpret_cast<const bf16x8*>(Ks + KSWZ(r32, cb)), b1 = *reinterpret_cast<const bf16x8*>(Ks + KSWZ(32 + r32, cb));
    p0 = __builtin_amdgcn_mfma_f32_32x32x16_bf16(b0, qr[d0], p0, 0, 0, 0); p1 = __builtin_amdgcn_mfma_f32_32x32x16_bf16(b1, qr[d0], p1, 0, 0, 0); }
}
__device__ __forceinline__ void expA(f32x16& p0) {
#pragma unroll
  for (int r = 0; r < 16; ++r) p0[r] = __builtin_amdgcn_exp2f(p0[r]);
}
__device__ __forceinline__ void finishB(f32x16& p0, f32x16& p1, float& l_reg, bf16x8& pa0, bf16x8& pa1, bf16x8& pa2, bf16x8& pa3) {
#pragma unroll
  for (int r = 0; r < 16; ++r) p1[r] = __builtin_amdgcn_exp2f(p1[r]);
  float ps = 0;
#pragma unroll
  for (int r = 0; r < 16; ++r) ps += p0[r];
#pragma unroll
  for (int r = 0; r < 16; ++r) ps += p1[r];
  l_reg += ps;
#define PK4(P, BASE, OUT) do { unsigned a0 = cvt_pk_bf16(P[BASE + 0], P[BASE + 1]), a1 = cvt_pk_bf16(P[BASE + 2], P[BASE + 3]);   \
    unsigned b0 = cvt_pk_bf16(P[BASE + 4], P[BASE + 5]), b1 = cvt_pk_bf16(P[BASE + 6], P[BASE + 7]);                              \
    auto r0 = __builtin_amdgcn_permlane32_swap(a0, b0, false, false); auto r1 = __builtin_amdgcn_permlane32_swap(a1, b1, false, false); \
    u32x4 w = {r0[0], r1[0], r0[1], r1[1]}; OUT = *reinterpret_cast<bf16x8*>(&w); } while (0)
  PK4(p0, 0, pa0); PK4(p0, 8, pa1); PK4(p1, 0, pa2); PK4(p1, 8, pa3);
#undef PK4
}

typedef short v4i16_t __attribute__((ext_vector_type(4)));
__device__ __forceinline__ s16x4 vtr(int addr) { return __builtin_bit_cast(s16x4, __builtin_amdgcn_ds_read_tr16_b64_v4i16((LAS v4i16_t*)(uintptr_t)(unsigned)addr)); }
template <int D0> __device__ __forceinline__ void pv_one_v(f32x16& od, int vb, bf16x8 pa0, bf16x8 pa1, bf16x8 pa2, bf16x8 pa3) {
  const s16x4 l0 = vtr(vb + v_rd_off(D0, 0, 0)), h0 = vtr(vb + v_rd_off(D0, 0, 1)), l1 = vtr(vb + v_rd_off(D0, 1, 0)), h1 = vtr(vb + v_rd_off(D0, 1, 1));
  const s16x4 l2 = vtr(vb + v_rd_off(D0, 2, 0)), h2 = vtr(vb + v_rd_off(D0, 2, 1)), l3 = vtr(vb + v_rd_off(D0, 3, 0)), h3 = vtr(vb + v_rd_off(D0, 3, 1));
#define PK(L, H) (bf16x8){L[0], L[1], L[2], L[3], H[0], H[1], H[2], H[3]}
  od = __builtin_amdgcn_mfma_f32_32x32x16_bf16(pa0, PK(l0, h0), od, 0, 0, 0);
  od = __builtin_amdgcn_mfma_f32_32x32x16_bf16(pa1, PK(l1, h1), od, 0, 0, 0);
  od = __builtin_amdgcn_mfma_f32_32x32x16_bf16(pa2, PK(l2, h2), od, 0, 0, 0);
  od = __builtin_amdgcn_mfma_f32_32x32x16_bf16(pa3, PK(l3, h3), od, 0, 0, 0);
#undef PK
}
__device__ __forceinline__ void pv_d0_v(f32x16* o, int vb, bf16x8 pa0, bf16x8 pa1, bf16x8 pa2, bf16x8 pa3) {
  pv_one_v<0>(o[0], vb, pa0, pa1, pa2, pa3); pv_one_v<1>(o[1], vb, pa0, pa1, pa2, pa3); pv_one_v<2>(o[2], vb, pa0, pa1, pa2, pa3); pv_one_v<3>(o[3], vb, pa0, pa1, pa2, pa3);
}
__device__ __forceinline__ void glds16(const void* g, unsigned lds_base) {
    unsigned sv; asm volatile("s_mov_b32 %0, m0\n\ts_mov_b32 m0, %2\n\ts_nop 0\n\tglobal_load_lds_dwordx4 %1, off\n\ts_mov_b32 m0, %0" : "=&s"(sv) : "v"(g), "s"(lds_base) : "memory"); }
__device__ __forceinline__ void glds16s(const void* gbase, unsigned voff, unsigned lds_base) {
    unsigned sv; asm volatile("s_mov_b32 %0, m0\n\ts_mov_b32 m0, %3\n\ts_nop 0\n\tglobal_load_lds_dwordx4 %1, %2\n\ts_mov_b32 m0, %0" : "=&s"(sv) : "v"(voff), "s"(gbase), "s"(lds_base) : "memory"); }
__device__ __forceinline__ int v_st_u(int k, int c) { return ((k >> 3) * 4 + (c >> 5)) * 512 + ((k & 7) * 32 + (c & 31)) * 2; }
__device__ __forceinline__ void attn_unit_a2(const bf16_t* __restrict__ Qrow0, const Tiles T, bf16_t* __restrict__ Orow0, const bool masked, const LAS float* bias, const int qr0, char* lds, const int tid) {
  const int wid = __builtin_amdgcn_readfirstlane(tid >> 6), lane = tid & 63, r32 = lane & 31, hi = lane >> 5;
  char* V_lds = lds; char* K_lds = lds + 2 * SHM_V;
  float* wsf = (float*)(lds + 2 * SHM_V + 2 * SHM_K) + wid * 64; float* li_l = wsf; float* al_l = wsf + 32;
  const int rp = wid >> 2, cbk = wid & 3;
  const int qloc = (2 * rp + (r32 >> 4)) * 64 + 16 * cbk + (r32 & 15);
  const int qr = qr0 + 2 * rp + (r32 >> 4), qc = 16 * cbk + (r32 & 15);
  const int rs = qr - 4 < 0 ? 0 : (qr - 4 > 248 ? 248 : qr - 4), cs = qc - 8 < 0 ? 0 : (qc - 8 > 48 ? 48 : qc - 8);
  const int kb = 16 * cbk - 8 < 0 ? 0 : (16 * cbk - 8 > 32 ? 32 : 16 * cbk - 8);
  const int rsa = (qr0 + 2 * rp - 4) < 0 ? 0 : ((qr0 + 2 * rp - 4) > 248 ? 248 : (qr0 + 2 * rp - 4)), rsb = (qr0 + 2 * rp - 3) < 0 ? 0 : ((qr0 + 2 * rp - 3) > 248 ? 248 : (qr0 + 2 * rp - 3));
  float m_reg = NEGBIG, l_reg = 0; f32x16 o[4] = {};
  const int sr = tid >> 4, sc = (tid & 15) * 8, vst0 = v_st_u(sr, sc), kst0 = KSWZ(sr, sc * 2);
  const int vb0 = (int)(uintptr_t)V_lds + v_rd_base(lane);
  const char* Qr = lds + QL_OFF + qloc * QL_STRIDE + hi * 16;
  bf16x8 vs0, vs1, ks0, ks1;
#define SLOAD1(j_) do { const bf16_t* kp_ = tile_ptr(T, (j_)) + (long)sr * LDP + sc; \
    vs0 = *reinterpret_cast<const bf16x8*>(kp_ + T.vdelta); vs1 = *reinterpret_cast<const bf16x8*>(kp_ + T.vdelta + 32L * LDP); \
    ks0 = *reinterpret_cast<const bf16x8*>(kp_); ks1 = *reinterpret_cast<const bf16x8*>(kp_ + 32L * LDP); } while (0)
#define SWRITE1(b) do { *(bf16x8*)(V_lds + (b) * SHM_V + vst0) = vs0; *(bf16x8*)(V_lds + (b) * SHM_V + vst0 + 8192) = vs1; \
    *(bf16x8*)(K_lds + (b) * SHM_K + kst0) = ks0; *(bf16x8*)(K_lds + (b) * SHM_K + kst0 + 8192) = ks1; } while (0)
  const int NT = T.nt;
  __syncthreads();
#pragma unroll
  for (int p = 0; p < 8; ++p) { const int idx = tid + 512 * p; *(bf16x8*)(lds + QL_OFF + (idx >> 4) * QL_STRIDE + (idx & 15) * 16) = *reinterpret_cast<const bf16x8*>(Qrow0 + (long)(idx >> 4) * LDP + (idx & 15) * 8); }
  SLOAD1(0); SWRITE1(0); __syncthreads();
  for (int j = 0; j < NT; ++j) {
    const int buf = j & 1;
    if (j + 1 < NT) SLOAD1(j + 1);
    const bool ctxt = j < T.nctx; const int kr = T.lat0 + j - T.nctx;
    const bool live = ctxt || !masked || ((unsigned)(kr - rsa) < 8u) || ((unsigned)(kr - rsb) < 8u);
    if (live) {
      const int nblk = (ctxt || !masked) ? 2 : 1;
      for (int blk = 0; blk < nblk; ++blk) {
        const int kbb = (ctxt || !masked) ? 32 * blk : kb;
        f32x16 p = {}; const char* Ks = K_lds + buf * SHM_K;
#pragma unroll
        for (int d0 = 0; d0 < 8; ++d0) { const int cb = (d0 * 16 + hi * 8) * 2; const bf16x8 q = *reinterpret_cast<const bf16x8*>(Qr + d0 * 32);
          const bf16x8 b0 = *reinterpret_cast<const bf16x8*>(Ks + KSWZ(kbb + r32, cb)); p = __builtin_amdgcn_mfma_f32_32x32x16_bf16(b0, q, p, 0, 0, 0); }
        if (masked && !ctxt) {
          const bool rowok = (unsigned)(kr - rs) < 8u; const LAS float* bp = bias + ((kr - qr + 7) * 31 + 15 - qc + kbb + 4 * hi);
          const int t = rowok ? (kbb + 4 * hi - cs) : 0x40000000;
#pragma unroll
          for (int r = 0; r < 16; ++r) { const int c0 = (r & 3) + 8 * (r >> 2); const float bv = bp[c0]; p[r] = ((unsigned)(t + c0) < 16u) ? p[r] + bv : NEGBIG; }
        }
        float pmax = p[0];
#pragma unroll
        for (int r = 1; r < 16; ++r) pmax = fmaxf(pmax, p[r]);
        { auto rr = __builtin_amdgcn_permlane32_swap(__float_as_uint(pmax), __float_as_uint(pmax), false, false); pmax = fmaxf(__uint_as_float(rr[0]), __uint_as_float(rr[1])); }
        float mn, al;
        if (__builtin_expect(__all(pmax - m_reg <= THR_L2), 1)) { mn = m_reg; al = 1.f; } else { mn = fmaxf(m_reg, pmax); al = __builtin_amdgcn_exp2f(m_reg - mn); m_reg = mn; }
        float ps = 0.f;
#pragma unroll
        for (int r = 0; r < 16; ++r) { p[r] = __builtin_amdgcn_exp2f(p[r] - mn); ps += p[r]; }
        { auto rr = __builtin_amdgcn_permlane32_swap(__float_as_uint(ps), __float_as_uint(ps), false, false); ps = __uint_as_float(rr[0]) + __uint_as_float(rr[1]); }
        l_reg = l_reg * al + ps;
        if (__any(al < 1.f)) { if (hi == 0) al_l[r32] = al; asm volatile("s_waitcnt lgkmcnt(0)" ::: "memory");
#pragma unroll
          for (int d = 0; d < 4; ++d)
#pragma unroll
            for (int r = 0; r < 16; ++r) o[d][r] *= al_l[crow(r, hi)]; }
        u32x4 w0 = {cvt_pk_bf16(p[0], p[1]), cvt_pk_bf16(p[2], p[3]), cvt_pk_bf16(p[4], p[5]), cvt_pk_bf16(p[6], p[7])}, w1 = {cvt_pk_bf16(p[8], p[9]), cvt_pk_bf16(p[10], p[11]), cvt_pk_bf16(p[12], p[13]), cvt_pk_bf16(p[14], p[15])};
        const bf16x8 pa0 = *reinterpret_cast<bf16x8*>(&w0), pa1 = *reinterpret_cast<bf16x8*>(&w1);
        const int vb = vb0 + buf * (int)SHM_V + (kbb >> 3) * 2048;
#pragma unroll
        for (int d0 = 0; d0 < 4; ++d0) { const s16x4 l0 = vtr(vb + d0 * 512), h0 = vtr(vb + d0 * 512 + 2048), l1 = vtr(vb + d0 * 512 + 4096), h1 = vtr(vb + d0 * 512 + 6144);
          o[d0] = __builtin_amdgcn_mfma_f32_32x32x16_bf16(pa0, (bf16x8){l0[0], l0[1], l0[2], l0[3], h0[0], h0[1], h0[2], h0[3]}, o[d0], 0, 0, 0);
          o[d0] = __builtin_amdgcn_mfma_f32_32x32x16_bf16(pa1, (bf16x8){l1[0], l1[1], l1[2], l1[3], h1[0], h1[1], h1[2], h1[3]}, o[d0], 0, 0, 0); }
      }
    }
    if (j + 1 < NT) SWRITE1(buf ^ 1);
    __syncthreads();
  }
  if (hi == 0) li_l[r32] = l_reg; asm volatile("s_waitcnt lgkmcnt(0)" ::: "memory");
#pragma unroll
  for (int r = 0; r < 16; ++r) { const int i = crow(r, hi); const float rl = __builtin_amdgcn_rcpf(li_l[i]);
    bf16_t* Ow = Orow0 + (long)((2 * rp + (i >> 4)) * 64 + 16 * cbk + (i & 15)) * LDOUT;
#pragma unroll
    for (int d0 = 0; d0 < 4; ++d0) Ow[d0 * 32 + r32] = f2bf(o[d0][r] * rl); }
#undef SLOAD1
#undef SWRITE1
}

#define B3_MF(a, b, c) __builtin_amdgcn_mfma_f32_32x32x16_bf16(a, b, c, 0, 0, 0)
#define B3_PIN(x) asm volatile("" : "+v"(x))
#define B3_WAITBAR(N) asm volatile("s_waitcnt vmcnt(" #N ") lgkmcnt(0)\n\ts_barrier" ::: "memory")
struct TilesB3 { const bf16_t* kctx; const bf16_t* klat; long vdelta; int nt; };
__device__ __forceinline__ void attn_unit_b3(const bf16_t* __restrict__ Qrow0, const TilesB3 T, bf16_t* __restrict__ Orow0, const MP mp, const unsigned* __restrict__ kmax2, char* lds, const int tid) {
  const int wid = __builtin_amdgcn_readfirstlane(tid >> 6), lane = tid & 63, r32 = lane & 31, hi = lane >> 5;
  constexpr int KRING = 0, VRING = 65536, WSF = 131072, SLOT = 16384;
  float* li_l = (float*)(lds + WSF) + wid * 64;
  float l_reg = 0; f32x16 o[4] = {}; bf16x8 qr[4];
  const int qrow = (wid & 3) * 32 + r32, map = wid >> 2, mapoff = map * 64;
  const bf16_t* Qw = Qrow0 + (long)qrow * LDP + mapoff + hi * 8;
#pragma unroll
  for (int d0 = 0; d0 < 4; ++d0) qr[d0] = *reinterpret_cast<const bf16x8*>(Qw + d0 * 16);
  f32x16 nb;
  { float q2 = 0.f;
#pragma unroll
    for (int d0 = 0; d0 < 4; ++d0) { const u32x4 w = *reinterpret_cast<const u32x4*>(&qr[d0]);
      q2 += bflo(w.x) * bflo(w.x) + bfhi(w.x) * bfhi(w.x) + bflo(w.y) * bflo(w.y) + bfhi(w.y) * bfhi(w.y) + bflo(w.z) * bflo(w.z) + bfhi(w.z) * bfhi(w.z) + bflo(w.w) * bflo(w.w) + bfhi(w.w) * bfhi(w.w); }
    { auto rr = __builtin_amdgcn_permlane32_swap(__float_as_uint(q2), __float_as_uint(q2), false, false); q2 = __uint_as_float(rr[0]) + __uint_as_float(rr[1]); }
    const float negb = -sqrtf(q2 * __uint_as_float(kmax2[map])) * 1.0001f;
#pragma unroll
    for (int r = 0; r < 16; ++r) nb[r] = negb; }
  B3_PIN(nb);
  const int rowk = 4 * wid + (lane >> 4); const unsigned koff = (unsigned)(rowk * LDP + (((lane & 15) ^ (rowk & 7)) * 8)) * 2u;
  const int sub0 = 2 * wid + (lane >> 5), key0 = (sub0 >> 2) * 8 + ((lane & 31) >> 2);
  const unsigned voff = (unsigned)(key0 * LDP + (sub0 & 3) * 32 + (lane & 3) * 8) * 2u + (unsigned)(T.vdelta * 2);
  const unsigned lds0 = (unsigned)(uintptr_t)lds; const unsigned kdst = lds0 + KRING + (unsigned)wid * 1024u, vdst = lds0 + VRING + (unsigned)wid * 1024u;
#define B3_TPTR(j_) ((const char*)(((j_) < 4) ? T.kctx + (long)(j_) * 64 * LDP : T.klat + (long)((j_) - 4) * 64 * LDP))
#define B3_DMAK(j_, sl_) do { const char* sp_ = B3_TPTR(j_); glds16s(sp_, koff, (unsigned)__builtin_amdgcn_readfirstlane(kdst + (sl_))); glds16s(sp_ + (size_t)32 * LDP * 2, koff, (unsigned)__builtin_amdgcn_readfirstlane(kdst + (sl_) + 8192)); } while (0)
#define B3_DMAV(j_, sl_) do { const char* sp_ = B3_TPTR(j_); glds16s(sp_, voff, (unsigned)__builtin_amdgcn_readfirstlane(vdst + (sl_))); glds16s(sp_ + (size_t)32 * LDP * 2, voff, (unsigned)__builtin_amdgcn_readfirstlane(vdst + (sl_) + 8192)); } while (0)
  int kro[4];
#pragma unroll
  for (int d0 = 0; d0 < 4; ++d0) kro[d0] = r32 * 256 + (((d0 * 16 + hi * 8) * 2 + mapoff * 2) ^ ((r32 & 7) << 4));
  const LAS char* kring = (const LAS char*)(uintptr_t)(lds0 + KRING);
  const int vbase = (int)lds0 + VRING + v_rd_base(lane);
#define B3_KF(kp_, n_, d0_) (*(const LAS bf16x8*)((kp_) + kro[d0_] + (n_) * 8192))
#define B3_VF(dst_, vp_, g_) do { const s16x4 lo_ = vtr((vp_) + v_rd_off((g_) & 3, (g_) >> 2, 0)), hi_ = vtr((vp_) + v_rd_off((g_) & 3, (g_) >> 2, 1)); dst_ = (bf16x8){lo_[0], lo_[1], lo_[2], lo_[3], hi_[0], hi_[1], hi_[2], hi_[3]}; } while (0)
  const int NT = T.nt;
#define B3_SL(j_) (((j_) & 3) * SLOT)
  f32x16 pA0, pA1, pB0, pB1; bf16x8 pa0, pa1, pa2, pa3;
  __syncthreads();
  B3_DMAK(0, B3_SL(0)); B3_DMAV(0, B3_SL(0)); B3_DMAK(1, B3_SL(1)); B3_DMAK(2, B3_SL(2)); B3_DMAV(1, B3_SL(1));
  B3_WAITBAR(8);
  { const LAS char* kp = kring + B3_SL(0); bf16x8 kf[8];
#pragma unroll
    for (int d0 = 0; d0 < 4; ++d0) { kf[2 * d0] = B3_KF(kp, 0, d0); kf[2 * d0 + 1] = B3_KF(kp, 1, d0); }
    pA0 = B3_MF(kf[0], qr[0], nb); pA1 = B3_MF(kf[1], qr[0], nb); pA0 = B3_MF(kf[2], qr[1], pA0); pA1 = B3_MF(kf[3], qr[1], pA1);
    pA0 = B3_MF(kf[4], qr[2], pA0); pA1 = B3_MF(kf[5], qr[2], pA1); pA0 = B3_MF(kf[6], qr[3], pA0); pA1 = B3_MF(kf[7], qr[3], pA1);
#pragma unroll
    for (int r = 0; r < 16; ++r) { pA0[r] = __builtin_amdgcn_exp2f(pA0[r]); pA1[r] = __builtin_amdgcn_exp2f(pA1[r]); l_reg += pA0[r] + pA1[r]; } }
  B3_WAITBAR(0);
#define B3_GA(MFS, P, i_, CA, CB) do { MFS; CA = cvt_pk_bf16(P[i_], P[(i_) + 1]); CB = cvt_pk_bf16(P[(i_) + 2], P[(i_) + 3]); } while (0)
#define B3_SW(OUT, c0_, c1_, c2_, c3_) do { u32x4 w_ = {c0_, c1_, c2_, c3_}; OUT = *reinterpret_cast<bf16x8*>(&w_); B3_PIN(OUT); } while (0)
#define B3_GB(MFS, X, i_) do { MFS; X[i_] = __builtin_amdgcn_exp2f(X[i_]); X[(i_) + 1] = __builtin_amdgcn_exp2f(X[(i_) + 1]); sacc += X[i_]; sacc += X[(i_) + 1]; B3_PIN(X); B3_PIN(sacc); SBAR(); } while (0)
#define B3_STEP(C0, C1, P0, P1, t_) do { SBAR(); \
    const LAS char* kp_ = kring + B3_SL(t_); const int vp_ = vbase + B3_SL((t_) - 1); bf16x8 kf[8], vf[8]; unsigned c0_, c1_, c2_, c3_; float sacc = 0.f; \
    _Pragma("unroll") for (int d0 = 0; d0 < 4; ++d0) { kf[2 * d0] = B3_KF(kp_, 0, d0); kf[2 * d0 + 1] = B3_KF(kp_, 1, d0); } SBAR(); \
    B3_GA(C0 = B3_MF(kf[0], qr[0], nb), P0, 0, c0_, c1_); SBAR(); \
    B3_GA(C1 = B3_MF(kf[1], qr[0], nb), P0, 4, c2_, c3_); B3_SW(pa0, c0_, c1_, c2_, c3_); SBAR(); \
    B3_GA(C0 = B3_MF(kf[2], qr[1], C0), P0, 8, c0_, c1_); SBAR(); \
    B3_GA(C1 = B3_MF(kf[3], qr[1], C1), P0, 12, c2_, c3_); B3_SW(pa1, c0_, c1_, c2_, c3_); SBAR(); \
    B3_VF(vf[0], vp_, 0); B3_GA(C0 = B3_MF(kf[4], qr[2], C0), P1, 0, c0_, c1_); SBAR(); \
    B3_VF(vf[1], vp_, 1); B3_GA(C1 = B3_MF(kf[5], qr[2], C1), P1, 4, c2_, c3_); B3_SW(pa2, c0_, c1_, c2_, c3_); SBAR(); \
    B3_VF(vf[2], vp_, 2); B3_GA(C0 = B3_MF(kf[6], qr[3], C0), P1, 8, c0_, c1_); SBAR(); \
    B3_VF(vf[3], vp_, 3); B3_GA(C1 = B3_MF(kf[7], qr[3], C1), P1, 12, c2_, c3_); B3_SW(pa3, c0_, c1_, c2_, c3_); SBAR(); \
    B3_VF(vf[4], vp_, 4);  B3_GB(o[0] = B3_MF(pa0, vf[0], o[0]), C0, 0); \
    B3_VF(vf[5], vp_, 5);  B3_GB(o[1] = B3_MF(pa0, vf[1], o[1]), C0, 2); \
    B3_VF(vf[6], vp_, 6);  B3_GB(o[2] = B3_MF(pa0, vf[2], o[2]), C0, 4); \
    B3_VF(vf[7], vp_, 7);  B3_GB(o[3] = B3_MF(pa0, vf[3], o[3]), C0, 6); \
    B3_VF(vf[0], vp_, 8);  B3_GB(o[0] = B3_MF(pa1, vf[4], o[0]), C0, 8); \
    B3_VF(vf[1], vp_, 9);  B3_GB(o[1] = B3_MF(pa1, vf[5], o[1]), C0, 10); \
    B3_VF(vf[2], vp_, 10); B3_GB(o[2] = B3_MF(pa1, vf[6], o[2]), C0, 12); \
    B3_VF(vf[3], vp_, 11); B3_GB(o[3] = B3_MF(pa1, vf[7], o[3]), C0, 14); \
    B3_VF(vf[4], vp_, 12); B3_GB(o[0] = B3_MF(pa2, vf[0], o[0]), C1, 0); \
    B3_VF(vf[5], vp_, 13); B3_GB(o[1] = B3_MF(pa2, vf[1], o[1]), C1, 2); \
    B3_VF(vf[6], vp_, 14); B3_GB(o[2] = B3_MF(pa2, vf[2], o[2]), C1, 4); \
    B3_VF(vf[7], vp_, 15); B3_GB(o[3] = B3_MF(pa2, vf[3], o[3]), C1, 6); \
    B3_GB(o[0] = B3_MF(pa3, vf[4], o[0]), C1, 8); \
    B3_GB(o[1] = B3_MF(pa3, vf[5], o[1]), C1, 10); \
    B3_GB(o[2] = B3_MF(pa3, vf[6], o[2]), C1, 12); \
    B3_GB(o[3] = B3_MF(pa3, vf[7], o[3]), C1, 14); \
    l_reg += sacc; } while (0)
  int t = 1;
  for (; t + 3 < NT; t += 2) {
    B3_DMAK(t + 2, B3_SL(t + 2)); B3_DMAK(t + 3, B3_SL(t + 3)); B3_DMAV(t + 1, B3_SL(t + 1)); B3_DMAV(t + 2, B3_SL(t + 2));
    B3_STEP(pB0, pB1, pA0, pA1, t); B3_STEP(pA0, pA1, pB0, pB1, t + 1);
    B3_WAITBAR(0);
  }
  B3_DMAK(t + 2, B3_SL(t + 2)); B3_DMAV(t + 1, B3_SL(t + 1)); B3_DMAV(t + 2, B3_SL(t + 2));
  B3_STEP(pB0, pB1, pA0, pA1, t); B3_STEP(pA0, pA1, pB0, pB1, t + 1);
  B3_WAITBAR(0);
  B3_STEP(pB0, pB1, pA0, pA1, t + 2);
  { unsigned c[16];
#pragma unroll
    for (int i = 0; i < 8; ++i) { c[i] = cvt_pk_bf16(pB0[2 * i], pB0[2 * i + 1]); c[8 + i] = cvt_pk_bf16(pB1[2 * i], pB1[2 * i + 1]); }
    B3_SW(pa0, c[0], c[1], c[2], c[3]); B3_SW(pa1, c[4], c[5], c[6], c[7]); B3_SW(pa2, c[8], c[9], c[10], c[11]); B3_SW(pa3, c[12], c[13], c[14], c[15]);
    pv_d0_v(o, vbase + B3_SL(NT - 1), pa0, pa1, pa2, pa3); }
#undef B3_STEP
#undef B3_GA
#undef B3_GB
#undef B3_SW
  { auto rr = __builtin_amdgcn_permlane32_swap(__float_as_uint(l_reg), __float_as_uint(l_reg), false, false); l_reg = __uint_as_float(rr[0]) + __uint_as_float(rr[1]); }
  if (hi == 0) li_l[r32] = l_reg; asm volatile("s_waitcnt lgkmcnt(0)" ::: "memory");
#pragma unroll
  for (int r = 0; r < 16; ++r) { const float rl = __builtin_amdgcn_rcpf(li_l[crow(r, hi)]);
#pragma unroll
    for (int d0 = 0; d0 < 4; ++d0) o[d0][r] *= rl; }
  __syncthreads();
  float* X = (float*)lds + (size_t)(wid & 3) * 32 * 128;
  if (wid >= 4) {
#pragma unroll
    for (int d0 = 0; d0 < 4; ++d0)
#pragma unroll
      for (int r = 0; r < 16; ++r) X[crow(r, hi) * 128 + d0 * 32 + r32] = o[d0][r];
  }
  __syncthreads();
  if (wid < 4) {
    float ss[16];
#pragma unroll
    for (int r = 0; r < 16; ++r) { float s = 0.f;
#pragma unroll
      for (int d0 = 0; d0 < 4; ++d0) { const float v = o[d0][r] - mp.lam * X[crow(r, hi) * 128 + d0 * 32 + r32]; o[d0][r] = v; s += v * v; }
      ss[r] = s; }
#pragma unroll
    for (int r = 0; r < 16; ++r) ss[r] = rsqrtf(sum32(ss[r]) * (1.0f / 128.0f) + 1e-6f) * mp.post;
    float gcol[4];
#pragma unroll
    for (int d0 = 0; d0 < 4; ++d0) gcol[d0] = mp.normg[d0 * 32 + r32];
    bf16_t* Ow = Orow0 + (long)(wid * 32) * LDOUT;
#pragma unroll
    for (int r = 0; r < 16; ++r) { const int orow = crow(r, hi);
#pragma unroll
      for (int d0 = 0; d0 < 4; ++d0) Ow[(long)orow * LDOUT + d0 * 32 + r32] = f2bf(o[d0][r] * ss[r] * gcol[d0]); }
  }
}
}
struct Args { const float* in[23]; float* out; unsigned char* ws; int ph_lo, ph_hi; };
typedef const Args __attribute__((address_space(4)))* KArgs;
struct Ctx {
    KArgs ka; LAS unsigned char* lds; char* ldsg; int tid, lane, wave, G, wg;
    __device__ __forceinline__ const float* in(int k) const { return ka->in[k]; }
    __device__ __forceinline__ float* out() const { return ka->out; }
    __device__ __forceinline__ unsigned char* ws() const { return ka->ws; }
    __device__ __forceinline__ float* modp() const { return (float*)(ws() + WS_MODP); }
    __device__ __forceinline__ float* mod() const { return (float*)(ws() + WS_MOD); }
    __device__ __forceinline__ float* misc() const { return (float*)(ws() + WS_MISC); }
    __device__ __forceinline__ float* rope() const { return (float*)(ws() + WS_ROPE); }
    __device__ __forceinline__ float* xc() const { return (float*)(ws() + WS_XC); }
    __device__ __forceinline__ bf16_t* xb() const { return (bf16_t*)(ws() + WS_XB); }
    __device__ __forceinline__ float* aff() const { return (float*)(ws() + WS_AFF); }
    __device__ __forceinline__ int* rowidx() const { return (int*)(ws() + WS_ROWIDX); }
    __device__ __forceinline__ float* gatev() const { return (float*)(ws() + WS_GATEV); }
    __device__ __forceinline__ int* slot() const { return (int*)(ws() + WS_SLOT); }
    __device__ __forceinline__ bf16_t* H() const { return (bf16_t*)(ws() + WS_H); }
    __device__ __forceinline__ bf16_t* P() const { return (bf16_t*)(ws() + WS_P); }
    __device__ __forceinline__ bf16_t* O() const { return (bf16_t*)(ws() + WS_O); }
    __device__ __forceinline__ bf16_t* S() const { return (bf16_t*)(ws() + WS_S); }
    __device__ __forceinline__ bf16_t* U() const { return (bf16_t*)(ws() + WS_H); }
    __device__ __forceinline__ bf16_t* ACT() const { return (bf16_t*)(ws() + WS_P + ACT_OFF); }
    __device__ __forceinline__ bf16_t* Y() const { return (bf16_t*)(ws() + WS_P + Y_OFF); }
    __device__ __forceinline__ bf16_t* w_in_t(int l) const { return (bf16_t*)(ws() + WS_W + (size_t)l * WL_BYTES + WL_IN); }
    __device__ __forceinline__ bf16_t* w_out_t(int l) const { return (bf16_t*)(ws() + WS_W + (size_t)l * WL_BYTES + WL_OUT); }
    __device__ __forceinline__ bf16_t* w_gu_t(int l) const { return (bf16_t*)(ws() + WS_W + (size_t)l * WL_BYTES + WL_GU); }
    __device__ __forceinline__ bf16_t* w_dn_t(int l) const { return (bf16_t*)(ws() + WS_W + (size_t)l * WL_BYTES + WL_DN); }
};
__device__ __forceinline__ int hw_lane() { int l; asm volatile("v_mbcnt_lo_u32_b32 %0, -1, 0\n\tv_mbcnt_hi_u32_b32 %0, -1, %0" : "=v"(l)); return l; }
__device__ __forceinline__ Ctx make_ctx(unsigned char* lds_raw, int wave_s) {
    Ctx F; KArgs p = (KArgs)__builtin_amdgcn_kernarg_segment_ptr(); asm volatile("" : "+s"(p));
    F.ka = p; F.lds = (LAS unsigned char*)lds_raw; F.ldsg = (char*)lds_raw;
    F.lane = hw_lane(); F.wave = wave_s; F.tid = wave_s * 64 + F.lane; F.G = gridDim.x; F.wg = blockIdx.x; return F;
}
enum { I_X = 0, I_C, I_CTX, I_CCTX, I_WMOD, I_BMOD, I_N1G, I_WIN, I_RPB, I_DLAM, I_DNG, I_RDF, I_RDB, I_GNG, I_GNB, I_SINK, I_WOUT, I_N2G, I_WR, I_WG, I_WU, I_WD, I_FNG };

__device__ __forceinline__ void ph_mod_partial(const Ctx& F) {
    const float* c = F.in(I_C); const float* cc = F.in(I_CCTX); const float* wm = F.in(I_WMOD);
    for (int gid = F.wg * 512 + F.tid; gid < 2 * 16 * 3072; gid += F.G * 512) {
        const int cg = gid % 3072, ks = (gid / 3072) % 16, l = gid / (3072 * 16);
        const float* w = wm + (size_t)l * DM * 12288 + (size_t)(ks * 128) * 12288 + cg * 4;
        f32x4 a0 = {0.f, 0.f, 0.f, 0.f}, a1 = a0, a2 = a0;
#pragma unroll 8
        for (int k = 0; k < 128; ++k) { const f32x4 wv = *(const f32x4*)(w + (size_t)k * 12288); const int kk = ks * 128 + k;
            const float s0 = siluf(c[kk]), s1 = siluf(c[DM + kk]), s2 = siluf(cc[kk]); a0 += s0 * wv; a1 += s1 * wv; a2 += s2 * wv; }
        float* o = F.modp() + (size_t)((ks * 2 + l) * 3) * 12288 + cg * 4;
        *(f32x4*)(o) = a0; *(f32x4*)(o + 12288) = a1; *(f32x4*)(o + 2 * 12288) = a2;
    }
}
__device__ __forceinline__ void ph_mod_reduce(const Ctx& F) {
    const int NMOD = 2 * 3 * 12288, NR128 = 256 * 32, NR64 = 256 * 16;
    for (int idx = F.wg * 512 + F.tid; idx < NMOD + NR128 + NR64 + 2; idx += F.G * 512) {
        if (idx < NMOD) { const int l = idx / (3 * 12288), v = (idx / 12288) % 3, col = idx % 12288; float s = F.in(I_BMOD)[l * 12288 + col];
            for (int ks = 0; ks < 16; ++ks) s += F.modp()[(size_t)((ks * 2 + l) * 3 + v) * 12288 + col];
            F.mod()[idx] = s;
        } else if (idx < NMOD + NR128) { const int e = idx - NMOD, pos = e >> 5, i = e & 31; const float inv = powf(10000.0f, -(float)i / 32.0f); const float a = (float)pos * inv;
            F.rope()[e] = cosf(a); F.rope()[NR128 + e] = sinf(a);
        } else if (idx < NMOD + NR128 + NR64) { const int e = idx - NMOD - NR128, pos = e >> 4, i = e & 15; const float inv = powf(10000.0f, -(float)i / 16.0f); const float a = (float)pos * inv;
            F.rope()[2 * NR128 + e] = cosf(a); F.rope()[2 * NR128 + NR64 + e] = sinf(a);
        } else { const int l = idx - (NMOD + NR128 + NR64); const float* dl = F.in(I_DLAM) + l * 4 * 64; float s1 = 0.f, s2 = 0.f;
            for (int i = 0; i < 64; ++i) { s1 += dl[i] * dl[64 + i]; s2 += dl[128 + i] * dl[192 + i]; }
            const float lam_init = 0.8f - 0.6f * expf(-0.3f * (float)l);
            F.misc()[l * 2] = expf(s1) - expf(s2) + lam_init; F.misc()[l * 2 + 1] = lam_init; }
    }
}
__device__ __forceinline__ int inproj_perm(int np) {
    const int pn = np >> 8, p = np & 255;
    if (pn >= 6 && pn <= 9) { const int half = p >> 7, pp = p & 127, sh = pp >> 5, rc = (pp >> 4) & 1, i = pp & 15; return pn * 256 + sh * 64 + rc * 32 + half * 16 + i; }
    if ((pn >= 12 && pn <= 15) || (pn >= 20 && pn <= 22)) { const int half = p >> 7, pp = p & 127, hs = pp >> 6, rc = (pp >> 5) & 1, i = pp & 31; return pn * 256 + hs * 128 + rc * 64 + half * 32 + i; }
    return np;
}
__device__ __forceinline__ float inproj_scale(int col) {
    if (col < C_AK) return 0.08838834764831845f * LOG2E;
    if (col >= C_BQ && col < C_BK) return 0.125f * LOG2E;
    if (col >= C_CK && col < C_CV) return 0.08838834764831845f;
    if (col >= C_DQ && col < C_DK) return 0.08838834764831845f * LOG2E;
    return 1.0f;
}
struct CvTile { const float* src; bf16_t* dst; int nsrc, K, n0, k0, kind; };
__device__ __forceinline__ CvTile cv_tile(const Ctx& F, int t) {
    const int T_IN = 96 * 32, T_OUT = 32 * 32, T_GU = 16 * 32 * 32, T_DN = 16 * 32 * 16, TL = T_IN + T_OUT + T_GU + T_DN;
    const int l = t / TL; int r = t % TL; CvTile c;
    if (r < T_IN) { c.kind = 0; c.n0 = (r % 96) * 64; c.k0 = (r / 96) * 64; c.src = F.in(I_WIN) + (size_t)l * DM * INW; c.nsrc = INW; c.K = DM; c.dst = F.w_in_t(l); }
    else if (r < T_IN + T_OUT) { r -= T_IN; c.kind = 1; c.n0 = (r % 32) * 64; c.k0 = (r / 32) * 64; c.src = F.in(I_WOUT) + (size_t)l * DM * DM; c.nsrc = DM; c.K = DM; c.dst = F.w_out_t(l); }
    else if (r < T_IN + T_OUT + T_GU) { r -= T_IN + T_OUT; c.kind = 2; const int e = r / 1024, rr = r % 1024; c.n0 = (rr % 32) * 64; c.k0 = (rr / 32) * 64;
        const int half = (c.n0 & 255) >> 7; c.src = (half ? F.in(I_WU) : F.in(I_WG)) + (size_t)(l * NE + e) * DM * FF; c.nsrc = FF; c.K = DM; c.dst = F.w_gu_t(l) + (size_t)e * 2048 * DM; }
    else { r -= T_IN + T_OUT + T_GU; c.kind = 3; const int e = r / 512, rr = r % 512; c.n0 = (rr % 32) * 64; c.k0 = (rr / 32) * 64; c.src = F.in(I_WD) + (size_t)(l * NE + e) * FF * DM; c.nsrc = DM; c.K = FF; c.dst = F.w_dn_t(l) + (size_t)e * DM * FF; }
    return c;
}
__device__ __forceinline__ void ph_convert(const Ctx& F) {
    LAS float* tile = (LAS float*)F.lds;
    const int TL = 96 * 32 + 32 * 32 + 16 * 32 * 32 + 16 * 32 * 16, NT = 2 * TL;
    const int tx = F.tid & 63, ty = F.tid >> 6, kx2 = F.tid & 31, ny = F.tid >> 5;
    float v[4][8]; float sc[4];
#define CV_LOAD(t0_) do { _Pragma("unroll") for (int u = 0; u < 4; ++u) { const int t = (t0_) + u; if (t < NT) { const CvTile c = cv_tile(F, t); \
            const int np = c.n0 + tx; int scol = np; sc[u] = 1.0f; \
            if (c.kind == 0) { scol = inproj_perm(np); sc[u] = inproj_scale(scol); } else if (c.kind == 2) { scol = (np >> 8) * 128 + (np & 127); } \
            _Pragma("unroll") for (int i = 0; i < 8; ++i) v[u][i] = c.src[(size_t)(c.k0 + ty + 8 * i) * c.nsrc + scol]; } } } while (0)
    int t0 = F.wg * 4;
    __syncthreads();
    if (t0 < NT) CV_LOAD(t0);
    for (; t0 < NT; t0 += 4 * F.G) {
#pragma unroll
        for (int u = 0; u < 4; ++u) { const int t = t0 + u; if (t < NT) {
#pragma unroll
            for (int i = 0; i < 8; ++i) tile[u * (64 * 65) + (ty + 8 * i) * 65 + tx] = v[u][i] * sc[u]; } }
        if (t0 + 4 * F.G < NT) CV_LOAD(t0 + 4 * F.G);
        asm volatile("s_waitcnt lgkmcnt(0)" ::: "memory"); __builtin_amdgcn_s_barrier();
#pragma unroll
        for (int u = 0; u < 4; ++u) { const int t = t0 + u; if (t < NT) { const CvTile c = cv_tile(F, t);
#pragma unroll
            for (int i = 0; i < 4; ++i) { const int nn = ny + 16 * i; const float lo = tile[u * (64 * 65) + (2 * kx2) * 65 + nn], hi = tile[u * (64 * 65) + (2 * kx2 + 1) * 65 + nn];
                *(unsigned*)(c.dst + (size_t)(c.n0 + nn) * c.K + c.k0 + 2 * kx2) = cvt_pk_bf16(lo, hi); } } }
        asm volatile("s_waitcnt lgkmcnt(0)" ::: "memory"); __builtin_amdgcn_s_barrier();
    }
#undef CV_LOAD
    __syncthreads();
}

__device__ __forceinline__ float wave_sum(float s) { return sum64(s); }
__device__ __forceinline__ void load_x(const Ctx& F, const void* xrow, bool bf, f32x4 (&x)[8]) {
    const int lane = F.lane;
    if (bf) {
#pragma unroll
        for (int j = 0; j < 8; ++j) { const u32x2 w = *(const u32x2*)((const bf16_t*)xrow + j * 256 + lane * 4); x[j] = (f32x4){bflo(w.x), bfhi(w.x), bflo(w.y), bfhi(w.y)}; }
    } else {
#pragma unroll
        for (int j = 0; j < 8; ++j) x[j] = *(const f32x4*)((const float*)xrow + j * 256 + lane * 4);
    }
}
__device__ __forceinline__ void ld_y(const Ctx& F, int s, u32x2 (&w)[8]) {
    const bf16_t* y = F.Y() + (size_t)s * DM + F.lane * 4;
#pragma unroll
    for (int j = 0; j < 8; ++j) w[j] = *(const u32x2*)(y + j * 256);
}
__device__ __forceinline__ void acc_y(f32x4 (&ys)[8], const u32x2 (&w)[8]) {
#pragma unroll
    for (int j = 0; j < 8; ++j) ys[j] += (f32x4){bflo(w[j].x), bfhi(w[j].x), bflo(w[j].y), bfhi(w[j].y)};
}
__device__ __forceinline__ int load_slots(const Ctx& F, int row) { return F.slot()[(size_t)row * NE + (F.lane & 15)]; }
__device__ __forceinline__ void moe_fold2(const Ctx& F, const LAS float* g2, int sva, int svb, f32x4 (&xa)[8], f32x4 (&xb)[8]) {
    f32x4 ya[8], yb[8];
#pragma unroll
    for (int j = 0; j < 8; ++j) { ya[j] = (f32x4){0.f, 0.f, 0.f, 0.f}; yb[j] = (f32x4){0.f, 0.f, 0.f, 0.f}; }
    unsigned ma = (unsigned)__builtin_amdgcn_ballot_w64(sva >= 0) & 0xFFFFu, mb = (unsigned)__builtin_amdgcn_ballot_w64(svb >= 0) & 0xFFFFu;
    while ((ma | mb) != 0u) {
        const bool ha = ma != 0u, hb = mb != 0u; u32x2 wa[8], wb[8];
        if (ha) { const int e = __builtin_ctz(ma); ma &= ma - 1u; ld_y(F, __builtin_amdgcn_readlane(sva, e), wa); }
        if (hb) { const int e = __builtin_ctz(mb); mb &= mb - 1u; ld_y(F, __builtin_amdgcn_readlane(svb, e), wb); }
        if (ha) acc_y(ya, wa);
        if (hb) acc_y(yb, wb);
    }
#pragma unroll
    for (int j = 0; j < 8; ++j) { const f32x4 g = *(const LAS f32x4*)(g2 + j * 256 + F.lane * 4); xa[j] += g * ya[j]; xb[j] += g * yb[j]; }
}
__device__ __forceinline__ float row_rstd(const f32x4 (&x)[8]) {
    float s = 0.f;
#pragma unroll
    for (int j = 0; j < 8; ++j) s += x[j][0] * x[j][0] + x[j][1] * x[j][1] + x[j][2] * x[j][2] + x[j][3] * x[j][3];
    s = wave_sum(s); return rsqrtf(s * (1.0f / DM) + 1e-6f);
}
__device__ __forceinline__ void norm1_row(const Ctx& F, int li, int row, const float* ng, f32x4 (&x)[8]) {
    const bool lat = row < NLAT; const int v = lat ? row / SEQ : 2;
    if (li != 0) {
        if (lat) { bf16_t* xo = F.xb() + (size_t)row * DM;
#pragma unroll
            for (int j = 0; j < 8; ++j) { u32x2 w; w.x = cvt_pk_bf16(x[j][0], x[j][1]); w.y = cvt_pk_bf16(x[j][2], x[j][3]); *(u32x2*)(xo + j * 256 + F.lane * 4) = w;
                x[j] = (f32x4){bflo(w.x), bfhi(w.x), bflo(w.y), bfhi(w.y)}; }
        } else { float* xo = F.xc() + (size_t)(row - NLAT) * DM;
#pragma unroll
            for (int j = 0; j < 8; ++j) *(f32x4*)(xo + j * 256 + F.lane * 4) = x[j]; } }
    const float rs = row_rstd(x);
    const LAS float* gs = (const LAS float*)F.lds + v * (2 * DM); const LAS float* s0p = gs + DM;
    bf16_t* h = F.H() + (size_t)row * DM;
#pragma unroll
    for (int j = 0; j < 8; ++j) { const int c = j * 256 + F.lane * 4; const f32x4 g = *(const LAS f32x4*)(gs + c), s0 = *(const LAS f32x4*)(s0p + c);
        const f32x4 y = x[j] * rs * g + s0; u32x2 w; w.x = cvt_pk_bf16(y[0], y[1]); w.y = cvt_pk_bf16(y[2], y[3]); *(u32x2*)(h + c) = w; }
}
__device__ __forceinline__ const void* norm1_src(const Ctx& F, int li, int row, bool& bf) {
    const bool lat = row < NLAT; bf = (li != 0) && lat;
    if (li == 0) return lat ? (const void*)(F.in(I_X) + (size_t)row * DM) : (const void*)(F.in(I_CTX) + (size_t)(row - NLAT) * DM);
    return lat ? (const void*)(F.xb() + (size_t)row * DM) : (const void*)(F.xc() + (size_t)(row - NLAT) * DM);
}
__device__ __forceinline__ void ph_norm1(const Ctx& F, int li) {
    const float* ng = F.in(I_N1G) + li * DM;
    __syncthreads();
    for (int i = F.tid; i < 3 * DM; i += 512) { const int v = i / DM, c = i - v * DM; const float* sh = F.mod() + (size_t)(li * 3 + v) * 12288;
        ((LAS float*)F.lds)[v * (2 * DM) + c] = ng[c] * (1.0f + sh[DM + c]); ((LAS float*)F.lds)[v * (2 * DM) + DM + c] = sh[c];
        if (li != 0) ((LAS float*)F.lds)[6 * DM + i] = F.mod()[(size_t)((li - 1) * 3 + v) * 12288 + 5 * DM + c]; }
    __syncthreads();
    for (int row = (F.wg * 8 + F.wave) * 2; row < MTOT; row += F.G * 16) {
        f32x4 xa[8], xb[8]; bool bfa, bfb; const void* pa = norm1_src(F, li, row, bfa); const void* pb = norm1_src(F, li, row + 1, bfb);
        int sva = -1, svb = -1; if (li != 0) { sva = load_slots(F, row); svb = load_slots(F, row + 1); }
        load_x(F, pa, bfa, xa); load_x(F, pb, bfb, xb);
        if (li != 0) moe_fold2(F, (const LAS float*)F.lds + 6 * DM + (row < NLAT ? row / SEQ : 2) * DM, sva, svb, xa, xb);
        norm1_row(F, li, row, ng, xa); norm1_row(F, li, row + 1, ng, xb);
    }
}
__device__ __forceinline__ void ph_final(const Ctx& F) {
    __syncthreads();
    for (int i = F.tid; i < 3 * DM; i += 512) ((LAS float*)F.lds)[i] = i < DM ? F.in(I_FNG)[i] : F.mod()[(size_t)(3 + (i / DM - 1)) * 12288 + 5 * DM + (i & (DM - 1))];
    __syncthreads();
    const LAS float* ng = (const LAS float*)F.lds;
    for (int row = (F.wg * 8 + F.wave) * 2; row < NLAT; row += F.G * 16) {
        f32x4 xa[8], xb[8]; const int sva = load_slots(F, row), svb = load_slots(F, row + 1);
        load_x(F, F.xb() + (size_t)row * DM, true, xa); load_x(F, F.xb() + (size_t)(row + 1) * DM, true, xb);
        moe_fold2(F, ng + DM + (row / SEQ) * DM, sva, svb, xa, xb);
        const float ra = row_rstd(xa), rb = row_rstd(xb); float* xr = F.out() + (size_t)row * DM;
#pragma unroll
        for (int j = 0; j < 8; ++j) { const int c = j * 256 + F.lane * 4; const f32x4 g = *(const LAS f32x4*)(ng + c); *(f32x4*)(xr + c) = xa[j] * ra * g; *(f32x4*)(xr + DM + c) = xb[j] * rb * g; }
    }
}
__device__ __forceinline__ void router_reduce_store(float (&v)[16], int lane, float* affrow) {
    float a[8];
#pragma unroll
    for (int i = 0; i < 8; ++i) { auto rr = __builtin_amdgcn_permlane32_swap(__float_as_uint(v[i]), __float_as_uint(v[i + 8]), false, false); a[i] = __uint_as_float(rr[0]) + __uint_as_float(rr[1]); }
    float b[4]; const bool b16 = (lane & 16) != 0;
#pragma unroll
    for (int i = 0; i < 4; ++i) { const float keep = b16 ? a[i + 4] : a[i], send = b16 ? a[i] : a[i + 4]; b[i] = keep + xshf<16>(send); }
    float c[2]; const bool b8 = (lane & 8) != 0;
#pragma unroll
    for (int i = 0; i < 2; ++i) { const float keep = b8 ? b[i + 2] : b[i], send = b8 ? b[i] : b[i + 2]; c[i] = keep + xshf<8>(send); }
    const bool b4 = (lane & 4) != 0; float lg = (b4 ? c[1] : c[0]) + xshf<4>(b4 ? c[0] : c[1]);
    lg += xshf<2>(lg); lg += xshf<1>(lg);
    float mx = lg; mx = fmaxf(mx, xshf<4>(mx)); mx = fmaxf(mx, xshf<8>(mx)); mx = fmaxf(mx, xshf<16>(mx));
    { auto rr = __builtin_amdgcn_permlane32_swap(__float_as_uint(mx), __float_as_uint(mx), false, false); mx = fmaxf(__uint_as_float(rr[0]), __uint_as_float(rr[1])); }
    const float ex = expf(lg - mx); float den = ex; den += xshf<4>(den); den += xshf<8>(den); den += xshf<16>(den);
    { auto rr = __builtin_amdgcn_permlane32_swap(__float_as_uint(den), __float_as_uint(den), false, false); den = __uint_as_float(rr[0]) + __uint_as_float(rr[1]); }
    const int e = ((lane >> 5) & 1) * 8 + ((lane >> 4) & 1) * 4 + ((lane >> 3) & 1) * 2 + ((lane >> 2) & 1);
    if ((lane & 3) == 0) affrow[e] = ex / den;
}
__device__ __forceinline__ void ph_norm2(const Ctx& F, int li, int rbeg, int rend, int wg0, int nwg) {
    const float* ng = F.in(I_N2G) + li * DM; const float* wr = F.in(I_WR) + (size_t)li * DM * NE; LAS float* wl = (LAS float*)F.lds;
    __syncthreads();
    int ts_ = F.tid; asm volatile("" : "+v"(ts_));
    for (int h = 0; h < 2; ++h) { f32x4 wv[8];
#pragma unroll
      for (int q = 0; q < 8; ++q) wv[q] = *(const f32x4*)(wr + (size_t)(ts_ + 512 * (h * 8 + q)) * 4);
#pragma unroll
      for (int q = 0; q < 8; ++q) { const int i4 = ts_ + 512 * (h * 8 + q), k = i4 >> 2, e0 = (i4 & 3) * 4; wl[(e0 + 0) * DM + k] = wv[q][0]; wl[(e0 + 1) * DM + k] = wv[q][1]; wl[(e0 + 2) * DM + k] = wv[q][2]; wl[(e0 + 3) * DM + k] = wv[q][3]; } }
    LAS float* gsl = wl + NE * DM;
    for (int i = F.tid; i < 2 * DM; i += 512) { const int v = (rbeg < NLAT) ? i / DM : 2, c = i & (DM - 1); gsl[i] = ng[c] * (1.0f + F.mod()[(size_t)(li * 3 + v) * 12288 + 4 * DM + c]); }
    __syncthreads();
    for (int row0 = rbeg + ((F.wg - wg0) * 8 + F.wave) * 4; row0 < rend; row0 += nwg * 32) {
        const bool lat = row0 < NLAT; const int v = lat ? row0 / SEQ : 2;
        const float* sh = F.mod() + (size_t)(li * 3 + v) * 12288 + 3 * DM; const LAS float* gsv = gsl + (lat ? v * DM : 0);
        f32x4 x[4][8];
        if (lat) { const bf16_t* xin = F.xb() + (size_t)row0 * DM;
#pragma unroll
            for (int r = 0; r < 4; ++r)
#pragma unroll
                for (int j = 0; j < 8; ++j) { const u32x2 w = *(const u32x2*)(xin + (size_t)r * DM + j * 256 + F.lane * 4); x[r][j] = (f32x4){bflo(w.x), bfhi(w.x), bflo(w.y), bfhi(w.y)}; }
        } else { const float* xin = F.xc() + (size_t)(row0 - NLAT) * DM;
#pragma unroll
            for (int r = 0; r < 4; ++r)
#pragma unroll
                for (int j = 0; j < 8; ++j) x[r][j] = *(const f32x4*)(xin + (size_t)r * DM + j * 256 + F.lane * 4); }
        float rs[4];
#pragma unroll
        for (int r = 0; r < 4; ++r) rs[r] = row_rstd(x[r]);
#pragma unroll
        for (int j = 0; j < 8; ++j) { const int c = j * 256 + F.lane * 4; const f32x4 s0 = *(const f32x4*)(sh + c); const f32x4 gs = *(const LAS f32x4*)(gsv + c);
#pragma unroll
            for (int r = 0; r < 4; ++r) { const f32x4 y = x[r][j] * rs[r] * gs + s0; x[r][j] = y; u32x2 w; w.x = cvt_pk_bf16(y[0], y[1]); w.y = cvt_pk_bf16(y[2], y[3]); *(u32x2*)(F.H() + (size_t)(row0 + r) * DM + c) = w; } }
        float lg[4][16];
#pragma unroll
        for (int e = 0; e < NE; ++e) { f32x2 a0 = {0.f, 0.f}, a1 = {0.f, 0.f}, a2 = {0.f, 0.f}, a3 = {0.f, 0.f};
#pragma unroll
            for (int j = 0; j < 8; ++j) { const f32x4 w = *(const LAS f32x4*)(wl + e * DM + j * 256 + F.lane * 4); const f32x2 wlo = __builtin_shufflevector(w, w, 0, 1), whi = __builtin_shufflevector(w, w, 2, 3);
                a0 += __builtin_shufflevector(x[0][j], x[0][j], 0, 1) * wlo; a0 += __builtin_shufflevector(x[0][j], x[0][j], 2, 3) * whi;
                a1 += __builtin_shufflevector(x[1][j], x[1][j], 0, 1) * wlo; a1 += __builtin_shufflevector(x[1][j], x[1][j], 2, 3) * whi;
                a2 += __builtin_shufflevector(x[2][j], x[2][j], 0, 1) * wlo; a2 += __builtin_shufflevector(x[2][j], x[2][j], 2, 3) * whi;
                a3 += __builtin_shufflevector(x[3][j], x[3][j], 0, 1) * wlo; a3 += __builtin_shufflevector(x[3][j], x[3][j], 2, 3) * whi; }
            float s0 = a0[0] + a0[1], s1 = a1[0] + a1[1], s2 = a2[0] + a2[1], s3 = a3[0] + a3[1];
            asm volatile("" : "+v"(s0), "+v"(s1), "+v"(s2), "+v"(s3) :: "memory"); __builtin_amdgcn_sched_barrier(0);
            lg[0][e] = s0; lg[1][e] = s1; lg[2][e] = s2; lg[3][e] = s3; }
#pragma unroll
        for (int r = 0; r < 4; ++r) router_reduce_store(lg[r], F.lane, F.aff() + (size_t)(row0 + r) * NE);
    }
}

__device__ __forceinline__ void topk_group(const Ctx& F, int N, int k, int row_base  , int e, int out_base  ) {
    LAS unsigned* keys = (LAS unsigned*)F.lds; LAS unsigned* hist = keys + 16384; LAS unsigned* sh = hist + 256;
    const int tid = F.tid;
    __syncthreads();
    for (int i = tid; i < N; i += 512) keys[i] = __float_as_uint(F.aff()[(size_t)(row_base + i) * NE + e]);
    unsigned prefix = 0u, need = (unsigned)k;
    for (int shift = 24; shift >= 0; shift -= 8) {
        if (tid < 256) hist[tid] = 0u;
        __syncthreads();
        for (int i = tid; i < N; i += 512) { const unsigned key = keys[i]; if (shift == 24 || (key >> (shift + 8)) == (prefix >> (shift + 8))) atomicAdd((unsigned*)&hist[(key >> shift) & 255u], 1u); }
        __syncthreads();
        if (tid < 64) {
            const int b0 = 255 - 4 * tid; const unsigned c0 = hist[b0], c1 = hist[b0 - 1], c2 = hist[b0 - 2], c3 = hist[b0 - 3]; const unsigned loc = c0 + c1 + c2 + c3;
            unsigned inc = loc;
#pragma unroll
            for (int o = 1; o < 64; o <<= 1) { const unsigned t = lane_up(inc, tid, o); if (tid >= o) inc += t; }
            const unsigned before = inc - loc;
            if (before < need && need <= inc) { unsigned cum = before; int d;
                if (cum + c0 >= need) d = b0; else { cum += c0; if (cum + c1 >= need) d = b0 - 1; else { cum += c1; if (cum + c2 >= need) d = b0 - 2; else { cum += c2; d = b0 - 3; } } }
                sh[0] = prefix | ((unsigned)d << shift); sh[1] = need - cum; }
        }
        __syncthreads();
        prefix = sh[0]; need = sh[1];
        __syncthreads();
    }
    const int per = N >= 512 ? N / 512 : 1; const int nact = N / per; unsigned cg = 0u, ce = 0u;
    if (tid < nact) for (int i = 0; i < per; ++i) { const unsigned key = keys[tid * per + i]; cg += key > prefix; ce += key == prefix; }
    unsigned pk = cg | (ce << 16), inc = pk;
#pragma unroll
    for (int o = 1; o < 64; o <<= 1) { const unsigned t = lane_up(inc, F.lane, o); if (F.lane >= o) inc += t; }
    if (F.lane == 63) sh[8 + F.wave] = inc;
    __syncthreads();
    unsigned woff = 0u;
    for (int w = 0; w < F.wave; ++w) woff += sh[8 + w];
    const unsigned exc = inc - pk + woff; unsigned gb = exc & 0xffffu, eb = exc >> 16; const unsigned ngt = (unsigned)k - need;
    if (tid < nact) for (int i = 0; i < per; ++i) { const int ti = tid * per + i; const unsigned key = keys[ti]; int s = -1;
        if (key > prefix) { s = (int)gb; ++gb; } else if (key == prefix) { if (eb < need) s = (int)(ngt + eb); ++eb; }
        const int row = row_base + ti;
        if (s >= 0) { F.rowidx()[out_base + s] = row; F.gatev()[out_base + s] = __uint_as_float(key); }
        F.slot()[(size_t)row * NE + e] = s >= 0 ? out_base + s : -1; }
    __syncthreads();
}
__device__ __forceinline__ void ph_topk(const Ctx& F, int li) {
    const int ngroups = (li == 0) ? 64 : 32;
    for (int g = F.wg; g < ngroups; g += F.G) {
        if (g < 32) { const int b = g >> 4, e = g & 15; topk_group(F, SEQ, CAP, b * SEQ, e, g * CAP); }
        else { const int b = (g - 32) >> 4, e = (g - 32) & 15; const int base = NBATCH * NE * CAP + e * 256;
            topk_group(F, LCTX, CAPC, NLAT + b * LCTX, e, base + b * CAPC);
            if (b == 0 && F.tid < 192) { F.rowidx()[base + 64 + F.tid] = 0; F.gatev()[base + 64 + F.tid] = 0.f; } }
    }
}

constexpr size_t CTL_KMAX = 16384;
namespace ret {
constexpr int TS = 136;
constexpr int TILE_B = 128 * TS * 2;
__device__ __forceinline__ float log2_gamma(float decay) { return -log1pf(expf(-decay)) * LOG2E; }
__device__ __forceinline__ int chunk_row0(int b, int c) { return c < 2 ? NLAT + b * LCTX + c * 128 : b * SEQ + (c - 2) * 128; }
__device__ __forceinline__ f32x16 mm_block(const LAS bf16_t* A, int ra, const LAS bf16_t* B, int rb, int r32, int hi, f32x16 acc) {
#pragma unroll
    for (int s = 0; s < 8; ++s) { const bf16x8 a = *(const LAS bf16x8*)(A + (ra + r32) * TS + 16 * s + 8 * hi), b = *(const LAS bf16x8*)(B + (rb + r32) * TS + 16 * s + 8 * hi);
        acc = __builtin_amdgcn_mfma_f32_32x32x16_bf16(a, b, acc, 0, 0, 0); }
    return acc;
}
__device__ __forceinline__ bf16x8 scale8(bf16x8 v, float s) {
    const u32x4 w = *reinterpret_cast<const u32x4*>(&v); u32x4 o;
    o.x = cvt_pk_bf16(bflo(w.x) * s, bfhi(w.x) * s); o.y = cvt_pk_bf16(bflo(w.y) * s, bfhi(w.y) * s); o.z = cvt_pk_bf16(bflo(w.z) * s, bfhi(w.z) * s); o.w = cvt_pk_bf16(bflo(w.w) * s, bfhi(w.w) * s);
    return *reinterpret_cast<const bf16x8*>(&o);
}
__device__ __forceinline__ f32x16 mm_block_rowscaled(const LAS bf16_t* A, int ra, float rowscale, const LAS bf16_t* B, int rb, int r32, int hi, f32x16 acc) {
#pragma unroll
    for (int s = 0; s < 8; ++s) { const bf16x8 a = scale8(*(const LAS bf16x8*)(A + (ra + r32) * TS + 16 * s + 8 * hi), rowscale), b = *(const LAS bf16x8*)(B + (rb + r32) * TS + 16 * s + 8 * hi);
        acc = __builtin_amdgcn_mfma_f32_32x32x16_bf16(a, b, acc, 0, 0, 0); }
    return acc;
}
__device__ __forceinline__ void ld4(const bf16_t* src, int ld, int tid, bf16x8 (&v)[4]) {
#pragma unroll
    for (int p = 0; p < 4; ++p) { const int idx = tid + 512 * p; v[p] = *reinterpret_cast<const bf16x8*>(src + (size_t)(idx >> 4) * ld + (idx & 15) * 8); }
}
__device__ __forceinline__ void st4_nat(LAS bf16_t* dst, int tid, const bf16x8 (&v)[4]) {
#pragma unroll
    for (int p = 0; p < 4; ++p) { const int idx = tid + 512 * p; *(LAS bf16x8*)(dst + (idx >> 4) * TS + (idx & 15) * 8) = v[p]; }
}
__device__ __forceinline__ void st4_tr(LAS bf16_t* dst, int tid, const bf16x8 (&v)[4], float e0, float e1) {
#pragma unroll
    for (int p = 0; p < 4; ++p) { const int idx = tid + 512 * p; const int m = idx >> 4, c0 = (idx & 15) * 8; const float sc = __builtin_amdgcn_exp2f(e0 + e1 * (float)m);
#pragma unroll
        for (int i = 0; i < 8; ++i) dst[(c0 + i) * TS + m] = f2bf(bf2f((bf16_t)v[p][i]) * sc); }
}

__device__ __forceinline__ void st4_vst(LAS bf16_t* dst, int tid, const bf16x8 (&v)[4]) {
#pragma unroll
    for (int p = 0; p < 4; ++p) { const int idx = tid + 512 * p; const int m = idx >> 4, c0 = (idx & 15) * 8; *(LAS bf16x8*)((LAS char*)dst + (m >> 6) * 16384 + att::v_st(m & 63, c0)) = v[p]; }
}
__device__ __forceinline__ void st4_vst_scaled(LAS bf16_t* dst, int tid, const bf16x8 (&v)[4], float e0, float e1) {
#pragma unroll
    for (int p = 0; p < 4; ++p) { const int idx = tid + 512 * p; const int m = idx >> 4, c0 = (idx & 15) * 8; *(LAS bf16x8*)((LAS char*)dst + (m >> 6) * 16384 + att::v_st(m & 63, c0)) = scale8(v[p], __builtin_amdgcn_exp2f(e0 + e1 * (float)m)); }
}
template <int KS> __device__ __forceinline__ bf16x8 trfrag(int base) {
    const s16x4 lo = att::vtr(base + (KS >> 2) * 16384 + att::v_rd_off(0, KS & 3, 0)), hi = att::vtr(base + (KS >> 2) * 16384 + att::v_rd_off(0, KS & 3, 1));
    return (bf16x8){lo[0], lo[1], lo[2], lo[3], hi[0], hi[1], hi[2], hi[3]};
}
__device__ __forceinline__ f32x16 mm_block_trB(const LAS bf16_t* A, int ra, int tb, int r32, int hi, f32x16 acc) {
#define RET_STEP(KS) acc = __builtin_amdgcn_mfma_f32_32x32x16_bf16(*(const LAS bf16x8*)(A + (ra + r32) * TS + 16 * KS + 8 * hi), trfrag<KS>(tb), acc, 0, 0, 0)
    RET_STEP(0); RET_STEP(1); RET_STEP(2); RET_STEP(3); RET_STEP(4); RET_STEP(5); RET_STEP(6); RET_STEP(7);
#undef RET_STEP
    return acc;
}

__device__ __forceinline__ void c1_unit(const Ctx& F, int li, int bh, int c) {
    const int b = bh >> 2, h = bh & 3, tid = F.tid, wid = F.wave, r32 = F.lane & 31, hi = F.lane >> 5;
    LAS bf16_t* TVt = (LAS bf16_t*)F.lds; LAS bf16_t* KF = TVt + 16384; LAS bf16_t* KB = KF + 16384;
    const float lf = log2_gamma(F.in(I_RDF)[li * 4 + h]), lb = log2_gamma(F.in(I_RDB)[li * 4 + h]);
    const bf16_t* base = F.P() + (size_t)chunk_row0(b, c) * INW + h * HD;
    bf16x8 kv[4], vv[4]; ld4(base + C_CK, INW, tid, kv); ld4(base + C_CV, INW, tid, vv);
    __syncthreads();
    st4_vst(TVt, tid, vv); st4_vst_scaled(KF, tid, kv, 127.f * lf, -lf); st4_vst_scaled(KB, tid, kv, 0.f, lb);
    __syncthreads();
    const int dvb = wid >> 1, dk0 = 2 * (wid & 1); const int l0 = (int)(uintptr_t)F.lds + att::v_rd_base(F.lane);
    const int av = l0 + dvb * 512, bf0 = l0 + 32768 + dk0 * 512, bb0 = l0 + 65536 + dk0 * 512;
    f32x16 f0 = {}, f1 = {}, g0 = {}, g1 = {};
#define C1_STEP(KS) do { const bf16x8 a_ = trfrag<KS>(av); f0 = __builtin_amdgcn_mfma_f32_32x32x16_bf16(a_, trfrag<KS>(bf0), f0, 0, 0, 0); f1 = __builtin_amdgcn_mfma_f32_32x32x16_bf16(a_, trfrag<KS>(bf0 + 512), f1, 0, 0, 0); \
        g0 = __builtin_amdgcn_mfma_f32_32x32x16_bf16(a_, trfrag<KS>(bb0), g0, 0, 0, 0); g1 = __builtin_amdgcn_mfma_f32_32x32x16_bf16(a_, trfrag<KS>(bb0 + 512), g1, 0, 0, 0); } while (0)
    C1_STEP(0); C1_STEP(1); C1_STEP(2); C1_STEP(3); C1_STEP(4); C1_STEP(5); C1_STEP(6); C1_STEP(7);
#undef C1_STEP
    bf16_t* Uf = F.U() + ((size_t)(0 * 8 + bh) * NCH + c) * 16384; bf16_t* Ub = F.U() + ((size_t)(1 * 8 + bh) * NCH + c) * 16384;
#pragma unroll
    for (int r = 0; r < 16; ++r) { const int o_ = (dvb * 32 + crow(r, hi)) * 128 + dk0 * 32 + r32; Uf[o_] = f2bf(f0[r]); Uf[o_ + 32] = f2bf(f1[r]); Ub[o_] = f2bf(g0[r]); Ub[o_ + 32] = f2bf(g1[r]); }
}
__device__ __forceinline__ void c2_scan(const Ctx& F, int li) {
    for (int gid = F.wg * 512 + F.tid; gid < 2 * 8 * 8192; gid += F.G * 512) {
        const int dir = gid >> 16, bh = (gid >> 13) & 7, el = (gid & 8191) * 2, h = bh & 3;
        const float lg = log2_gamma((dir ? F.in(I_RDB) : F.in(I_RDF))[li * 4 + h]); const float cd = __builtin_amdgcn_exp2f(128.f * lg);
        const unsigned* U = (const unsigned*)(F.U() + (size_t)(dir * 8 + bh) * NCH * 16384 + el); unsigned* S = (unsigned*)(F.S() + (size_t)(dir * 8 + bh) * NCH * 16384 + el);
        float s0 = 0.f, s1 = 0.f;
        if (dir == 0) {
#pragma unroll 16
            for (int c = 0; c < NCH; ++c) { const unsigned u = U[(size_t)c * 8192]; S[(size_t)c * 8192] = cvt_pk_bf16(s0, s1); s0 = cd * s0 + bflo(u); s1 = cd * s1 + bfhi(u); }
        } else {
            { const unsigned u1 = U[(size_t)1 * 8192], u0 = U[0]; S[(size_t)1 * 8192] = 0u; s0 = bflo(u1); s1 = bfhi(u1); S[0] = cvt_pk_bf16(s0, s1); s0 = cd * s0 + bflo(u0); s1 = cd * s1 + bfhi(u0); }
#pragma unroll 16
            for (int c = NCH - 1; c >= 2; --c) { const unsigned u = U[(size_t)c * 8192]; S[(size_t)c * 8192] = cvt_pk_bf16(s0, s1); s0 = cd * s0 + bflo(u); s1 = cd * s1 + bfhi(u); }
        }
    }
}
__device__ __forceinline__ void c3_unit(const Ctx& F, int li, int bh, int c) {
    int tid_ = F.tid, lane_ = F.lane; asm volatile("" : "+v"(tid_), "+v"(lane_));
    const int b = bh >> 2, h = bh & 3, tid = tid_, wid = F.wave, lane = lane_, r32 = lane & 31, hi = lane >> 5;
    LAS bf16_t* TQ = (LAS bf16_t*)F.lds; LAS bf16_t* TK = TQ + 128 * TS; LAS bf16_t* TV = TK + 128 * TS; LAS bf16_t* TP = TV + 128 * TS; LAS float* ST = (LAS float*)(TP + 128 * TS);
    const float lf = log2_gamma(F.in(I_RDF)[li * 4 + h]), lb = log2_gamma(F.in(I_RDB)[li * 4 + h]);
    const int row0 = chunk_row0(b, c);
    const bf16_t* base = F.P() + (size_t)row0 * INW + h * HD;
    bf16x8 qv[4], kv[4], vv[4], sf[4], sb[4], gv[4];
    ld4(base + C_CQ, INW, tid, qv); ld4(base + C_CK, INW, tid, kv); ld4(base + C_CV, INW, tid, vv);
    ld4(F.S() + ((size_t)(0 * 8 + bh) * NCH + c) * 16384, 128, tid, sf);
    __syncthreads();
    st4_nat(TQ, tid, qv); st4_nat(TK, tid, kv); st4_vst(TV, tid, vv);
    __syncthreads();
    const int rb = wid >> 1, cb0 = 2 * (wid & 1);
    {
        f32x16 s0 = {}, s1 = {}; s0 = mm_block(TQ, rb * 32, TK, cb0 * 32, r32, hi, s0); s1 = mm_block(TQ, rb * 32, TK, (cb0 + 1) * 32, r32, hi, s1);
#pragma unroll
        for (int r = 0; r < 16; ++r) { const int n = rb * 32 + crow(r, hi);
#pragma unroll
            for (int i = 0; i < 2; ++i) { const int m = (cb0 + i) * 32 + r32; const int d = n - m; float w = __builtin_amdgcn_exp2f((float)d * (d > 0 ? lf : -lb)); w = (d == 0) ? 2.0f : w;
                TP[n * TS + m] = f2bf((i ? s1[r] : s0[r]) * w); } }
    }
    __syncthreads();
    st4_nat(TK, tid, sf);
    asm volatile("" ::: "memory");
    ld4(F.S() + ((size_t)(1 * 8 + bh) * NCH + c) * 16384, 128, tid, sb);
    ld4(base + C_CG, INW, tid, gv);
    __syncthreads();
    const int nrow = rb * 32 + r32;
    f32x16 o0 = {}, o1 = {};
    { const int tvb = (int)(uintptr_t)F.lds + 2 * TILE_B + att::v_rd_base(lane) + cb0 * 512;
      o0 = mm_block_trB(TP, rb * 32, tvb, r32, hi, o0); o1 = mm_block_trB(TP, rb * 32, tvb + 512, r32, hi, o1); }
    { const float qs = __builtin_amdgcn_exp2f((float)(nrow + 1) * lf);
      o0 = mm_block_rowscaled(TQ, rb * 32, qs, TK, cb0 * 32, r32, hi, o0); o1 = mm_block_rowscaled(TQ, rb * 32, qs, TK, (cb0 + 1) * 32, r32, hi, o1); }
    __syncthreads();
    st4_nat(TK, tid, sb);
    __syncthreads();
    { const float qs = __builtin_amdgcn_exp2f((float)(128 - nrow) * lb);
      o0 = mm_block_rowscaled(TQ, rb * 32, qs, TK, cb0 * 32, r32, hi, o0); o1 = mm_block_rowscaled(TQ, rb * 32, qs, TK, (cb0 + 1) * 32, r32, hi, o1); }
#pragma unroll
    for (int r = 0; r < 16; ++r) { float s1 = o0[r] + o1[r], s2 = o0[r] * o0[r] + o1[r] * o1[r];
        s1 = sum32(s1); s2 = sum32(s2);
        if (r32 == 0) { ST[(rb * 32 + crow(r, hi)) * 4 + (wid & 1) * 2] = s1; ST[(rb * 32 + crow(r, hi)) * 4 + (wid & 1) * 2 + 1] = s2; } }
    __syncthreads();
    st4_nat(TQ, tid, gv);
    __syncthreads();
    const float* gg = F.in(I_GNG) + li * 512 + h * HD; const float* gb = F.in(I_GNB) + li * 512 + h * HD;
    float g0 = gg[cb0 * 32 + r32], g1 = gg[(cb0 + 1) * 32 + r32], b0 = gb[cb0 * 32 + r32], b1 = gb[(cb0 + 1) * 32 + r32];
#pragma unroll
    for (int r = 0; r < 16; ++r) { const int n = rb * 32 + crow(r, hi); const f32x4 st = *(const LAS f32x4*)(ST + n * 4);
        const float mean = (st[0] + st[2]) * (1.0f / 128.0f), var = (st[1] + st[3]) * (1.0f / 128.0f) - mean * mean, rstd = rsqrtf(var + 1e-5f);
        bf16_t* op = F.O() + (size_t)(row0 + n) * DM + 1024 + h * HD;
        const float gt0 = bf2f(TQ[n * TS + cb0 * 32 + r32]), gt1 = bf2f(TQ[n * TS + (cb0 + 1) * 32 + r32]);
        op[cb0 * 32 + r32] = f2bf(siluf(gt0) * ((o0[r] - mean) * rstd * g0 + b0)); op[(cb0 + 1) * 32 + r32] = f2bf(siluf(gt1) * ((o1[r] - mean) * rstd * g1 + b1)); }
}
}
__device__ __forceinline__ int clampi(int x, int lo, int hi) { return x < lo ? lo : (x > hi ? hi : x); }
__device__ __forceinline__ void unitA(const Ctx& F, int li, int idx) {
    const bool ctxq = idx >= 512; const int bh = ctxq ? idx - 512 : (idx & 7), qb = ctxq ? 0 : (idx >> 3), b = bh >> 2, h = bh & 3;
    LAS float* biasL = (LAS float*)(F.lds + att::BIAS_OFF);
    __syncthreads();
    { const float* rp = F.in(I_RPB) + (size_t)(li * 4 + h) * 15 * 31; for (int i = F.tid; i < 15 * 31; i += 512) biasL[i] = rp[i] * LOG2E; }
    att::Tiles T; att::MP mp{};
    const bf16_t* ctxrow = F.P() + (size_t)(NLAT + b * LCTX) * INW; const bf16_t* latrow = F.P() + (size_t)(b * SEQ) * INW;
    T.kctx = ctxrow + C_AK + h * HD; T.klat = latrow + C_AK + h * HD; T.vdelta = C_AV - C_AK; T.nctx = 4;
    const int r32 = F.lane & 31;
    const int qr0 = qb * 4; const int lo = clampi(qr0 - 4, 0, 248), hi_ = clampi(qr0 - 1, 0, 248) + 7;
    T.lat0 = lo; T.nt = ctxq ? 4 : 4 + (hi_ - lo + 1);
    const size_t qrow = ctxq ? (size_t)(NLAT + b * LCTX) : (size_t)(b * SEQ + qb * 256);
    int tidA_ = F.tid; asm volatile("" : "+v"(tidA_));
    att::attn_unit_a2(F.P() + qrow * INW + C_AQ + h * HD, T, F.O() + qrow * DM + h * HD, !ctxq, (const LAS float*)(F.lds + att::BIAS_OFF), qr0, F.ldsg, tidA_);
}
__device__ __forceinline__ void unitD(const Ctx& F, int li, int idx) {
    const bool ctxq = idx >= 512; const int bh = ctxq ? idx - 512 : (idx & 7), qb = ctxq ? 0 : (idx >> 3), b = bh >> 2, h = bh & 3, kv = h >> 1;
    att::Tiles T; att::MP mp{};
    const bf16_t* ctxrow = F.P() + (size_t)(NLAT + b * LCTX) * INW; const bf16_t* latrow = F.P() + (size_t)(b * SEQ) * INW;
    T.kctx = ctxrow + C_DK + kv * HD; T.klat = latrow + C_DK + kv * HD; T.vdelta = C_DV - C_DK; T.nctx = 4;
    mp.sink_l2 = F.in(I_SINK)[li * 4 + h] * LOG2E;
    const int lo = qb * 4 - 2 < 0 ? 0 : qb * 4 - 2, hi_ = qb * 4 + 5 > 255 ? 255 : qb * 4 + 5;
    T.lat0 = lo; T.nt = ctxq ? 4 : 4 + (hi_ - lo + 1); mp.masked = !ctxq; mp.tq = qb * 256 + F.wave * 32 + (F.lane & 31);
    const size_t qrow = ctxq ? (size_t)(NLAT + b * LCTX) : (size_t)(b * SEQ + qb * 256);
    int tidD_ = F.tid; asm volatile("" : "+v"(tidD_));
    att::attn_unit_simple<2>(F.P() + qrow * INW + C_DQ + h * HD, T, F.O() + qrow * DM + 1536 + h * HD, mp, F.ldsg, tidD_);
}
__device__ __forceinline__ void unitB(const Ctx& F, int li, int idx) {
    const bool ctxq = idx >= 1024; const int j = ctxq ? idx - 1024 : idx; const int bh = j & 7, qb = j >> 3, b = bh >> 2, h = bh & 3;
    att::TilesB3 T; att::MP mp{};
    const bf16_t* ctxrow = F.P() + (size_t)(NLAT + b * LCTX) * INW; const bf16_t* latrow = F.P() + (size_t)(b * SEQ) * INW;
    T.kctx = ctxrow + C_BK + h * HD; T.klat = latrow + C_BK + h * HD; T.vdelta = C_BV - C_BK; T.nt = ctxq ? 4 : 4 + SEQ / 64;
    mp.lam = F.misc()[li * 2]; mp.post = 1.0f - F.misc()[li * 2 + 1]; mp.normg = F.in(I_DNG) + li * HD;
    const size_t qrow = (ctxq ? (size_t)(NLAT + b * LCTX) : (size_t)(b * SEQ)) + (size_t)qb * 128;
    att::attn_unit_b3(F.P() + qrow * INW + C_BQ + h * HD, T, F.O() + qrow * DM + 512 + h * HD, mp, (const unsigned*)(F.ws() + WS_CTL + CTL_KMAX) + li * 16 + b * 8 + h * 2, F.ldsg, F.tid);
}

#define DYN_UNITS(ctr_, n_, slot_, BODY) do { unsigned nx_ = 0u; if (F.tid == 0) nx_ = __hip_atomic_fetch_add((ctr_), 1u, __ATOMIC_RELAXED, __HIP_MEMORY_SCOPE_AGENT); \
    for (;;) { __syncthreads(); if (F.tid == 0) (slot_)[0] = nx_; __syncthreads(); const int idx = (int)__builtin_amdgcn_readfirstlane((slot_)[0]); if (idx >= (n_)) break; \
        if (F.tid == 0) nx_ = __hip_atomic_fetch_add((ctr_), 1u, __ATOMIC_RELAXED, __HIP_MEMORY_SCOPE_AGENT); BODY } } while (0)
#define DYN_UNITS_X(ctr_, nper_, slot_, BODY) do { const unsigned x0_ = xb_xcc_id() & 7u; unsigned left_ = 0xFFu; \
    for (unsigned r_ = 0; r_ < 8u; ++r_) { const unsigned x_ = (x0_ + r_) & 7u; \
        if (r_ == 1u) { __syncthreads(); if (F.tid < 8) { const unsigned c_ = __hip_atomic_load((ctr_) + F.tid * 8, __ATOMIC_RELAXED, __HIP_MEMORY_SCOPE_AGENT); if (c_ >= (unsigned)(nper_)) atomicAnd((unsigned*)&(slot_)[2], ~(1u << F.tid)); } \
            __syncthreads(); left_ = __builtin_amdgcn_readfirstlane((slot_)[2]); } \
        if (r_ >= 1u && !((left_ >> x_) & 1u)) continue; \
        unsigned* cx_ = (ctr_) + x_ * 8; unsigned nx_ = 0u; if (F.tid == 0) nx_ = __hip_atomic_fetch_add(cx_, 1u, __ATOMIC_RELAXED, __HIP_MEMORY_SCOPE_AGENT); \
        for (;;) { __syncthreads(); if (F.tid == 0) (slot_)[0] = nx_; __syncthreads(); const int j_ = (int)__builtin_amdgcn_readfirstlane((slot_)[0]); if (j_ >= (nper_)) break; \
            if (F.tid == 0) nx_ = __hip_atomic_fetch_add(cx_, 1u, __ATOMIC_RELAXED, __HIP_MEMORY_SCOPE_AGENT); const int idx = j_ * 8 + (int)x_; BODY } } } while (0)
constexpr size_t CTL_DYN = 32768;
constexpr int LDS_SCRATCH = 147456, LDS_BYTES = LDS_SCRATCH + 256, IDXL_OFF = 131072;
constexpr int N_PHASES = 23;
__global__ void __launch_bounds__(512, 2) fwd_kernel(Args a) {
    extern __shared__ __attribute__((aligned(16))) unsigned char lds_raw[];
    volatile LAS unsigned* misc = (volatile LAS unsigned*)((LAS unsigned char*)lds_raw + LDS_SCRATCH);
    const int wave_s = __builtin_amdgcn_readfirstlane(threadIdx.x >> 6);
    if (wave_s == 0) { const int l0 = hw_lane(); if (l0 < 4) misc[l0] = 0u; }
    __syncthreads();
    const int lo = a.ph_lo, hi = a.ph_hi;
#ifdef DIAG_BARWAIT
    unsigned barwait_ = 0u;
#endif
    const bool use_bar = (hi - lo) > 1;
    XcdBarrier bar; bar.bar = (unsigned*)(a.ws + WS_CTL); bar.x = 0; bar.st = misc;
    if (use_bar) bar = xcd_barrier_post((unsigned*)(a.ws + WS_CTL), misc, wave_s == 0 && hw_lane() == 0);
#define FCTX const Ctx F = make_ctx(lds_raw, wave_s)
#ifndef PHMASK
#define PHMASK 0xFFFFFFFFu
#endif
#define EN(j) (((PHMASK) >> (j)) & 1u)
#ifndef REPMASK
#define REPMASK 0u
#endif
#define NREP(j) ((((REPMASK) >> (j)) & 1u) ? 2 : 1)
#define IN(k) (lo <= (k) && (k) < hi)
#ifdef EXP_BAR2
#define SEAM(k) do { if (IN(k) && IN((k) + 1)) { xcd_barrier(bar, wave_s == 0 && hw_lane() == 0); xcd_barrier(bar, wave_s == 0 && hw_lane() == 0); } } while (0)
#else
#ifdef DIAG_BARWAIT
#define SEAM(k) do { if (IN(k) && IN((k) + 1)) { const unsigned long long w0_ = wall_clock64(); xcd_barrier(bar, wave_s == 0 && hw_lane() == 0); if ((DIAG_SEAMS >> (k)) & 1u) barwait_ += (unsigned)(wall_clock64() - w0_); } } while (0)
#else
#define SEAM(k) do { if (IN(k) && IN((k) + 1)) xcd_barrier(bar, wave_s == 0 && hw_lane() == 0); } while (0)
#endif
#endif
    for (int rep_ = 0; rep_ < NREP(0); ++rep_) if (EN(0) && IN(0)) { FCTX; ph_mod_partial(F); } SEAM(0);
    for (int rep_ = 0; rep_ < NREP(1); ++rep_) if (EN(1) && IN(1)) { FCTX; ph_mod_reduce(F); ph_convert(F); } SEAM(1);
    const int F_G = gridDim.x;
    for (int li = 0; li < DEPTH; ++li) {
        const int pb = 2 + li * 10;
        for (int rep_ = 0; rep_ < (li == 0 ? NREP(2) : 1); ++rep_) if (EN(2) && IN(pb + 0)) { FCTX; ph_norm1(F, li); } SEAM(pb + 0);
        const bool split_in = use_bar && EN(3) && EN(4) && IN(pb + 1) && IN(pb + 2) && F_G >= 96;
        for (int rep_ = 0; rep_ < NREP(3); ++rep_) if (EN(3) && IN(pb + 1)) {
            if (split_in) {
                { FCTX; pg8::Gemm g{F.H(), F.w_in_t(li), DM, nullptr}; pg8::EpiInProj E{F.P(), F.rope(), (unsigned*)(F.ws() + WS_CTL + CTL_KMAX) + li * 16};
                  pg8::StaticOrder S; S.init(NLAT / 256, INW / 256, F.G, F.wg); pg8::gemm_phase<pg8::EpiInProj, pg8::StaticOrder, false>(F.lds, g, S, E, nullptr, F.tid); }
                xcd_barrier(bar, wave_s == 0 && hw_lane() == 0);
                if (blockIdx.x < 48) { FCTX; pg8::Gemm g{F.H(), F.w_in_t(li), DM, nullptr}; pg8::EpiInProj E{F.P(), F.rope(), (unsigned*)(F.ws() + WS_CTL + CTL_KMAX) + li * 16};
                  pg8::OffsetOrder S; S.init(NCTX / 256, INW / 256, 48, F.wg); S.pm0 = NLAT / 256; pg8::gemm_phase<pg8::EpiInProj, pg8::OffsetOrder, false>(F.lds, g, S, E, nullptr, F.tid); }
                else { FCTX; for (int idx = F.wg - 48; idx < 8 * (NCH - 2); idx += F.G - 48) ret::c1_unit(F, li, idx & 7, 2 + (idx >> 3)); }
            } else {
                FCTX; pg8::Gemm g{F.H(), F.w_in_t(li), DM, nullptr}; pg8::EpiInProj E{F.P(), F.rope(), (unsigned*)(F.ws() + WS_CTL + CTL_KMAX) + li * 16};
                pg8::StaticOrder S; S.init(MTOT / 256, INW / 256, F.G, F.wg);
#ifdef EXP_NOEPI_REP
                if (rep_ == 1) pg8::gemm_phase<pg8::EpiInProj, pg8::StaticOrder, false, true>(F.lds, g, S, E, nullptr, F.tid); else
#endif
                pg8::gemm_phase<pg8::EpiInProj, pg8::StaticOrder, false>(F.lds, g, S, E, nullptr, F.tid);
            }
        } SEAM(pb + 1);
        for (int rep_ = 0; rep_ < NREP(4); ++rep_) if (EN(4) && IN(pb + 2)) {
            FCTX;
            for (int r2_ = 0; r2_ < NREP(15); ++r2_) if (EN(15)) { if (split_in) { for (int idx = (F.wg + F.G - 120) % F.G; idx < 16; idx += F.G) ret::c1_unit(F, li, idx & 7, idx >> 3); }   else { for (int idx = F.wg; idx < 8 * NCH; idx += F.G) ret::c1_unit(F, li, idx & 7, idx >> 3); } }
            const int nAD = (li == 0) ? 520 : 512;
            if (!(split_in && EN(13) && EN(14) && EN(16) && EN(17) && IN(pb + 4))) {
            for (int r2_ = 0; r2_ < NREP(13); ++r2_) if (EN(13)) for (int idx = (F.wg + 8) % F.G; idx < nAD; idx += F.G) unitA(F, li, idx);
            for (int r2_ = 0; r2_ < NREP(14); ++r2_) if (EN(14)) for (int idx = F.wg; idx < nAD; idx += F.G) unitD(F, li, idx); }
        } SEAM(pb + 2);
        for (int rep_ = 0; rep_ < NREP(5); ++rep_) if (EN(5) && IN(pb + 3)) { FCTX; ret::c2_scan(F, li); } SEAM(pb + 3);
        for (int rep_ = 0; rep_ < NREP(6); ++rep_) if (EN(6) && IN(pb + 4)) {
            FCTX; const int nB = (li == 0) ? 1040 : 1024;
            if (EN(16)) for (int idx = F.wg; idx < nB; idx += F.G) unitB(F, li, idx);
            if (split_in && EN(13) && EN(14) && EN(16) && EN(17) && IN(pb + 2)) {
                unsigned* ctr = (unsigned*)(F.ws() + WS_CTL + CTL_DYN) + (li * 4 + 0) * 64; volatile LAS unsigned* slot = misc + 8; const int nAD = (li == 0) ? 520 : 512;
                __syncthreads(); if (F.tid == 0) slot[2] = 0xFFu; DYN_UNITS_X(ctr, nAD / 8, slot, { unitA(F, li, idx); });
                __syncthreads(); if (F.tid == 0) slot[2] = 0xFFu; DYN_UNITS_X(ctr + 128, nAD / 8, slot, { unitD(F, li, idx); }); }
            if (EN(17)) { if (use_bar) { unsigned* ctr = (unsigned*)(F.ws() + WS_CTL + CTL_DYN) + (li * 4 + 1) * 64; volatile LAS unsigned* slot = misc + 8;
                    DYN_UNITS(ctr, nB, slot, { if (idx < 1024) ret::c3_unit(F, li, idx & 7, 2 + (idx >> 3)); else ret::c3_unit(F, li, (idx - 1024) & 7, (idx - 1024) >> 3); }); }
                else for (int idx = F.wg; idx < nB; idx += F.G) { if (idx < 1024) ret::c3_unit(F, li, idx & 7, 2 + (idx >> 3)); else ret::c3_unit(F, li, (idx - 1024) & 7, (idx - 1024) >> 3); } }
        } SEAM(pb + 4);
        const bool split_out = use_bar && li == 0 && EN(7) && EN(8) && IN(pb + 5) && IN(pb + 6) && F_G >= 64;
        for (int rep_ = 0; rep_ < (li == 0 ? NREP(7) : 1); ++rep_) if (EN(7) && IN(pb + 5)) {
            FCTX; pg8::Gemm g{F.O(), F.w_out_t(li), DM, nullptr};
            pg8::EpiOutProj E{li == 0 ? F.in(I_X) : nullptr, F.xb(), F.xb(), F.in(I_CTX), F.xc(), F.mod() + (size_t)li * 3 * 12288};
            pg8::StaticOrder S; S.init((li == 0 && !split_out) ? MTOT / 256 : NLAT / 256, DM / 256, F.G, F.wg);
            pg8::gemm_phase<pg8::EpiOutProj, pg8::StaticOrder, false>(F.lds, g, S, E, nullptr, F.tid);
        } SEAM(pb + 5);
        for (int rep_ = 0; rep_ < NREP(8); ++rep_) if (EN(8) && IN(pb + 6)) {
            if (split_out) {
                if (blockIdx.x < 16) { FCTX; pg8::Gemm g{F.O(), F.w_out_t(li), DM, nullptr}; pg8::EpiOutProj E{F.in(I_X), F.xb(), F.xb(), F.in(I_CTX), F.xc(), F.mod() + (size_t)li * 3 * 12288};
                    pg8::OffsetOrder S; S.init(NCTX / 256, DM / 256, 16, F.wg); S.pm0 = NLAT / 256; pg8::gemm_phase<pg8::EpiOutProj, pg8::OffsetOrder, false>(F.lds, g, S, E, nullptr, F.tid); }
                else { FCTX; ph_norm2(F, li, 0, NLAT, 16, F.G - 16); }
                xcd_barrier(bar, wave_s == 0 && hw_lane() == 0);
                if (blockIdx.x < 16) { FCTX; ph_norm2(F, li, NLAT, MTOT, 0, 16); }
            } else { FCTX; ph_norm2(F, li, 0, NLAT, 0, F.G); if (li == 0) ph_norm2(F, li, NLAT, MTOT, 0, F.G); }
        } SEAM(pb + 6);
        for (int rep_ = 0; rep_ < NREP(9); ++rep_) if (EN(9) && IN(pb + 7)) { FCTX; ph_topk(F, li); } SEAM(pb + 7);
        for (int rep_ = 0; rep_ < NREP(10); ++rep_) if (EN(10) && IN(pb + 8)) {
            FCTX; pg8::Gemm g{F.H(), F.w_gu_t(li), DM, F.rowidx()}; pg8::MoeOrder S; S.init(li == 0 ? 272 : 256, 8, F.G, F.wg); pg8::EpiSwiGLU E{F.ACT()};
            pg8::gemm_phase<pg8::EpiSwiGLU, pg8::MoeOrder, true>(F.lds, g, S, E, (LAS int*)(F.lds + IDXL_OFF), F.tid);
        } SEAM(pb + 8);
        for (int rep_ = 0; rep_ < NREP(11); ++rep_) if (EN(11) && IN(pb + 9)) {
            FCTX; pg8::Gemm g{F.ACT(), F.w_dn_t(li), FF, nullptr}; pg8::MoeOrder S; S.init(li == 0 ? 272 : 256, 8, F.G, F.wg); pg8::EpiDown E{F.Y(), F.gatev()};
            pg8::gemm_phase<pg8::EpiDown, pg8::MoeOrder, false>(F.lds, g, S, E, nullptr, F.tid);
        } SEAM(pb + 9);
    }
    for (int rep_ = 0; rep_ < NREP(12); ++rep_) if (EN(12) && IN(22)) { FCTX; ph_final(F); }
#ifdef DIAG_BARWAIT
    if (blockIdx.x == DIAG_WG && wave_s == 0 && hw_lane() == 0 && barwait_ > (unsigned)DIAG_BARWAIT) a.out[(size_t)DIAG_WG * 3] += 1000.0f;
#endif
#undef IN
#undef SEAM
#undef FCTX
}

#ifndef N_LAUNCHES
#define N_LAUNCHES 1
#endif
extern "C" void kernel_launch(void* const* d_in, const int* in_sizes, int n_in, void* d_out, int out_size, void* d_ws, size_t ws_size, hipStream_t stream) {
    static int grid = 0;
    if (grid == 0) {
        if (n_in != 23 || out_size != NLAT * DM || ws_size < WS_END) { fprintf(stderr, "kernel_launch: unexpected shapes: n_in %d out %d ws %zu (need %zu)\n", n_in, out_size, ws_size, (size_t)WS_END); grid = -1; return; }
        int dev = 0, cus = 0, per_cu = 0;
        if (hipGetDevice(&dev) != hipSuccess || hipDeviceGetAttribute(&cus, hipDeviceAttributeMultiprocessorCount, dev) != hipSuccess) { grid = -1; return; }
        if (hipFuncSetAttribute((const void*)fwd_kernel, hipFuncAttributeMaxDynamicSharedMemorySize, LDS_BYTES) != hipSuccess) { fprintf(stderr, "kernel_launch: hipFuncSetAttribute failed\n"); grid = -1; return; }
        if (hipOccupancyMaxActiveBlocksPerMultiprocessor(&per_cu, (const void*)fwd_kernel, 512, LDS_BYTES) != hipSuccess || per_cu < 1) fprintf(stderr, "kernel_launch: occupancy query says %d\n", per_cu);
        (void)hipGetLastError();
        grid = cus;
    }
    if (grid < 0) return;
    hipMemsetAsync((char*)d_ws + WS_CTL, 0, CTL_BYTES, stream);
    Args a{};
    for (int i = 0; i < 23; ++i) a.in[i] = (const float*)d_in[i];
    a.out = (float*)d_out; a.ws = (unsigned char*)d_ws;
    for (int k = 0; k < N_LAUNCHES; ++k) {
        a.ph_lo = (N_LAUNCHES == 1) ? 0 : k; a.ph_hi = (N_LAUNCHES == 1) ? N_PHASES : k + 1;
        hipLaunchKernelGGL(fwd_kernel, dim3(grid), dim3(512), LDS_BYTES, stream, a);
    }
    const hipError_t le = hipPeekAtLastError();
    if (le != hipSuccess) fprintf(stderr, "kernel_launch: launch failed: %s\n", hipGetErrorName(le));
}
```
